# Optimizing an MI355X kernel written in HIP

```python
import math
import jax, jax.numpy as jnp
from jax import lax
import numpy as np

D_MODEL = 1024
BATCH = 2
SEQ = 8192
DEPTH = 4

GRID_W = 64
CTX_LEN = 256

N_ATTN_LAYERS = (DEPTH + 1) // 2
N_SSM_LAYERS = DEPTH // 2

ATTN_WIDTH = D_MODEL // 2
HEAD_DIM = 64
N_Q_HEADS = ATTN_WIDTH // HEAD_DIM
N_KV_HEADS = 2
Q_PER_KV = N_Q_HEADS // N_KV_HEADS
KV_WIDTH = N_KV_HEADS * HEAD_DIM
Q_BLOCK = 128
ROPE_THETA = 10000.0
GMLP_WIDTH = D_MODEL // 2
GMLP_CHUNK = 128
GMLP_GROUPS = 4
GMLP_GROUP_DIM = GMLP_WIDTH // GMLP_GROUPS
MIX_IN = ATTN_WIDTH + 2 * KV_WIDTH + 2 * GMLP_WIDTH
MIX_OUT = ATTN_WIDTH + GMLP_WIDTH
SSM_INNER = 2 * D_MODEL
SSM_HEAD_DIM = 64
SSM_HEADS = SSM_INNER // SSM_HEAD_DIM
SSM_GROUPS = 4
SSM_STATE = 128
SSM_CONV = 3
SSM_CHUNK = 128
SSM_BC_WIDTH = SSM_GROUPS * SSM_STATE
SSM_CONV_DIM = SSM_INNER + 2 * SSM_BC_WIDTH
SSM_IN = SSM_INNER + SSM_CONV_DIM + 2 * SSM_HEADS
FFN_HIDDEN = -(-8 * D_MODEL // (3 * 256)) * 256
NORM_EPS = 1e-6

kernel_name = "hybrid_dit_gmlp_gqa_ssd_block"


def rms_norm(x, g):
    xf = x.astype(jnp.float32)
    y = xf * lax.rsqrt(jnp.mean(xf * xf, axis=-1, keepdims=True) + NORM_EPS)
    return (y * g.astype(jnp.float32)).astype(x.dtype)


def adaln(cond, w, b):
    return jnp.split(jax.nn.silu(cond) @ w + b, 6, axis=-1)


def modulate(h, shift, scale):
    return h * (1 + scale) + shift


def axial_rope_tables(rows):
    t = jnp.arange(rows * GRID_W)
    row = (t // GRID_W).astype(jnp.float32)
    col = (t % GRID_W).astype(jnp.float32)
    n_freq = HEAD_DIM // 4
    inv = ROPE_THETA ** (-jnp.arange(n_freq, dtype=jnp.float32) / n_freq)
    ang = jnp.concatenate([row[:, None] * inv, col[:, None] * inv], axis=-1)
    return jnp.cos(ang), jnp.sin(ang)


def apply_rope(x, cos, sin):
    half = HEAD_DIM // 2
    x1 = x[..., :half].astype(jnp.float32)
    x2 = x[..., half:].astype(jnp.float32)
    cs = cos[None, :, None, :]
    sn = sin[None, :, None, :]
    return jnp.concatenate([x1 * cs - x2 * sn, x2 * cs + x1 * sn], axis=-1).astype(x.dtype)


def gqa_attend(q, k, v):
    s = jnp.einsum("bqkgd,btkd->bkgqt", q, k).astype(jnp.float32) * (HEAD_DIM ** -0.5)
    p = jax.nn.softmax(s, axis=-1).astype(v.dtype)
    return jnp.einsum("bkgqt,btkd->bqkgd", p, v)


def latent_attention(q, k, v, k_ctx, v_ctx):
    b, s = q.shape[:2]
    k_all = jnp.concatenate([k_ctx, k], axis=1)
    v_all = jnp.concatenate([v_ctx, v], axis=1)
    qb = q.reshape(b, s // Q_BLOCK, Q_BLOCK, N_KV_HEADS, Q_PER_KV, HEAD_DIM).transpose(1, 0, 2, 3, 4, 5)
    o = lax.map(lambda qi: gqa_attend(qi, k_all, v_all), qb)
    return o.transpose(1, 0, 2, 3, 4, 5).reshape(b, s, ATTN_WIDTH)


def spatial_gating(u, v, norm_g, w_s, b_s):
    b, l, _ = u.shape
    vn = rms_norm(v.reshape(b, l, GMLP_GROUPS, GMLP_GROUP_DIM), norm_g.reshape(GMLP_GROUPS, GMLP_GROUP_DIM))
    vc = vn.reshape(b, l // GMLP_CHUNK, GMLP_CHUNK, GMLP_GROUPS, GMLP_GROUP_DIM)
    s = jnp.einsum("gpq,bnqgc->bnpgc", w_s, vc) + b_s.T[None, None, :, :, None]
    return u * s.reshape(b, l, GMLP_WIDTH)


def attn_gmlp_mixer(hx, hc, w_in, w_out, q_g, k_g, sgu_g, sgu_w, sgu_b, cos, sin):
    def project(h):
        b, l = h.shape[:2]
        p = h @ w_in
        q, k, v, gm = jnp.split(p, [ATTN_WIDTH, ATTN_WIDTH + KV_WIDTH, ATTN_WIDTH + 2 * KV_WIDTH], axis=-1)
        q = rms_norm(q.reshape(b, l, N_Q_HEADS, HEAD_DIM), q_g)
        k = rms_norm(k.reshape(b, l, N_KV_HEADS, HEAD_DIM), k_g)
        v = v.reshape(b, l, N_KV_HEADS, HEAD_DIM)
        gu, gv = jnp.split(jax.nn.gelu(gm), 2, axis=-1)
        return q, k, v, gu, gv

    b, l = hx.shape[:2]
    lc = hc.shape[1]
    qx, kx, vx, ux, gx = project(hx)
    qc, kc, vc, uc, gc = project(hc)
    qx = apply_rope(qx, cos, sin)
    kx = apply_rope(kx, cos, sin)
    att_x = latent_attention(qx.reshape(b, l, N_KV_HEADS, Q_PER_KV, HEAD_DIM), kx, vx, kc, vc)
    att_c = gqa_attend(qc.reshape(b, lc, N_KV_HEADS, Q_PER_KV, HEAD_DIM), kc, vc).reshape(b, lc, ATTN_WIDTH)
    sg_x = spatial_gating(ux, gx, sgu_g, sgu_w, sgu_b)
    sg_c = spatial_gating(uc, gc, sgu_g, sgu_w, sgu_b)
    out_x = jnp.concatenate([att_x, sg_x], axis=-1) @ w_out
    out_c = jnp.concatenate([att_c, sg_c], axis=-1) @ w_out
    return out_x, out_c


def depthwise_conv(x, w, b):
    k = w.shape[0]
    y = lax.conv_general_dilated(x, w[:, None, :].astype(x.dtype), window_strides=(1,),
                                 padding=[((k - 1) // 2, k // 2)],
                                 dimension_numbers=("NWC", "WIO", "NWC"),
                                 feature_group_count=x.shape[-1])
    return y + b


def ssd_scan(x, dt, a, bm, cm, h0):
    b, l, h, p = x.shape
    g, n = bm.shape[2], bm.shape[3]
    r = h // g
    nc = l // SSM_CHUNK
    L = SSM_CHUNK
    xd = (x * dt[..., None]).reshape(b, nc, L, g, r, p)
    da = (dt * a).reshape(b, nc, L, g, r).transpose(0, 3, 4, 1, 2)
    bc = bm.reshape(b, nc, L, g, n)
    cc = cm.reshape(b, nc, L, g, n)
    a_cs = jnp.cumsum(da, axis=-1)
    lower = jnp.tril(jnp.ones((L, L), dtype=bool))
    seg = jnp.where(lower, a_cs[..., :, None] - a_cs[..., None, :], -jnp.inf)
    decay_in = jnp.exp(seg)
    cb = jnp.einsum("bclgn,bcsgn->bgcls", cc, bc)
    y_diag = jnp.einsum("bgcls,bgrcls,bcsgrp->bclgrp", cb, decay_in, xd)
    decay_to_end = jnp.exp(a_cs[..., -1:] - a_cs)
    chunk_states = jnp.einsum("bcsgn,bgrcs,bcsgrp->cbgrpn", bc, decay_to_end, xd)
    chunk_decay = jnp.exp(a_cs[..., -1]).transpose(3, 0, 1, 2)

    def step(state, inp):
        s_c, dec = inp
        return state * dec[..., None, None] + s_c, state

    h_final, h_start = lax.scan(step, h0.reshape(b, g, r, p, n), (chunk_states, chunk_decay))
    y_off = jnp.einsum("bclgn,cbgrpn,bgrcl->bclgrp", cc, h_start, jnp.exp(a_cs))
    y = (y_diag + y_off).reshape(b, l, h, p)
    return y, h_final.reshape(b, h, p, n)


def maybe_flip(t, rev):
    return jnp.flip(t, axis=1) if rev else t


def ssd_mixer(hx, hc, w_in, conv_w, conv_b, dt_bias, a_log, d_skip, norm_g, w_out):
    a = -jnp.exp(a_log.astype(jnp.float32))

    def prep(h):
        b, l = h.shape[:2]
        p = h @ w_in
        z, xbc, dt = jnp.split(p, [SSM_INNER, SSM_INNER + SSM_CONV_DIM], axis=-1)
        xbc = jax.nn.silu(depthwise_conv(xbc, conv_w, conv_b))
        xs, bm, cm = jnp.split(xbc, [SSM_INNER, SSM_INNER + SSM_BC_WIDTH], axis=-1)
        xs = xs.reshape(b, l, SSM_HEADS, SSM_HEAD_DIM).astype(jnp.float32)
        bm = bm.reshape(b, l, SSM_GROUPS, SSM_STATE).astype(jnp.float32)
        cm = cm.reshape(b, l, SSM_GROUPS, SSM_STATE).astype(jnp.float32)
        dt = jax.nn.softplus(dt.astype(jnp.float32).reshape(b, l, 2, SSM_HEADS) + dt_bias.astype(jnp.float32))
        return z, xs, bm, cm, dt

    zx, xx, bx, cx, dtx = prep(hx)
    zc, xc, bc, cc, dtc = prep(hc)
    b = hx.shape[0]
    d = d_skip.astype(jnp.float32)[:, None]
    y_x = d * xx
    y_c = d * xc
    for direction in range(2):
        rev = direction == 1
        h0 = jnp.zeros((b, SSM_HEADS, SSM_HEAD_DIM, SSM_STATE), jnp.float32)
        yc_d, hc_d = ssd_scan(maybe_flip(xc, rev), maybe_flip(dtc[:, :, direction], rev), a[direction],
                              maybe_flip(bc, rev), maybe_flip(cc, rev), h0)
        yx_d, _ = ssd_scan(maybe_flip(xx, rev), maybe_flip(dtx[:, :, direction], rev), a[direction],
                           maybe_flip(bx, rev), maybe_flip(cx, rev), hc_d)
        y_c = y_c + maybe_flip(yc_d, rev)
        y_x = y_x + maybe_flip(yx_d, rev)

    def finish(y, z):
        b_, l_ = z.shape[:2]
        y = y.reshape(b_, l_, SSM_INNER) * jax.nn.silu(z.astype(jnp.float32))
        y = rms_norm(y.reshape(b_, l_, SSM_GROUPS, SSM_INNER // SSM_GROUPS),
                     norm_g.reshape(SSM_GROUPS, SSM_INNER // SSM_GROUPS)).reshape(b_, l_, SSM_INNER)
        return y.astype(z.dtype) @ w_out

    return finish(y_x, zx), finish(y_c, zc)


def swiglu(h, w_in, w_out):
    g, u = jnp.split(h @ w_in, 2, axis=-1)
    return (jax.nn.silu(g) * u) @ w_out


def setup_inputs(seed: int = 0) -> dict:
    key = jax.random.key(seed)
    ks = jax.random.split(key, 28)
    f32 = jnp.float32

    def nrm(k, shape, fan_in):
        return jax.random.normal(k, shape, f32) * fan_in ** -0.5

    def gain(k, shape):
        return 1.0 + 0.05 * jax.random.normal(k, shape, f32)

    dt0 = jnp.exp(jax.random.uniform(ks[22], (N_SSM_LAYERS, 2, SSM_HEADS), f32, math.log(1e-3), math.log(1e-1)))
    return {
        "x": jax.random.normal(ks[0], (BATCH, SEQ, D_MODEL), f32),
        "c": jax.random.normal(ks[1], (BATCH, D_MODEL), f32),
        "ctx": jax.random.normal(ks[2], (BATCH, CTX_LEN, D_MODEL), f32),
        "c_ctx": jax.random.normal(ks[3], (D_MODEL,), f32),
        "ada_w": nrm(ks[4], (DEPTH, D_MODEL, 6 * D_MODEL), D_MODEL),
        "ada_b": 0.02 * jax.random.normal(ks[5], (DEPTH, 6 * D_MODEL), f32),
        "norm1_g": gain(ks[6], (DEPTH, D_MODEL)),
        "norm2_g": gain(ks[7], (DEPTH, D_MODEL)),
        "ffn_w_in": nrm(ks[8], (DEPTH, D_MODEL, 2 * FFN_HIDDEN), D_MODEL),
        "ffn_w_out": nrm(ks[9], (DEPTH, FFN_HIDDEN, D_MODEL), FFN_HIDDEN),
        "mix_w_in": nrm(ks[10], (N_ATTN_LAYERS, D_MODEL, MIX_IN), D_MODEL),
        "mix_w_out": nrm(ks[11], (N_ATTN_LAYERS, MIX_OUT, D_MODEL), MIX_OUT),
        "q_norm_g": gain(ks[12], (N_ATTN_LAYERS, HEAD_DIM)),
        "k_norm_g": gain(ks[13], (N_ATTN_LAYERS, HEAD_DIM)),
        "sgu_norm_g": gain(ks[14], (N_ATTN_LAYERS, GMLP_WIDTH)),
        "sgu_w": nrm(ks[15], (N_ATTN_LAYERS, GMLP_GROUPS, GMLP_CHUNK, GMLP_CHUNK), GMLP_CHUNK),
        "sgu_b": gain(ks[16], (N_ATTN_LAYERS, GMLP_GROUPS, GMLP_CHUNK)),
        "ssm_w_in": nrm(ks[17], (N_SSM_LAYERS, D_MODEL, SSM_IN), D_MODEL),
        "ssm_conv_w": nrm(ks[18], (N_SSM_LAYERS, SSM_CONV, SSM_CONV_DIM), SSM_CONV),
        "ssm_conv_b": 0.02 * jax.random.normal(ks[19], (N_SSM_LAYERS, SSM_CONV_DIM), f32),
        "ssm_dt_bias": dt0 + jnp.log(-jnp.expm1(-dt0)),
        "ssm_a_log": jnp.log(jax.random.uniform(ks[20], (N_SSM_LAYERS, 2, SSM_HEADS), f32, 1.0, 16.0)),
        "ssm_d": gain(ks[21], (N_SSM_LAYERS, SSM_HEADS)),
        "ssm_norm_g": gain(ks[23], (N_SSM_LAYERS, SSM_INNER)),
        "ssm_w_out": nrm(ks[24], (N_SSM_LAYERS, SSM_INNER, D_MODEL), SSM_INNER),
    }


def reference(x, c, ctx, c_ctx, ada_w, ada_b, norm1_g, norm2_g, ffn_w_in, ffn_w_out,
              mix_w_in, mix_w_out, q_norm_g, k_norm_g, sgu_norm_g, sgu_w, sgu_b,
              ssm_w_in, ssm_conv_w, ssm_conv_b, ssm_dt_bias, ssm_a_log, ssm_d, ssm_norm_g, ssm_w_out):
    rows = x.shape[1] // GRID_W
    cos, sin = axial_rope_tables(rows)
    h_ctx = ctx
    cond_x = c[:, None, :]
    cond_c = c_ctx[None, None, :]
    for i in range(DEPTH):
        last = i == DEPTH - 1
        mx = adaln(cond_x, ada_w[i], ada_b[i])
        mc = adaln(cond_c, ada_w[i], ada_b[i])
        hx = modulate(rms_norm(x, norm1_g[i]), mx[0], mx[1])
        hc = modulate(rms_norm(h_ctx, norm1_g[i]), mc[0], mc[1])
        j = i // 2
        if i % 2 == 0:
            ox, oc = attn_gmlp_mixer(hx, hc, mix_w_in[j], mix_w_out[j], q_norm_g[j], k_norm_g[j],
                                     sgu_norm_g[j], sgu_w[j], sgu_b[j], cos, sin)
        else:
            ox, oc = ssd_mixer(hx, hc, ssm_w_in[j], ssm_conv_w[j], ssm_conv_b[j], ssm_dt_bias[j],
                               ssm_a_log[j], ssm_d[j], ssm_norm_g[j], ssm_w_out[j])
        x = x + mx[2] * ox
        x = x + mx[5] * swiglu(modulate(rms_norm(x, norm2_g[i]), mx[3], mx[4]), ffn_w_in[i], ffn_w_out[i])
        if not last:
            h_ctx = h_ctx + mc[2] * oc
            h_ctx = h_ctx + mc[5] * swiglu(modulate(rms_norm(h_ctx, norm2_g[i]), mc[3], mc[4]), ffn_w_in[i], ffn_w_out[i])
    return x
```

```cpp
#include <hip/hip_runtime.h>
#include <hip/hip_cooperative_groups.h>
#include <cstdio>
#include <cstdint>
namespace cg = cooperative_groups;

typedef unsigned short bf16_t;
typedef short bf16x8 __attribute__((ext_vector_type(8)));
typedef short bf16x4 __attribute__((ext_vector_type(4)));
typedef float f32x4 __attribute__((ext_vector_type(4)));
typedef unsigned u32x4 __attribute__((ext_vector_type(4)));
typedef unsigned u32x2 __attribute__((ext_vector_type(2)));

constexpr int D = 1024, NB = 2, SEQ = 8192, CTX = 256;
constexpr int ML = NB * SEQ;
constexpr int MC = NB * CTX;
constexpr int MT = ML + MC;
constexpr int TALL = CTX + SEQ;
constexpr int FFH = 2816;
constexpr int MIXIN = 1792;
constexpr int SSMIN = 5184, SSMIN_PAD = 5248;
constexpr int SSI = 2048;
constexpr float EPS = 1e-6f;

constexpr size_t MB = 1024 * 1024;
constexpr size_t WS_MOD = 0;
constexpr size_t WS_ROPE = 1 * MB;
constexpr size_t WS_XCTX = 3 * MB;
constexpr size_t WS_SGW = 5 * MB + 512 * 1024;
constexpr size_t WS_WT = 8 * MB;
constexpr size_t WT_FFNIN = 0;
constexpr size_t WT_FFNOUT = WT_FFNIN + (size_t)5632 * 1024 * 2;
constexpr size_t WT_MIXIN = WT_FFNOUT + (size_t)1024 * 2816 * 2;
constexpr size_t WT_MIXOUT = WT_MIXIN + (size_t)SSMIN_PAD * 1024 * 2;
constexpr size_t WT_END = WT_MIXOUT + (size_t)1024 * 2048 * 2;
constexpr size_t WS_R0 = WS_WT + ((WT_END + MB - 1) / MB) * MB;
constexpr size_t SZ_XBC = (size_t)MT * 3072 * 2;
constexpr size_t SZ_HN = (size_t)MT * 1024 * 2;
constexpr size_t WS_XBC = WS_R0;
constexpr size_t WS_HN = WS_XBC + SZ_XBC;
constexpr size_t WS_YF = WS_XBC;
constexpr size_t WS_YB = WS_YF + (size_t)MT * 2048 * 2;
constexpr size_t WS_R1 = WS_HN + SZ_HN;
constexpr size_t WS_Z = WS_R1;
constexpr size_t WS_XT = WS_Z + (size_t)MT * 2048 * 2;
constexpr size_t WS_BN = WS_XT + (size_t)MT * 2048 * 2;
constexpr size_t WS_CN = WS_BN + (size_t)MT * 512 * 2;
constexpr size_t WS_BT = WS_CN + (size_t)MT * 512 * 2;
constexpr size_t WS_DT = WS_BT + (size_t)MT * 512 * 2;
constexpr size_t WS_END_ODD = WS_DT + (size_t)MT * 64 * 4;
constexpr size_t WS_Q = WS_R1;
constexpr size_t WS_K = WS_Q + (size_t)MT * 512 * 2;
constexpr size_t WS_VT = WS_K + (size_t)MT * 128 * 2;
constexpr size_t WS_U = WS_VT + (size_t)MT * 128 * 2;
constexpr size_t WS_GVT = WS_U + (size_t)MT * 512 * 2;
constexpr size_t WS_AS = WS_GVT + (size_t)MT * 512 * 2;
constexpr size_t WS_HID = WS_R1;
constexpr size_t WS_TOTAL = WS_END_ODD;
static_assert(WS_TOTAL < (size_t)400 * MB, "workspace too large");
static_assert(WS_AS + (size_t)MT * 1024 * 2 <= WS_END_ODD, "even buffers fit");
static_assert(WS_HID + (size_t)MT * FFH * 2 <= WS_END_ODD, "hid fits");

constexpr int LDS_BYTES = 73728;
constexpr int GST = 72;
constexpr int SST = 136;

struct Params {
    const float* x; const float* c; const float* ctx; const float* c_ctx;
    const float* ada_w; const float* ada_b; const float* norm1_g; const float* norm2_g;
    const float* ffn_w_in; const float* ffn_w_out; const float* mix_w_in; const float* mix_w_out;
    const float* q_norm_g; const float* k_norm_g; const float* sgu_norm_g; const float* sgu_w; const float* sgu_b;
    const float* ssm_w_in; const float* ssm_conv_w; const float* ssm_conv_b; const float* ssm_dt_bias;
    const float* ssm_a_log; const float* ssm_d; const float* ssm_norm_g; const float* ssm_w_out;
    float* out; unsigned char* ws;
};

__device__ __forceinline__ int tid_() { int t = threadIdx.x; asm volatile("" : "+v"(t)); return t; }
__device__ __forceinline__ bf16_t f2bf(float f) {
    unsigned u = __float_as_uint(f);
    u += 0x7fffu + ((u >> 16) & 1u);
    return (bf16_t)(u >> 16);
}
__device__ __forceinline__ float bf2f(bf16_t h) { return __uint_as_float(((unsigned)h) << 16); }
__device__ __forceinline__ unsigned pack2(float a, float b) { return (unsigned)f2bf(a) | ((unsigned)f2bf(b) << 16); }
__device__ __forceinline__ float siluf(float v) { return v / (1.f + __expf(-v)); }
__device__ __forceinline__ float geluf(float v) {
    const float u = 0.7978845608028654f * (v + 0.044715f * v * v * v);
    return v / (1.f + __expf(-2.f * u));
}
__device__ __forceinline__ float softplusf(float v) { return v > 20.f ? v : log1pf(expf(v)); }
__device__ __forceinline__ int seg_of(int row) { return row < SEQ ? 0 : (row < ML ? 1 : 2); }
__device__ __forceinline__ float* xrow(const Params& p, int row) {
    return row < ML ? p.out + (size_t)row * D : (float*)(p.ws + WS_XCTX) + (size_t)(row - ML) * D;
}
__device__ __forceinline__ f32x4 mfma16(bf16x8 a, bf16x8 b, f32x4 c) { return __builtin_amdgcn_mfma_f32_16x16x32_bf16(a, b, c, 0, 0, 0); }
__device__ __forceinline__ bf16x8 lds16(const bf16_t* p) { return *(const bf16x8*)p; }
__device__ __forceinline__ bf16x8 lds8x2(const bf16_t* p0, const bf16_t* p1) {
    const bf16x4 a = *(const bf16x4*)p0, b = *(const bf16x4*)p1;
    bf16x8 r; r[0] = a[0]; r[1] = a[1]; r[2] = a[2]; r[3] = a[3]; r[4] = b[0]; r[5] = b[1]; r[6] = b[2]; r[7] = b[3];
    return r;
}
__device__ __forceinline__ bf16x8 pack8(f32x4 a, f32x4 b) {
    bf16x8 r;
    r[0] = (short)f2bf(a[0]); r[1] = (short)f2bf(a[1]); r[2] = (short)f2bf(a[2]); r[3] = (short)f2bf(a[3]);
    r[4] = (short)f2bf(b[0]); r[5] = (short)f2bf(b[1]); r[6] = (short)f2bf(b[2]); r[7] = (short)f2bf(b[3]);
    return r;
}
__device__ __forceinline__ void st4bf(bf16_t* dst, float a, float b, float c, float d) {
    u32x2 w; w.x = pack2(a, b); w.y = pack2(c, d); *(u32x2*)dst = w;
}

__device__ __forceinline__ void gemm_tile(const bf16_t* __restrict__ A, int lda, const bf16_t* __restrict__ W, int ldw, int K,
                                          f32x4 (&acc)[2][8], bf16_t* sA, bf16_t* sW) {
    const int tid = tid_(), lane = tid & 63, wave = tid >> 6, l16 = lane & 15, quad = lane >> 4;
    const int srow = tid >> 3, skc = (tid & 7) * 8;
    const bf16_t* ap = A + (size_t)srow * lda + skc;
    const bf16_t* wp = W + (size_t)srow * ldw + skc;
    u32x4 ra[4], rw[4];
#pragma unroll
    for (int i = 0; i < 4; ++i) { ra[i] = *(const u32x4*)(ap + (size_t)(i * 32) * lda); rw[i] = *(const u32x4*)(wp + (size_t)(i * 32) * ldw); }
#pragma unroll
    for (int i = 0; i < 2; ++i)
#pragma unroll
        for (int j = 0; j < 8; ++j) acc[i][j] = (f32x4){0.f, 0.f, 0.f, 0.f};
    const int nk = K >> 6;
    for (int kt = 0; kt < nk; ++kt) {
        __syncthreads();
#pragma unroll
        for (int i = 0; i < 4; ++i) {
            *(u32x4*)(sA + (srow + i * 32) * GST + skc) = ra[i];
            *(u32x4*)(sW + (srow + i * 32) * GST + skc) = rw[i];
        }
        __syncthreads();
        if (kt + 1 < nk) {
            const int k0 = (kt + 1) << 6;
#pragma unroll
            for (int i = 0; i < 4; ++i) { ra[i] = *(const u32x4*)(ap + (size_t)(i * 32) * lda + k0); rw[i] = *(const u32x4*)(wp + (size_t)(i * 32) * ldw + k0); }
        }
#pragma unroll
        for (int ks = 0; ks < 2; ++ks) {
            bf16x8 af[2];
#pragma unroll
            for (int i = 0; i < 2; ++i) af[i] = lds16(sA + (wave * 32 + i * 16 + l16) * GST + ks * 32 + quad * 8);
#pragma unroll
            for (int j = 0; j < 8; ++j) {
                const bf16x8 wf = lds16(sW + (j * 16 + l16) * GST + ks * 32 + quad * 8);
#pragma unroll
                for (int i = 0; i < 2; ++i) acc[i][j] = mfma16(wf, af[i], acc[i][j]);
            }
        }
    }
}

__device__ __forceinline__ void epi_resid(const Params& p, int m0, int n0, const f32x4 (&acc)[2][8], const float* gate  ) {
    const int lane = tid_() & 63, wave = tid_() >> 6, l16 = lane & 15, quad = lane >> 4;
#pragma unroll
    for (int i = 0; i < 2; ++i) {
        const int row = m0 + wave * 32 + i * 16 + l16;
        float* xr = xrow(p, row);
        const float* g = gate + (size_t)seg_of(row) * 6144;
#pragma unroll
        for (int j = 0; j < 8; ++j) {
            const int col = n0 + j * 16 + quad * 4;
            const f32x4 gv = *(const f32x4*)(g + col);
            f32x4 xv = *(f32x4*)(xr + col);
            xv += gv * acc[i][j];
            *(f32x4*)(xr + col) = xv;
        }
    }
}

__device__ __forceinline__ void epi_swiglu(const Params& p, int m0, int n0, const f32x4 (&acc)[2][8]) {
    const int lane = tid_() & 63, wave = tid_() >> 6, l16 = lane & 15, quad = lane >> 4;
    bf16_t* hid = (bf16_t*)(p.ws + WS_HID);
#pragma unroll
    for (int i = 0; i < 2; ++i) {
        const int row = m0 + wave * 32 + i * 16 + l16;
#pragma unroll
        for (int jj = 0; jj < 4; ++jj) {
            const f32x4 g = acc[i][2 * jj], u = acc[i][2 * jj + 1];
            const int hc = (n0 >> 1) + jj * 16 + quad * 4;
            st4bf(hid + (size_t)row * FFH + hc, siluf(g[0]) * u[0], siluf(g[1]) * u[1], siluf(g[2]) * u[2], siluf(g[3]) * u[3]);
        }
    }
}

__device__ __forceinline__ void epi_mixin(const Params& p, int j2, int m0, int tn, f32x4 (&acc)[2][8]) {
    const int lane = tid_() & 63, wave = tid_() >> 6, l16 = lane & 15, quad = lane >> 4;
    if (tn < 5) {
        const float* gsrc = (tn < 4 ? p.q_norm_g : p.k_norm_g) + j2 * 64;
        const float* cosT = (const float*)(p.ws + WS_ROPE);
        const float* sinT = cosT + 8192 * 32;
#pragma unroll
        for (int i = 0; i < 2; ++i) {
            const int row = m0 + wave * 32 + i * 16 + l16;
#pragma unroll
            for (int hh = 0; hh < 2; ++hh) {
                float ss = 0.f;
#pragma unroll
                for (int j = 0; j < 4; ++j) { const f32x4 v = acc[i][hh * 4 + j]; ss += v[0] * v[0] + v[1] * v[1] + v[2] * v[2] + v[3] * v[3]; }
                ss += __shfl_xor(ss, 16); ss += __shfl_xor(ss, 32);
                const float rstd = rsqrtf(ss * (1.f / 64.f) + EPS);
                f32x4 y[4];
#pragma unroll
                for (int j = 0; j < 4; ++j) {
                    const f32x4 gv = *(const f32x4*)(gsrc + j * 16 + quad * 4);
                    y[j] = acc[i][hh * 4 + j] * rstd * gv;
                }
                if (row < ML) {
                    const int s = row & (SEQ - 1);
#pragma unroll
                    for (int j = 0; j < 2; ++j) {
                        const f32x4 cs = *(const f32x4*)(cosT + (size_t)s * 32 + j * 16 + quad * 4);
                        const f32x4 sn = *(const f32x4*)(sinT + (size_t)s * 32 + j * 16 + quad * 4);
                        const f32x4 x1 = y[j], x2 = y[j + 2];
                        y[j] = x1 * cs - x2 * sn;
                        y[j + 2] = x2 * cs + x1 * sn;
                    }
                }
                if (tn < 4) {
                    bf16_t* q = (bf16_t*)(p.ws + WS_Q) + (size_t)row * 512 + (tn * 2 + hh) * 64;
#pragma unroll
                    for (int j = 0; j < 4; ++j) st4bf(q + j * 16 + quad * 4, y[j][0] * 0.125f, y[j][1] * 0.125f, y[j][2] * 0.125f, y[j][3] * 0.125f);
                } else {
                    const int b = row < ML ? (row >> 13) : ((row - ML) >> 8);
                    const int t = row < ML ? CTX + (row & (SEQ - 1)) : ((row - ML) & (CTX - 1));
                    bf16_t* k = (bf16_t*)(p.ws + WS_K) + ((size_t)b * TALL + t) * 128 + hh * 64;
#pragma unroll
                    for (int j = 0; j < 4; ++j) st4bf(k + j * 16 + quad * 4, y[j][0], y[j][1], y[j][2], y[j][3]);
                }
            }
        }
    } else if (tn == 5) {
        bf16_t* vt = (bf16_t*)(p.ws + WS_VT);
#pragma unroll
        for (int i = 0; i < 2; ++i) {
            const int row = m0 + wave * 32 + i * 16 + l16;
            const int b = row < ML ? (row >> 13) : ((row - ML) >> 8);
            const int t = row < ML ? CTX + (row & (SEQ - 1)) : ((row - ML) & (CTX - 1));
#pragma unroll
            for (int j = 0; j < 8; ++j) {
                const int kh = j >> 2;
#pragma unroll
                for (int r = 0; r < 4; ++r) {
                    const int d = (j & 3) * 16 + quad * 4 + r;
                    vt[((size_t)(b * 2 + kh) * 64 + d) * TALL + t] = f2bf(acc[i][j][r]);
                }
            }
        }
    } else if (tn < 10) {
        bf16_t* u = (bf16_t*)(p.ws + WS_U);
#pragma unroll
        for (int i = 0; i < 2; ++i) {
            const int row = m0 + wave * 32 + i * 16 + l16;
#pragma unroll
            for (int j = 0; j < 8; ++j) {
                const f32x4 v = acc[i][j];
                st4bf(u + (size_t)row * 512 + (tn - 6) * 128 + j * 16 + quad * 4, geluf(v[0]), geluf(v[1]), geluf(v[2]), geluf(v[3]));
            }
        }
    } else {
        const int g = tn - 10;
        const float* gn = p.sgu_norm_g + j2 * 512 + g * 128;
        bf16_t* gvt = (bf16_t*)(p.ws + WS_GVT);
#pragma unroll
        for (int i = 0; i < 2; ++i) {
            const int row = m0 + wave * 32 + i * 16 + l16;
            float ss = 0.f;
#pragma unroll
            for (int j = 0; j < 8; ++j) {
                f32x4 v = acc[i][j];
                v[0] = geluf(v[0]); v[1] = geluf(v[1]); v[2] = geluf(v[2]); v[3] = geluf(v[3]);
                acc[i][j] = v;
                ss += v[0] * v[0] + v[1] * v[1] + v[2] * v[2] + v[3] * v[3];
            }
            ss += __shfl_xor(ss, 16); ss += __shfl_xor(ss, 32);
            const float rstd = rsqrtf(ss * (1.f / 128.f) + EPS);
            const int chunk = row >> 7, pt = row & 127;
#pragma unroll
            for (int j = 0; j < 8; ++j) {
                const f32x4 gv = *(const f32x4*)(gn + j * 16 + quad * 4);
#pragma unroll
                for (int r = 0; r < 4; ++r) {
                    const int cc = g * 128 + j * 16 + quad * 4 + r;
                    gvt[((size_t)chunk * 512 + cc) * 128 + pt] = f2bf(acc[i][j][r] * rstd * gv[r]);
                }
            }
        }
    }
}

__device__ __forceinline__ void epi_ssmin(const Params& p, int j2, int m0, int tn, const f32x4 (&acc)[2][8]) {
    const int lane = tid_() & 63, wave = tid_() >> 6, l16 = lane & 15, quad = lane >> 4;
#pragma unroll
    for (int i = 0; i < 2; ++i) {
        const int row = m0 + wave * 32 + i * 16 + l16;
        if (tn < 16) {
            bf16_t* z = (bf16_t*)(p.ws + WS_Z) + (size_t)row * 2048 + tn * 128;
#pragma unroll
            for (int j = 0; j < 8; ++j) { const f32x4 v = acc[i][j]; st4bf(z + j * 16 + quad * 4, siluf(v[0]), siluf(v[1]), siluf(v[2]), siluf(v[3])); }
        } else if (tn < 40) {
            bf16_t* xb = (bf16_t*)(p.ws + WS_XBC) + (size_t)row * 3072 + (tn - 16) * 128;
#pragma unroll
            for (int j = 0; j < 8; ++j) { const f32x4 v = acc[i][j]; st4bf(xb + j * 16 + quad * 4, v[0], v[1], v[2], v[3]); }
        } else {
            float* dt = (float*)(p.ws + WS_DT) + (size_t)row * 64;
            const float* bias = p.ssm_dt_bias + j2 * 64;
#pragma unroll
            for (int j = 0; j < 4; ++j) {
                const int c = j * 16 + quad * 4;
                const f32x4 v = acc[i][j];
                f32x4 o;
                o[0] = softplusf(v[0] + bias[c + 0]); o[1] = softplusf(v[1] + bias[c + 1]);
                o[2] = softplusf(v[2] + bias[c + 2]); o[3] = softplusf(v[3] + bias[c + 3]);
                *(f32x4*)(dt + c) = o;
            }
        }
    }
}

enum { G_MIXIN = 0, G_MIXOUT, G_SSMIN, G_SSMOUT, G_FFNIN, G_FFNOUT };

template <int KIND>
__device__ void gemm_phase(const Params& p, int layer, bf16_t* smem) {
    const int j2 = layer >> 1;
    const bf16_t* A; const bf16_t* W; int lda, K, N;
    const unsigned char* wt = p.ws + WS_WT;
    if (KIND == G_MIXIN) { A = (const bf16_t*)(p.ws + WS_HN); lda = 1024; W = (const bf16_t*)(wt + WT_MIXIN); K = 1024; N = MIXIN; }
    else if (KIND == G_MIXOUT) { A = (const bf16_t*)(p.ws + WS_AS); lda = 1024; W = (const bf16_t*)(wt + WT_MIXOUT); K = 1024; N = 1024; }
    else if (KIND == G_SSMIN) { A = (const bf16_t*)(p.ws + WS_HN); lda = 1024; W = (const bf16_t*)(wt + WT_MIXIN); K = 1024; N = SSMIN_PAD; }
    else if (KIND == G_SSMOUT) { A = (const bf16_t*)(p.ws + WS_YF); lda = 2048; W = (const bf16_t*)(wt + WT_MIXOUT); K = 2048; N = 1024; }
    else if (KIND == G_FFNIN) { A = (const bf16_t*)(p.ws + WS_HN); lda = 1024; W = (const bf16_t*)(wt + WT_FFNIN); K = 1024; N = 2 * FFH; }
    else { A = (const bf16_t*)(p.ws + WS_HID); lda = FFH; W = (const bf16_t*)(wt + WT_FFNOUT); K = FFH; N = 1024; }
    const int ldw = K;
    const int nN = N >> 7, nM = MT >> 7;
    const float* mod = (const float*)(p.ws + WS_MOD) + (size_t)layer * 3 * 6144;
    bf16_t* sA = smem; bf16_t* sW = smem + 128 * GST;
    for (int t = blockIdx.x; t < nM * nN; t += gridDim.x) {
        const int tm = t / nN, tn = t - tm * nN;
        f32x4 acc[2][8];
        gemm_tile(A + (size_t)tm * 128 * lda, lda, W + (size_t)tn * 128 * ldw, ldw, K, acc, sA, sW);
        if (KIND == G_MIXIN) epi_mixin(p, j2, tm * 128, tn, acc);
        else if (KIND == G_MIXOUT || KIND == G_SSMOUT) epi_resid(p, tm * 128, tn * 128, acc, mod + 2 * 1024);
        else if (KIND == G_SSMIN) epi_ssmin(p, j2, tm * 128, tn, acc);
        else if (KIND == G_FFNIN) epi_swiglu(p, tm * 128, tn * 128, acc);
        else epi_resid(p, tm * 128, tn * 128, acc, mod + 5 * 1024);
    }
}

__device__ void norm_phase(const Params& p, int layer, int which) {
    const int lane = tid_() & 63, wave = tid_() >> 6;
    const float* g = (which ? p.norm2_g : p.norm1_g) + layer * 1024;
    const float* mod = (const float*)(p.ws + WS_MOD) + (size_t)layer * 3 * 6144;
    bf16_t* hn = (bf16_t*)(p.ws + WS_HN);
    for (int row = blockIdx.x * 4 + wave; row < MT; row += gridDim.x * 4) {
        const float* xr = xrow(p, row);
        f32x4 v[4]; float ss = 0.f;
#pragma unroll
        for (int i = 0; i < 4; ++i) { v[i] = *(const f32x4*)(xr + i * 256 + lane * 4); ss += v[i][0] * v[i][0] + v[i][1] * v[i][1] + v[i][2] * v[i][2] + v[i][3] * v[i][3]; }
#pragma unroll
        for (int o = 1; o < 64; o <<= 1) ss += __shfl_xor(ss, o);
        const float rstd = rsqrtf(ss * (1.f / 1024.f) + EPS);
        const float* m = mod + (size_t)seg_of(row) * 6144 + (which ? 3 * 1024 : 0);
#pragma unroll
        for (int i = 0; i < 4; ++i) {
            const int col = i * 256 + lane * 4;
            const f32x4 gv = *(const f32x4*)(g + col), sh = *(const f32x4*)(m + col), sc = *(const f32x4*)(m + 1024 + col);
            const f32x4 y = (v[i] * rstd * gv) * (sc + 1.f) + sh;
            st4bf(hn + (size_t)row * 1024 + col, y[0], y[1], y[2], y[3]);
        }
    }
}

__device__ void convert_wt(const float* __restrict__ W, int K, int N, bf16_t* __restrict__ Wt, int mode, float* tile) {
    const int tid = tid_();
    const int nKt = K >> 6, nNt = N >> 6;
    for (int t = blockIdx.x; t < nKt * nNt; t += gridDim.x) {
        const int kt = t / nNt, nt = t - kt * nNt;
        __syncthreads();
#pragma unroll
        for (int i = 0; i < 16; ++i) {
            const int kk = (tid >> 6) + i * 4, nn = tid & 63;
            tile[kk * 65 + nn] = W[(size_t)(kt * 64 + kk) * N + nt * 64 + nn];
        }
        __syncthreads();
#pragma unroll
        for (int i = 0; i < 16; ++i) {
            const int nn = (tid >> 6) + i * 4, kk = tid & 63;
            const int n = nt * 64 + nn;
            int dr = n;
            if (mode == 1) { const int hm = n < FFH ? n : n - FFH; dr = (hm >> 4) * 32 + (hm & 15) + (n < FFH ? 0 : 16); }
            Wt[(size_t)dr * K + kt * 64 + kk] = f2bf(tile[kk * 65 + nn]);
        }
    }
}

__device__ void convert_layer_weights(const Params& p, int layer, float* tile) {
    unsigned char* wt = p.ws + WS_WT;
    const int j2 = layer >> 1;
    convert_wt(p.ffn_w_in + (size_t)layer * 1024 * 2 * FFH, 1024, 2 * FFH, (bf16_t*)(wt + WT_FFNIN), 1, tile);
    convert_wt(p.ffn_w_out + (size_t)layer * FFH * 1024, FFH, 1024, (bf16_t*)(wt + WT_FFNOUT), 0, tile);
    if ((layer & 1) == 0) {
        convert_wt(p.mix_w_in + (size_t)j2 * 1024 * MIXIN, 1024, MIXIN, (bf16_t*)(wt + WT_MIXIN), 0, tile);
        convert_wt(p.mix_w_out + (size_t)j2 * 1024 * 1024, 1024, 1024, (bf16_t*)(wt + WT_MIXOUT), 0, tile);
    } else {
        convert_wt(p.ssm_w_in + (size_t)j2 * 1024 * SSMIN, 1024, SSMIN, (bf16_t*)(wt + WT_MIXIN), 0, tile);
        convert_wt(p.ssm_w_out + (size_t)j2 * SSI * 1024, SSI, 1024, (bf16_t*)(wt + WT_MIXOUT), 0, tile);
        bf16_t* padp = (bf16_t*)(wt + WT_MIXIN) + (size_t)SSMIN * 1024;
        for (int i = blockIdx.x * 256 + tid_(); i < (SSMIN_PAD - SSMIN) * 1024; i += gridDim.x * 256) padp[i] = 0;
    }
}

__device__ void prologue(const Params& p, float* smf) {
    const int tid = tid_();
    const size_t gtid = (size_t)blockIdx.x * 256 + tid, gsz = (size_t)gridDim.x * 256;
    {
        const f32x4* s = (const f32x4*)p.x; f32x4* d = (f32x4*)p.out;
        for (size_t i = gtid; i < (size_t)ML * D / 4; i += gsz) d[i] = s[i];
        const f32x4* s2 = (const f32x4*)p.ctx; f32x4* d2 = (f32x4*)(p.ws + WS_XCTX);
        for (size_t i = gtid; i < (size_t)MC * D / 4; i += gsz) d2[i] = s2[i];
    }
    {
        float* cosT = (float*)(p.ws + WS_ROPE); float* sinT = cosT + 8192 * 32;
        for (size_t i = gtid; i < (size_t)8192 * 32; i += gsz) {
            const int s = (int)(i >> 5), j = (int)(i & 31), f = j & 15;
            const float inv = powf(10000.f, -(float)f / 16.f);
            const float pos = (float)(j < 16 ? (s >> 6) : (s & 63));
            const float ang = pos * inv;
            cosT[i] = cosf(ang); sinT[i] = sinf(ang);
        }
    }
    {
        bf16_t* sgw = (bf16_t*)(p.ws + WS_SGW);
        for (size_t i = gtid; i < (size_t)2 * 4 * 128 * 128; i += gsz) sgw[i] = f2bf(p.sgu_w[i]);
    }
    {
        float* sc = smf;
        float* red = smf + 3 * 1024;
        __syncthreads();
        for (int i = tid; i < 3 * 1024; i += 256) {
            const int sgi = i >> 10, k = i & 1023;
            const float v = sgi < 2 ? p.c[sgi * 1024 + k] : p.c_ctx[k];
            sc[i] = siluf(v);
        }
        __syncthreads();
        float* mod = (float*)(p.ws + WS_MOD);
        const int cl = tid & 63, kg = tid >> 6;
        for (int wi = blockIdx.x; wi < 4 * 96; wi += gridDim.x) {
            const int layer = wi / 96, cb = wi - layer * 96;
            const float* w = p.ada_w + (size_t)layer * 1024 * 6144 + cb * 64 + cl;
            float s0 = 0.f, s1 = 0.f, s2 = 0.f;
            for (int k = kg * 256; k < kg * 256 + 256; ++k) {
                const float wv = w[(size_t)k * 6144];
                s0 += sc[k] * wv; s1 += sc[1024 + k] * wv; s2 += sc[2048 + k] * wv;
            }
            __syncthreads();
            red[(kg * 3 + 0) * 64 + cl] = s0; red[(kg * 3 + 1) * 64 + cl] = s1; red[(kg * 3 + 2) * 64 + cl] = s2;
            __syncthreads();
            if (tid < 192) {
                const int sgi = tid >> 6;
                const float v = red[(0 * 3 + sgi) * 64 + cl] + red[(1 * 3 + sgi) * 64 + cl] + red[(2 * 3 + sgi) * 64 + cl] + red[(3 * 3 + sgi) * 64 + cl];
                const int n = cb * 64 + cl;
                mod[((size_t)layer * 3 + sgi) * 6144 + n] = v + p.ada_b[layer * 6144 + n];
            }
        }
        __syncthreads();
    }
    convert_layer_weights(p, 0, smf);
}

__device__ void attn_item(const Params& p, int b, int h, int q0row, int nkeys, bf16_t* smem) {
    const int tid = tid_(), lane = tid & 63, wave = tid >> 6, l16 = lane & 15, quad = lane >> 4;
    const int kh = h >> 2;
    const bf16_t* Q = (const bf16_t*)(p.ws + WS_Q);
    const bf16_t* Kb = (const bf16_t*)(p.ws + WS_K) + (size_t)b * TALL * 128 + kh * 64;
    const bf16_t* Vb = (const bf16_t*)(p.ws + WS_VT) + (size_t)(b * 2 + kh) * 64 * TALL;
    bf16_t* sK = smem; bf16_t* sV = smem + 64 * GST;
    bf16x8 qf[2][2];
#pragma unroll
    for (int i = 0; i < 2; ++i)
#pragma unroll
        for (int ks = 0; ks < 2; ++ks)
            qf[i][ks] = *(const bf16x8*)(Q + (size_t)(q0row + wave * 32 + i * 16 + l16) * 512 + h * 64 + ks * 32 + quad * 8);
    f32x4 o[4][2];
#pragma unroll
    for (int d = 0; d < 4; ++d)
#pragma unroll
        for (int i = 0; i < 2; ++i) o[d][i] = (f32x4){0.f, 0.f, 0.f, 0.f};
    float mrun[2] = {-INFINITY, -INFINITY}, lrun[2] = {0.f, 0.f};
    const int srow = tid >> 3, skc = (tid & 7) * 8;
    u32x4 rk[2], rv[2];
#pragma unroll
    for (int i = 0; i < 2; ++i) {
        rk[i] = *(const u32x4*)(Kb + (size_t)(srow + i * 32) * 128 + skc);
        rv[i] = *(const u32x4*)(Vb + (size_t)(srow + i * 32) * TALL + skc);
    }
    const int nt = nkeys >> 6;
    constexpr float LOG2E = 1.4426950408889634f;
    for (int kt = 0; kt < nt; ++kt) {
        __syncthreads();
#pragma unroll
        for (int i = 0; i < 2; ++i) {
            *(u32x4*)(sK + (srow + i * 32) * GST + skc) = rk[i];
            *(u32x4*)(sV + (srow + i * 32) * GST + skc) = rv[i];
        }
        __syncthreads();
        if (kt + 1 < nt) {
            const int t0 = (kt + 1) << 6;
#pragma unroll
            for (int i = 0; i < 2; ++i) {
                rk[i] = *(const u32x4*)(Kb + (size_t)(t0 + srow + i * 32) * 128 + skc);
                rv[i] = *(const u32x4*)(Vb + (size_t)(srow + i * 32) * TALL + t0 + skc);
            }
        }
        f32x4 s[4][2];
#pragma unroll
        for (int tt = 0; tt < 4; ++tt)
#pragma unroll
            for (int i = 0; i < 2; ++i) s[tt][i] = (f32x4){0.f, 0.f, 0.f, 0.f};
#pragma unroll
        for (int ks = 0; ks < 2; ++ks)
#pragma unroll
            for (int tt = 0; tt < 4; ++tt) {
                const bf16x8 kf = lds16(sK + (tt * 16 + l16) * GST + ks * 32 + quad * 8);
#pragma unroll
                for (int i = 0; i < 2; ++i) s[tt][i] = mfma16(kf, qf[i][ks], s[tt][i]);
            }
        bf16x8 pf[2][2];
#pragma unroll
        for (int i = 0; i < 2; ++i) {
            float mx = -INFINITY;
#pragma unroll
            for (int tt = 0; tt < 4; ++tt) mx = fmaxf(mx, fmaxf(fmaxf(s[tt][i][0], s[tt][i][1]), fmaxf(s[tt][i][2], s[tt][i][3])));
            mx = fmaxf(mx, __shfl_xor(mx, 16)); mx = fmaxf(mx, __shfl_xor(mx, 32));
            const float mnew = fmaxf(mrun[i], mx);
            const float alpha = exp2f((mrun[i] - mnew) * LOG2E);
            mrun[i] = mnew;
            const float mb = mnew * LOG2E;
            float ls = 0.f;
#pragma unroll
            for (int tt = 0; tt < 4; ++tt) {
#pragma unroll
                for (int r = 0; r < 4; ++r) { const float e = exp2f(s[tt][i][r] * LOG2E - mb); s[tt][i][r] = e; ls += e; }
            }
            lrun[i] = lrun[i] * alpha + ls;
#pragma unroll
            for (int d = 0; d < 4; ++d) o[d][i] *= alpha;
#pragma unroll
            for (int ksp = 0; ksp < 2; ++ksp) pf[ksp][i] = pack8(s[2 * ksp][i], s[2 * ksp + 1][i]);
        }
#pragma unroll
        for (int ksp = 0; ksp < 2; ++ksp)
#pragma unroll
            for (int d = 0; d < 4; ++d) {
                const bf16_t* vp = sV + (d * 16 + l16) * GST + ksp * 32 + quad * 4;
                const bf16x8 vf = lds8x2(vp, vp + 16);
#pragma unroll
                for (int i = 0; i < 2; ++i) o[d][i] = mfma16(vf, pf[ksp][i], o[d][i]);
            }
    }
    bf16_t* as = (bf16_t*)(p.ws + WS_AS);
#pragma unroll
    for (int i = 0; i < 2; ++i) {
        float l = lrun[i];
        l += __shfl_xor(l, 16); l += __shfl_xor(l, 32);
        const float inv = 1.f / l;
        const int row = q0row + wave * 32 + i * 16 + l16;
#pragma unroll
        for (int d = 0; d < 4; ++d)
            st4bf(as + (size_t)row * 1024 + h * 64 + d * 16 + quad * 4, o[d][i][0] * inv, o[d][i][1] * inv, o[d][i][2] * inv, o[d][i][3] * inv);
    }
}

__device__ void sg_item(const Params& p, int j2, int chunk, int g, bf16_t* smem) {
    const int lane = tid_() & 63, wave = tid_() >> 6, l16 = lane & 15, quad = lane >> 4;
    const bf16_t* A = (const bf16_t*)(p.ws + WS_SGW) + (size_t)(j2 * 4 + g) * 128 * 128;
    const bf16_t* W = (const bf16_t*)(p.ws + WS_GVT) + ((size_t)chunk * 512 + g * 128) * 128;
    f32x4 acc[2][8];
    gemm_tile(A, 128, W, 128, 128, acc, smem, smem + 128 * GST);
    const bf16_t* u = (const bf16_t*)(p.ws + WS_U);
    bf16_t* as = (bf16_t*)(p.ws + WS_AS);
    const float* bs = p.sgu_b + (size_t)(j2 * 4 + g) * 128;
#pragma unroll
    for (int i = 0; i < 2; ++i) {
        const int pt = wave * 32 + i * 16 + l16;
        const int row = chunk * 128 + pt;
        const float bias = bs[pt];
#pragma unroll
        for (int j = 0; j < 8; ++j) {
            const int c = g * 128 + j * 16 + quad * 4;
            const u32x2 uw = *(const u32x2*)(u + (size_t)row * 512 + c);
            const float u0 = __uint_as_float(uw.x << 16), u1 = __uint_as_float(uw.x & 0xffff0000u);
            const float u2 = __uint_as_float(uw.y << 16), u3 = __uint_as_float(uw.y & 0xffff0000u);
            const f32x4 v = acc[i][j];
            st4bf(as + (size_t)row * 1024 + 512 + c, u0 * (v[0] + bias), u1 * (v[1] + bias), u2 * (v[2] + bias), u3 * (v[3] + bias));
        }
    }
}

__device__ void attn_sg_phase(const Params& p, int layer, bf16_t* smem) {
    const int j2 = layer >> 1;
    const int nA = NB * 8 * 64, nS = (MT / 128) * 4, nC = NB * 8 * 2;
    for (int t = blockIdx.x; t < nA + nS + nC; t += gridDim.x) {
        if (t < nA) {
            const int qb = t & 63, h = (t >> 6) & 7, b = t >> 9;
            attn_item(p, b, h, b * SEQ + qb * 128, TALL, smem);
        } else if (t < nA + nS) {
            const int u = t - nA;
            sg_item(p, j2, u >> 2, u & 3, smem);
        } else {
            const int u = t - nA - nS;
            const int qb = u & 1, h = (u >> 1) & 7, b = u >> 4;
            attn_item(p, b, h, ML + b * CTX + qb * 128, CTX, smem);
        }
    }
}

__device__ void conv_phase(const Params& p, int layer, float* smf) {
    const int j2 = layer >> 1, tid = tid_();
    const bf16_t* xbc = (const bf16_t*)(p.ws + WS_XBC);
    bf16_t* XT = (bf16_t*)(p.ws + WS_XT); bf16_t* Bn = (bf16_t*)(p.ws + WS_BN); bf16_t* Cn = (bf16_t*)(p.ws + WS_CN); bf16_t* BT = (bf16_t*)(p.ws + WS_BT);
    const float* cw = p.ssm_conv_w + (size_t)j2 * 3 * 3072;
    const float* cb = p.ssm_conv_b + (size_t)j2 * 3072;
    float* sin_ = smf;
    float* sout = smf + 66 * 65;
    const int nCt = 3072 / 64, nRt = MT / 64;
    for (int t = blockIdx.x; t < nCt * nRt; t += gridDim.x) {
        const int rt = t / nCt, ct = t - rt * nCt;
        const int r0 = rt * 64, c0 = ct * 64;
        const bool first = r0 < ML ? ((r0 & (SEQ - 1)) == 0) : (((r0 - ML) & (CTX - 1)) == 0);
        const bool last = r0 < ML ? (((r0 + 64) & (SEQ - 1)) == 0) : ((((r0 + 64) - ML) & (CTX - 1)) == 0);
        __syncthreads();
        for (int e = tid; e < 66 * 64; e += 256) {
            const int rr = e >> 6, c = e & 63;
            const int row = r0 - 1 + rr;
            float v = 0.f;
            if (!((rr == 0 && first) || (rr == 65 && last))) v = bf2f(xbc[(size_t)row * 3072 + c0 + c]);
            sin_[rr * 65 + c] = v;
        }
        __syncthreads();
        {
            const int c = tid & 63;
            const float w0 = cw[c0 + c], w1 = cw[3072 + c0 + c], w2 = cw[2 * 3072 + c0 + c], bb = cb[c0 + c];
#pragma unroll
            for (int k = 0; k < 16; ++k) {
                const int tt = (tid >> 6) + k * 4;
                const float v = w0 * sin_[tt * 65 + c] + w1 * sin_[(tt + 1) * 65 + c] + w2 * sin_[(tt + 2) * 65 + c] + bb;
                const float y = siluf(v);
                sout[c * 65 + tt] = y;
                if (c0 >= 2048) {
                    if (c0 < 2560) Bn[(size_t)(r0 + tt) * 512 + (c0 - 2048) + c] = f2bf(y);
                    else Cn[(size_t)(r0 + tt) * 512 + (c0 - 2560) + c] = f2bf(y);
                }
            }
        }
        __syncthreads();
        if (c0 < 2560) {
            bf16_t* dst = c0 < 2048 ? XT + (size_t)c0 * MT : BT + (size_t)(c0 - 2048) * MT;
            const int tt = tid & 63;
#pragma unroll
            for (int k = 0; k < 16; ++k) {
                const int c = (tid >> 6) + k * 4;
                dst[(size_t)c * MT + r0 + tt] = f2bf(sout[c * 65 + tt]);
            }
        }
    }
}

__device__ void ssd_item(const Params& p, int j2, int b, int dir, int h, bf16_t* smem) {
    const int tid = tid_(), lane = tid & 63, wave = tid >> 6, l16 = lane & 15, quad = lane >> 4;
    const int g = h >> 3;
    bf16_t* sB = smem;
    bf16_t* sX = sB + 128 * SST;
    bf16_t* sH = sX + 64 * SST;
    float* sda = (float*)(sH + 64 * SST);
    float* sacs = sda + 128;
    float* sdt = sacs + 128;
    const bf16_t* XT = (const bf16_t*)(p.ws + WS_XT) + (size_t)(h * 64) * MT;
    const bf16_t* Bn = (const bf16_t*)(p.ws + WS_BN) + g * 128;
    const bf16_t* Cn = (const bf16_t*)(p.ws + WS_CN) + g * 128;
    const bf16_t* BT = (const bf16_t*)(p.ws + WS_BT) + (size_t)(g * 128) * MT;
    const float* DT = (const float*)(p.ws + WS_DT) + dir * 32 + h;
    bf16_t* Y = (bf16_t*)(p.ws + (dir ? WS_YB : WS_YF));
    const float a = -expf(p.ssm_a_log[(j2 * 2 + dir) * 32 + h]);
    const float dsk = p.ssm_d[j2 * 32 + h];
    f32x4 st[2][4];
#pragma unroll
    for (int nt = 0; nt < 2; ++nt)
#pragma unroll
        for (int pt = 0; pt < 4; ++pt) st[nt][pt] = (f32x4){0.f, 0.f, 0.f, 0.f};
#pragma unroll 1
    for (int cc = 0; cc < 66; ++cc) {
        int row0;
        if (cc < 2) { const int ci = dir ? 1 - cc : cc; row0 = ML + b * CTX + ci * 128; }
        else { const int k = cc - 2; const int ci = dir ? 63 - k : k; row0 = b * SEQ + ci * 128; }
        __syncthreads();
#pragma unroll
        for (int i = 0; i < 8; ++i) {
            const int c = tid + i * 256, r = c >> 4, kc = (c & 15) * 8;
            *(u32x4*)(sB + r * SST + kc) = *(const u32x4*)(Bn + (size_t)(row0 + r) * 512 + kc);
        }
#pragma unroll
        for (int i = 0; i < 4; ++i) {
            const int c = tid + i * 256, r = c >> 4, kc = (c & 15) * 8;
            *(u32x4*)(sX + r * SST + kc) = *(const u32x4*)(XT + (size_t)r * MT + row0 + kc);
        }
        if (tid < 128) { const float dtv = DT[(size_t)(row0 + tid) * 64]; sdt[tid] = dtv; sda[tid] = dtv * a; }
#pragma unroll
        for (int nt = 0; nt < 2; ++nt)
#pragma unroll
            for (int pt = 0; pt < 4; ++pt) {
                const f32x4 v = st[nt][pt];
                st4bf(sH + (pt * 16 + l16) * SST + wave * 32 + nt * 16 + quad * 4, v[0], v[1], v[2], v[3]);
            }
        __syncthreads();
        if (tid < 128) {
            float s = 0.f;
            if (dir == 0) { for (int m = 0; m <= tid; ++m) s += sda[m]; }
            else { for (int m = 127; m >= tid; --m) s += sda[m]; }
            sacs[tid] = s;
        }
        __syncthreads();
        const float total = dir == 0 ? sacs[127] : sacs[0];
        bf16x8 cf[2][4];
#pragma unroll
        for (int i = 0; i < 2; ++i)
#pragma unroll
            for (int ks = 0; ks < 4; ++ks)
                cf[i][ks] = *(const bf16x8*)(Cn + (size_t)(row0 + wave * 32 + i * 16 + l16) * 512 + ks * 32 + quad * 8);
        float acl[2];
#pragma unroll
        for (int i = 0; i < 2; ++i) acl[i] = sacs[wave * 32 + i * 16 + l16];
        __builtin_amdgcn_sched_barrier(0);
        f32x4 y[4][2];
#pragma unroll
        for (int pt = 0; pt < 4; ++pt)
#pragma unroll
            for (int i = 0; i < 2; ++i) y[pt][i] = (f32x4){0.f, 0.f, 0.f, 0.f};
#pragma unroll
        for (int ks = 0; ks < 4; ++ks)
#pragma unroll
            for (int pt = 0; pt < 4; ++pt) {
                const bf16x8 hf = lds16(sH + (pt * 16 + l16) * SST + ks * 32 + quad * 8);
#pragma unroll
                for (int i = 0; i < 2; ++i) y[pt][i] = mfma16(hf, cf[i][ks], y[pt][i]);
                __builtin_amdgcn_sched_barrier(0);
            }
#pragma unroll
        for (int i = 0; i < 2; ++i) {
            const float e = __expf(acl[i]);
#pragma unroll
            for (int pt = 0; pt < 4; ++pt) y[pt][i] *= e;
        }
        __builtin_amdgcn_sched_barrier(0);
#pragma unroll 1
        for (int sp = 0; sp < 4; ++sp) {
            if (dir == 0 ? (sp > wave) : (sp < wave)) continue;
            f32x4 gt[2][2];
#pragma unroll
            for (int s2 = 0; s2 < 2; ++s2)
#pragma unroll
                for (int i = 0; i < 2; ++i) gt[s2][i] = (f32x4){0.f, 0.f, 0.f, 0.f};
#pragma unroll
            for (int ks = 0; ks < 4; ++ks)
#pragma unroll
                for (int s2 = 0; s2 < 2; ++s2) {
                    const bf16x8 bfr = lds16(sB + (sp * 32 + s2 * 16 + l16) * SST + ks * 32 + quad * 8);
#pragma unroll
                    for (int i = 0; i < 2; ++i) gt[s2][i] = mfma16(bfr, cf[i][ks], gt[s2][i]);
                    __builtin_amdgcn_sched_barrier(0);
                }
            bf16x8 mf[2];
#pragma unroll
            for (int i = 0; i < 2; ++i) {
                const int l = wave * 32 + i * 16 + l16;
#pragma unroll
                for (int s2 = 0; s2 < 2; ++s2)
#pragma unroll
                    for (int r = 0; r < 4; ++r) {
                        const int s = sp * 32 + s2 * 16 + quad * 4 + r;
                        const bool valid = dir == 0 ? (s <= l) : (s >= l);
                        const float df = fminf(acl[i] - sacs[s], 0.f);
                        gt[s2][i][r] = valid ? gt[s2][i][r] * __expf(df) * sdt[s] : 0.f;
                    }
                mf[i] = pack8(gt[0][i], gt[1][i]);
            }
#pragma unroll
            for (int pt = 0; pt < 4; ++pt) {
                const bf16_t* xp = sX + (pt * 16 + l16) * SST + sp * 32 + quad * 4;
                const bf16x8 xf = lds8x2(xp, xp + 16);
#pragma unroll
                for (int i = 0; i < 2; ++i) y[pt][i] = mfma16(xf, mf[i], y[pt][i]);
            }
        }
        __builtin_amdgcn_sched_barrier(0);
#pragma unroll
        for (int i = 0; i < 2; ++i) {
            const int l = wave * 32 + i * 16 + l16;
#pragma unroll
            for (int pt = 0; pt < 4; ++pt) {
                f32x4 v = y[pt][i];
                if (dir == 0) {
#pragma unroll
                    for (int r = 0; r < 4; ++r) v[r] += dsk * bf2f(sX[(pt * 16 + quad * 4 + r) * SST + l]);
                }
                st4bf(Y + (size_t)(row0 + l) * 2048 + h * 64 + pt * 16 + quad * 4, v[0], v[1], v[2], v[3]);
            }
        }
        __builtin_amdgcn_sched_barrier(0);
        {
            const float dec = __expf(total);
#pragma unroll
            for (int nt = 0; nt < 2; ++nt)
#pragma unroll
                for (int pt = 0; pt < 4; ++pt) st[nt][pt] *= dec;
#pragma unroll 1
            for (int ks = 0; ks < 4; ++ks) {
                float w[8];
#pragma unroll
                for (int e = 0; e < 8; ++e) { const int s = ks * 32 + quad * 8 + e; w[e] = sdt[s] * __expf(total - sacs[s]); }
                bf16x8 xbf[4];
#pragma unroll
                for (int pt = 0; pt < 4; ++pt) xbf[pt] = lds16(sX + (pt * 16 + l16) * SST + ks * 32 + quad * 8);
#pragma unroll
                for (int nt = 0; nt < 2; ++nt) {
                    const bf16x8 raw = *(const bf16x8*)(BT + (size_t)(wave * 32 + nt * 16 + l16) * MT + row0 + ks * 32 + quad * 8);
                    bf16x8 bw;
#pragma unroll
                    for (int e = 0; e < 8; ++e) bw[e] = (short)f2bf(bf2f((bf16_t)raw[e]) * w[e]);
#pragma unroll
                    for (int pt = 0; pt < 4; ++pt) st[nt][pt] = mfma16(bw, xbf[pt], st[nt][pt]);
                }
            }
        }
    }
}

__device__ void ssd_phase(const Params& p, int layer, bf16_t* smem) {
    const int j2 = layer >> 1;
    for (int t = blockIdx.x; t < NB * 2 * 32; t += gridDim.x) {
        const int h = t & 31, dir = (t >> 5) & 1, b = t >> 6;
        ssd_item(p, j2, b, dir, h, smem);
    }
}

__device__ void finish_phase(const Params& p, int layer) {
    const int j2 = layer >> 1, lane = tid_() & 63, wave = tid_() >> 6;
    bf16_t* yf = (bf16_t*)(p.ws + WS_YF); const bf16_t* yb = (const bf16_t*)(p.ws + WS_YB); const bf16_t* z = (const bf16_t*)(p.ws + WS_Z);
    const float* gn = p.ssm_norm_g + (size_t)j2 * 2048;
    for (int row = blockIdx.x * 4 + wave; row < MT; row += gridDim.x * 4) {
#pragma unroll
        for (int g = 0; g < 4; ++g) {
            const size_t off = (size_t)row * 2048 + g * 512 + lane * 8;
            const u32x4 a = *(const u32x4*)(yf + off), bq = *(const u32x4*)(yb + off), zq = *(const u32x4*)(z + off);
            const unsigned aw[4] = {a.x, a.y, a.z, a.w}, bw[4] = {bq.x, bq.y, bq.z, bq.w}, zw[4] = {zq.x, zq.y, zq.z, zq.w};
            float v[8]; float ss = 0.f;
#pragma unroll
            for (int k = 0; k < 4; ++k) {
                v[2 * k] = (__uint_as_float(aw[k] << 16) + __uint_as_float(bw[k] << 16)) * __uint_as_float(zw[k] << 16);
                v[2 * k + 1] = (__uint_as_float(aw[k] & 0xffff0000u) + __uint_as_float(bw[k] & 0xffff0000u)) * __uint_as_float(zw[k] & 0xffff0000u);
                ss += v[2 * k] * v[2 * k] + v[2 * k + 1] * v[2 * k + 1];
            }
#pragma unroll
            for (int o = 1; o < 64; o <<= 1) ss += __shfl_xor(ss, o);
            const float rstd = rsqrtf(ss * (1.f / 512.f) + EPS);
            const f32x4 g0 = *(const f32x4*)(gn + g * 512 + lane * 8), g1 = *(const f32x4*)(gn + g * 512 + lane * 8 + 4);
            u32x4 o4;
            o4.x = pack2(v[0] * rstd * g0[0], v[1] * rstd * g0[1]); o4.y = pack2(v[2] * rstd * g0[2], v[3] * rstd * g0[3]);
            o4.z = pack2(v[4] * rstd * g1[0], v[5] * rstd * g1[1]); o4.w = pack2(v[6] * rstd * g1[2], v[7] * rstd * g1[3]);
            *(u32x4*)(yf + off) = o4;
        }
    }
}

__global__ void __launch_bounds__(256, 2) hybrid_fwd(Params p) {
    extern __shared__ __attribute__((aligned(16))) unsigned char lds[];
    cg::grid_group grid = cg::this_grid();
    bf16_t* smem = (bf16_t*)lds; float* smf = (float*)lds;
    enum { C_NORM1 = 0, C_MIXIN, C_ATTN, C_MIXOUT, C_NORM2, C_FFNIN, C_FFNOUT, C_SSMIN, C_CONV, C_SSD, C_FINISH, C_SSMOUT, C_PRO };
    const unsigned long long evc = 0x6543210ull;
    const unsigned long long odc = 0x654BA9870ull;
    for (int ph = 0; ph < 33; ++ph) {
        int code, layer;
        if (ph == 0) { code = C_PRO; layer = 0; }
        else {
            const int q = ph - 1, pair = q >> 4, r = q & 15;
            if (r < 7) { layer = 2 * pair; code = (int)((evc >> (4 * r)) & 15); }
            else { layer = 2 * pair + 1; code = (int)((odc >> (4 * (r - 7))) & 15); }
        }
        Params q = p;
        asm volatile("" : "+s"(q.ws));
        asm volatile("" : "+s"(q.out));
        switch (code) {
            case C_PRO: prologue(q, smf); break;
            case C_NORM1: if (layer > 0) convert_layer_weights(q, layer, smf); norm_phase(q, layer, 0); break;
            case C_NORM2: norm_phase(q, layer, 1); break;
            case C_MIXIN: gemm_phase<G_MIXIN>(q, layer, smem); break;
            case C_ATTN: attn_sg_phase(q, layer, smem); break;
            case C_MIXOUT: gemm_phase<G_MIXOUT>(q, layer, smem); break;
            case C_FFNIN: gemm_phase<G_FFNIN>(q, layer, smem); break;
            case C_FFNOUT: gemm_phase<G_FFNOUT>(q, layer, smem); break;
            case C_SSMIN: gemm_phase<G_SSMIN>(q, layer, smem); break;
            case C_CONV: conv_phase(q, layer, smf); break;
            case C_SSD: ssd_phase(q, layer, smem); break;
            case C_FINISH: finish_phase(q, layer); break;
            case C_SSMOUT: gemm_phase<G_SSMOUT>(q, layer, smem); break;
            default: break;
        }
        grid.sync();
    }
}

extern "C" void kernel_launch(void* const* d_in, const int* in_sizes, int n_in, void* d_out, int out_size, void* d_ws, size_t ws_size, hipStream_t stream) {
    static int grid_blocks = 0;
    if (grid_blocks == 0) {
        if (ws_size < WS_TOTAL) { fprintf(stderr, "kernel_launch: workspace too small: %zu < %zu\n", ws_size, (size_t)WS_TOTAL); grid_blocks = -1; return; }
        int dev = 0, cus = 0, per_cu = 0;
        hipGetDevice(&dev);
        hipDeviceGetAttribute(&cus, hipDeviceAttributeMultiprocessorCount, dev);
        if (hipFuncSetAttribute((const void*)hybrid_fwd, hipFuncAttributeMaxDynamicSharedMemorySize, LDS_BYTES) != hipSuccess) { fprintf(stderr, "kernel_launch: hipFuncSetAttribute failed\n"); }
        if (hipOccupancyMaxActiveBlocksPerMultiprocessor(&per_cu, (const void*)hybrid_fwd, 256, LDS_BYTES) != hipSuccess || per_cu < 1) { fprintf(stderr, "kernel_launch: occupancy query failed (%d)\n", per_cu); per_cu = 1; }
        if (per_cu > 2) per_cu = 2;
        (void)hipGetLastError();
        grid_blocks = cus * per_cu;
    }
    if (grid_blocks < 0) return;
    Params p{};
    const float** f = (const float**)&p;
    for (int i = 0; i < 25; ++i) f[i] = (const float*)d_in[i];
    p.out = (float*)d_out; p.ws = (unsigned char*)d_ws;
    void* args[] = {&p};
    hipError_t e = hipLaunchCooperativeKernel((const void*)hybrid_fwd, dim3(grid_blocks), dim3(256), args, LDS_BYTES, stream);
    if (e != hipSuccess) fprintf(stderr, "cooperative launch failed: %s (grid %d)\n", hipGetErrorString(e), grid_blocks);
}
```

```cpp
#include <hip/hip_runtime.h>
#include <hip/hip_cooperative_groups.h>
#include <cstdio>
#include <cstdint>
namespace cg = cooperative_groups;

typedef unsigned short bf16_t;
typedef short bf16x8 __attribute__((ext_vector_type(8)));
typedef short bf16x4 __attribute__((ext_vector_type(4)));
typedef float f32x4 __attribute__((ext_vector_type(4)));
typedef unsigned u32x4 __attribute__((ext_vector_type(4)));
typedef unsigned u32x2 __attribute__((ext_vector_type(2)));

constexpr int D = 1024, NB = 2, SEQ = 8192, CTX = 256;
constexpr int ML = NB * SEQ;
constexpr int MC = NB * CTX;
constexpr int MT = ML + MC;
constexpr int TALL = CTX + SEQ;
constexpr int FFH = 2816;
constexpr int MIXIN = 1792;
constexpr int SSMIN = 5184, SSMIN_PAD = 5248;
constexpr int SSI = 2048;
constexpr float EPS = 1e-6f;

constexpr size_t MB = 1024 * 1024;
constexpr size_t WS_MOD = 0;
constexpr size_t WS_ROPE = 1 * MB;
constexpr size_t WS_XCTX = 3 * MB;
constexpr size_t WS_SGW = 5 * MB + 512 * 1024;
constexpr size_t WS_WT = 8 * MB;
constexpr size_t WT_FFNIN = 0;
constexpr size_t WT_FFNOUT = WT_FFNIN + (size_t)5632 * 1024 * 2;
constexpr size_t WT_MIXIN = WT_FFNOUT + (size_t)1024 * 2816 * 2;
constexpr size_t WT_MIXOUT = WT_MIXIN + (size_t)SSMIN_PAD * 1024 * 2;
constexpr size_t WT_END = WT_MIXOUT + (size_t)1024 * 2048 * 2;
constexpr size_t WS_R0 = WS_WT + ((WT_END + MB - 1) / MB) * MB;
constexpr size_t SZ_XBC = (size_t)MT * 3072 * 2;
constexpr size_t SZ_HN = (size_t)MT * 1024 * 2;
constexpr size_t WS_XBC = WS_R0;
constexpr size_t WS_HN = WS_XBC + SZ_XBC;
constexpr size_t WS_YF = WS_XBC;
constexpr size_t WS_YB = WS_YF + (size_t)MT * 2048 * 2;
constexpr size_t WS_R1 = WS_HN + SZ_HN;
constexpr size_t WS_Z = WS_R1;
constexpr size_t WS_XT = WS_Z + (size_t)MT * 2048 * 2;
constexpr size_t WS_BN = WS_XT + (size_t)MT * 2048 * 2;
constexpr size_t WS_CN = WS_BN + (size_t)MT * 512 * 2;
constexpr size_t WS_BT = WS_CN + (size_t)MT * 512 * 2;
constexpr size_t WS_DT = WS_BT + (size_t)MT * 512 * 2;
constexpr size_t WS_END_ODD = WS_DT + (size_t)MT * 64 * 4;
constexpr size_t WS_Q = WS_R1;
constexpr size_t WS_K = WS_Q + (size_t)MT * 512 * 2;
constexpr size_t WS_VT = WS_K + (size_t)MT * 128 * 2;
constexpr size_t WS_U = WS_VT + (size_t)MT * 128 * 2;
constexpr size_t WS_GVT = WS_U + (size_t)MT * 512 * 2;
constexpr size_t WS_AS = WS_GVT + (size_t)MT * 512 * 2;
constexpr size_t WS_HID = WS_R1;
constexpr size_t WS_TOTAL = WS_END_ODD;
static_assert(WS_TOTAL < (size_t)400 * MB, "workspace too large");
static_assert(WS_AS + (size_t)MT * 1024 * 2 <= WS_END_ODD, "even buffers fit");
static_assert(WS_HID + (size_t)MT * FFH * 2 <= WS_END_ODD, "hid fits");

constexpr int LDS_BYTES = 73728;
constexpr int GST = 72;
constexpr int SST = 136;

struct Params {
    const float* x; const float* c; const float* ctx; const float* c_ctx;
    const float* ada_w; const float* ada_b; const float* norm1_g; const float* norm2_g;
    const float* ffn_w_in; const float* ffn_w_out; const float* mix_w_in; const float* mix_w_out;
    const float* q_norm_g; const float* k_norm_g; const float* sgu_norm_g; const float* sgu_w; const float* sgu_b;
    const float* ssm_w_in; const float* ssm_conv_w; const float* ssm_conv_b; const float* ssm_dt_bias;
    const float* ssm_a_log; const float* ssm_d; const float* ssm_norm_g; const float* ssm_w_out;
    float* out; unsigned char* ws;
};

__device__ __forceinline__ int tid_() { int t = threadIdx.x; asm volatile("" : "+v"(t)); return t; }
__device__ __forceinline__ bf16_t f2bf(float f) {
    unsigned u = __float_as_uint(f);
    u += 0x7fffu + ((u >> 16) & 1u);
    return (bf16_t)(u >> 16);
}
__device__ __forceinline__ float bf2f(bf16_t h) { return __uint_as_float(((unsigned)h) << 16); }
__device__ __forceinline__ unsigned pack2(float a, float b) { unsigned r; asm volatile("v_cvt_pk_bf16_f32 %0, %1, %2" : "=v"(r) : "v"(a), "v"(b)); return r; }
__device__ __forceinline__ float siluf(float v) { return v / (1.f + __expf(-v)); }
__device__ __forceinline__ float geluf(float v) {
    const float u = 0.7978845608028654f * (v + 0.044715f * v * v * v);
    return v / (1.f + __expf(-2.f * u));
}
__device__ __forceinline__ float softplusf(float v) { return v > 20.f ? v : log1pf(expf(v)); }
__device__ __forceinline__ int seg_of(int row) { return row < SEQ ? 0 : (row < ML ? 1 : 2); }
__device__ __forceinline__ float* xrow(const Params& p, int row) {
    return row < ML ? p.out + (size_t)row * D : (float*)(p.ws + WS_XCTX) + (size_t)(row - ML) * D;
}
__device__ __forceinline__ void lds_sync() {
    __builtin_amdgcn_fence(__ATOMIC_RELEASE, "workgroup", "local");
    __builtin_amdgcn_s_barrier();
    __builtin_amdgcn_fence(__ATOMIC_ACQUIRE, "workgroup", "local");
}
typedef float f32x2 __attribute__((ext_vector_type(2)));
__device__ __forceinline__ f32x2 scan128(float s0, float s1, int lane, int dir) {
    if (dir == 0) {
#pragma unroll
        for (int o = 1; o < 64; o <<= 1) { const float t0 = __shfl_up(s0, o), t1 = __shfl_up(s1, o); s0 += lane >= o ? t0 : 0.f; s1 += lane >= o ? t1 : 0.f; }
        s1 += __shfl(s0, 63);
    } else {
#pragma unroll
        for (int o = 1; o < 64; o <<= 1) { const float t0 = __shfl_down(s0, o), t1 = __shfl_down(s1, o); s0 += lane + o < 64 ? t0 : 0.f; s1 += lane + o < 64 ? t1 : 0.f; }
        s0 += __shfl(s1, 0);
    }
    return (f32x2){s0, s1};
}
__device__ __forceinline__ f32x4 mfma16(bf16x8 a, bf16x8 b, f32x4 c) { return __builtin_amdgcn_mfma_f32_16x16x32_bf16(a, b, c, 0, 0, 0); }
__device__ __forceinline__ bf16x8 lds16(const bf16_t* p) { return *(const bf16x8*)p; }
__device__ __forceinline__ bf16x8 lds8x2(const bf16_t* p0, const bf16_t* p1) {
    const bf16x4 a = *(const bf16x4*)p0, b = *(const bf16x4*)p1;
    bf16x8 r; r[0] = a[0]; r[1] = a[1]; r[2] = a[2]; r[3] = a[3]; r[4] = b[0]; r[5] = b[1]; r[6] = b[2]; r[7] = b[3];
    return r;
}
__device__ __forceinline__ bf16x8 pack8(f32x4 a, f32x4 b) {
    u32x4 w; w.x = pack2(a[0], a[1]); w.y = pack2(a[2], a[3]); w.z = pack2(b[0], b[1]); w.w = pack2(b[2], b[3]);
    return __builtin_bit_cast(bf16x8, w);
}
__device__ __forceinline__ void st4bf(bf16_t* dst, float a, float b, float c, float d) {
    u32x2 w; w.x = pack2(a, b); w.y = pack2(c, d); *(u32x2*)dst = w;
}

template <int MI>
__device__ __forceinline__ void gemm_tile(const bf16_t* __restrict__ A, int lda, const bf16_t* __restrict__ W, int ldw, int K,
                                          f32x4 (&acc)[MI][8], bf16_t* sA, bf16_t* sW) {
    const int tid = tid_(), lane = tid & 63, wave = tid >> 6, l16 = lane & 15, quad = lane >> 4;
    const int srow = tid >> 3, skc = (tid & 7) * 8;
    const bf16_t* ap = A + (size_t)srow * lda + skc;
    const bf16_t* wp = W + (size_t)srow * ldw + skc;
    u32x4 ra[2 * MI], rw[4];
#pragma unroll
    for (int i = 0; i < 2 * MI; ++i) ra[i] = *(const u32x4*)(ap + (size_t)(i * 32) * lda);
#pragma unroll
    for (int i = 0; i < 4; ++i) rw[i] = *(const u32x4*)(wp + (size_t)(i * 32) * ldw);
#pragma unroll
    for (int i = 0; i < MI; ++i)
#pragma unroll
        for (int j = 0; j < 8; ++j) acc[i][j] = (f32x4){0.f, 0.f, 0.f, 0.f};
    const int nk = K >> 6;
    for (int kt = 0; kt < nk; ++kt) {
        lds_sync();
#pragma unroll
        for (int i = 0; i < 2 * MI; ++i) *(u32x4*)(sA + (srow + i * 32) * GST + skc) = ra[i];
#pragma unroll
        for (int i = 0; i < 4; ++i) *(u32x4*)(sW + (srow + i * 32) * GST + skc) = rw[i];
        lds_sync();
        if (kt + 1 < nk) {
            const int k0 = (kt + 1) << 6;
#pragma unroll
            for (int i = 0; i < 2 * MI; ++i) ra[i] = *(const u32x4*)(ap + (size_t)(i * 32) * lda + k0);
#pragma unroll
            for (int i = 0; i < 4; ++i) rw[i] = *(const u32x4*)(wp + (size_t)(i * 32) * ldw + k0);
        }
#pragma unroll
        for (int ks = 0; ks < 2; ++ks) {
            bf16x8 af[MI];
#pragma unroll
            for (int i = 0; i < MI; ++i) af[i] = lds16(sA + (wave * 16 * MI + i * 16 + l16) * GST + ks * 32 + quad * 8);
#pragma unroll
            for (int j = 0; j < 8; ++j) {
                const bf16x8 wf = lds16(sW + (j * 16 + l16) * GST + ks * 32 + quad * 8);
#pragma unroll
                for (int i = 0; i < MI; ++i) acc[i][j] = mfma16(wf, af[i], acc[i][j]);
            }
        }
    }
}

template <int MI>
__device__ __forceinline__ void epi_resid(const Params& p, int m0, int n0, const f32x4 (&acc)[MI][8], const float* gate  ) {
    const int lane = tid_() & 63, wave = tid_() >> 6, l16 = lane & 15, quad = lane >> 4;
#pragma unroll
    for (int i = 0; i < MI; ++i) {
        const int row = m0 + wave * 16 * MI + i * 16 + l16;
        float* xr = xrow(p, row);
        const float* g = gate + (size_t)seg_of(row) * 6144;
#pragma unroll
        for (int j = 0; j < 8; ++j) {
            const int col = n0 + j * 16 + quad * 4;
            const f32x4 gv = *(const f32x4*)(g + col);
            f32x4 xv = *(f32x4*)(xr + col);
            xv += gv * acc[i][j];
            *(f32x4*)(xr + col) = xv;
        }
    }
}

template <int MI>
__device__ __forceinline__ void epi_swiglu(const Params& p, int m0, int n0, const f32x4 (&acc)[MI][8]) {
    const int lane = tid_() & 63, wave = tid_() >> 6, l16 = lane & 15, quad = lane >> 4;
    bf16_t* hid = (bf16_t*)(p.ws + WS_HID);
#pragma unroll
    for (int i = 0; i < MI; ++i) {
        const int row = m0 + wave * 16 * MI + i * 16 + l16;
#pragma unroll
        for (int jj = 0; jj < 4; ++jj) {
            const f32x4 g = acc[i][2 * jj], u = acc[i][2 * jj + 1];
            const int hc = (n0 >> 1) + jj * 16 + quad * 4;
            st4bf(hid + (size_t)row * FFH + hc, siluf(g[0]) * u[0], siluf(g[1]) * u[1], siluf(g[2]) * u[2], siluf(g[3]) * u[3]);
        }
    }
}

template <int MI>
__device__ __forceinline__ void epi_mixin(const Params& p, int j2, int m0, int tn, f32x4 (&acc)[MI][8]) {
    const int lane = tid_() & 63, wave = tid_() >> 6, l16 = lane & 15, quad = lane >> 4;
    if (tn < 5) {
        const float* gsrc = (tn < 4 ? p.q_norm_g : p.k_norm_g) + j2 * 64;
        const float* cosT = (const float*)(p.ws + WS_ROPE);
        const float* sinT = cosT + 8192 * 32;
#pragma unroll
        for (int i = 0; i < MI; ++i) {
            const int row = m0 + wave * 16 * MI + i * 16 + l16;
#pragma unroll
            for (int hh = 0; hh < 2; ++hh) {
                float ss = 0.f;
#pragma unroll
                for (int j = 0; j < 4; ++j) { const f32x4 v = acc[i][hh * 4 + j]; ss += v[0] * v[0] + v[1] * v[1] + v[2] * v[2] + v[3] * v[3]; }
                ss += __shfl_xor(ss, 16); ss += __shfl_xor(ss, 32);
                const float rstd = rsqrtf(ss * (1.f / 64.f) + EPS);
                f32x4 y[4];
#pragma unroll
                for (int j = 0; j < 4; ++j) {
                    const f32x4 gv = *(const f32x4*)(gsrc + j * 16 + quad * 4);
                    y[j] = acc[i][hh * 4 + j] * rstd * gv;
                }
                if (row < ML) {
                    const int s = row & (SEQ - 1);
#pragma unroll
                    for (int j = 0; j < 2; ++j) {
                        const f32x4 cs = *(const f32x4*)(cosT + (size_t)s * 32 + j * 16 + quad * 4);
                        const f32x4 sn = *(const f32x4*)(sinT + (size_t)s * 32 + j * 16 + quad * 4);
                        const f32x4 x1 = y[j], x2 = y[j + 2];
                        y[j] = x1 * cs - x2 * sn;
                        y[j + 2] = x2 * cs + x1 * sn;
                    }
                }
                if (tn < 4) {
                    bf16_t* q = (bf16_t*)(p.ws + WS_Q) + (size_t)row * 512 + (tn * 2 + hh) * 64;
#pragma unroll
                    for (int j = 0; j < 4; ++j) st4bf(q + j * 16 + quad * 4, y[j][0] * 0.125f, y[j][1] * 0.125f, y[j][2] * 0.125f, y[j][3] * 0.125f);
                } else {
                    const int b = row < ML ? (row >> 13) : ((row - ML) >> 8);
                    const int t = row < ML ? CTX + (row & (SEQ - 1)) : ((row - ML) & (CTX - 1));
                    bf16_t* k = (bf16_t*)(p.ws + WS_K) + ((size_t)b * TALL + t) * 128 + hh * 64;
#pragma unroll
                    for (int j = 0; j < 4; ++j) st4bf(k + j * 16 + quad * 4, y[j][0], y[j][1], y[j][2], y[j][3]);
                }
            }
        }
    } else if (tn == 5) {
        bf16_t* vt = (bf16_t*)(p.ws + WS_VT);
#pragma unroll
        for (int i = 0; i < MI; ++i) {
            const int row = m0 + wave * 16 * MI + i * 16 + l16;
            const int b = row < ML ? (row >> 13) : ((row - ML) >> 8);
            const int t = row < ML ? CTX + (row & (SEQ - 1)) : ((row - ML) & (CTX - 1));
#pragma unroll
            for (int j = 0; j < 8; ++j) {
                const int kh = j >> 2;
#pragma unroll
                for (int r = 0; r < 4; ++r) {
                    const int d = (j & 3) * 16 + quad * 4 + r;
                    vt[((size_t)(b * 2 + kh) * 64 + d) * TALL + t] = f2bf(acc[i][j][r]);
                }
            }
        }
    } else if (tn < 10) {
        bf16_t* u = (bf16_t*)(p.ws + WS_U);
#pragma unroll
        for (int i = 0; i < MI; ++i) {
            const int row = m0 + wave * 16 * MI + i * 16 + l16;
#pragma unroll
            for (int j = 0; j < 8; ++j) {
                const f32x4 v = acc[i][j];
                st4bf(u + (size_t)row * 512 + (tn - 6) * 128 + j * 16 + quad * 4, geluf(v[0]), geluf(v[1]), geluf(v[2]), geluf(v[3]));
            }
        }
    } else {
        const int g = tn - 10;
        const float* gn = p.sgu_norm_g + j2 * 512 + g * 128;
        bf16_t* gvt = (bf16_t*)(p.ws + WS_GVT);
#pragma unroll
        for (int i = 0; i < MI; ++i) {
            const int row = m0 + wave * 16 * MI + i * 16 + l16;
            float ss = 0.f;
#pragma unroll
            for (int j = 0; j < 8; ++j) {
                f32x4 v = acc[i][j];
                v[0] = geluf(v[0]); v[1] = geluf(v[1]); v[2] = geluf(v[2]); v[3] = geluf(v[3]);
                acc[i][j] = v;
                ss += v[0] * v[0] + v[1] * v[1] + v[2] * v[2] + v[3] * v[3];
            }
            ss += __shfl_xor(ss, 16); ss += __shfl_xor(ss, 32);
            const float rstd = rsqrtf(ss * (1.f / 128.f) + EPS);
            const int chunk = row >> 7, pt = row & 127;
#pragma unroll
            for (int j = 0; j < 8; ++j) {
                const f32x4 gv = *(const f32x4*)(gn + j * 16 + quad * 4);
#pragma unroll
                for (int r = 0; r < 4; ++r) {
                    const int cc = g * 128 + j * 16 + quad * 4 + r;
                    gvt[((size_t)chunk * 512 + cc) * 128 + pt] = f2bf(acc[i][j][r] * rstd * gv[r]);
                }
            }
        }
    }
}

template <int MI>
__device__ __forceinline__ void epi_ssmin(const Params& p, int j2, int m0, int tn, const f32x4 (&acc)[MI][8]) {
    const int lane = tid_() & 63, wave = tid_() >> 6, l16 = lane & 15, quad = lane >> 4;
#pragma unroll
    for (int i = 0; i < MI; ++i) {
        const int row = m0 + wave * 16 * MI + i * 16 + l16;
        if (tn < 16) {
            bf16_t* z = (bf16_t*)(p.ws + WS_Z) + (size_t)row * 2048 + tn * 128;
#pragma unroll
            for (int j = 0; j < 8; ++j) { const f32x4 v = acc[i][j]; st4bf(z + j * 16 + quad * 4, siluf(v[0]), siluf(v[1]), siluf(v[2]), siluf(v[3])); }
        } else if (tn < 40) {
            bf16_t* xb = (bf16_t*)(p.ws + WS_XBC) + (size_t)row * 3072 + (tn - 16) * 128;
#pragma unroll
            for (int j = 0; j < 8; ++j) { const f32x4 v = acc[i][j]; st4bf(xb + j * 16 + quad * 4, v[0], v[1], v[2], v[3]); }
        } else {
            float* dt = (float*)(p.ws + WS_DT) + (size_t)row * 64;
            const float* bias = p.ssm_dt_bias + j2 * 64;
#pragma unroll
            for (int j = 0; j < 4; ++j) {
                const int c = j * 16 + quad * 4;
                const f32x4 v = acc[i][j];
                f32x4 o;
                o[0] = softplusf(v[0] + bias[c + 0]); o[1] = softplusf(v[1] + bias[c + 1]);
                o[2] = softplusf(v[2] + bias[c + 2]); o[3] = softplusf(v[3] + bias[c + 3]);
                *(f32x4*)(dt + c) = o;
            }
        }
    }
}

enum { G_MIXIN = 0, G_MIXOUT, G_SSMIN, G_SSMOUT, G_FFNIN, G_FFNOUT };

template <int KIND>
__device__ void gemm_phase(const Params& p, int layer, bf16_t* smem) {
    const int j2 = layer >> 1;
    const bf16_t* A; const bf16_t* W; int lda, K, N;
    const unsigned char* wt = p.ws + WS_WT;
    if (KIND == G_MIXIN) { A = (const bf16_t*)(p.ws + WS_HN); lda = 1024; W = (const bf16_t*)(wt + WT_MIXIN); K = 1024; N = MIXIN; }
    else if (KIND == G_MIXOUT) { A = (const bf16_t*)(p.ws + WS_AS); lda = 1024; W = (const bf16_t*)(wt + WT_MIXOUT); K = 1024; N = 1024; }
    else if (KIND == G_SSMIN) { A = (const bf16_t*)(p.ws + WS_HN); lda = 1024; W = (const bf16_t*)(wt + WT_MIXIN); K = 1024; N = SSMIN_PAD; }
    else if (KIND == G_SSMOUT) { A = (const bf16_t*)(p.ws + WS_YF); lda = 2048; W = (const bf16_t*)(wt + WT_MIXOUT); K = 2048; N = 1024; }
    else if (KIND == G_FFNIN) { A = (const bf16_t*)(p.ws + WS_HN); lda = 1024; W = (const bf16_t*)(wt + WT_FFNIN); K = 1024; N = 2 * FFH; }
    else { A = (const bf16_t*)(p.ws + WS_HID); lda = FFH; W = (const bf16_t*)(wt + WT_FFNOUT); K = FFH; N = 1024; }
    const int ldw = K;
    constexpr int MI = (KIND == G_MIXIN) ? 2 : 4;
    const int nN = N >> 7, nM = MT / (64 * MI);
    const float* mod = (const float*)(p.ws + WS_MOD) + (size_t)layer * 3 * 6144;
    bf16_t* sA = smem; bf16_t* sW = smem + 64 * MI * GST;
    for (int t = blockIdx.x; t < nM * nN; t += gridDim.x) {
        const int tm = t / nN, tn = t - tm * nN;
        f32x4 acc[MI][8];
        gemm_tile<MI>(A + (size_t)tm * (64 * MI) * lda, lda, W + (size_t)tn * 128 * ldw, ldw, K, acc, sA, sW);
        if (KIND == G_MIXIN) epi_mixin<MI>(p, j2, tm * (64 * MI), tn, acc);
        else if (KIND == G_MIXOUT || KIND == G_SSMOUT) epi_resid<MI>(p, tm * (64 * MI), tn * 128, acc, mod + 2 * 1024);
        else if (KIND == G_SSMIN) epi_ssmin<MI>(p, j2, tm * (64 * MI), tn, acc);
        else if (KIND == G_FFNIN) epi_swiglu<MI>(p, tm * (64 * MI), tn * 128, acc);
        else epi_resid<MI>(p, tm * (64 * MI), tn * 128, acc, mod + 5 * 1024);
    }
}

__device__ void norm_phase(const Params& p, int layer, int which) {
    const int lane = tid_() & 63, wave = tid_() >> 6;
    const float* g = (which ? p.norm2_g : p.norm1_g) + layer * 1024;
    const float* mod = (const float*)(p.ws + WS_MOD) + (size_t)layer * 3 * 6144;
    bf16_t* hn = (bf16_t*)(p.ws + WS_HN);
    for (int row = blockIdx.x * 4 + wave; row < MT; row += gridDim.x * 4) {
        const float* xr = xrow(p, row);
        f32x4 v[4]; float ss = 0.f;
#pragma unroll
        for (int i = 0; i < 4; ++i) { v[i] = *(const f32x4*)(xr + i * 256 + lane * 4); ss += v[i][0] * v[i][0] + v[i][1] * v[i][1] + v[i][2] * v[i][2] + v[i][3] * v[i][3]; }
#pragma unroll
        for (int o = 1; o < 64; o <<= 1) ss += __shfl_xor(ss, o);
        const float rstd = rsqrtf(ss * (1.f / 1024.f) + EPS);
        const float* m = mod + (size_t)seg_of(row) * 6144 + (which ? 3 * 1024 : 0);
#pragma unroll
        for (int i = 0; i < 4; ++i) {
            const int col = i * 256 + lane * 4;
            const f32x4 gv = *(const f32x4*)(g + col), sh = *(const f32x4*)(m + col), sc = *(const f32x4*)(m + 1024 + col);
            const f32x4 y = (v[i] * rstd * gv) * (sc + 1.f) + sh;
            st4bf(hn + (size_t)row * 1024 + col, y[0], y[1], y[2], y[3]);
        }
    }
}

__device__ void convert_wt(const float* __restrict__ W, int K, int N, bf16_t* __restrict__ Wt, int mode, float* tile) {
    const int tid = tid_();
    const int nKt = K >> 6, nNt = N >> 6;
    for (int t = blockIdx.x; t < nKt * nNt; t += gridDim.x) {
        const int kt = t / nNt, nt = t - kt * nNt;
        lds_sync();
#pragma unroll
        for (int i = 0; i < 16; ++i) {
            const int kk = (tid >> 6) + i * 4, nn = tid & 63;
            tile[kk * 65 + nn] = W[(size_t)(kt * 64 + kk) * N + nt * 64 + nn];
        }
        lds_sync();
#pragma unroll
        for (int i = 0; i < 16; ++i) {
            const int nn = (tid >> 6) + i * 4, kk = tid & 63;
            const int n = nt * 64 + nn;
            int dr = n;
            if (mode == 1) { const int hm = n < FFH ? n : n - FFH; dr = (hm >> 4) * 32 + (hm & 15) + (n < FFH ? 0 : 16); }
            Wt[(size_t)dr * K + kt * 64 + kk] = f2bf(tile[kk * 65 + nn]);
        }
    }
}

__device__ void convert_layer_weights(const Params& p, int layer, float* tile) {
    unsigned char* wt = p.ws + WS_WT;
    const int j2 = layer >> 1;
    convert_wt(p.ffn_w_in + (size_t)layer * 1024 * 2 * FFH, 1024, 2 * FFH, (bf16_t*)(wt + WT_FFNIN), 1, tile);
    convert_wt(p.ffn_w_out + (size_t)layer * FFH * 1024, FFH, 1024, (bf16_t*)(wt + WT_FFNOUT), 0, tile);
    if ((layer & 1) == 0) {
        convert_wt(p.mix_w_in + (size_t)j2 * 1024 * MIXIN, 1024, MIXIN, (bf16_t*)(wt + WT_MIXIN), 0, tile);
        convert_wt(p.mix_w_out + (size_t)j2 * 1024 * 1024, 1024, 1024, (bf16_t*)(wt + WT_MIXOUT), 0, tile);
    } else {
        convert_wt(p.ssm_w_in + (size_t)j2 * 1024 * SSMIN, 1024, SSMIN, (bf16_t*)(wt + WT_MIXIN), 0, tile);
        convert_wt(p.ssm_w_out + (size_t)j2 * SSI * 1024, SSI, 1024, (bf16_t*)(wt + WT_MIXOUT), 0, tile);
        bf16_t* padp = (bf16_t*)(wt + WT_MIXIN) + (size_t)SSMIN * 1024;
        for (int i = blockIdx.x * 256 + tid_(); i < (SSMIN_PAD - SSMIN) * 1024; i += gridDim.x * 256) padp[i] = 0;
    }
}

__device__ void prologue(const Params& p, float* smf) {
    const int tid = tid_();
    const size_t gtid = (size_t)blockIdx.x * 256 + tid, gsz = (size_t)gridDim.x * 256;
    {
        const f32x4* s = (const f32x4*)p.x; f32x4* d = (f32x4*)p.out;
        for (size_t i = gtid; i < (size_t)ML * D / 4; i += gsz) d[i] = s[i];
        const f32x4* s2 = (const f32x4*)p.ctx; f32x4* d2 = (f32x4*)(p.ws + WS_XCTX);
        for (size_t i = gtid; i < (size_t)MC * D / 4; i += gsz) d2[i] = s2[i];
    }
    {
        float* cosT = (float*)(p.ws + WS_ROPE); float* sinT = cosT + 8192 * 32;
        for (size_t i = gtid; i < (size_t)8192 * 32; i += gsz) {
            const int s = (int)(i >> 5), j = (int)(i & 31), f = j & 15;
            const float inv = powf(10000.f, -(float)f / 16.f);
            const float pos = (float)(j < 16 ? (s >> 6) : (s & 63));
            const float ang = pos * inv;
            cosT[i] = cosf(ang); sinT[i] = sinf(ang);
        }
    }
    {
        bf16_t* sgw = (bf16_t*)(p.ws + WS_SGW);
        for (size_t i = gtid; i < (size_t)2 * 4 * 128 * 128; i += gsz) sgw[i] = f2bf(p.sgu_w[i]);
    }
    {
        float* sc = smf;
        float* red = smf + 3 * 1024;
        lds_sync();
        for (int i = tid; i < 3 * 1024; i += 256) {
            const int sgi = i >> 10, k = i & 1023;
            const float v = sgi < 2 ? p.c[sgi * 1024 + k] : p.c_ctx[k];
            sc[i] = siluf(v);
        }
        lds_sync();
        float* mod = (float*)(p.ws + WS_MOD);
        const int cl = tid & 63, kg = tid >> 6;
        for (int wi = blockIdx.x; wi < 4 * 96; wi += gridDim.x) {
            const int layer = wi / 96, cb = wi - layer * 96;
            const float* w = p.ada_w + (size_t)layer * 1024 * 6144 + cb * 64 + cl;
            float s0 = 0.f, s1 = 0.f, s2 = 0.f;
            for (int k = kg * 256; k < kg * 256 + 256; ++k) {
                const float wv = w[(size_t)k * 6144];
                s0 += sc[k] * wv; s1 += sc[1024 + k] * wv; s2 += sc[2048 + k] * wv;
            }
            lds_sync();
            red[(kg * 3 + 0) * 64 + cl] = s0; red[(kg * 3 + 1) * 64 + cl] = s1; red[(kg * 3 + 2) * 64 + cl] = s2;
            lds_sync();
            if (tid < 192) {
                const int sgi = tid >> 6;
                const float v = red[(0 * 3 + sgi) * 64 + cl] + red[(1 * 3 + sgi) * 64 + cl] + red[(2 * 3 + sgi) * 64 + cl] + red[(3 * 3 + sgi) * 64 + cl];
                const int n = cb * 64 + cl;
                mod[((size_t)layer * 3 + sgi) * 6144 + n] = v + p.ada_b[layer * 6144 + n];
            }
        }
        lds_sync();
    }
    convert_layer_weights(p, 0, smf);
}

__device__ void attn_item(const Params& p, int b, int h, int q0row, int nkeys, bf16_t* smem) {
    const int tid = tid_(), lane = tid & 63, wave = tid >> 6, l16 = lane & 15, quad = lane >> 4;
    const int kh = h >> 2;
    const bf16_t* Q = (const bf16_t*)(p.ws + WS_Q);
    const bf16_t* Kb = (const bf16_t*)(p.ws + WS_K) + (size_t)b * TALL * 128 + kh * 64;
    const bf16_t* Vb = (const bf16_t*)(p.ws + WS_VT) + (size_t)(b * 2 + kh) * 64 * TALL;
    bf16_t* sK = smem; bf16_t* sV = smem + 64 * GST;
    bf16x8 qf[2][2];
#pragma unroll
    for (int i = 0; i < 2; ++i)
#pragma unroll
        for (int ks = 0; ks < 2; ++ks)
            qf[i][ks] = *(const bf16x8*)(Q + (size_t)(q0row + wave * 32 + i * 16 + l16) * 512 + h * 64 + ks * 32 + quad * 8);
    f32x4 o[4][2];
#pragma unroll
    for (int d = 0; d < 4; ++d)
#pragma unroll
        for (int i = 0; i < 2; ++i) o[d][i] = (f32x4){0.f, 0.f, 0.f, 0.f};
    float mrun[2] = {-INFINITY, -INFINITY}, lrun[2] = {0.f, 0.f};
    const int srow = tid >> 3, skc = (tid & 7) * 8;
    u32x4 rk[2], rv[2];
#pragma unroll
    for (int i = 0; i < 2; ++i) {
        rk[i] = *(const u32x4*)(Kb + (size_t)(srow + i * 32) * 128 + skc);
        rv[i] = *(const u32x4*)(Vb + (size_t)(srow + i * 32) * TALL + skc);
    }
    const int nt = nkeys >> 6;
    constexpr float LOG2E = 1.4426950408889634f;
    for (int kt = 0; kt < nt; ++kt) {
        lds_sync();
#pragma unroll
        for (int i = 0; i < 2; ++i) {
            *(u32x4*)(sK + (srow + i * 32) * GST + skc) = rk[i];
            *(u32x4*)(sV + (srow + i * 32) * GST + skc) = rv[i];
        }
        lds_sync();
        if (kt + 1 < nt) {
            const int t0 = (kt + 1) << 6;
#pragma unroll
            for (int i = 0; i < 2; ++i) {
                rk[i] = *(const u32x4*)(Kb + (size_t)(t0 + srow + i * 32) * 128 + skc);
                rv[i] = *(const u32x4*)(Vb + (size_t)(srow + i * 32) * TALL + t0 + skc);
            }
        }
        f32x4 s[4][2];
#pragma unroll
        for (int tt = 0; tt < 4; ++tt)
#pragma unroll
            for (int i = 0; i < 2; ++i) s[tt][i] = (f32x4){0.f, 0.f, 0.f, 0.f};
#pragma unroll
        for (int ks = 0; ks < 2; ++ks)
#pragma unroll
            for (int tt = 0; tt < 4; ++tt) {
                const bf16x8 kf = lds16(sK + (tt * 16 + l16) * GST + ks * 32 + quad * 8);
#pragma unroll
                for (int i = 0; i < 2; ++i) s[tt][i] = mfma16(kf, qf[i][ks], s[tt][i]);
            }
        bf16x8 pf[2][2];
#pragma unroll
        for (int i = 0; i < 2; ++i) {
            float mx = -INFINITY;
#pragma unroll
            for (int tt = 0; tt < 4; ++tt) mx = fmaxf(mx, fmaxf(fmaxf(s[tt][i][0], s[tt][i][1]), fmaxf(s[tt][i][2], s[tt][i][3])));
            mx = fmaxf(mx, __shfl_xor(mx, 16)); mx = fmaxf(mx, __shfl_xor(mx, 32));
            const float mnew = fmaxf(mrun[i], mx);
            const float alpha = __builtin_amdgcn_exp2f((mrun[i] - mnew) * LOG2E);
            mrun[i] = mnew;
            const float mb = mnew * LOG2E;
            float ls = 0.f;
#pragma unroll
            for (int tt = 0; tt < 4; ++tt) {
#pragma unroll
                for (int r = 0; r < 4; ++r) { const float e = __builtin_amdgcn_exp2f(s[tt][i][r] * LOG2E - mb); s[tt][i][r] = e; ls += e; }
            }
            lrun[i] = lrun[i] * alpha + ls;
#pragma unroll
            for (int d = 0; d < 4; ++d) o[d][i] *= alpha;
#pragma unroll
            for (int ksp = 0; ksp < 2; ++ksp) pf[ksp][i] = pack8(s[2 * ksp][i], s[2 * ksp + 1][i]);
        }
#pragma unroll
        for (int ksp = 0; ksp < 2; ++ksp)
#pragma unroll
            for (int d = 0; d < 4; ++d) {
                const bf16_t* vp = sV + (d * 16 + l16) * GST + ksp * 32 + quad * 4;
                const bf16x8 vf = lds8x2(vp, vp + 16);
#pragma unroll
                for (int i = 0; i < 2; ++i) o[d][i] = mfma16(vf, pf[ksp][i], o[d][i]);
            }
    }
    bf16_t* as = (bf16_t*)(p.ws + WS_AS);
#pragma unroll
    for (int i = 0; i < 2; ++i) {
        float l = lrun[i];
        l += __shfl_xor(l, 16); l += __shfl_xor(l, 32);
        const float inv = 1.f / l;
        const int row = q0row + wave * 32 + i * 16 + l16;
#pragma unroll
        for (int d = 0; d < 4; ++d)
            st4bf(as + (size_t)row * 1024 + h * 64 + d * 16 + quad * 4, o[d][i][0] * inv, o[d][i][1] * inv, o[d][i][2] * inv, o[d][i][3] * inv);
    }
}

__device__ void sg_item(const Params& p, int j2, int chunk, int g, bf16_t* smem) {
    const int lane = tid_() & 63, wave = tid_() >> 6, l16 = lane & 15, quad = lane >> 4;
    const bf16_t* A = (const bf16_t*)(p.ws + WS_SGW) + (size_t)(j2 * 4 + g) * 128 * 128;
    const bf16_t* W = (const bf16_t*)(p.ws + WS_GVT) + ((size_t)chunk * 512 + g * 128) * 128;
    f32x4 acc[2][8];
    gemm_tile<2>(A, 128, W, 128, 128, acc, smem, smem + 128 * GST);
    const bf16_t* u = (const bf16_t*)(p.ws + WS_U);
    bf16_t* as = (bf16_t*)(p.ws + WS_AS);
    const float* bs = p.sgu_b + (size_t)(j2 * 4 + g) * 128;
#pragma unroll
    for (int i = 0; i < 2; ++i) {
        const int pt = wave * 32 + i * 16 + l16;
        const int row = chunk * 128 + pt;
        const float bias = bs[pt];
#pragma unroll
        for (int j = 0; j < 8; ++j) {
            const int c = g * 128 + j * 16 + quad * 4;
            const u32x2 uw = *(const u32x2*)(u + (size_t)row * 512 + c);
            const float u0 = __uint_as_float(uw.x << 16), u1 = __uint_as_float(uw.x & 0xffff0000u);
            const float u2 = __uint_as_float(uw.y << 16), u3 = __uint_as_float(uw.y & 0xffff0000u);
            const f32x4 v = acc[i][j];
            st4bf(as + (size_t)row * 1024 + 512 + c, u0 * (v[0] + bias), u1 * (v[1] + bias), u2 * (v[2] + bias), u3 * (v[3] + bias));
        }
    }
}

__device__ void attn_sg_phase(const Params& p, int layer, bf16_t* smem) {
    const int j2 = layer >> 1;
    const int nA = NB * 8 * 64, nS = (MT / 128) * 4, nC = NB * 8 * 2;
    for (int t = blockIdx.x; t < nA + nS + nC; t += gridDim.x) {
        if (t < nA) {
            const int qb = t & 63, h = (t >> 6) & 7, b = t >> 9;
            attn_item(p, b, h, b * SEQ + qb * 128, TALL, smem);
        } else if (t < nA + nS) {
            const int u = t - nA;
            sg_item(p, j2, u >> 2, u & 3, smem);
        } else {
            const int u = t - nA - nS;
            const int qb = u & 1, h = (u >> 1) & 7, b = u >> 4;
            attn_item(p, b, h, ML + b * CTX + qb * 128, CTX, smem);
        }
    }
}

__device__ void conv_phase(const Params& p, int layer, float* smf) {
    const int j2 = layer >> 1, tid = tid_();
    const bf16_t* xbc = (const bf16_t*)(p.ws + WS_XBC);
    bf16_t* XT = (bf16_t*)(p.ws + WS_XT); bf16_t* Bn = (bf16_t*)(p.ws + WS_BN); bf16_t* Cn = (bf16_t*)(p.ws + WS_CN); bf16_t* BT = (bf16_t*)(p.ws + WS_BT);
    const float* cw = p.ssm_conv_w + (size_t)j2 * 3 * 3072;
    const float* cb = p.ssm_conv_b + (size_t)j2 * 3072;
    float* sin_ = smf;
    float* sout = smf + 66 * 65;
    const int nCt = 3072 / 64, nRt = MT / 64;
    for (int t = blockIdx.x; t < nCt * nRt; t += gridDim.x) {
        const int rt = t / nCt, ct = t - rt * nCt;
        const int r0 = rt * 64, c0 = ct * 64;
        const bool first = r0 < ML ? ((r0 & (SEQ - 1)) == 0) : (((r0 - ML) & (CTX - 1)) == 0);
        const bool last = r0 < ML ? (((r0 + 64) & (SEQ - 1)) == 0) : ((((r0 + 64) - ML) & (CTX - 1)) == 0);
        lds_sync();
        for (int e = tid; e < 66 * 64; e += 256) {
            const int rr = e >> 6, c = e & 63;
            const int row = r0 - 1 + rr;
            float v = 0.f;
            if (!((rr == 0 && first) || (rr == 65 && last))) v = bf2f(xbc[(size_t)row * 3072 + c0 + c]);
            sin_[rr * 65 + c] = v;
        }
        lds_sync();
        {
            const int c = tid & 63;
            const float w0 = cw[c0 + c], w1 = cw[3072 + c0 + c], w2 = cw[2 * 3072 + c0 + c], bb = cb[c0 + c];
#pragma unroll
            for (int k = 0; k < 16; ++k) {
                const int tt = (tid >> 6) + k * 4;
                const float v = w0 * sin_[tt * 65 + c] + w1 * sin_[(tt + 1) * 65 + c] + w2 * sin_[(tt + 2) * 65 + c] + bb;
                const float y = siluf(v);
                sout[c * 65 + tt] = y;
                if (c0 >= 2048) {
                    if (c0 < 2560) Bn[(size_t)(r0 + tt) * 512 + (c0 - 2048) + c] = f2bf(y);
                    else Cn[(size_t)(r0 + tt) * 512 + (c0 - 2560) + c] = f2bf(y);
                }
            }
        }
        lds_sync();
        if (c0 < 2560) {
            bf16_t* dst = c0 < 2048 ? XT + (size_t)c0 * MT : BT + (size_t)(c0 - 2048) * MT;
            const int tt = tid & 63;
#pragma unroll
            for (int k = 0; k < 16; ++k) {
                const int c = (tid >> 6) + k * 4;
                dst[(size_t)c * MT + r0 + tt] = f2bf(sout[c * 65 + tt]);
            }
        }
    }
}

__device__ void ssd_diag_item(const Params& p, int j2, int row0, int h, bf16_t* smem) {
    const int tid = tid_(), lane = tid & 63, wave = tid >> 6, l16 = lane & 15, quad = lane >> 4;
    const int g = h >> 3;
    bf16_t* sB = smem;
    bf16_t* sX = sB + 128 * SST;
    float* sda = (float*)(sX + 64 * SST);
    float* sPf = sda + 256;
    float* sRb = sPf + 128;
    float* sdtf = sRb + 128;
    float* sdtb = sdtf + 128;
    const bf16_t* XT = (const bf16_t*)(p.ws + WS_XT) + (size_t)(h * 64) * MT;
    const bf16_t* Bn = (const bf16_t*)(p.ws + WS_BN) + g * 128;
    const bf16_t* Cn = (const bf16_t*)(p.ws + WS_CN) + g * 128;
    const float* DT = (const float*)(p.ws + WS_DT);
    bf16_t* Y = (bf16_t*)(p.ws + WS_YF);
    const float af = -expf(p.ssm_a_log[(j2 * 2 + 0) * 32 + h]);
    const float ab = -expf(p.ssm_a_log[(j2 * 2 + 1) * 32 + h]);
    const float dsk = p.ssm_d[j2 * 32 + h];
    lds_sync();
#pragma unroll
    for (int i = 0; i < 8; ++i) {
        const int c = tid + i * 256, r = c >> 4, kc = (c & 15) * 8;
        *(u32x4*)(sB + r * SST + kc) = *(const u32x4*)(Bn + (size_t)(row0 + r) * 512 + kc);
    }
#pragma unroll
    for (int i = 0; i < 4; ++i) {
        const int c = tid + i * 256, r = c >> 4, kc = (c & 15) * 8;
        *(u32x4*)(sX + r * SST + kc) = *(const u32x4*)(XT + (size_t)r * MT + row0 + kc);
    }
    {
        const int d = wave >> 1;
        const float d0 = DT[(size_t)(row0 + lane) * 64 + d * 32 + h], d1 = DT[(size_t)(row0 + 64 + lane) * 64 + d * 32 + h];
        const float aa = d ? ab : af;
        const f32x2 sc2 = scan128(d0 * aa, d1 * aa, lane, d);
        float* sc = d ? sRb : sPf; float* sd = d ? sdtb : sdtf;
        if ((wave & 1) == 0) { sc[lane] = sc2.x; sd[lane] = d0; } else { sc[64 + lane] = sc2.y; sd[64 + lane] = d1; }
    }
    bf16x8 cf[2][4];
#pragma unroll
    for (int i = 0; i < 2; ++i)
#pragma unroll
        for (int ks = 0; ks < 4; ++ks)
            cf[i][ks] = *(const bf16x8*)(Cn + (size_t)(row0 + wave * 32 + i * 16 + l16) * 512 + ks * 32 + quad * 8);
    lds_sync();
    float pfl[2], rbl[2];
#pragma unroll
    for (int i = 0; i < 2; ++i) { pfl[i] = sPf[wave * 32 + i * 16 + l16]; rbl[i] = sRb[wave * 32 + i * 16 + l16]; }
    f32x4 y[4][2];
#pragma unroll
    for (int pt = 0; pt < 4; ++pt)
#pragma unroll
        for (int i = 0; i < 2; ++i) y[pt][i] = (f32x4){0.f, 0.f, 0.f, 0.f};
#pragma unroll 1
    for (int sp = 0; sp < 4; ++sp) {
        f32x4 gt[2][2];
#pragma unroll
        for (int s2 = 0; s2 < 2; ++s2)
#pragma unroll
            for (int i = 0; i < 2; ++i) gt[s2][i] = (f32x4){0.f, 0.f, 0.f, 0.f};
#pragma unroll
        for (int ks = 0; ks < 4; ++ks)
#pragma unroll
            for (int s2 = 0; s2 < 2; ++s2) {
                const bf16x8 bfr = lds16(sB + (sp * 32 + s2 * 16 + l16) * SST + ks * 32 + quad * 8);
#pragma unroll
                for (int i = 0; i < 2; ++i) gt[s2][i] = mfma16(bfr, cf[i][ks], gt[s2][i]);
            }
        bf16x8 mf[2];
#pragma unroll
        for (int i = 0; i < 2; ++i) {
            const int l = wave * 32 + i * 16 + l16;
#pragma unroll
            for (int s2 = 0; s2 < 2; ++s2)
#pragma unroll
                for (int r = 0; r < 4; ++r) {
                    const int s = sp * 32 + s2 * 16 + quad * 4 + r;
                    const float arg = s < l ? (pfl[i] - sPf[s]) : (rbl[i] - sRb[s]);
                    float coef = __expf(fminf(arg, 0.f)) * (s < l ? sdtf[s] : sdtb[s]);
                    if (s == l) coef = sdtf[s] + sdtb[s];
                    gt[s2][i][r] *= coef;
                }
            mf[i] = pack8(gt[0][i], gt[1][i]);
        }
#pragma unroll
        for (int pt = 0; pt < 4; ++pt) {
            const bf16_t* xp = sX + (pt * 16 + l16) * SST + sp * 32 + quad * 4;
            const bf16x8 xf = lds8x2(xp, xp + 16);
#pragma unroll
            for (int i = 0; i < 2; ++i) y[pt][i] = mfma16(xf, mf[i], y[pt][i]);
        }
    }
#pragma unroll
    for (int i = 0; i < 2; ++i) {
        const int l = wave * 32 + i * 16 + l16;
#pragma unroll
        for (int pt = 0; pt < 4; ++pt) {
            f32x4 v = y[pt][i];
#pragma unroll
            for (int r = 0; r < 4; ++r) v[r] += dsk * bf2f(sX[(pt * 16 + quad * 4 + r) * SST + l]);
            st4bf(Y + (size_t)(row0 + l) * 2048 + h * 64 + pt * 16 + quad * 4, v[0], v[1], v[2], v[3]);
        }
    }
}

__device__ void ssd_diag_phase(const Params& p, int layer, bf16_t* smem) {
    const int j2 = layer >> 1;
    for (int t = blockIdx.x; t < (MT / 128) * 32; t += gridDim.x) {
        const int h = t & 31, chunk = t >> 5;
        ssd_diag_item(p, j2, chunk * 128, h, smem);
    }
}

struct SsdPre { u32x4 xq; u32x4 bt[2][4]; u32x4 cf[2][4]; u32x2 yold[2]; float dt0, dt1; };

__device__ __forceinline__ int ssd_row0(int b, int dir, int cc) {
    if (cc < 2) { const int ci = dir ? 1 - cc : cc; return ML + b * CTX + ci * 128; }
    const int k = cc - 2; const int ci = dir ? 63 - k : k; return b * SEQ + ci * 128;
}

__device__ void ssd_scan_item(const Params& p, int j2, int b, int dir, int h, int pq, bf16_t* smem) {
    const int tid = tid_(), lane = tid & 63, wave = tid >> 6, l16 = lane & 15, quad = lane >> 4;
    const int g = h >> 3;
    bf16_t* sX = smem;
    bf16_t* sH = sX + 16 * SST;
    float* sacs = (float*)(sH + 16 * SST);
    float* sdt = sacs + 128;
    const bf16_t* XT = (const bf16_t*)(p.ws + WS_XT) + (size_t)(h * 64 + pq * 16 + (tid >> 4)) * MT + (tid & 15) * 8;
    const bf16_t* Cn = (const bf16_t*)(p.ws + WS_CN) + g * 128 + (size_t)(wave * 32 + l16) * 512 + quad * 8;
    const bf16_t* BT = (const bf16_t*)(p.ws + WS_BT) + (size_t)(g * 128 + wave * 32 + l16) * MT + quad * 8;
    const float* DT = (const float*)(p.ws + WS_DT) + dir * 32 + h;
    bf16_t* Y = (bf16_t*)(p.ws + (dir ? WS_YB : WS_YF)) + (size_t)(wave * 32 + l16) * 2048 + h * 64 + pq * 16 + quad * 4;
    const float a = -expf(p.ssm_a_log[(j2 * 2 + dir) * 32 + h]);
    f32x4 st[2];
    st[0] = (f32x4){0.f, 0.f, 0.f, 0.f}; st[1] = (f32x4){0.f, 0.f, 0.f, 0.f};
    SsdPre nx;
    {
        const int row0 = ssd_row0(b, dir, 0);
        nx.xq = *(const u32x4*)(XT + row0);
#pragma unroll
        for (int nt = 0; nt < 2; ++nt)
#pragma unroll
            for (int ks = 0; ks < 4; ++ks) nx.bt[nt][ks] = *(const u32x4*)(BT + (size_t)(nt * 16) * MT + row0 + ks * 32);
#pragma unroll
        for (int i = 0; i < 2; ++i)
#pragma unroll
            for (int ks = 0; ks < 4; ++ks) nx.cf[i][ks] = *(const u32x4*)(Cn + (size_t)(row0 + i * 16) * 512 + ks * 32);
#pragma unroll
        for (int i = 0; i < 2; ++i) nx.yold[i] = dir == 0 ? *(const u32x2*)(Y + (size_t)(row0 + i * 16) * 2048) : (u32x2){0u, 0u};
        nx.dt0 = DT[(size_t)(row0 + lane) * 64]; nx.dt1 = DT[(size_t)(row0 + 64 + lane) * 64];
    }
#pragma unroll 1
    for (int cc = 0; cc < 66; ++cc) {
        const int row0 = ssd_row0(b, dir, cc);
        const SsdPre cu = nx;
        lds_sync();
        *(u32x4*)(sX + (tid >> 4) * SST + (tid & 15) * 8) = cu.xq;
#pragma unroll
        for (int nt = 0; nt < 2; ++nt) st4bf(sH + l16 * SST + wave * 32 + nt * 16 + quad * 4, st[nt][0], st[nt][1], st[nt][2], st[nt][3]);
        if (wave < 2) {
            const f32x2 sc2 = scan128(cu.dt0 * a, cu.dt1 * a, lane, dir);
            if (wave == 0) { sacs[lane] = sc2.x; sdt[lane] = cu.dt0; } else { sacs[64 + lane] = sc2.y; sdt[64 + lane] = cu.dt1; }
        }
        lds_sync();
        if (cc + 1 < 66) {
            const int r1 = ssd_row0(b, dir, cc + 1);
            nx.xq = *(const u32x4*)(XT + r1);
#pragma unroll
            for (int nt = 0; nt < 2; ++nt)
#pragma unroll
                for (int ks = 0; ks < 4; ++ks) nx.bt[nt][ks] = *(const u32x4*)(BT + (size_t)(nt * 16) * MT + r1 + ks * 32);
#pragma unroll
            for (int i = 0; i < 2; ++i)
#pragma unroll
                for (int ks = 0; ks < 4; ++ks) nx.cf[i][ks] = *(const u32x4*)(Cn + (size_t)(r1 + i * 16) * 512 + ks * 32);
#pragma unroll
            for (int i = 0; i < 2; ++i) nx.yold[i] = dir == 0 ? *(const u32x2*)(Y + (size_t)(r1 + i * 16) * 2048) : (u32x2){0u, 0u};
            nx.dt0 = DT[(size_t)(r1 + lane) * 64]; nx.dt1 = DT[(size_t)(r1 + 64 + lane) * 64];
        }
        const float total = dir == 0 ? sacs[127] : sacs[0];
        f32x4 yo[2];
        yo[0] = (f32x4){0.f, 0.f, 0.f, 0.f}; yo[1] = (f32x4){0.f, 0.f, 0.f, 0.f};
#pragma unroll
        for (int ks = 0; ks < 4; ++ks) {
            const bf16x8 hf = lds16(sH + l16 * SST + ks * 32 + quad * 8);
#pragma unroll
            for (int i = 0; i < 2; ++i) yo[i] = mfma16(hf, __builtin_bit_cast(bf16x8, cu.cf[i][ks]), yo[i]);
        }
#pragma unroll
        for (int i = 0; i < 2; ++i) {
            const float e = __expf(sacs[wave * 32 + i * 16 + l16]);
            const float o0 = __uint_as_float(cu.yold[i].x << 16), o1 = __uint_as_float(cu.yold[i].x & 0xffff0000u);
            const float o2 = __uint_as_float(cu.yold[i].y << 16), o3 = __uint_as_float(cu.yold[i].y & 0xffff0000u);
            st4bf(Y + (size_t)(row0 + i * 16) * 2048, yo[i][0] * e + o0, yo[i][1] * e + o1, yo[i][2] * e + o2, yo[i][3] * e + o3);
        }
        {
            const float dec = __expf(total);
            st[0] *= dec; st[1] *= dec;
#pragma unroll
            for (int ks = 0; ks < 4; ++ks) {
                float w[8];
#pragma unroll
                for (int e = 0; e < 8; ++e) { const int s = ks * 32 + quad * 8 + e; w[e] = sdt[s] * __expf(total - sacs[s]); }
                const bf16x8 xbf = lds16(sX + l16 * SST + ks * 32 + quad * 8);
#pragma unroll
                for (int nt = 0; nt < 2; ++nt) {
                    const u32x4 raw = cu.bt[nt][ks];
                    u32x4 sw;
                    sw.x = pack2(__uint_as_float(raw.x << 16) * w[0], __uint_as_float(raw.x & 0xffff0000u) * w[1]);
                    sw.y = pack2(__uint_as_float(raw.y << 16) * w[2], __uint_as_float(raw.y & 0xffff0000u) * w[3]);
                    sw.z = pack2(__uint_as_float(raw.z << 16) * w[4], __uint_as_float(raw.z & 0xffff0000u) * w[5]);
                    sw.w = pack2(__uint_as_float(raw.w << 16) * w[6], __uint_as_float(raw.w & 0xffff0000u) * w[7]);
                    st[nt] = mfma16(__builtin_bit_cast(bf16x8, sw), xbf, st[nt]);
                }
            }
        }
    }
}

__device__ void ssd_scan_phase(const Params& p, int layer, bf16_t* smem) {
    const int j2 = layer >> 1;
    for (int t = blockIdx.x; t < NB * 2 * 32 * 4; t += gridDim.x) {
        const int pq = t & 3, h = (t >> 2) & 31, dir = (t >> 7) & 1, b = t >> 8;
        ssd_scan_item(p, j2, b, dir, h, pq, smem);
    }
}

__device__ void finish_phase(const Params& p, int layer) {
    const int j2 = layer >> 1, lane = tid_() & 63, wave = tid_() >> 6;
    bf16_t* yf = (bf16_t*)(p.ws + WS_YF); const bf16_t* yb = (const bf16_t*)(p.ws + WS_YB); const bf16_t* z = (const bf16_t*)(p.ws + WS_Z);
    const float* gn = p.ssm_norm_g + (size_t)j2 * 2048;
    for (int row = blockIdx.x * 4 + wave; row < MT; row += gridDim.x * 4) {
#pragma unroll
        for (int g = 0; g < 4; ++g) {
            const size_t off = (size_t)row * 2048 + g * 512 + lane * 8;
            const u32x4 a = *(const u32x4*)(yf + off), bq = *(const u32x4*)(yb + off), zq = *(const u32x4*)(z + off);
            const unsigned aw[4] = {a.x, a.y, a.z, a.w}, bw[4] = {bq.x, bq.y, bq.z, bq.w}, zw[4] = {zq.x, zq.y, zq.z, zq.w};
            float v[8]; float ss = 0.f;
#pragma unroll
            for (int k = 0; k < 4; ++k) {
                v[2 * k] = (__uint_as_float(aw[k] << 16) + __uint_as_float(bw[k] << 16)) * __uint_as_float(zw[k] << 16);
                v[2 * k + 1] = (__uint_as_float(aw[k] & 0xffff0000u) + __uint_as_float(bw[k] & 0xffff0000u)) * __uint_as_float(zw[k] & 0xffff0000u);
                ss += v[2 * k] * v[2 * k] + v[2 * k + 1] * v[2 * k + 1];
            }
#pragma unroll
            for (int o = 1; o < 64; o <<= 1) ss += __shfl_xor(ss, o);
            const float rstd = rsqrtf(ss * (1.f / 512.f) + EPS);
            const f32x4 g0 = *(const f32x4*)(gn + g * 512 + lane * 8), g1 = *(const f32x4*)(gn + g * 512 + lane * 8 + 4);
            u32x4 o4;
            o4.x = pack2(v[0] * rstd * g0[0], v[1] * rstd * g0[1]); o4.y = pack2(v[2] * rstd * g0[2], v[3] * rstd * g0[3]);
            o4.z = pack2(v[4] * rstd * g1[0], v[5] * rstd * g1[1]); o4.w = pack2(v[6] * rstd * g1[2], v[7] * rstd * g1[3]);
            *(u32x4*)(yf + off) = o4;
        }
    }
}

__global__ void __launch_bounds__(256, 2) hybrid_fwd(Params p) {
    extern __shared__ __attribute__((aligned(16))) unsigned char lds[];
    cg::grid_group grid = cg::this_grid();
    bf16_t* smem = (bf16_t*)lds; float* smf = (float*)lds;
    enum { C_NORM1 = 0, C_MIXIN, C_ATTN, C_MIXOUT, C_NORM2, C_FFNIN, C_FFNOUT, C_SSMIN, C_CONV, C_SSD, C_FINISH, C_SSMOUT, C_PRO, C_SSDB };
    const unsigned long long evc = 0x6543210ull;
    const unsigned long long odc = 0x654BAD9870ull;
    for (int ph = 0; ph < 35; ++ph) {
        int code, layer;
        if (ph == 0) { code = C_PRO; layer = 0; }
        else {
            const int q = ph - 1, pair = q / 17, r = q - pair * 17;
            if (r < 7) { layer = 2 * pair; code = (int)((evc >> (4 * r)) & 15); }
            else { layer = 2 * pair + 1; code = (int)((odc >> (4 * (r - 7))) & 15); }
        }
        Params q = p;
        asm volatile("" : "+s"(q.ws));
        asm volatile("" : "+s"(q.out));
        switch (code) {
            case C_PRO: prologue(q, smf); break;
            case C_NORM1: if (layer > 0) convert_layer_weights(q, layer, smf); norm_phase(q, layer, 0); break;
            case C_NORM2: norm_phase(q, layer, 1); break;
            case C_MIXIN: gemm_phase<G_MIXIN>(q, layer, smem); break;
            case C_ATTN: attn_sg_phase(q, layer, smem); break;
            case C_MIXOUT: gemm_phase<G_MIXOUT>(q, layer, smem); break;
            case C_FFNIN: gemm_phase<G_FFNIN>(q, layer, smem); break;
            case C_FFNOUT: gemm_phase<G_FFNOUT>(q, layer, smem); break;
            case C_SSMIN: gemm_phase<G_SSMIN>(q, layer, smem); break;
            case C_CONV: conv_phase(q, layer, smf); break;
            case C_SSD: ssd_diag_phase(q, layer, smem); break;
            case C_SSDB: ssd_scan_phase(q, layer, smem); break;
            case C_FINISH: finish_phase(q, layer); break;
            case C_SSMOUT: gemm_phase<G_SSMOUT>(q, layer, smem); break;
            default: break;
        }
        grid.sync();
    }
}

extern "C" void kernel_launch(void* const* d_in, const int* in_sizes, int n_in, void* d_out, int out_size, void* d_ws, size_t ws_size, hipStream_t stream) {
    static int grid_blocks = 0;
    if (grid_blocks == 0) {
        if (ws_size < WS_TOTAL) { fprintf(stderr, "kernel_launch: workspace too small: %zu < %zu\n", ws_size, (size_t)WS_TOTAL); grid_blocks = -1; return; }
        int dev = 0, cus = 0, per_cu = 0;
        hipGetDevice(&dev);
        hipDeviceGetAttribute(&cus, hipDeviceAttributeMultiprocessorCount, dev);
        if (hipFuncSetAttribute((const void*)hybrid_fwd, hipFuncAttributeMaxDynamicSharedMemorySize, LDS_BYTES) != hipSuccess) { fprintf(stderr, "kernel_launch: hipFuncSetAttribute failed\n"); }
        if (hipOccupancyMaxActiveBlocksPerMultiprocessor(&per_cu, (const void*)hybrid_fwd, 256, LDS_BYTES) != hipSuccess || per_cu < 1) { fprintf(stderr, "kernel_launch: occupancy query failed (%d)\n", per_cu); per_cu = 1; }
        if (per_cu > 2) per_cu = 2;
        (void)hipGetLastError();
        grid_blocks = cus * per_cu;
    }
    if (grid_blocks < 0) return;
    Params p{};
    const float** f = (const float**)&p;
    for (int i = 0; i < 25; ++i) f[i] = (const float*)d_in[i];
    p.out = (float*)d_out; p.ws = (unsigned char*)d_ws;
    void* args[] = {&p};
    hipError_t e = hipLaunchCooperativeKernel((const void*)hybrid_fwd, dim3(grid_blocks), dim3(256), args, LDS_BYTES, stream);
    if (e != hipSuccess) fprintf(stderr, "cooperative launch failed: %s (grid %d)\n", hipGetErrorString(e), grid_blocks);
}
```

```cpp
#include <hip/hip_runtime.h>
#include <hip/hip_cooperative_groups.h>
#include <cstdio>
#include <cstdint>
namespace cg = cooperative_groups;

typedef unsigned short bf16_t;
typedef short bf16x8 __attribute__((ext_vector_type(8)));
typedef short bf16x4 __attribute__((ext_vector_type(4)));
typedef float f32x4 __attribute__((ext_vector_type(4)));
typedef unsigned u32x4 __attribute__((ext_vector_type(4)));
typedef unsigned u32x2 __attribute__((ext_vector_type(2)));

constexpr int D = 1024, NB = 2, SEQ = 8192, CTX = 256;
constexpr int ML = NB * SEQ;
constexpr int MC = NB * CTX;
constexpr int MT = ML + MC;
constexpr int TALL = CTX + SEQ;
constexpr int FFH = 2816;
constexpr int MIXIN = 1792;
constexpr int SSMIN = 5184, SSMIN_PAD = 5248;
constexpr int SSI = 2048;
constexpr float EPS = 1e-6f;

constexpr size_t MB = 1024 * 1024;
constexpr size_t WS_MOD = 0;
constexpr size_t WS_ROPE = 1 * MB;
constexpr size_t WS_XCTX = 3 * MB;
constexpr size_t WS_SGW = 5 * MB + 512 * 1024;
constexpr size_t WS_BAR = 7 * MB;
constexpr size_t WS_WT = 8 * MB;
constexpr size_t WT_FFNIN = 0;
constexpr size_t WT_FFNOUT = WT_FFNIN + (size_t)5632 * 1024 * 2;
constexpr size_t WT_MIXIN = WT_FFNOUT + (size_t)1024 * 2816 * 2;
constexpr size_t WT_MIXOUT = WT_MIXIN + (size_t)SSMIN_PAD * 1024 * 2;
constexpr size_t WT_END = WT_MIXOUT + (size_t)1024 * 2048 * 2;
constexpr size_t WS_R0 = WS_WT + ((WT_END + MB - 1) / MB) * MB;
constexpr size_t SZ_XBC = (size_t)MT * 3072 * 2;
constexpr size_t SZ_HN = (size_t)MT * 1024 * 2;
constexpr size_t WS_XBC = WS_R0;
constexpr size_t WS_HN = WS_XBC + SZ_XBC;
constexpr size_t WS_YF = WS_XBC;
constexpr size_t WS_YB = WS_YF + (size_t)MT * 2048 * 2;
constexpr size_t WS_R1 = WS_HN + SZ_HN;
constexpr size_t WS_Z = WS_R1;
constexpr size_t WS_XT = WS_Z + (size_t)MT * 2048 * 2;
constexpr size_t WS_BN = WS_XT + (size_t)MT * 2048 * 2;
constexpr size_t WS_CN = WS_BN + (size_t)MT * 512 * 2;
constexpr size_t WS_BT = WS_CN + (size_t)MT * 512 * 2;
constexpr size_t WS_DT = WS_BT + (size_t)MT * 512 * 2;
constexpr size_t WS_END_ODD = WS_DT + (size_t)MT * 64 * 4;
constexpr size_t WS_Q = WS_R1;
constexpr size_t WS_K = WS_Q + (size_t)MT * 512 * 2;
constexpr size_t WS_VT = WS_K + (size_t)MT * 128 * 2;
constexpr size_t WS_U = WS_VT + (size_t)MT * 128 * 2;
constexpr size_t WS_GVT = WS_U + (size_t)MT * 512 * 2;
constexpr size_t WS_AS = WS_GVT + (size_t)MT * 512 * 2;
constexpr size_t WS_HID = WS_R1;
constexpr size_t WS_TOTAL = WS_END_ODD;
static_assert(WS_TOTAL < (size_t)400 * MB, "workspace too large");
static_assert(WS_AS + (size_t)MT * 1024 * 2 <= WS_END_ODD, "even buffers fit");
static_assert(WS_HID + (size_t)MT * FFH * 2 <= WS_END_ODD, "hid fits");

constexpr int LDS_BYTES = 73728;
constexpr int GST = 72;
constexpr int SST = 136;

struct Params {
    const float* x; const float* c; const float* ctx; const float* c_ctx;
    const float* ada_w; const float* ada_b; const float* norm1_g; const float* norm2_g;
    const float* ffn_w_in; const float* ffn_w_out; const float* mix_w_in; const float* mix_w_out;
    const float* q_norm_g; const float* k_norm_g; const float* sgu_norm_g; const float* sgu_w; const float* sgu_b;
    const float* ssm_w_in; const float* ssm_conv_w; const float* ssm_conv_b; const float* ssm_dt_bias;
    const float* ssm_a_log; const float* ssm_d; const float* ssm_norm_g; const float* ssm_w_out;
    float* out; unsigned char* ws;
};

__device__ __forceinline__ int tid_() { int t = threadIdx.x; asm volatile("" : "+v"(t)); return t; }
__device__ __forceinline__ bf16_t f2bf(float f) {
    unsigned u = __float_as_uint(f);
    u += 0x7fffu + ((u >> 16) & 1u);
    return (bf16_t)(u >> 16);
}
__device__ __forceinline__ float bf2f(bf16_t h) { return __uint_as_float(((unsigned)h) << 16); }
__device__ __forceinline__ unsigned pack2(float a, float b) { unsigned r; asm volatile("v_cvt_pk_bf16_f32 %0, %1, %2" : "=v"(r) : "v"(a), "v"(b)); return r; }
__device__ __forceinline__ float siluf(float v) { return v / (1.f + __expf(-v)); }
__device__ __forceinline__ float geluf(float v) {
    const float u = 0.7978845608028654f * (v + 0.044715f * v * v * v);
    return v / (1.f + __expf(-2.f * u));
}
__device__ __forceinline__ float softplusf(float v) { return v > 20.f ? v : log1pf(expf(v)); }
__device__ __forceinline__ int seg_of(int row) { return row < SEQ ? 0 : (row < ML ? 1 : 2); }
__device__ __forceinline__ float* xrow(const Params& p, int row) {
    return row < ML ? p.out + (size_t)row * D : (float*)(p.ws + WS_XCTX) + (size_t)(row - ML) * D;
}
__device__ __forceinline__ void lds_sync() {
    __builtin_amdgcn_fence(__ATOMIC_RELEASE, "workgroup", "local");
    __builtin_amdgcn_s_barrier();
    __builtin_amdgcn_fence(__ATOMIC_ACQUIRE, "workgroup", "local");
}
typedef float f32x2 __attribute__((ext_vector_type(2)));
__device__ __forceinline__ f32x2 scan128(float s0, float s1, int lane, int dir) {
    if (dir == 0) {
#pragma unroll
        for (int o = 1; o < 64; o <<= 1) { const float t0 = __shfl_up(s0, o), t1 = __shfl_up(s1, o); s0 += lane >= o ? t0 : 0.f; s1 += lane >= o ? t1 : 0.f; }
        s1 += __shfl(s0, 63);
    } else {
#pragma unroll
        for (int o = 1; o < 64; o <<= 1) { const float t0 = __shfl_down(s0, o), t1 = __shfl_down(s1, o); s0 += lane + o < 64 ? t0 : 0.f; s1 += lane + o < 64 ? t1 : 0.f; }
        s0 += __shfl(s1, 0);
    }
    return (f32x2){s0, s1};
}
__device__ __forceinline__ f32x4 mfma16(bf16x8 a, bf16x8 b, f32x4 c) { return __builtin_amdgcn_mfma_f32_16x16x32_bf16(a, b, c, 0, 0, 0); }
__device__ __forceinline__ bf16x8 lds16(const bf16_t* p) { return *(const bf16x8*)p; }
__device__ __forceinline__ bf16x8 lds8x2(const bf16_t* p0, const bf16_t* p1) {
    const bf16x4 a = *(const bf16x4*)p0, b = *(const bf16x4*)p1;
    bf16x8 r; r[0] = a[0]; r[1] = a[1]; r[2] = a[2]; r[3] = a[3]; r[4] = b[0]; r[5] = b[1]; r[6] = b[2]; r[7] = b[3];
    return r;
}
__device__ __forceinline__ bf16x8 pack8(f32x4 a, f32x4 b) {
    u32x4 w; w.x = pack2(a[0], a[1]); w.y = pack2(a[2], a[3]); w.z = pack2(b[0], b[1]); w.w = pack2(b[2], b[3]);
    return __builtin_bit_cast(bf16x8, w);
}
__device__ __forceinline__ void st4bf(bf16_t* dst, float a, float b, float c, float d) {
    u32x2 w; w.x = pack2(a, b); w.y = pack2(c, d); *(u32x2*)dst = w;
}


#define XB_TMO      128
#define XB_XCNT(j)  (256  + 64 * (j))
#define XB_XSUB(j)  (1280 + 64 * (j))
#define XB_XGEN(j)  (2304 + 64 * (j))
#define XB_TOP      3328
#define XB_TOPGEN   3392
#define XCD_BAR_WORDS 3456
#define XB_SPIN_CAP (1u << 18)
#define LAS __attribute__((address_space(3)))
__device__ __forceinline__ unsigned xb_ld(unsigned* p)              { return __hip_atomic_load(p, __ATOMIC_RELAXED, __HIP_MEMORY_SCOPE_AGENT); }
__device__ __forceinline__ unsigned xb_add(unsigned* p, unsigned v) { return __hip_atomic_fetch_add(p, v, __ATOMIC_RELAXED, __HIP_MEMORY_SCOPE_AGENT); }
__device__ __forceinline__ unsigned xb_xcc_id() { return (unsigned)__builtin_amdgcn_s_getreg((3 << 11) | 20) & 0xFu; }
#define XB_SPIN(cond, bar) do { unsigned _sp = 0; while (cond) { __builtin_amdgcn_s_sleep(1); \
    if ((++_sp & 255u) == 0u) { if (xb_ld(&(bar)[XB_TMO])) break; if (_sp > XB_SPIN_CAP) { atomicAdd(&(bar)[XB_TMO], 1u); break; } } } } while (0)
struct XcdBarrier { unsigned* bar; unsigned x; volatile LAS unsigned* st; };
__device__ __forceinline__ XcdBarrier xcd_barrier_post(unsigned* bar, volatile LAS unsigned* st) {
    XcdBarrier b; b.bar = bar; b.x = xb_xcc_id(); b.st = st;
    if (threadIdx.x == 0) (void)xb_add(&bar[XB_XCNT(b.x)], 1u);
    return b;
}
__device__ __forceinline__ void xcd_barrier_complete(unsigned* bar, unsigned x, unsigned& nloc, unsigned& nx) {
    const unsigned G = gridDim.x * gridDim.y * gridDim.z;
    unsigned sum, cnt, mine, sp = 0u;
    for (;;) {
        sum = 0u; cnt = 0u; mine = 0u;
#pragma unroll
        for (unsigned j = 0; j < 16; ++j) { const unsigned c = xb_ld(&bar[XB_XCNT(j)]); sum += c; cnt += (c > 0u) ? 1u : 0u; mine = (j == x) ? c : mine; }
        if (sum == G) break;
        __builtin_amdgcn_s_sleep(1);
        if ((++sp & 255u) == 0u) { if (xb_ld(&bar[XB_TMO])) break; if (sp > XB_SPIN_CAP) { atomicAdd(&bar[XB_TMO], 1u); break; } }
    }
    nloc = mine > 0u ? mine : 1u; nx = cnt > 0u ? cnt : 1u;
}
__device__ __forceinline__ void xcd_barrier(const XcdBarrier& b) {
    asm volatile("s_waitcnt vmcnt(0)" ::: "memory");
    __syncthreads();
    if (threadIdx.x == 0) {
        unsigned* bar = b.bar;
        __builtin_amdgcn_s_waitcnt(0);
        unsigned nloc = b.st[0], nx = b.st[1];
        if (nloc == 0u) { xcd_barrier_complete(bar, b.x, nloc, nx); b.st[0] = nloc; b.st[1] = nx; }
        const unsigned old = xb_add(&bar[XB_XSUB(b.x)], 1u);
        const unsigned gen = old / nloc;
        if (old + 1u == (gen + 1u) * nloc) {
            __builtin_amdgcn_fence(__ATOMIC_RELEASE, "agent");
            asm volatile("s_waitcnt vmcnt(0)" ::: "memory");
            const unsigned og = xb_add(&bar[XB_TOP], 1u);
            const unsigned tg = og / nx;
            if (og + 1u == (tg + 1u) * nx) xb_add(&bar[XB_TOPGEN], 1u);
            else XB_SPIN(xb_ld(&bar[XB_TOPGEN]) == tg, bar);
            __builtin_amdgcn_fence(__ATOMIC_ACQUIRE, "agent");
            xb_add(&bar[XB_XGEN(b.x)], 1u);
            asm volatile("s_waitcnt vmcnt(0)" ::: "memory");
        } else {
            XB_SPIN(xb_ld(&bar[XB_XGEN(b.x)]) == gen, bar);
            __builtin_amdgcn_fence(__ATOMIC_ACQUIRE, "agent");
            asm volatile("s_waitcnt vmcnt(0)" ::: "memory");
        }
    }
    __syncthreads();
}

template <int MI, int lda, int ldw, int K>
__device__ __forceinline__ void gemm_tile(const bf16_t* __restrict__ A, const bf16_t* __restrict__ W,
                                          f32x4 (&acc)[MI][8], bf16_t* sW) {
    const int tid = tid_(), lane = tid & 63, wave = tid >> 6, l16 = lane & 15, quad = lane >> 4;
    const int srow = tid >> 3, skc = (tid & 7) * 8;
    const bf16_t* ap = A + (size_t)(wave * 16 * MI + l16) * lda + quad * 8;
    const bf16_t* wp = W + (size_t)srow * ldw + skc;
    u32x4 ra[MI][2], rw[4];
#pragma unroll
    for (int i = 0; i < MI; ++i)
#pragma unroll
        for (int ks = 0; ks < 2; ++ks) ra[i][ks] = *(const u32x4*)(ap + (size_t)(i * 16) * lda + ks * 32);
#pragma unroll
    for (int i = 0; i < 4; ++i) rw[i] = *(const u32x4*)(wp + (size_t)(i * 32) * ldw);
#pragma unroll
    for (int i = 0; i < MI; ++i)
#pragma unroll
        for (int j = 0; j < 8; ++j) acc[i][j] = (f32x4){0.f, 0.f, 0.f, 0.f};
    constexpr int nk = K >> 6;
#pragma unroll 1
    for (int kt = 0; kt < nk; ++kt) {
        lds_sync();
#pragma unroll
        for (int i = 0; i < 4; ++i) *(u32x4*)(sW + (srow + i * 32) * GST + skc) = rw[i];
        u32x4 af[MI][2];
#pragma unroll
        for (int i = 0; i < MI; ++i)
#pragma unroll
            for (int ks = 0; ks < 2; ++ks) af[i][ks] = ra[i][ks];
        lds_sync();
        if (kt + 1 < nk) {
            const int k0 = (kt + 1) << 6;
#pragma unroll
            for (int i = 0; i < MI; ++i)
#pragma unroll
                for (int ks = 0; ks < 2; ++ks) ra[i][ks] = *(const u32x4*)(ap + (size_t)(i * 16) * lda + k0 + ks * 32);
#pragma unroll
            for (int i = 0; i < 4; ++i) rw[i] = *(const u32x4*)(wp + (size_t)(i * 32) * ldw + k0);
        }
#pragma unroll
        for (int ks = 0; ks < 2; ++ks) {
#pragma unroll
            for (int j = 0; j < 8; ++j) {
                const bf16x8 wf = lds16(sW + (j * 16 + l16) * GST + ks * 32 + quad * 8);
#pragma unroll
                for (int i = 0; i < MI; ++i) acc[i][j] = mfma16(wf, __builtin_bit_cast(bf16x8, af[i][ks]), acc[i][j]);
            }
        }
    }
}

template <int MI>
__device__ __forceinline__ void epi_resid(const Params& p, int m0, int n0, const f32x4 (&acc)[MI][8], const float* gate  ) {
    const int lane = tid_() & 63, wave = tid_() >> 6, l16 = lane & 15, quad = lane >> 4;
#pragma unroll
    for (int i = 0; i < MI; ++i) {
        const int row = m0 + wave * 16 * MI + i * 16 + l16;
        float* xr = xrow(p, row);
        const float* g = gate + (size_t)seg_of(row) * 6144;
#pragma unroll
        for (int j = 0; j < 8; ++j) {
            const int col = n0 + j * 16 + quad * 4;
            const f32x4 gv = *(const f32x4*)(g + col);
            f32x4 xv = *(f32x4*)(xr + col);
            xv += gv * acc[i][j];
            *(f32x4*)(xr + col) = xv;
        }
    }
}

template <int MI>
__device__ __forceinline__ void epi_swiglu(const Params& p, int m0, int n0, const f32x4 (&acc)[MI][8]) {
    const int lane = tid_() & 63, wave = tid_() >> 6, l16 = lane & 15, quad = lane >> 4;
    bf16_t* hid = (bf16_t*)(p.ws + WS_HID);
#pragma unroll
    for (int i = 0; i < MI; ++i) {
        const int row = m0 + wave * 16 * MI + i * 16 + l16;
#pragma unroll
        for (int jj = 0; jj < 4; ++jj) {
            const f32x4 g = acc[i][2 * jj], u = acc[i][2 * jj + 1];
            const int hc = (n0 >> 1) + jj * 16 + quad * 4;
            st4bf(hid + (size_t)row * FFH + hc, siluf(g[0]) * u[0], siluf(g[1]) * u[1], siluf(g[2]) * u[2], siluf(g[3]) * u[3]);
        }
    }
}

template <int MI>
__device__ __forceinline__ void epi_mixin(const Params& p, int j2, int m0, int tn, f32x4 (&acc)[MI][8]) {
    const int lane = tid_() & 63, wave = tid_() >> 6, l16 = lane & 15, quad = lane >> 4;
    if (tn < 5) {
        const float* gsrc = (tn < 4 ? p.q_norm_g : p.k_norm_g) + j2 * 64;
        const float* cosT = (const float*)(p.ws + WS_ROPE);
        const float* sinT = cosT + 8192 * 32;
#pragma unroll
        for (int i = 0; i < MI; ++i) {
            const int row = m0 + wave * 16 * MI + i * 16 + l16;
#pragma unroll
            for (int hh = 0; hh < 2; ++hh) {
                float ss = 0.f;
#pragma unroll
                for (int j = 0; j < 4; ++j) { const f32x4 v = acc[i][hh * 4 + j]; ss += v[0] * v[0] + v[1] * v[1] + v[2] * v[2] + v[3] * v[3]; }
                ss += __shfl_xor(ss, 16); ss += __shfl_xor(ss, 32);
                const float rstd = rsqrtf(ss * (1.f / 64.f) + EPS);
                f32x4 y[4];
#pragma unroll
                for (int j = 0; j < 4; ++j) {
                    const f32x4 gv = *(const f32x4*)(gsrc + j * 16 + quad * 4);
                    y[j] = acc[i][hh * 4 + j] * rstd * gv;
                }
                if (row < ML) {
                    const int s = row & (SEQ - 1);
#pragma unroll
                    for (int j = 0; j < 2; ++j) {
                        const f32x4 cs = *(const f32x4*)(cosT + (size_t)s * 32 + j * 16 + quad * 4);
                        const f32x4 sn = *(const f32x4*)(sinT + (size_t)s * 32 + j * 16 + quad * 4);
                        const f32x4 x1 = y[j], x2 = y[j + 2];
                        y[j] = x1 * cs - x2 * sn;
                        y[j + 2] = x2 * cs + x1 * sn;
                    }
                }
                if (tn < 4) {
                    bf16_t* q = (bf16_t*)(p.ws + WS_Q) + (size_t)row * 512 + (tn * 2 + hh) * 64;
#pragma unroll
                    for (int j = 0; j < 4; ++j) st4bf(q + j * 16 + quad * 4, y[j][0] * 0.125f, y[j][1] * 0.125f, y[j][2] * 0.125f, y[j][3] * 0.125f);
                } else {
                    const int b = row < ML ? (row >> 13) : ((row - ML) >> 8);
                    const int t = row < ML ? CTX + (row & (SEQ - 1)) : ((row - ML) & (CTX - 1));
                    bf16_t* k = (bf16_t*)(p.ws + WS_K) + ((size_t)b * TALL + t) * 128 + hh * 64;
#pragma unroll
                    for (int j = 0; j < 4; ++j) st4bf(k + j * 16 + quad * 4, y[j][0], y[j][1], y[j][2], y[j][3]);
                }
            }
        }
    } else if (tn == 5) {
        bf16_t* vt = (bf16_t*)(p.ws + WS_VT);
#pragma unroll
        for (int i = 0; i < MI; ++i) {
            const int row = m0 + wave * 16 * MI + i * 16 + l16;
            const int b = row < ML ? (row >> 13) : ((row - ML) >> 8);
            const int t = row < ML ? CTX + (row & (SEQ - 1)) : ((row - ML) & (CTX - 1));
#pragma unroll
            for (int j = 0; j < 8; ++j) {
                const int kh = j >> 2;
#pragma unroll
                for (int r = 0; r < 4; ++r) {
                    const int d = (j & 3) * 16 + quad * 4 + r;
                    vt[((size_t)(b * 2 + kh) * 64 + d) * TALL + t] = f2bf(acc[i][j][r]);
                }
            }
        }
    } else if (tn < 10) {
        bf16_t* u = (bf16_t*)(p.ws + WS_U);
#pragma unroll
        for (int i = 0; i < MI; ++i) {
            const int row = m0 + wave * 16 * MI + i * 16 + l16;
#pragma unroll
            for (int j = 0; j < 8; ++j) {
                const f32x4 v = acc[i][j];
                st4bf(u + (size_t)row * 512 + (tn - 6) * 128 + j * 16 + quad * 4, geluf(v[0]), geluf(v[1]), geluf(v[2]), geluf(v[3]));
            }
        }
    } else {
        const int g = tn - 10;
        const float* gn = p.sgu_norm_g + j2 * 512 + g * 128;
        bf16_t* gvt = (bf16_t*)(p.ws + WS_GVT);
#pragma unroll
        for (int i = 0; i < MI; ++i) {
            const int row = m0 + wave * 16 * MI + i * 16 + l16;
            float ss = 0.f;
#pragma unroll
            for (int j = 0; j < 8; ++j) {
                f32x4 v = acc[i][j];
                v[0] = geluf(v[0]); v[1] = geluf(v[1]); v[2] = geluf(v[2]); v[3] = geluf(v[3]);
                acc[i][j] = v;
                ss += v[0] * v[0] + v[1] * v[1] + v[2] * v[2] + v[3] * v[3];
            }
            ss += __shfl_xor(ss, 16); ss += __shfl_xor(ss, 32);
            const float rstd = rsqrtf(ss * (1.f / 128.f) + EPS);
            const int chunk = row >> 7, pt = row & 127;
#pragma unroll
            for (int j = 0; j < 8; ++j) {
                const f32x4 gv = *(const f32x4*)(gn + j * 16 + quad * 4);
#pragma unroll
                for (int r = 0; r < 4; ++r) {
                    const int cc = g * 128 + j * 16 + quad * 4 + r;
                    gvt[((size_t)chunk * 512 + cc) * 128 + pt] = f2bf(acc[i][j][r] * rstd * gv[r]);
                }
            }
        }
    }
}

template <int MI>
__device__ __forceinline__ void epi_ssmin(const Params& p, int j2, int m0, int tn, const f32x4 (&acc)[MI][8]) {
    const int lane = tid_() & 63, wave = tid_() >> 6, l16 = lane & 15, quad = lane >> 4;
#pragma unroll
    for (int i = 0; i < MI; ++i) {
        const int row = m0 + wave * 16 * MI + i * 16 + l16;
        if (tn < 16) {
            bf16_t* z = (bf16_t*)(p.ws + WS_Z) + (size_t)row * 2048 + tn * 128;
#pragma unroll
            for (int j = 0; j < 8; ++j) { const f32x4 v = acc[i][j]; st4bf(z + j * 16 + quad * 4, siluf(v[0]), siluf(v[1]), siluf(v[2]), siluf(v[3])); }
        } else if (tn < 40) {
            bf16_t* xb = (bf16_t*)(p.ws + WS_XBC) + (size_t)row * 3072 + (tn - 16) * 128;
#pragma unroll
            for (int j = 0; j < 8; ++j) { const f32x4 v = acc[i][j]; st4bf(xb + j * 16 + quad * 4, v[0], v[1], v[2], v[3]); }
        } else {
            float* dt = (float*)(p.ws + WS_DT) + (size_t)row * 64;
            const float* bias = p.ssm_dt_bias + j2 * 64;
#pragma unroll
            for (int j = 0; j < 4; ++j) {
                const int c = j * 16 + quad * 4;
                const f32x4 v = acc[i][j];
                f32x4 o;
                o[0] = softplusf(v[0] + bias[c + 0]); o[1] = softplusf(v[1] + bias[c + 1]);
                o[2] = softplusf(v[2] + bias[c + 2]); o[3] = softplusf(v[3] + bias[c + 3]);
                *(f32x4*)(dt + c) = o;
            }
        }
    }
}

enum { G_MIXIN = 0, G_MIXOUT, G_SSMIN, G_SSMOUT, G_FFNIN, G_FFNOUT };

template <int KIND>
__device__ void gemm_phase(const Params& p, int layer, bf16_t* smem) {
    const int j2 = layer >> 1;
    constexpr int lda = (KIND == G_SSMOUT) ? 2048 : (KIND == G_FFNOUT) ? FFH : 1024;
    constexpr int K = lda, ldw = K;
    constexpr int N = (KIND == G_MIXIN) ? MIXIN : (KIND == G_SSMIN) ? SSMIN_PAD : (KIND == G_FFNIN) ? 2 * FFH : 1024;
    constexpr size_t aoff = (KIND == G_MIXOUT) ? WS_AS : (KIND == G_SSMOUT) ? WS_YF : (KIND == G_FFNOUT) ? WS_HID : WS_HN;
    constexpr size_t woff = (KIND == G_MIXIN || KIND == G_SSMIN) ? WT_MIXIN : (KIND == G_MIXOUT || KIND == G_SSMOUT) ? WT_MIXOUT : (KIND == G_FFNIN) ? WT_FFNIN : WT_FFNOUT;
    const bf16_t* A = (const bf16_t*)(p.ws + aoff);
    const bf16_t* W = (const bf16_t*)(p.ws + WS_WT + woff);
    constexpr int MI = (KIND == G_MIXIN) ? 2 : 4;
    constexpr int nN = N >> 7, nM = MT / (64 * MI);
    const float* mod = (const float*)(p.ws + WS_MOD) + (size_t)layer * 3 * 6144;
    bf16_t* sW = smem;
    for (int t = blockIdx.x; t < nM * nN; t += gridDim.x) {
        const int tm = t / nN, tn = t - tm * nN;
        f32x4 acc[MI][8];
        gemm_tile<MI, lda, ldw, K>(A + (size_t)tm * (64 * MI) * lda, W + (size_t)tn * 128 * ldw, acc, sW);
        if (KIND == G_MIXIN) epi_mixin<MI>(p, j2, tm * (64 * MI), tn, acc);
        else if (KIND == G_MIXOUT || KIND == G_SSMOUT) epi_resid<MI>(p, tm * (64 * MI), tn * 128, acc, mod + 2 * 1024);
        else if (KIND == G_SSMIN) epi_ssmin<MI>(p, j2, tm * (64 * MI), tn, acc);
        else if (KIND == G_FFNIN) epi_swiglu<MI>(p, tm * (64 * MI), tn * 128, acc);
        else epi_resid<MI>(p, tm * (64 * MI), tn * 128, acc, mod + 5 * 1024);
    }
}

__device__ void norm_phase(const Params& p, int layer, int which) {
    const int lane = tid_() & 63, wave = tid_() >> 6;
    const float* g = (which ? p.norm2_g : p.norm1_g) + layer * 1024;
    const float* mod = (const float*)(p.ws + WS_MOD) + (size_t)layer * 3 * 6144;
    bf16_t* hn = (bf16_t*)(p.ws + WS_HN);
    for (int row = blockIdx.x * 4 + wave; row < MT; row += gridDim.x * 4) {
        const float* xr = xrow(p, row);
        f32x4 v[4]; float ss = 0.f;
#pragma unroll
        for (int i = 0; i < 4; ++i) { v[i] = *(const f32x4*)(xr + i * 256 + lane * 4); ss += v[i][0] * v[i][0] + v[i][1] * v[i][1] + v[i][2] * v[i][2] + v[i][3] * v[i][3]; }
#pragma unroll
        for (int o = 1; o < 64; o <<= 1) ss += __shfl_xor(ss, o);
        const float rstd = rsqrtf(ss * (1.f / 1024.f) + EPS);
        const float* m = mod + (size_t)seg_of(row) * 6144 + (which ? 3 * 1024 : 0);
#pragma unroll
        for (int i = 0; i < 4; ++i) {
            const int col = i * 256 + lane * 4;
            const f32x4 gv = *(const f32x4*)(g + col), sh = *(const f32x4*)(m + col), sc = *(const f32x4*)(m + 1024 + col);
            const f32x4 y = (v[i] * rstd * gv) * (sc + 1.f) + sh;
            st4bf(hn + (size_t)row * 1024 + col, y[0], y[1], y[2], y[3]);
        }
    }
}

__device__ void convert_wt(const float* __restrict__ W, int K, int N, bf16_t* __restrict__ Wt, int mode, float* tile) {
    const int tid = tid_();
    const int nKt = K >> 6, nNt = N >> 6;
    for (int t = blockIdx.x; t < nKt * nNt; t += gridDim.x) {
        const int kt = t / nNt, nt = t - kt * nNt;
        lds_sync();
#pragma unroll
        for (int i = 0; i < 16; ++i) {
            const int kk = (tid >> 6) + i * 4, nn = tid & 63;
            tile[kk * 65 + nn] = W[(size_t)(kt * 64 + kk) * N + nt * 64 + nn];
        }
        lds_sync();
#pragma unroll
        for (int i = 0; i < 16; ++i) {
            const int nn = (tid >> 6) + i * 4, kk = tid & 63;
            const int n = nt * 64 + nn;
            int dr = n;
            if (mode == 1) { const int hm = n < FFH ? n : n - FFH; dr = (hm >> 4) * 32 + (hm & 15) + (n < FFH ? 0 : 16); }
            Wt[(size_t)dr * K + kt * 64 + kk] = f2bf(tile[kk * 65 + nn]);
        }
    }
}

__device__ void convert_layer_weights(const Params& p, int layer, float* tile) {
    unsigned char* wt = p.ws + WS_WT;
    const int j2 = layer >> 1;
    convert_wt(p.ffn_w_in + (size_t)layer * 1024 * 2 * FFH, 1024, 2 * FFH, (bf16_t*)(wt + WT_FFNIN), 1, tile);
    convert_wt(p.ffn_w_out + (size_t)layer * FFH * 1024, FFH, 1024, (bf16_t*)(wt + WT_FFNOUT), 0, tile);
    if ((layer & 1) == 0) {
        convert_wt(p.mix_w_in + (size_t)j2 * 1024 * MIXIN, 1024, MIXIN, (bf16_t*)(wt + WT_MIXIN), 0, tile);
        convert_wt(p.mix_w_out + (size_t)j2 * 1024 * 1024, 1024, 1024, (bf16_t*)(wt + WT_MIXOUT), 0, tile);
    } else {
        convert_wt(p.ssm_w_in + (size_t)j2 * 1024 * SSMIN, 1024, SSMIN, (bf16_t*)(wt + WT_MIXIN), 0, tile);
        convert_wt(p.ssm_w_out + (size_t)j2 * SSI * 1024, SSI, 1024, (bf16_t*)(wt + WT_MIXOUT), 0, tile);
        bf16_t* padp = (bf16_t*)(wt + WT_MIXIN) + (size_t)SSMIN * 1024;
        for (int i = blockIdx.x * 256 + tid_(); i < (SSMIN_PAD - SSMIN) * 1024; i += gridDim.x * 256) padp[i] = 0;
    }
}

__device__ void prologue(const Params& p, float* smf) {
    const int tid = tid_();
    const size_t gtid = (size_t)blockIdx.x * 256 + tid, gsz = (size_t)gridDim.x * 256;
    {
        const f32x4* s = (const f32x4*)p.x; f32x4* d = (f32x4*)p.out;
        for (size_t i = gtid; i < (size_t)ML * D / 4; i += gsz) d[i] = s[i];
        const f32x4* s2 = (const f32x4*)p.ctx; f32x4* d2 = (f32x4*)(p.ws + WS_XCTX);
        for (size_t i = gtid; i < (size_t)MC * D / 4; i += gsz) d2[i] = s2[i];
    }
    {
        float* cosT = (float*)(p.ws + WS_ROPE); float* sinT = cosT + 8192 * 32;
        for (size_t i = gtid; i < (size_t)8192 * 32; i += gsz) {
            const int s = (int)(i >> 5), j = (int)(i & 31), f = j & 15;
            const float inv = powf(10000.f, -(float)f / 16.f);
            const float pos = (float)(j < 16 ? (s >> 6) : (s & 63));
            const float ang = pos * inv;
            cosT[i] = cosf(ang); sinT[i] = sinf(ang);
        }
    }
    {
        bf16_t* sgw = (bf16_t*)(p.ws + WS_SGW);
        for (size_t i = gtid; i < (size_t)2 * 4 * 128 * 128; i += gsz) sgw[i] = f2bf(p.sgu_w[i]);
    }
    {
        float* sc = smf;
        float* red = smf + 3 * 1024;
        lds_sync();
        for (int i = tid; i < 3 * 1024; i += 256) {
            const int sgi = i >> 10, k = i & 1023;
            const float v = sgi < 2 ? p.c[sgi * 1024 + k] : p.c_ctx[k];
            sc[i] = siluf(v);
        }
        lds_sync();
        float* mod = (float*)(p.ws + WS_MOD);
        const int cl = tid & 63, kg = tid >> 6;
        for (int wi = blockIdx.x; wi < 4 * 96; wi += gridDim.x) {
            const int layer = wi / 96, cb = wi - layer * 96;
            const float* w = p.ada_w + (size_t)layer * 1024 * 6144 + cb * 64 + cl;
            float s0 = 0.f, s1 = 0.f, s2 = 0.f;
            for (int k = kg * 256; k < kg * 256 + 256; ++k) {
                const float wv = w[(size_t)k * 6144];
                s0 += sc[k] * wv; s1 += sc[1024 + k] * wv; s2 += sc[2048 + k] * wv;
            }
            lds_sync();
            red[(kg * 3 + 0) * 64 + cl] = s0; red[(kg * 3 + 1) * 64 + cl] = s1; red[(kg * 3 + 2) * 64 + cl] = s2;
            lds_sync();
            if (tid < 192) {
                const int sgi = tid >> 6;
                const float v = red[(0 * 3 + sgi) * 64 + cl] + red[(1 * 3 + sgi) * 64 + cl] + red[(2 * 3 + sgi) * 64 + cl] + red[(3 * 3 + sgi) * 64 + cl];
                const int n = cb * 64 + cl;
                mod[((size_t)layer * 3 + sgi) * 6144 + n] = v + p.ada_b[layer * 6144 + n];
            }
        }
        lds_sync();
    }
    convert_layer_weights(p, 0, smf);
}

__device__ void attn_item(const Params& p, int b, int h, int q0row, int nkeys, bf16_t* smem) {
    const int tid = tid_(), lane = tid & 63, wave = tid >> 6, l16 = lane & 15, quad = lane >> 4;
    const int kh = h >> 2;
    const bf16_t* Q = (const bf16_t*)(p.ws + WS_Q);
    const bf16_t* Kb = (const bf16_t*)(p.ws + WS_K) + (size_t)b * TALL * 128 + kh * 64;
    const bf16_t* Vb = (const bf16_t*)(p.ws + WS_VT) + (size_t)(b * 2 + kh) * 64 * TALL;
    bf16_t* sK = smem; bf16_t* sV = smem + 64 * GST;
    bf16x8 qf[2][2];
#pragma unroll
    for (int i = 0; i < 2; ++i)
#pragma unroll
        for (int ks = 0; ks < 2; ++ks)
            qf[i][ks] = *(const bf16x8*)(Q + (size_t)(q0row + wave * 32 + i * 16 + l16) * 512 + h * 64 + ks * 32 + quad * 8);
    f32x4 o[4][2];
#pragma unroll
    for (int d = 0; d < 4; ++d)
#pragma unroll
        for (int i = 0; i < 2; ++i) o[d][i] = (f32x4){0.f, 0.f, 0.f, 0.f};
    float mrun[2] = {-INFINITY, -INFINITY}, lrun[2] = {0.f, 0.f};
    const int srow = tid >> 3, skc = (tid & 7) * 8;
    u32x4 rk[2], rv[2];
#pragma unroll
    for (int i = 0; i < 2; ++i) {
        rk[i] = *(const u32x4*)(Kb + (size_t)(srow + i * 32) * 128 + skc);
        rv[i] = *(const u32x4*)(Vb + (size_t)(srow + i * 32) * TALL + skc);
    }
    const int nt = nkeys >> 6;
    constexpr float LOG2E = 1.4426950408889634f;
    for (int kt = 0; kt < nt; ++kt) {
        lds_sync();
#pragma unroll
        for (int i = 0; i < 2; ++i) {
            *(u32x4*)(sK + (srow + i * 32) * GST + skc) = rk[i];
            *(u32x4*)(sV + (srow + i * 32) * GST + skc) = rv[i];
        }
        lds_sync();
        if (kt + 1 < nt) {
            const int t0 = (kt + 1) << 6;
#pragma unroll
            for (int i = 0; i < 2; ++i) {
                rk[i] = *(const u32x4*)(Kb + (size_t)(t0 + srow + i * 32) * 128 + skc);
                rv[i] = *(const u32x4*)(Vb + (size_t)(srow + i * 32) * TALL + t0 + skc);
            }
        }
        f32x4 s[4][2];
#pragma unroll
        for (int tt = 0; tt < 4; ++tt)
#pragma unroll
            for (int i = 0; i < 2; ++i) s[tt][i] = (f32x4){0.f, 0.f, 0.f, 0.f};
#pragma unroll
        for (int ks = 0; ks < 2; ++ks)
#pragma unroll
            for (int tt = 0; tt < 4; ++tt) {
                const bf16x8 kf = lds16(sK + (tt * 16 + l16) * GST + ks * 32 + quad * 8);
#pragma unroll
                for (int i = 0; i < 2; ++i) s[tt][i] = mfma16(kf, qf[i][ks], s[tt][i]);
            }
        bf16x8 pf[2][2];
#pragma unroll
        for (int i = 0; i < 2; ++i) {
            float mx = -INFINITY;
#pragma unroll
            for (int tt = 0; tt < 4; ++tt) mx = fmaxf(mx, fmaxf(fmaxf(s[tt][i][0], s[tt][i][1]), fmaxf(s[tt][i][2], s[tt][i][3])));
            mx = fmaxf(mx, __shfl_xor(mx, 16)); mx = fmaxf(mx, __shfl_xor(mx, 32));
            const float mnew = fmaxf(mrun[i], mx);
            const float alpha = __builtin_amdgcn_exp2f((mrun[i] - mnew) * LOG2E);
            mrun[i] = mnew;
            const float mb = mnew * LOG2E;
            float ls = 0.f;
#pragma unroll
            for (int tt = 0; tt < 4; ++tt) {
#pragma unroll
                for (int r = 0; r < 4; ++r) { const float e = __builtin_amdgcn_exp2f(s[tt][i][r] * LOG2E - mb); s[tt][i][r] = e; ls += e; }
            }
            lrun[i] = lrun[i] * alpha + ls;
#pragma unroll
            for (int d = 0; d < 4; ++d) o[d][i] *= alpha;
#pragma unroll
            for (int ksp = 0; ksp < 2; ++ksp) pf[ksp][i] = pack8(s[2 * ksp][i], s[2 * ksp + 1][i]);
        }
#pragma unroll
        for (int ksp = 0; ksp < 2; ++ksp)
#pragma unroll
            for (int d = 0; d < 4; ++d) {
                const bf16_t* vp = sV + (d * 16 + l16) * GST + ksp * 32 + quad * 4;
                const bf16x8 vf = lds8x2(vp, vp + 16);
#pragma unroll
                for (int i = 0; i < 2; ++i) o[d][i] = mfma16(vf, pf[ksp][i], o[d][i]);
            }
    }
    bf16_t* as = (bf16_t*)(p.ws + WS_AS);
#pragma unroll
    for (int i = 0; i < 2; ++i) {
        float l = lrun[i];
        l += __shfl_xor(l, 16); l += __shfl_xor(l, 32);
        const float inv = 1.f / l;
        const int row = q0row + wave * 32 + i * 16 + l16;
#pragma unroll
        for (int d = 0; d < 4; ++d)
            st4bf(as + (size_t)row * 1024 + h * 64 + d * 16 + quad * 4, o[d][i][0] * inv, o[d][i][1] * inv, o[d][i][2] * inv, o[d][i][3] * inv);
    }
}

__device__ void sg_item(const Params& p, int j2, int chunk, int g, bf16_t* smem) {
    const int lane = tid_() & 63, wave = tid_() >> 6, l16 = lane & 15, quad = lane >> 4;
    const bf16_t* A = (const bf16_t*)(p.ws + WS_SGW) + (size_t)(j2 * 4 + g) * 128 * 128;
    const bf16_t* W = (const bf16_t*)(p.ws + WS_GVT) + ((size_t)chunk * 512 + g * 128) * 128;
    f32x4 acc[2][8];
    gemm_tile<2, 128, 128, 128>(A, W, acc, smem);
    const bf16_t* u = (const bf16_t*)(p.ws + WS_U);
    bf16_t* as = (bf16_t*)(p.ws + WS_AS);
    const float* bs = p.sgu_b + (size_t)(j2 * 4 + g) * 128;
#pragma unroll
    for (int i = 0; i < 2; ++i) {
        const int pt = wave * 32 + i * 16 + l16;
        const int row = chunk * 128 + pt;
        const float bias = bs[pt];
#pragma unroll
        for (int j = 0; j < 8; ++j) {
            const int c = g * 128 + j * 16 + quad * 4;
            const u32x2 uw = *(const u32x2*)(u + (size_t)row * 512 + c);
            const float u0 = __uint_as_float(uw.x << 16), u1 = __uint_as_float(uw.x & 0xffff0000u);
            const float u2 = __uint_as_float(uw.y << 16), u3 = __uint_as_float(uw.y & 0xffff0000u);
            const f32x4 v = acc[i][j];
            st4bf(as + (size_t)row * 1024 + 512 + c, u0 * (v[0] + bias), u1 * (v[1] + bias), u2 * (v[2] + bias), u3 * (v[3] + bias));
        }
    }
}

__device__ void attn_sg_phase(const Params& p, int layer, bf16_t* smem) {
    const int j2 = layer >> 1;
    const int nA = NB * 8 * 64, nS = (MT / 128) * 4, nC = NB * 8 * 2;
    for (int t = blockIdx.x; t < nA + nS + nC; t += gridDim.x) {
        if (t < nA) {
            const int qb = t & 63, h = (t >> 6) & 7, b = t >> 9;
            attn_item(p, b, h, b * SEQ + qb * 128, TALL, smem);
        } else if (t < nA + nS) {
            const int u = t - nA;
            sg_item(p, j2, u >> 2, u & 3, smem);
        } else {
            const int u = t - nA - nS;
            const int qb = u & 1, h = (u >> 1) & 7, b = u >> 4;
            attn_item(p, b, h, ML + b * CTX + qb * 128, CTX, smem);
        }
    }
}

__device__ void conv_phase(const Params& p, int layer, float* smf) {
    const int j2 = layer >> 1, tid = tid_();
    const bf16_t* xbc = (const bf16_t*)(p.ws + WS_XBC);
    bf16_t* XT = (bf16_t*)(p.ws + WS_XT); bf16_t* Bn = (bf16_t*)(p.ws + WS_BN); bf16_t* Cn = (bf16_t*)(p.ws + WS_CN); bf16_t* BT = (bf16_t*)(p.ws + WS_BT);
    const float* cw = p.ssm_conv_w + (size_t)j2 * 3 * 3072;
    const float* cb = p.ssm_conv_b + (size_t)j2 * 3072;
    float* sin_ = smf;
    float* sout = smf + 66 * 65;
    const int nCt = 3072 / 64, nRt = MT / 64;
    for (int t = blockIdx.x; t < nCt * nRt; t += gridDim.x) {
        const int rt = t / nCt, ct = t - rt * nCt;
        const int r0 = rt * 64, c0 = ct * 64;
        const bool first = r0 < ML ? ((r0 & (SEQ - 1)) == 0) : (((r0 - ML) & (CTX - 1)) == 0);
        const bool last = r0 < ML ? (((r0 + 64) & (SEQ - 1)) == 0) : ((((r0 + 64) - ML) & (CTX - 1)) == 0);
        lds_sync();
        for (int e = tid; e < 66 * 64; e += 256) {
            const int rr = e >> 6, c = e & 63;
            const int row = r0 - 1 + rr;
            float v = 0.f;
            if (!((rr == 0 && first) || (rr == 65 && last))) v = bf2f(xbc[(size_t)row * 3072 + c0 + c]);
            sin_[rr * 65 + c] = v;
        }
        lds_sync();
        {
            const int c = tid & 63;
            const float w0 = cw[c0 + c], w1 = cw[3072 + c0 + c], w2 = cw[2 * 3072 + c0 + c], bb = cb[c0 + c];
#pragma unroll
            for (int k = 0; k < 16; ++k) {
                const int tt = (tid >> 6) + k * 4;
                const float v = w0 * sin_[tt * 65 + c] + w1 * sin_[(tt + 1) * 65 + c] + w2 * sin_[(tt + 2) * 65 + c] + bb;
                const float y = siluf(v);
                sout[c * 65 + tt] = y;
                if (c0 >= 2048) {
                    if (c0 < 2560) Bn[(size_t)(r0 + tt) * 512 + (c0 - 2048) + c] = f2bf(y);
                    else Cn[(size_t)(r0 + tt) * 512 + (c0 - 2560) + c] = f2bf(y);
                }
            }
        }
        lds_sync();
        if (c0 < 2560) {
            bf16_t* dst = c0 < 2048 ? XT + (size_t)c0 * MT : BT + (size_t)(c0 - 2048) * MT;
            const int tt = tid & 63;
#pragma unroll
            for (int k = 0; k < 16; ++k) {
                const int c = (tid >> 6) + k * 4;
                dst[(size_t)c * MT + r0 + tt] = f2bf(sout[c * 65 + tt]);
            }
        }
    }
}

__device__ void ssd_diag_item(const Params& p, int j2, int row0, int h, bf16_t* smem) {
    const int tid = tid_(), lane = tid & 63, wave = tid >> 6, l16 = lane & 15, quad = lane >> 4;
    const int g = h >> 3;
    bf16_t* sB = smem;
    bf16_t* sX = sB + 128 * SST;
    float* sda = (float*)(sX + 64 * SST);
    float* sPf = sda + 256;
    float* sRb = sPf + 128;
    float* sdtf = sRb + 128;
    float* sdtb = sdtf + 128;
    const bf16_t* XT = (const bf16_t*)(p.ws + WS_XT) + (size_t)(h * 64) * MT;
    const bf16_t* Bn = (const bf16_t*)(p.ws + WS_BN) + g * 128;
    const bf16_t* Cn = (const bf16_t*)(p.ws + WS_CN) + g * 128;
    const float* DT = (const float*)(p.ws + WS_DT);
    bf16_t* Y = (bf16_t*)(p.ws + WS_YF);
    const float af = -expf(p.ssm_a_log[(j2 * 2 + 0) * 32 + h]);
    const float ab = -expf(p.ssm_a_log[(j2 * 2 + 1) * 32 + h]);
    const float dsk = p.ssm_d[j2 * 32 + h];
    lds_sync();
#pragma unroll
    for (int i = 0; i < 8; ++i) {
        const int c = tid + i * 256, r = c >> 4, kc = (c & 15) * 8;
        *(u32x4*)(sB + r * SST + kc) = *(const u32x4*)(Bn + (size_t)(row0 + r) * 512 + kc);
    }
#pragma unroll
    for (int i = 0; i < 4; ++i) {
        const int c = tid + i * 256, r = c >> 4, kc = (c & 15) * 8;
        *(u32x4*)(sX + r * SST + kc) = *(const u32x4*)(XT + (size_t)r * MT + row0 + kc);
    }
    {
        const int d = wave >> 1;
        const float d0 = DT[(size_t)(row0 + lane) * 64 + d * 32 + h], d1 = DT[(size_t)(row0 + 64 + lane) * 64 + d * 32 + h];
        const float aa = d ? ab : af;
        const f32x2 sc2 = scan128(d0 * aa, d1 * aa, lane, d);
        float* sc = d ? sRb : sPf; float* sd = d ? sdtb : sdtf;
        if ((wave & 1) == 0) { sc[lane] = sc2.x; sd[lane] = d0; } else { sc[64 + lane] = sc2.y; sd[64 + lane] = d1; }
    }
    bf16x8 cf[2][4];
#pragma unroll
    for (int i = 0; i < 2; ++i)
#pragma unroll
        for (int ks = 0; ks < 4; ++ks)
            cf[i][ks] = *(const bf16x8*)(Cn + (size_t)(row0 + wave * 32 + i * 16 + l16) * 512 + ks * 32 + quad * 8);
    lds_sync();
    float pfl[2], rbl[2];
#pragma unroll
    for (int i = 0; i < 2; ++i) { pfl[i] = sPf[wave * 32 + i * 16 + l16]; rbl[i] = sRb[wave * 32 + i * 16 + l16]; }
    f32x4 y[4][2];
#pragma unroll
    for (int pt = 0; pt < 4; ++pt)
#pragma unroll
        for (int i = 0; i < 2; ++i) y[pt][i] = (f32x4){0.f, 0.f, 0.f, 0.f};
#pragma unroll 1
    for (int sp = 0; sp < 4; ++sp) {
        f32x4 gt[2][2];
#pragma unroll
        for (int s2 = 0; s2 < 2; ++s2)
#pragma unroll
            for (int i = 0; i < 2; ++i) gt[s2][i] = (f32x4){0.f, 0.f, 0.f, 0.f};
#pragma unroll
        for (int ks = 0; ks < 4; ++ks)
#pragma unroll
            for (int s2 = 0; s2 < 2; ++s2) {
                const bf16x8 bfr = lds16(sB + (sp * 32 + s2 * 16 + l16) * SST + ks * 32 + quad * 8);
#pragma unroll
                for (int i = 0; i < 2; ++i) gt[s2][i] = mfma16(bfr, cf[i][ks], gt[s2][i]);
            }
        bf16x8 mf[2];
#pragma unroll
        for (int i = 0; i < 2; ++i) {
            const int l = wave * 32 + i * 16 + l16;
#pragma unroll
            for (int s2 = 0; s2 < 2; ++s2)
#pragma unroll
                for (int r = 0; r < 4; ++r) {
                    const int s = sp * 32 + s2 * 16 + quad * 4 + r;
                    const float arg = s < l ? (pfl[i] - sPf[s]) : (rbl[i] - sRb[s]);
                    float coef = __expf(fminf(arg, 0.f)) * (s < l ? sdtf[s] : sdtb[s]);
                    if (s == l) coef = sdtf[s] + sdtb[s];
                    gt[s2][i][r] *= coef;
                }
            mf[i] = pack8(gt[0][i], gt[1][i]);
        }
#pragma unroll
        for (int pt = 0; pt < 4; ++pt) {
            const bf16_t* xp = sX + (pt * 16 + l16) * SST + sp * 32 + quad * 4;
            const bf16x8 xf = lds8x2(xp, xp + 16);
#pragma unroll
            for (int i = 0; i < 2; ++i) y[pt][i] = mfma16(xf, mf[i], y[pt][i]);
        }
    }
#pragma unroll
    for (int i = 0; i < 2; ++i) {
        const int l = wave * 32 + i * 16 + l16;
#pragma unroll
        for (int pt = 0; pt < 4; ++pt) {
            f32x4 v = y[pt][i];
#pragma unroll
            for (int r = 0; r < 4; ++r) v[r] += dsk * bf2f(sX[(pt * 16 + quad * 4 + r) * SST + l]);
            st4bf(Y + (size_t)(row0 + l) * 2048 + h * 64 + pt * 16 + quad * 4, v[0], v[1], v[2], v[3]);
        }
    }
}

__device__ void ssd_diag_phase(const Params& p, int layer, bf16_t* smem) {
    const int j2 = layer >> 1;
    for (int t = blockIdx.x; t < (MT / 128) * 32; t += gridDim.x) {
        const int h = t & 31, chunk = t >> 5;
        ssd_diag_item(p, j2, chunk * 128, h, smem);
    }
}

struct SsdPre { u32x4 xq; u32x4 bt[2][4]; u32x4 cf[2][4]; u32x2 yold[2]; float dt0, dt1; };

__device__ __forceinline__ int ssd_row0(int b, int dir, int cc) {
    if (cc < 2) { const int ci = dir ? 1 - cc : cc; return ML + b * CTX + ci * 128; }
    const int k = cc - 2; const int ci = dir ? 63 - k : k; return b * SEQ + ci * 128;
}

__device__ void ssd_scan_item(const Params& p, int j2, int b, int dir, int h, int pq, bf16_t* smem) {
    const int tid = tid_(), lane = tid & 63, wave = tid >> 6, l16 = lane & 15, quad = lane >> 4;
    const int g = h >> 3;
    bf16_t* sX = smem;
    bf16_t* sH = sX + 16 * SST;
    float* sacs = (float*)(sH + 16 * SST);
    float* sdt = sacs + 128;
    const bf16_t* XT = (const bf16_t*)(p.ws + WS_XT) + (size_t)(h * 64 + pq * 16 + (tid >> 4)) * MT + (tid & 15) * 8;
    const bf16_t* Cn = (const bf16_t*)(p.ws + WS_CN) + g * 128 + (size_t)(wave * 32 + l16) * 512 + quad * 8;
    const bf16_t* BT = (const bf16_t*)(p.ws + WS_BT) + (size_t)(g * 128 + wave * 32 + l16) * MT + quad * 8;
    const float* DT = (const float*)(p.ws + WS_DT) + dir * 32 + h;
    bf16_t* Y = (bf16_t*)(p.ws + (dir ? WS_YB : WS_YF)) + (size_t)(wave * 32 + l16) * 2048 + h * 64 + pq * 16 + quad * 4;
    const float a = -expf(p.ssm_a_log[(j2 * 2 + dir) * 32 + h]);
    f32x4 st[2];
    st[0] = (f32x4){0.f, 0.f, 0.f, 0.f}; st[1] = (f32x4){0.f, 0.f, 0.f, 0.f};
    SsdPre nx;
    {
        const int row0 = ssd_row0(b, dir, 0);
        nx.xq = *(const u32x4*)(XT + row0);
#pragma unroll
        for (int nt = 0; nt < 2; ++nt)
#pragma unroll
            for (int ks = 0; ks < 4; ++ks) nx.bt[nt][ks] = *(const u32x4*)(BT + (size_t)(nt * 16) * MT + row0 + ks * 32);
#pragma unroll
        for (int i = 0; i < 2; ++i)
#pragma unroll
            for (int ks = 0; ks < 4; ++ks) nx.cf[i][ks] = *(const u32x4*)(Cn + (size_t)(row0 + i * 16) * 512 + ks * 32);
#pragma unroll
        for (int i = 0; i < 2; ++i) nx.yold[i] = dir == 0 ? *(const u32x2*)(Y + (size_t)(row0 + i * 16) * 2048) : (u32x2){0u, 0u};
        nx.dt0 = DT[(size_t)(row0 + lane) * 64]; nx.dt1 = DT[(size_t)(row0 + 64 + lane) * 64];
    }
#pragma unroll 1
    for (int cc = 0; cc < 66; ++cc) {
        const int row0 = ssd_row0(b, dir, cc);
        const SsdPre cu = nx;
        lds_sync();
        *(u32x4*)(sX + (tid >> 4) * SST + (tid & 15) * 8) = cu.xq;
#pragma unroll
        for (int nt = 0; nt < 2; ++nt) st4bf(sH + l16 * SST + wave * 32 + nt * 16 + quad * 4, st[nt][0], st[nt][1], st[nt][2], st[nt][3]);
        if (wave < 2) {
            const f32x2 sc2 = scan128(cu.dt0 * a, cu.dt1 * a, lane, dir);
            if (wave == 0) { sacs[lane] = sc2.x; sdt[lane] = cu.dt0; } else { sacs[64 + lane] = sc2.y; sdt[64 + lane] = cu.dt1; }
        }
        lds_sync();
        if (cc + 1 < 66) {
            const int r1 = ssd_row0(b, dir, cc + 1);
            nx.xq = *(const u32x4*)(XT + r1);
#pragma unroll
            for (int nt = 0; nt < 2; ++nt)
#pragma unroll
                for (int ks = 0; ks < 4; ++ks) nx.bt[nt][ks] = *(const u32x4*)(BT + (size_t)(nt * 16) * MT + r1 + ks * 32);
#pragma unroll
            for (int i = 0; i < 2; ++i)
#pragma unroll
                for (int ks = 0; ks < 4; ++ks) nx.cf[i][ks] = *(const u32x4*)(Cn + (size_t)(r1 + i * 16) * 512 + ks * 32);
#pragma unroll
            for (int i = 0; i < 2; ++i) nx.yold[i] = dir == 0 ? *(const u32x2*)(Y + (size_t)(r1 + i * 16) * 2048) : (u32x2){0u, 0u};
            nx.dt0 = DT[(size_t)(r1 + lane) * 64]; nx.dt1 = DT[(size_t)(r1 + 64 + lane) * 64];
        }
        const float total = dir == 0 ? sacs[127] : sacs[0];
        f32x4 yo[2];
        yo[0] = (f32x4){0.f, 0.f, 0.f, 0.f}; yo[1] = (f32x4){0.f, 0.f, 0.f, 0.f};
#pragma unroll
        for (int ks = 0; ks < 4; ++ks) {
            const bf16x8 hf = lds16(sH + l16 * SST + ks * 32 + quad * 8);
#pragma unroll
            for (int i = 0; i < 2; ++i) yo[i] = mfma16(hf, __builtin_bit_cast(bf16x8, cu.cf[i][ks]), yo[i]);
        }
#pragma unroll
        for (int i = 0; i < 2; ++i) {
            const float e = __expf(sacs[wave * 32 + i * 16 + l16]);
            const float o0 = __uint_as_float(cu.yold[i].x << 16), o1 = __uint_as_float(cu.yold[i].x & 0xffff0000u);
            const float o2 = __uint_as_float(cu.yold[i].y << 16), o3 = __uint_as_float(cu.yold[i].y & 0xffff0000u);
            st4bf(Y + (size_t)(row0 + i * 16) * 2048, yo[i][0] * e + o0, yo[i][1] * e + o1, yo[i][2] * e + o2, yo[i][3] * e + o3);
        }
        {
            const float dec = __expf(total);
            st[0] *= dec; st[1] *= dec;
#pragma unroll
            for (int ks = 0; ks < 4; ++ks) {
                float w[8];
#pragma unroll
                for (int e = 0; e < 8; ++e) { const int s = ks * 32 + quad * 8 + e; w[e] = sdt[s] * __expf(total - sacs[s]); }
                const bf16x8 xbf = lds16(sX + l16 * SST + ks * 32 + quad * 8);
#pragma unroll
                for (int nt = 0; nt < 2; ++nt) {
                    const u32x4 raw = cu.bt[nt][ks];
                    u32x4 sw;
                    sw.x = pack2(__uint_as_float(raw.x << 16) * w[0], __uint_as_float(raw.x & 0xffff0000u) * w[1]);
                    sw.y = pack2(__uint_as_float(raw.y << 16) * w[2], __uint_as_float(raw.y & 0xffff0000u) * w[3]);
                    sw.z = pack2(__uint_as_float(raw.z << 16) * w[4], __uint_as_float(raw.z & 0xffff0000u) * w[5]);
                    sw.w = pack2(__uint_as_float(raw.w << 16) * w[6], __uint_as_float(raw.w & 0xffff0000u) * w[7]);
                    st[nt] = mfma16(__builtin_bit_cast(bf16x8, sw), xbf, st[nt]);
                }
            }
        }
    }
}

__device__ void ssd_scan_phase(const Params& p, int layer, bf16_t* smem) {
    const int j2 = layer >> 1;
    for (int t = blockIdx.x; t < NB * 2 * 32 * 4; t += gridDim.x) {
        const int pq = t & 3, h = (t >> 2) & 31, dir = (t >> 7) & 1, b = t >> 8;
        ssd_scan_item(p, j2, b, dir, h, pq, smem);
    }
}

__device__ void finish_phase(const Params& p, int layer) {
    const int j2 = layer >> 1, lane = tid_() & 63, wave = tid_() >> 6;
    bf16_t* yf = (bf16_t*)(p.ws + WS_YF); const bf16_t* yb = (const bf16_t*)(p.ws + WS_YB); const bf16_t* z = (const bf16_t*)(p.ws + WS_Z);
    const float* gn = p.ssm_norm_g + (size_t)j2 * 2048;
    for (int row = blockIdx.x * 4 + wave; row < MT; row += gridDim.x * 4) {
#pragma unroll
        for (int g = 0; g < 4; ++g) {
            const size_t off = (size_t)row * 2048 + g * 512 + lane * 8;
            const u32x4 a = *(const u32x4*)(yf + off), bq = *(const u32x4*)(yb + off), zq = *(const u32x4*)(z + off);
            const unsigned aw[4] = {a.x, a.y, a.z, a.w}, bw[4] = {bq.x, bq.y, bq.z, bq.w}, zw[4] = {zq.x, zq.y, zq.z, zq.w};
            float v[8]; float ss = 0.f;
#pragma unroll
            for (int k = 0; k < 4; ++k) {
                v[2 * k] = (__uint_as_float(aw[k] << 16) + __uint_as_float(bw[k] << 16)) * __uint_as_float(zw[k] << 16);
                v[2 * k + 1] = (__uint_as_float(aw[k] & 0xffff0000u) + __uint_as_float(bw[k] & 0xffff0000u)) * __uint_as_float(zw[k] & 0xffff0000u);
                ss += v[2 * k] * v[2 * k] + v[2 * k + 1] * v[2 * k + 1];
            }
#pragma unroll
            for (int o = 1; o < 64; o <<= 1) ss += __shfl_xor(ss, o);
            const float rstd = rsqrtf(ss * (1.f / 512.f) + EPS);
            const f32x4 g0 = *(const f32x4*)(gn + g * 512 + lane * 8), g1 = *(const f32x4*)(gn + g * 512 + lane * 8 + 4);
            u32x4 o4;
            o4.x = pack2(v[0] * rstd * g0[0], v[1] * rstd * g0[1]); o4.y = pack2(v[2] * rstd * g0[2], v[3] * rstd * g0[3]);
            o4.z = pack2(v[4] * rstd * g1[0], v[5] * rstd * g1[1]); o4.w = pack2(v[6] * rstd * g1[2], v[7] * rstd * g1[3]);
            *(u32x4*)(yf + off) = o4;
        }
    }
}

__global__ void __launch_bounds__(256, 2) hybrid_fwd(Params p) {
    extern __shared__ __attribute__((aligned(16))) unsigned char lds[];
    cg::grid_group grid = cg::this_grid();
    bf16_t* smem = (bf16_t*)lds; float* smf = (float*)lds;
    volatile LAS unsigned* bst = (volatile LAS unsigned*)(lds + LDS_BYTES - 16);
    if (threadIdx.x == 0) { bst[0] = 0u; bst[1] = 0u; }
    __syncthreads();
    const XcdBarrier xb = xcd_barrier_post((unsigned*)(p.ws + WS_BAR), bst);
    enum { C_NORM1 = 0, C_MIXIN, C_ATTN, C_MIXOUT, C_NORM2, C_FFNIN, C_FFNOUT, C_SSMIN, C_CONV, C_SSD, C_FINISH, C_SSMOUT, C_PRO, C_SSDB };
    const unsigned long long evc = 0x6543210ull;
    const unsigned long long odc = 0x654BAD9870ull;
    for (int ph = 0; ph < 35; ++ph) {
        int code, layer;
        if (ph == 0) { code = C_PRO; layer = 0; }
        else {
            const int q = ph - 1, pair = q / 17, r = q - pair * 17;
            if (r < 7) { layer = 2 * pair; code = (int)((evc >> (4 * r)) & 15); }
            else { layer = 2 * pair + 1; code = (int)((odc >> (4 * (r - 7))) & 15); }
        }
        Params q = p;
        asm volatile("" : "+s"(q.ws));
        asm volatile("" : "+s"(q.out));
        switch (code) {
            case C_PRO: prologue(q, smf); break;
            case C_NORM1: if (layer > 0) convert_layer_weights(q, layer, smf); norm_phase(q, layer, 0); break;
            case C_NORM2: norm_phase(q, layer, 1); break;
            case C_MIXIN: gemm_phase<G_MIXIN>(q, layer, smem); break;
            case C_ATTN: attn_sg_phase(q, layer, smem); break;
            case C_MIXOUT: gemm_phase<G_MIXOUT>(q, layer, smem); break;
            case C_FFNIN: gemm_phase<G_FFNIN>(q, layer, smem); break;
            case C_FFNOUT: gemm_phase<G_FFNOUT>(q, layer, smem); break;
            case C_SSMIN: gemm_phase<G_SSMIN>(q, layer, smem); break;
            case C_CONV: conv_phase(q, layer, smf); break;
            case C_SSD: ssd_diag_phase(q, layer, smem); break;
            case C_SSDB: ssd_scan_phase(q, layer, smem); break;
            case C_FINISH: finish_phase(q, layer); break;
            case C_SSMOUT: gemm_phase<G_SSMOUT>(q, layer, smem); break;
            default: break;
        }
        if (ph == 0) grid.sync(); else xcd_barrier(xb);
    }
}

extern "C" void kernel_launch(void* const* d_in, const int* in_sizes, int n_in, void* d_out, int out_size, void* d_ws, size_t ws_size, hipStream_t stream) {
    static int grid_blocks = 0;
    if (grid_blocks == 0) {
        if (ws_size < WS_TOTAL) { fprintf(stderr, "kernel_launch: workspace too small: %zu < %zu\n", ws_size, (size_t)WS_TOTAL); grid_blocks = -1; return; }
        int dev = 0, cus = 0, per_cu = 0;
        hipGetDevice(&dev);
        hipDeviceGetAttribute(&cus, hipDeviceAttributeMultiprocessorCount, dev);
        if (hipFuncSetAttribute((const void*)hybrid_fwd, hipFuncAttributeMaxDynamicSharedMemorySize, LDS_BYTES) != hipSuccess) { fprintf(stderr, "kernel_launch: hipFuncSetAttribute failed\n"); }
        if (hipOccupancyMaxActiveBlocksPerMultiprocessor(&per_cu, (const void*)hybrid_fwd, 256, LDS_BYTES) != hipSuccess || per_cu < 1) { fprintf(stderr, "kernel_launch: occupancy query failed (%d)\n", per_cu); per_cu = 1; }
        if (per_cu > 2) per_cu = 2;
        (void)hipGetLastError();
        grid_blocks = cus * per_cu;
    }
    if (grid_blocks < 0) return;
    if (hipMemsetAsync((char*)d_ws + WS_BAR, 0, XCD_BAR_WORDS * sizeof(unsigned), stream) != hipSuccess) { fprintf(stderr, "kernel_launch: hipMemsetAsync failed\n"); return; }
    Params p{};
    const float** f = (const float**)&p;
    for (int i = 0; i < 25; ++i) f[i] = (const float*)d_in[i];
    p.out = (float*)d_out; p.ws = (unsigned char*)d_ws;
    void* args[] = {&p};
    hipError_t e = hipLaunchCooperativeKernel((const void*)hybrid_fwd, dim3(grid_blocks), dim3(256), args, LDS_BYTES, stream);
    if (e != hipSuccess) fprintf(stderr, "cooperative launch failed: %s (grid %d)\n", hipGetErrorString(e), grid_blocks);
}
```

```cpp
#include <hip/hip_runtime.h>
#include <hip/hip_cooperative_groups.h>
#include <cstdio>
#include <cstdint>
namespace cg = cooperative_groups;

typedef unsigned short bf16_t;
typedef short bf16x8 __attribute__((ext_vector_type(8)));
typedef short bf16x4 __attribute__((ext_vector_type(4)));
typedef float f32x4 __attribute__((ext_vector_type(4)));
typedef unsigned u32x4 __attribute__((ext_vector_type(4)));
typedef unsigned u32x2 __attribute__((ext_vector_type(2)));

constexpr int D = 1024, NB = 2, SEQ = 8192, CTX = 256;
constexpr int ML = NB * SEQ;
constexpr int MC = NB * CTX;
constexpr int MT = ML + MC;
constexpr int TALL = CTX + SEQ;
constexpr int FFH = 2816;
constexpr int MIXIN = 1792;
constexpr int SSMIN = 5184, SSMIN_PAD = 5248;
constexpr int SSI = 2048;
constexpr float EPS = 1e-6f;

constexpr size_t MB = 1024 * 1024;
constexpr size_t WS_MOD = 0;
constexpr size_t WS_ROPE = 1 * MB;
constexpr size_t WS_XCTX = 3 * MB;
constexpr size_t WS_SGW = 5 * MB + 512 * 1024;
constexpr size_t WS_BAR = 7 * MB;
constexpr size_t WS_WT = 8 * MB;
constexpr size_t WT_FFNIN = 0;
constexpr size_t WT_FFNOUT = WT_FFNIN + (size_t)5632 * 1024 * 2;
constexpr size_t WT_MIXIN = WT_FFNOUT + (size_t)1024 * 2816 * 2;
constexpr size_t WT_MIXOUT = WT_MIXIN + (size_t)SSMIN_PAD * 1024 * 2;
constexpr size_t WT_END = WT_MIXOUT + (size_t)1024 * 2048 * 2;
constexpr size_t WS_R0 = WS_WT + ((WT_END + MB - 1) / MB) * MB;
constexpr size_t SZ_XBC = (size_t)MT * 3072 * 2;
constexpr size_t SZ_HN = (size_t)MT * 1024 * 2;
constexpr size_t WS_XBC = WS_R0;
constexpr size_t WS_HN = WS_XBC + SZ_XBC;
constexpr size_t WS_YF = WS_XBC;
constexpr size_t WS_YB = WS_YF + (size_t)MT * 2048 * 2;
constexpr size_t WS_R1 = WS_HN + SZ_HN;
constexpr size_t WS_Z = WS_R1;
constexpr size_t WS_XT = WS_Z + (size_t)MT * 2048 * 2;
constexpr size_t WS_BN = WS_XT + (size_t)MT * 2048 * 2;
constexpr size_t WS_CN = WS_BN + (size_t)MT * 512 * 2;
constexpr size_t WS_BT = WS_CN + (size_t)MT * 512 * 2;
constexpr size_t WS_DT = WS_BT + (size_t)MT * 512 * 2;
constexpr size_t WS_END_ODD = WS_DT + (size_t)MT * 64 * 4;
constexpr size_t WS_Q = WS_R1;
constexpr size_t WS_K = WS_Q + (size_t)MT * 512 * 2;
constexpr size_t WS_VT = WS_K + (size_t)MT * 128 * 2;
constexpr size_t WS_U = WS_VT + (size_t)MT * 128 * 2;
constexpr size_t WS_GVT = WS_U + (size_t)MT * 512 * 2;
constexpr size_t WS_AS = WS_GVT + (size_t)MT * 512 * 2;
constexpr size_t WS_HID = WS_R1;
constexpr size_t WS_TOTAL = WS_END_ODD;
static_assert(WS_TOTAL < (size_t)400 * MB, "workspace too large");
static_assert(WS_AS + (size_t)MT * 1024 * 2 <= WS_END_ODD, "even buffers fit");
static_assert(WS_HID + (size_t)MT * FFH * 2 <= WS_END_ODD, "hid fits");

constexpr int LDS_BYTES = 73728;
constexpr int GST = 72;
constexpr int SST = 136;

struct Params {
    const float* x; const float* c; const float* ctx; const float* c_ctx;
    const float* ada_w; const float* ada_b; const float* norm1_g; const float* norm2_g;
    const float* ffn_w_in; const float* ffn_w_out; const float* mix_w_in; const float* mix_w_out;
    const float* q_norm_g; const float* k_norm_g; const float* sgu_norm_g; const float* sgu_w; const float* sgu_b;
    const float* ssm_w_in; const float* ssm_conv_w; const float* ssm_conv_b; const float* ssm_dt_bias;
    const float* ssm_a_log; const float* ssm_d; const float* ssm_norm_g; const float* ssm_w_out;
    float* out; unsigned char* ws;
};

typedef const __attribute__((address_space(4))) Params CParams;

__device__ __forceinline__ int tid_() { int t = threadIdx.x; asm volatile("" : "+v"(t)); return t; }
__device__ __forceinline__ bf16_t f2bf(float f) {
    unsigned u = __float_as_uint(f);
    u += 0x7fffu + ((u >> 16) & 1u);
    return (bf16_t)(u >> 16);
}
__device__ __forceinline__ float bf2f(bf16_t h) { return __uint_as_float(((unsigned)h) << 16); }
__device__ __forceinline__ unsigned pack2(float a, float b) { unsigned r; asm volatile("v_cvt_pk_bf16_f32 %0, %1, %2" : "=v"(r) : "v"(a), "v"(b)); return r; }
__device__ __forceinline__ float siluf(float v) { return v / (1.f + __expf(-v)); }
__device__ __forceinline__ float geluf(float v) {
    const float u = 0.7978845608028654f * (v + 0.044715f * v * v * v);
    return v / (1.f + __expf(-2.f * u));
}
__device__ __forceinline__ float softplusf(float v) { return v > 20.f ? v : log1pf(expf(v)); }
__device__ __forceinline__ int seg_of(int row) { return row < SEQ ? 0 : (row < ML ? 1 : 2); }
__device__ __forceinline__ float* xrow(CParams& p, int row) {
    return row < ML ? p.out + (size_t)row * D : (float*)(p.ws + WS_XCTX) + (size_t)(row - ML) * D;
}
__device__ __forceinline__ void lds_sync() {
    __builtin_amdgcn_fence(__ATOMIC_RELEASE, "workgroup", "local");
    __builtin_amdgcn_s_barrier();
    __builtin_amdgcn_fence(__ATOMIC_ACQUIRE, "workgroup", "local");
}
typedef float f32x2 __attribute__((ext_vector_type(2)));
__device__ __forceinline__ f32x2 scan128(float s0, float s1, int lane, int dir) {
    if (dir == 0) {
#pragma unroll
        for (int o = 1; o < 64; o <<= 1) { const float t0 = __shfl_up(s0, o), t1 = __shfl_up(s1, o); s0 += lane >= o ? t0 : 0.f; s1 += lane >= o ? t1 : 0.f; }
        s1 += __shfl(s0, 63);
    } else {
#pragma unroll
        for (int o = 1; o < 64; o <<= 1) { const float t0 = __shfl_down(s0, o), t1 = __shfl_down(s1, o); s0 += lane + o < 64 ? t0 : 0.f; s1 += lane + o < 64 ? t1 : 0.f; }
        s0 += __shfl(s1, 0);
    }
    return (f32x2){s0, s1};
}
__device__ __forceinline__ f32x4 mfma16(bf16x8 a, bf16x8 b, f32x4 c) { return __builtin_amdgcn_mfma_f32_16x16x32_bf16(a, b, c, 0, 0, 0); }
__device__ __forceinline__ bf16x8 lds16(const bf16_t* p) { return *(const bf16x8*)p; }
__device__ __forceinline__ bf16x8 lds8x2(const bf16_t* p0, const bf16_t* p1) {
    const bf16x4 a = *(const bf16x4*)p0, b = *(const bf16x4*)p1;
    bf16x8 r; r[0] = a[0]; r[1] = a[1]; r[2] = a[2]; r[3] = a[3]; r[4] = b[0]; r[5] = b[1]; r[6] = b[2]; r[7] = b[3];
    return r;
}
__device__ __forceinline__ bf16x8 pack8(f32x4 a, f32x4 b) {
    u32x4 w; w.x = pack2(a[0], a[1]); w.y = pack2(a[2], a[3]); w.z = pack2(b[0], b[1]); w.w = pack2(b[2], b[3]);
    return __builtin_bit_cast(bf16x8, w);
}
__device__ __forceinline__ void st4bf(bf16_t* dst, float a, float b, float c, float d) {
    u32x2 w; w.x = pack2(a, b); w.y = pack2(c, d); *(u32x2*)dst = w;
}


#define XB_TMO      128
#define XB_XCNT(j)  (256  + 64 * (j))
#define XB_XSUB(j)  (1280 + 64 * (j))
#define XB_XGEN(j)  (2304 + 64 * (j))
#define XB_TOP      3328
#define XB_TOPGEN   3392
#define XCD_BAR_WORDS 3456
#define XB_SPIN_CAP (1u << 18)
#define LAS __attribute__((address_space(3)))
__device__ __forceinline__ unsigned xb_ld(unsigned* p)              { return __hip_atomic_load(p, __ATOMIC_RELAXED, __HIP_MEMORY_SCOPE_AGENT); }
__device__ __forceinline__ unsigned xb_add(unsigned* p, unsigned v) { return __hip_atomic_fetch_add(p, v, __ATOMIC_RELAXED, __HIP_MEMORY_SCOPE_AGENT); }
__device__ __forceinline__ unsigned xb_xcc_id() { return (unsigned)__builtin_amdgcn_s_getreg((3 << 11) | 20) & 0xFu; }
#define XB_SPIN(cond, bar) do { unsigned _sp = 0; while (cond) { __builtin_amdgcn_s_sleep(1); \
    if ((++_sp & 255u) == 0u) { if (xb_ld(&(bar)[XB_TMO])) break; if (_sp > XB_SPIN_CAP) { atomicAdd(&(bar)[XB_TMO], 1u); break; } } } } while (0)
struct XcdBarrier { unsigned* bar; unsigned x; volatile LAS unsigned* st; };
__device__ __forceinline__ XcdBarrier xcd_barrier_post(unsigned* bar, volatile LAS unsigned* st) {
    XcdBarrier b; b.bar = bar; b.x = xb_xcc_id(); b.st = st;
    if (threadIdx.x == 0) (void)xb_add(&bar[XB_XCNT(b.x)], 1u);
    return b;
}
__device__ __forceinline__ void xcd_barrier_complete(unsigned* bar, unsigned x, unsigned& nloc, unsigned& nx) {
    const unsigned G = gridDim.x * gridDim.y * gridDim.z;
    unsigned sum, cnt, mine, sp = 0u;
    for (;;) {
        sum = 0u; cnt = 0u; mine = 0u;
#pragma unroll
        for (unsigned j = 0; j < 16; ++j) { const unsigned c = xb_ld(&bar[XB_XCNT(j)]); sum += c; cnt += (c > 0u) ? 1u : 0u; mine = (j == x) ? c : mine; }
        if (sum == G) break;
        __builtin_amdgcn_s_sleep(1);
        if ((++sp & 255u) == 0u) { if (xb_ld(&bar[XB_TMO])) break; if (sp > XB_SPIN_CAP) { atomicAdd(&bar[XB_TMO], 1u); break; } }
    }
    nloc = mine > 0u ? mine : 1u; nx = cnt > 0u ? cnt : 1u;
}
__device__ __forceinline__ void xcd_barrier(const XcdBarrier& b) {
    asm volatile("s_waitcnt vmcnt(0)" ::: "memory");
    __syncthreads();
    if (threadIdx.x == 0) {
        unsigned* bar = b.bar;
        __builtin_amdgcn_s_waitcnt(0);
        unsigned nloc = b.st[0], nx = b.st[1];
        if (nloc == 0u) { xcd_barrier_complete(bar, b.x, nloc, nx); b.st[0] = nloc; b.st[1] = nx; }
        const unsigned old = xb_add(&bar[XB_XSUB(b.x)], 1u);
        const unsigned gen = old / nloc;
        if (old + 1u == (gen + 1u) * nloc) {
            __builtin_amdgcn_fence(__ATOMIC_RELEASE, "agent");
            asm volatile("s_waitcnt vmcnt(0)" ::: "memory");
            const unsigned og = xb_add(&bar[XB_TOP], 1u);
            const unsigned tg = og / nx;
            if (og + 1u == (tg + 1u) * nx) xb_add(&bar[XB_TOPGEN], 1u);
            else XB_SPIN(xb_ld(&bar[XB_TOPGEN]) == tg, bar);
            __builtin_amdgcn_fence(__ATOMIC_ACQUIRE, "agent");
            xb_add(&bar[XB_XGEN(b.x)], 1u);
            asm volatile("s_waitcnt vmcnt(0)" ::: "memory");
        } else {
            XB_SPIN(xb_ld(&bar[XB_XGEN(b.x)]) == gen, bar);
            __builtin_amdgcn_fence(__ATOMIC_ACQUIRE, "agent");
            asm volatile("s_waitcnt vmcnt(0)" ::: "memory");
        }
    }
    __syncthreads();
}

template <int MI, int lda, int ldw, int K>
__device__ __forceinline__ void gemm_tile(const bf16_t* __restrict__ A, const bf16_t* __restrict__ W,
                                          f32x4 (&acc)[MI][8], bf16_t* sW) {
    const int tid = tid_(), lane = tid & 63, wave = tid >> 6, l16 = lane & 15, quad = lane >> 4;
    const int srow = tid >> 3, skc = (tid & 7) * 8;
    const bf16_t* ap = A + (size_t)(wave * 16 * MI + l16) * lda + quad * 8;
    const bf16_t* wp = W + (size_t)srow * ldw + skc;
    u32x4 ra[MI][2], rw[4];
#pragma unroll
    for (int i = 0; i < MI; ++i)
#pragma unroll
        for (int ks = 0; ks < 2; ++ks) ra[i][ks] = *(const u32x4*)(ap + (size_t)(i * 16) * lda + ks * 32);
#pragma unroll
    for (int i = 0; i < 4; ++i) rw[i] = *(const u32x4*)(wp + (size_t)(i * 32) * ldw);
#pragma unroll
    for (int i = 0; i < MI; ++i)
#pragma unroll
        for (int j = 0; j < 8; ++j) acc[i][j] = (f32x4){0.f, 0.f, 0.f, 0.f};
    constexpr int nk = K >> 6;
#pragma unroll 1
    for (int kt = 0; kt < nk; ++kt) {
        lds_sync();
#pragma unroll
        for (int i = 0; i < 4; ++i) *(u32x4*)(sW + (srow + i * 32) * GST + skc) = rw[i];
        u32x4 af[MI][2];
#pragma unroll
        for (int i = 0; i < MI; ++i)
#pragma unroll
            for (int ks = 0; ks < 2; ++ks) af[i][ks] = ra[i][ks];
        lds_sync();
        if (kt + 1 < nk) {
            const int k0 = (kt + 1) << 6;
#pragma unroll
            for (int i = 0; i < MI; ++i)
#pragma unroll
                for (int ks = 0; ks < 2; ++ks) ra[i][ks] = *(const u32x4*)(ap + (size_t)(i * 16) * lda + k0 + ks * 32);
#pragma unroll
            for (int i = 0; i < 4; ++i) rw[i] = *(const u32x4*)(wp + (size_t)(i * 32) * ldw + k0);
        }
#pragma unroll
        for (int ks = 0; ks < 2; ++ks) {
#pragma unroll
            for (int j = 0; j < 8; ++j) {
                const bf16x8 wf = lds16(sW + (j * 16 + l16) * GST + ks * 32 + quad * 8);
#pragma unroll
                for (int i = 0; i < MI; ++i) acc[i][j] = mfma16(wf, __builtin_bit_cast(bf16x8, af[i][ks]), acc[i][j]);
            }
        }
    }
}

template <int MI>
__device__ __forceinline__ void epi_resid(CParams& p, int m0, int n0, const f32x4 (&acc)[MI][8], const float* gate  ) {
    const int lane = tid_() & 63, wave = tid_() >> 6, l16 = lane & 15, quad = lane >> 4;
#pragma unroll
    for (int i = 0; i < MI; ++i) {
        const int row = m0 + wave * 16 * MI + i * 16 + l16;
        float* xr = xrow(p, row);
        const float* g = gate + (size_t)seg_of(row) * 6144;
#pragma unroll
        for (int j = 0; j < 8; ++j) {
            const int col = n0 + j * 16 + quad * 4;
            const f32x4 gv = *(const f32x4*)(g + col);
            f32x4 xv = *(f32x4*)(xr + col);
            xv += gv * acc[i][j];
            *(f32x4*)(xr + col) = xv;
        }
    }
}

template <int MI>
__device__ __forceinline__ void epi_swiglu(CParams& p, int m0, int n0, const f32x4 (&acc)[MI][8]) {
    const int lane = tid_() & 63, wave = tid_() >> 6, l16 = lane & 15, quad = lane >> 4;
    bf16_t* hid = (bf16_t*)(p.ws + WS_HID);
#pragma unroll
    for (int i = 0; i < MI; ++i) {
        const int row = m0 + wave * 16 * MI + i * 16 + l16;
#pragma unroll
        for (int jj = 0; jj < 4; ++jj) {
            const f32x4 g = acc[i][2 * jj], u = acc[i][2 * jj + 1];
            const int hc = (n0 >> 1) + jj * 16 + quad * 4;
            st4bf(hid + (size_t)row * FFH + hc, siluf(g[0]) * u[0], siluf(g[1]) * u[1], siluf(g[2]) * u[2], siluf(g[3]) * u[3]);
        }
    }
}

template <int MI>
__device__ __forceinline__ void epi_mixin(CParams& p, int j2, int m0, int tn, f32x4 (&acc)[MI][8]) {
    const int lane = tid_() & 63, wave = tid_() >> 6, l16 = lane & 15, quad = lane >> 4;
    if (tn < 5) {
        const float* gsrc = (tn < 4 ? p.q_norm_g : p.k_norm_g) + j2 * 64;
        const float* cosT = (const float*)(p.ws + WS_ROPE);
        const float* sinT = cosT + 8192 * 32;
#pragma unroll
        for (int i = 0; i < MI; ++i) {
            const int row = m0 + wave * 16 * MI + i * 16 + l16;
#pragma unroll
            for (int hh = 0; hh < 2; ++hh) {
                float ss = 0.f;
#pragma unroll
                for (int j = 0; j < 4; ++j) { const f32x4 v = acc[i][hh * 4 + j]; ss += v[0] * v[0] + v[1] * v[1] + v[2] * v[2] + v[3] * v[3]; }
                ss += __shfl_xor(ss, 16); ss += __shfl_xor(ss, 32);
                const float rstd = rsqrtf(ss * (1.f / 64.f) + EPS);
                f32x4 y[4];
#pragma unroll
                for (int j = 0; j < 4; ++j) {
                    const f32x4 gv = *(const f32x4*)(gsrc + j * 16 + quad * 4);
                    y[j] = acc[i][hh * 4 + j] * rstd * gv;
                }
                if (row < ML) {
                    const int s = row & (SEQ - 1);
#pragma unroll
                    for (int j = 0; j < 2; ++j) {
                        const f32x4 cs = *(const f32x4*)(cosT + (size_t)s * 32 + j * 16 + quad * 4);
                        const f32x4 sn = *(const f32x4*)(sinT + (size_t)s * 32 + j * 16 + quad * 4);
                        const f32x4 x1 = y[j], x2 = y[j + 2];
                        y[j] = x1 * cs - x2 * sn;
                        y[j + 2] = x2 * cs + x1 * sn;
                    }
                }
                if (tn < 4) {
                    bf16_t* q = (bf16_t*)(p.ws + WS_Q) + (size_t)row * 512 + (tn * 2 + hh) * 64;
#pragma unroll
                    for (int j = 0; j < 4; ++j) st4bf(q + j * 16 + quad * 4, y[j][0] * 0.125f, y[j][1] * 0.125f, y[j][2] * 0.125f, y[j][3] * 0.125f);
                } else {
                    const int b = row < ML ? (row >> 13) : ((row - ML) >> 8);
                    const int t = row < ML ? CTX + (row & (SEQ - 1)) : ((row - ML) & (CTX - 1));
                    bf16_t* k = (bf16_t*)(p.ws + WS_K) + ((size_t)b * TALL + t) * 128 + hh * 64;
#pragma unroll
                    for (int j = 0; j < 4; ++j) st4bf(k + j * 16 + quad * 4, y[j][0], y[j][1], y[j][2], y[j][3]);
                }
            }
        }
    } else if (tn == 5) {
        bf16_t* vt = (bf16_t*)(p.ws + WS_VT);
#pragma unroll
        for (int i = 0; i < MI; ++i) {
            const int row = m0 + wave * 16 * MI + i * 16 + l16;
            const int b = row < ML ? (row >> 13) : ((row - ML) >> 8);
            const int t = row < ML ? CTX + (row & (SEQ - 1)) : ((row - ML) & (CTX - 1));
#pragma unroll
            for (int j = 0; j < 8; ++j) {
                const int kh = j >> 2;
#pragma unroll
                for (int r = 0; r < 4; ++r) {
                    const int d = (j & 3) * 16 + quad * 4 + r;
                    vt[((size_t)(b * 2 + kh) * 64 + d) * TALL + t] = f2bf(acc[i][j][r]);
                }
            }
        }
    } else if (tn < 10) {
        bf16_t* u = (bf16_t*)(p.ws + WS_U);
#pragma unroll
        for (int i = 0; i < MI; ++i) {
            const int row = m0 + wave * 16 * MI + i * 16 + l16;
#pragma unroll
            for (int j = 0; j < 8; ++j) {
                const f32x4 v = acc[i][j];
                st4bf(u + (size_t)row * 512 + (tn - 6) * 128 + j * 16 + quad * 4, geluf(v[0]), geluf(v[1]), geluf(v[2]), geluf(v[3]));
            }
        }
    } else {
        const int g = tn - 10;
        const float* gn = p.sgu_norm_g + j2 * 512 + g * 128;
        bf16_t* gvt = (bf16_t*)(p.ws + WS_GVT);
#pragma unroll
        for (int i = 0; i < MI; ++i) {
            const int row = m0 + wave * 16 * MI + i * 16 + l16;
            float ss = 0.f;
#pragma unroll
            for (int j = 0; j < 8; ++j) {
                f32x4 v = acc[i][j];
                v[0] = geluf(v[0]); v[1] = geluf(v[1]); v[2] = geluf(v[2]); v[3] = geluf(v[3]);
                acc[i][j] = v;
                ss += v[0] * v[0] + v[1] * v[1] + v[2] * v[2] + v[3] * v[3];
            }
            ss += __shfl_xor(ss, 16); ss += __shfl_xor(ss, 32);
            const float rstd = rsqrtf(ss * (1.f / 128.f) + EPS);
            const int chunk = row >> 7, pt = row & 127;
#pragma unroll
            for (int j = 0; j < 8; ++j) {
                const f32x4 gv = *(const f32x4*)(gn + j * 16 + quad * 4);
#pragma unroll
                for (int r = 0; r < 4; ++r) {
                    const int cc = g * 128 + j * 16 + quad * 4 + r;
                    gvt[((size_t)chunk * 512 + cc) * 128 + pt] = f2bf(acc[i][j][r] * rstd * gv[r]);
                }
            }
        }
    }
}

template <int MI>
__device__ __forceinline__ void epi_ssmin(CParams& p, int j2, int m0, int tn, const f32x4 (&acc)[MI][8]) {
    const int lane = tid_() & 63, wave = tid_() >> 6, l16 = lane & 15, quad = lane >> 4;
#pragma unroll
    for (int i = 0; i < MI; ++i) {
        const int row = m0 + wave * 16 * MI + i * 16 + l16;
        if (tn < 16) {
            bf16_t* z = (bf16_t*)(p.ws + WS_Z) + (size_t)row * 2048 + tn * 128;
#pragma unroll
            for (int j = 0; j < 8; ++j) { const f32x4 v = acc[i][j]; st4bf(z + j * 16 + quad * 4, siluf(v[0]), siluf(v[1]), siluf(v[2]), siluf(v[3])); }
        } else if (tn < 40) {
            bf16_t* xb = (bf16_t*)(p.ws + WS_XBC) + (size_t)row * 3072 + (tn - 16) * 128;
#pragma unroll
            for (int j = 0; j < 8; ++j) { const f32x4 v = acc[i][j]; st4bf(xb + j * 16 + quad * 4, v[0], v[1], v[2], v[3]); }
        } else {
            float* dt = (float*)(p.ws + WS_DT) + (size_t)row * 64;
            const float* bias = p.ssm_dt_bias + j2 * 64;
#pragma unroll
            for (int j = 0; j < 4; ++j) {
                const int c = j * 16 + quad * 4;
                const f32x4 v = acc[i][j];
                f32x4 o;
                o[0] = softplusf(v[0] + bias[c + 0]); o[1] = softplusf(v[1] + bias[c + 1]);
                o[2] = softplusf(v[2] + bias[c + 2]); o[3] = softplusf(v[3] + bias[c + 3]);
                *(f32x4*)(dt + c) = o;
            }
        }
    }
}

enum { G_MIXIN = 0, G_MIXOUT, G_SSMIN, G_SSMOUT, G_FFNIN, G_FFNOUT };

template <int KIND>
__device__ void gemm_phase(CParams& p, int layer, bf16_t* smem) {
    const int j2 = layer >> 1;
    constexpr int lda = (KIND == G_SSMOUT) ? 2048 : (KIND == G_FFNOUT) ? FFH : 1024;
    constexpr int K = lda, ldw = K;
    constexpr int N = (KIND == G_MIXIN) ? MIXIN : (KIND == G_SSMIN) ? SSMIN_PAD : (KIND == G_FFNIN) ? 2 * FFH : 1024;
    constexpr size_t aoff = (KIND == G_MIXOUT) ? WS_AS : (KIND == G_SSMOUT) ? WS_YF : (KIND == G_FFNOUT) ? WS_HID : WS_HN;
    constexpr size_t woff = (KIND == G_MIXIN || KIND == G_SSMIN) ? WT_MIXIN : (KIND == G_MIXOUT || KIND == G_SSMOUT) ? WT_MIXOUT : (KIND == G_FFNIN) ? WT_FFNIN : WT_FFNOUT;
    const bf16_t* A = (const bf16_t*)(p.ws + aoff);
    const bf16_t* W = (const bf16_t*)(p.ws + WS_WT + woff);
    constexpr int MI = (KIND == G_MIXIN) ? 2 : 4;
    constexpr int nN = N >> 7, nM = MT / (64 * MI);
    const float* mod = (const float*)(p.ws + WS_MOD) + (size_t)layer * 3 * 6144;
    bf16_t* sW = smem;
    if (N == 1024) {
        const int nlat = (ML / 256) * 8, nctx = layer == 3 ? 0 : (MC / 64) * 8;
        const float* gate = mod + (KIND == G_FFNOUT ? 5 : 2) * 1024;
        for (int t = blockIdx.x; t < nlat + nctx; t += gridDim.x) {
            if (t < nlat) {
                const int u = (gridDim.x == 512) ? ((t & 7) * 64 + (t >> 3)) : t;
                const int tm = u >> 3, tn = u & 7;
                f32x4 acc[4][8];
                gemm_tile<4, lda, ldw, K>(A + (size_t)tm * 256 * lda, W + (size_t)tn * 128 * ldw, acc, sW);
                epi_resid<4>(p, tm * 256, tn * 128, acc, gate);
            } else {
                const int u = t - nlat, tm = u >> 3, tn = u & 7;
                f32x4 acc[1][8];
                gemm_tile<1, lda, ldw, K>(A + (size_t)(ML + tm * 64) * lda, W + (size_t)tn * 128 * ldw, acc, sW);
                epi_resid<1>(p, ML + tm * 64, tn * 128, acc, gate);
            }
        }
        return;
    }
    constexpr int T = nM * nN, share = (T + 7) / 8, nsc = (nN + 7) / 8;
    const int xcd = blockIdx.x & 7, slot = blockIdx.x >> 3, nslot = gridDim.x >> 3;
    for (int li = slot; li < share; li += nslot) {
        const int u = xcd * share + li;
        if (u >= T) break;
        int sc = u / (nM * 8); if (sc > nsc - 1) sc = nsc - 1;
        const int rem = u - sc * nM * 8, wd = (sc == nsc - 1) ? (nN - 8 * sc) : 8;
        const int tm = rem / wd, tn = sc * 8 + rem - tm * wd;
        f32x4 acc[MI][8];
        gemm_tile<MI, lda, ldw, K>(A + (size_t)tm * (64 * MI) * lda, W + (size_t)tn * 128 * ldw, acc, sW);
        if (KIND == G_MIXIN) epi_mixin<MI>(p, j2, tm * (64 * MI), tn, acc);
        else if (KIND == G_SSMIN) epi_ssmin<MI>(p, j2, tm * (64 * MI), tn, acc);
        else if (KIND == G_FFNIN) epi_swiglu<MI>(p, tm * (64 * MI), tn * 128, acc);
    }
}

__device__ void norm_phase(CParams& p, int layer, int which) {
    const int lane = tid_() & 63, wave = tid_() >> 6;
    const float* g = (which ? p.norm2_g : p.norm1_g) + layer * 1024;
    const float* mod = (const float*)(p.ws + WS_MOD) + (size_t)layer * 3 * 6144;
    bf16_t* hn = (bf16_t*)(p.ws + WS_HN);
    for (int row = blockIdx.x * 4 + wave; row < MT; row += gridDim.x * 4) {
        const float* xr = xrow(p, row);
        f32x4 v[4]; float ss = 0.f;
#pragma unroll
        for (int i = 0; i < 4; ++i) { v[i] = *(const f32x4*)(xr + i * 256 + lane * 4); ss += v[i][0] * v[i][0] + v[i][1] * v[i][1] + v[i][2] * v[i][2] + v[i][3] * v[i][3]; }
#pragma unroll
        for (int o = 1; o < 64; o <<= 1) ss += __shfl_xor(ss, o);
        const float rstd = rsqrtf(ss * (1.f / 1024.f) + EPS);
        const float* m = mod + (size_t)seg_of(row) * 6144 + (which ? 3 * 1024 : 0);
#pragma unroll
        for (int i = 0; i < 4; ++i) {
            const int col = i * 256 + lane * 4;
            const f32x4 gv = *(const f32x4*)(g + col), sh = *(const f32x4*)(m + col), sc = *(const f32x4*)(m + 1024 + col);
            const f32x4 y = (v[i] * rstd * gv) * (sc + 1.f) + sh;
            st4bf(hn + (size_t)row * 1024 + col, y[0], y[1], y[2], y[3]);
        }
    }
}

__device__ void convert_wt(const float* __restrict__ W, int K, int N, bf16_t* __restrict__ Wt, int mode, float* tile) {
    const int tid = tid_();
    const int nKt = K >> 6, nNt = N >> 6;
    for (int t = blockIdx.x; t < nKt * nNt; t += gridDim.x) {
        const int kt = t / nNt, nt = t - kt * nNt;
        lds_sync();
#pragma unroll
        for (int i = 0; i < 16; ++i) {
            const int kk = (tid >> 6) + i * 4, nn = tid & 63;
            tile[kk * 65 + nn] = W[(size_t)(kt * 64 + kk) * N + nt * 64 + nn];
        }
        lds_sync();
        {
            const int nn = tid >> 2, kq = (tid & 3) * 16;
            const int n = nt * 64 + nn;
            int dr = n;
            if (mode == 1) { const int hm = n < FFH ? n : n - FFH; dr = (hm >> 4) * 32 + (hm & 15) + (n < FFH ? 0 : 16); }
            u32x4 o0, o1;
            o0.x = pack2(tile[(kq + 0) * 65 + nn], tile[(kq + 1) * 65 + nn]); o0.y = pack2(tile[(kq + 2) * 65 + nn], tile[(kq + 3) * 65 + nn]);
            o0.z = pack2(tile[(kq + 4) * 65 + nn], tile[(kq + 5) * 65 + nn]); o0.w = pack2(tile[(kq + 6) * 65 + nn], tile[(kq + 7) * 65 + nn]);
            o1.x = pack2(tile[(kq + 8) * 65 + nn], tile[(kq + 9) * 65 + nn]); o1.y = pack2(tile[(kq + 10) * 65 + nn], tile[(kq + 11) * 65 + nn]);
            o1.z = pack2(tile[(kq + 12) * 65 + nn], tile[(kq + 13) * 65 + nn]); o1.w = pack2(tile[(kq + 14) * 65 + nn], tile[(kq + 15) * 65 + nn]);
            bf16_t* dst = Wt + (size_t)dr * K + kt * 64 + kq;
            *(u32x4*)dst = o0; *(u32x4*)(dst + 8) = o1;
        }
    }
}

__device__ void convert_layer_weights(CParams& p, int layer, float* tile) {
    unsigned char* wt = p.ws + WS_WT;
    const int j2 = layer >> 1;
    convert_wt(p.ffn_w_in + (size_t)layer * 1024 * 2 * FFH, 1024, 2 * FFH, (bf16_t*)(wt + WT_FFNIN), 1, tile);
    convert_wt(p.ffn_w_out + (size_t)layer * FFH * 1024, FFH, 1024, (bf16_t*)(wt + WT_FFNOUT), 0, tile);
    if ((layer & 1) == 0) {
        convert_wt(p.mix_w_in + (size_t)j2 * 1024 * MIXIN, 1024, MIXIN, (bf16_t*)(wt + WT_MIXIN), 0, tile);
        convert_wt(p.mix_w_out + (size_t)j2 * 1024 * 1024, 1024, 1024, (bf16_t*)(wt + WT_MIXOUT), 0, tile);
    } else {
        convert_wt(p.ssm_w_in + (size_t)j2 * 1024 * SSMIN, 1024, SSMIN, (bf16_t*)(wt + WT_MIXIN), 0, tile);
        convert_wt(p.ssm_w_out + (size_t)j2 * SSI * 1024, SSI, 1024, (bf16_t*)(wt + WT_MIXOUT), 0, tile);
        bf16_t* padp = (bf16_t*)(wt + WT_MIXIN) + (size_t)SSMIN * 1024;
        for (int i = blockIdx.x * 256 + tid_(); i < (SSMIN_PAD - SSMIN) * 1024; i += gridDim.x * 256) padp[i] = 0;
    }
}

__device__ void prologue(CParams& p, float* smf) {
    const int tid = tid_();
    const size_t gtid = (size_t)blockIdx.x * 256 + tid, gsz = (size_t)gridDim.x * 256;
    {
        const f32x4* s = (const f32x4*)p.x; f32x4* d = (f32x4*)p.out;
        for (size_t i = gtid; i < (size_t)ML * D / 4; i += gsz) d[i] = s[i];
        const f32x4* s2 = (const f32x4*)p.ctx; f32x4* d2 = (f32x4*)(p.ws + WS_XCTX);
        for (size_t i = gtid; i < (size_t)MC * D / 4; i += gsz) d2[i] = s2[i];
    }
    {
        float* cosT = (float*)(p.ws + WS_ROPE); float* sinT = cosT + 8192 * 32;
        for (size_t i = gtid; i < (size_t)8192 * 32; i += gsz) {
            const int s = (int)(i >> 5), j = (int)(i & 31), f = j & 15;
            const float inv = powf(10000.f, -(float)f / 16.f);
            const float pos = (float)(j < 16 ? (s >> 6) : (s & 63));
            const float ang = pos * inv;
            cosT[i] = cosf(ang); sinT[i] = sinf(ang);
        }
    }
    {
        bf16_t* sgw = (bf16_t*)(p.ws + WS_SGW);
        for (size_t i = gtid; i < (size_t)2 * 4 * 128 * 128; i += gsz) sgw[i] = f2bf(p.sgu_w[i]);
    }
    {
        float* sc = smf;
        float* red = smf + 3 * 1024;
        lds_sync();
        for (int i = tid; i < 3 * 1024; i += 256) {
            const int sgi = i >> 10, k = i & 1023;
            const float v = sgi < 2 ? p.c[sgi * 1024 + k] : p.c_ctx[k];
            sc[i] = siluf(v);
        }
        lds_sync();
        float* mod = (float*)(p.ws + WS_MOD);
        const int cl = tid & 63, kg = tid >> 6;
        for (int wi = blockIdx.x; wi < 4 * 96; wi += gridDim.x) {
            const int layer = wi / 96, cb = wi - layer * 96;
            const float* w = p.ada_w + (size_t)layer * 1024 * 6144 + cb * 64 + cl;
            float s0 = 0.f, s1 = 0.f, s2 = 0.f;
            for (int k = kg * 256; k < kg * 256 + 256; ++k) {
                const float wv = w[(size_t)k * 6144];
                s0 += sc[k] * wv; s1 += sc[1024 + k] * wv; s2 += sc[2048 + k] * wv;
            }
            lds_sync();
            red[(kg * 3 + 0) * 64 + cl] = s0; red[(kg * 3 + 1) * 64 + cl] = s1; red[(kg * 3 + 2) * 64 + cl] = s2;
            lds_sync();
            if (tid < 192) {
                const int sgi = tid >> 6;
                const float v = red[(0 * 3 + sgi) * 64 + cl] + red[(1 * 3 + sgi) * 64 + cl] + red[(2 * 3 + sgi) * 64 + cl] + red[(3 * 3 + sgi) * 64 + cl];
                const int n = cb * 64 + cl;
                mod[((size_t)layer * 3 + sgi) * 6144 + n] = v + p.ada_b[layer * 6144 + n];
            }
        }
        lds_sync();
    }
    convert_layer_weights(p, 0, smf);
}

__device__ void attn_item(CParams& p, int b, int h, int q0row, int nkeys, bf16_t* smem) {
    const int tid = tid_(), lane = tid & 63, wave = tid >> 6, l16 = lane & 15, quad = lane >> 4;
    const int kh = h >> 2;
    const bf16_t* Q = (const bf16_t*)(p.ws + WS_Q);
    const bf16_t* Kb = (const bf16_t*)(p.ws + WS_K) + (size_t)b * TALL * 128 + kh * 64;
    const bf16_t* Vb = (const bf16_t*)(p.ws + WS_VT) + (size_t)(b * 2 + kh) * 64 * TALL;
    bf16_t* sK = smem; bf16_t* sV = smem + 64 * GST;
    bf16x8 qf[2][2];
#pragma unroll
    for (int i = 0; i < 2; ++i)
#pragma unroll
        for (int ks = 0; ks < 2; ++ks)
            qf[i][ks] = *(const bf16x8*)(Q + (size_t)(q0row + wave * 32 + i * 16 + l16) * 512 + h * 64 + ks * 32 + quad * 8);
    f32x4 o[4][2];
#pragma unroll
    for (int d = 0; d < 4; ++d)
#pragma unroll
        for (int i = 0; i < 2; ++i) o[d][i] = (f32x4){0.f, 0.f, 0.f, 0.f};
    float mrun[2] = {-INFINITY, -INFINITY}, lrun[2] = {0.f, 0.f};
    const int srow = tid >> 3, skc = (tid & 7) * 8;
    u32x4 rk[2], rv[2];
#pragma unroll
    for (int i = 0; i < 2; ++i) {
        rk[i] = *(const u32x4*)(Kb + (size_t)(srow + i * 32) * 128 + skc);
        rv[i] = *(const u32x4*)(Vb + (size_t)(srow + i * 32) * TALL + skc);
    }
    const int nt = nkeys >> 6;
    constexpr float LOG2E = 1.4426950408889634f;
    for (int kt = 0; kt < nt; ++kt) {
        lds_sync();
#pragma unroll
        for (int i = 0; i < 2; ++i) {
            *(u32x4*)(sK + (srow + i * 32) * GST + skc) = rk[i];
            *(u32x4*)(sV + (srow + i * 32) * GST + skc) = rv[i];
        }
        lds_sync();
        if (kt + 1 < nt) {
            const int t0 = (kt + 1) << 6;
#pragma unroll
            for (int i = 0; i < 2; ++i) {
                rk[i] = *(const u32x4*)(Kb + (size_t)(t0 + srow + i * 32) * 128 + skc);
                rv[i] = *(const u32x4*)(Vb + (size_t)(srow + i * 32) * TALL + t0 + skc);
            }
        }
        f32x4 s[4][2];
#pragma unroll
        for (int tt = 0; tt < 4; ++tt)
#pragma unroll
            for (int i = 0; i < 2; ++i) s[tt][i] = (f32x4){0.f, 0.f, 0.f, 0.f};
#pragma unroll
        for (int ks = 0; ks < 2; ++ks)
#pragma unroll
            for (int tt = 0; tt < 4; ++tt) {
                const bf16x8 kf = lds16(sK + (tt * 16 + l16) * GST + ks * 32 + quad * 8);
#pragma unroll
                for (int i = 0; i < 2; ++i) s[tt][i] = mfma16(kf, qf[i][ks], s[tt][i]);
            }
        bf16x8 pf[2][2];
#pragma unroll
        for (int i = 0; i < 2; ++i) {
            float mx = -INFINITY;
#pragma unroll
            for (int tt = 0; tt < 4; ++tt) mx = fmaxf(mx, fmaxf(fmaxf(s[tt][i][0], s[tt][i][1]), fmaxf(s[tt][i][2], s[tt][i][3])));
            mx = fmaxf(mx, __shfl_xor(mx, 16)); mx = fmaxf(mx, __shfl_xor(mx, 32));
            const float mnew = fmaxf(mrun[i], mx);
            const float alpha = __builtin_amdgcn_exp2f((mrun[i] - mnew) * LOG2E);
            mrun[i] = mnew;
            const float mb = mnew * LOG2E;
            float ls = 0.f;
#pragma unroll
            for (int tt = 0; tt < 4; ++tt) {
#pragma unroll
                for (int r = 0; r < 4; ++r) { const float e = __builtin_amdgcn_exp2f(s[tt][i][r] * LOG2E - mb); s[tt][i][r] = e; ls += e; }
            }
            lrun[i] = lrun[i] * alpha + ls;
#pragma unroll
            for (int d = 0; d < 4; ++d) o[d][i] *= alpha;
#pragma unroll
            for (int ksp = 0; ksp < 2; ++ksp) pf[ksp][i] = pack8(s[2 * ksp][i], s[2 * ksp + 1][i]);
        }
#pragma unroll
        for (int ksp = 0; ksp < 2; ++ksp)
#pragma unroll
            for (int d = 0; d < 4; ++d) {
                const bf16_t* vp = sV + (d * 16 + l16) * GST + ksp * 32 + quad * 4;
                const bf16x8 vf = lds8x2(vp, vp + 16);
#pragma unroll
                for (int i = 0; i < 2; ++i) o[d][i] = mfma16(vf, pf[ksp][i], o[d][i]);
            }
    }
    bf16_t* as = (bf16_t*)(p.ws + WS_AS);
#pragma unroll
    for (int i = 0; i < 2; ++i) {
        float l = lrun[i];
        l += __shfl_xor(l, 16); l += __shfl_xor(l, 32);
        const float inv = 1.f / l;
        const int row = q0row + wave * 32 + i * 16 + l16;
#pragma unroll
        for (int d = 0; d < 4; ++d)
            st4bf(as + (size_t)row * 1024 + h * 64 + d * 16 + quad * 4, o[d][i][0] * inv, o[d][i][1] * inv, o[d][i][2] * inv, o[d][i][3] * inv);
    }
}

__device__ void sg_item(CParams& p, int j2, int chunk, int g, bf16_t* smem) {
    const int lane = tid_() & 63, wave = tid_() >> 6, l16 = lane & 15, quad = lane >> 4;
    const bf16_t* A = (const bf16_t*)(p.ws + WS_SGW) + (size_t)(j2 * 4 + g) * 128 * 128;
    const bf16_t* W = (const bf16_t*)(p.ws + WS_GVT) + ((size_t)chunk * 512 + g * 128) * 128;
    f32x4 acc[2][8];
    gemm_tile<2, 128, 128, 128>(A, W, acc, smem);
    const bf16_t* u = (const bf16_t*)(p.ws + WS_U);
    bf16_t* as = (bf16_t*)(p.ws + WS_AS);
    const float* bs = p.sgu_b + (size_t)(j2 * 4 + g) * 128;
#pragma unroll
    for (int i = 0; i < 2; ++i) {
        const int pt = wave * 32 + i * 16 + l16;
        const int row = chunk * 128 + pt;
        const float bias = bs[pt];
#pragma unroll
        for (int j = 0; j < 8; ++j) {
            const int c = g * 128 + j * 16 + quad * 4;
            const u32x2 uw = *(const u32x2*)(u + (size_t)row * 512 + c);
            const float u0 = __uint_as_float(uw.x << 16), u1 = __uint_as_float(uw.x & 0xffff0000u);
            const float u2 = __uint_as_float(uw.y << 16), u3 = __uint_as_float(uw.y & 0xffff0000u);
            const f32x4 v = acc[i][j];
            st4bf(as + (size_t)row * 1024 + 512 + c, u0 * (v[0] + bias), u1 * (v[1] + bias), u2 * (v[2] + bias), u3 * (v[3] + bias));
        }
    }
}

__device__ void attn_sg_phase(CParams& p, int layer, bf16_t* smem) {
    const int j2 = layer >> 1;
    const int nA = NB * 8 * 64, nS = (MT / 128) * 4, nC = NB * 8 * 2;
    for (int t = blockIdx.x; t < nA + nS + nC; t += gridDim.x) {
        if (t < nA) {
            const int qb = t & 63, h = (t >> 6) & 7, b = t >> 9;
            attn_item(p, b, h, b * SEQ + qb * 128, TALL, smem);
        } else if (t < nA + nS) {
            const int u = t - nA;
            sg_item(p, j2, u >> 2, u & 3, smem);
        } else {
            const int u = t - nA - nS;
            const int qb = u & 1, h = (u >> 1) & 7, b = u >> 4;
            attn_item(p, b, h, ML + b * CTX + qb * 128, CTX, smem);
        }
    }
}

__device__ void conv_phase(CParams& p, int layer, float* smf) {
    const int j2 = layer >> 1, tid = tid_();
    const bf16_t* xbc = (const bf16_t*)(p.ws + WS_XBC);
    bf16_t* XT = (bf16_t*)(p.ws + WS_XT); bf16_t* Bn = (bf16_t*)(p.ws + WS_BN); bf16_t* Cn = (bf16_t*)(p.ws + WS_CN); bf16_t* BT = (bf16_t*)(p.ws + WS_BT);
    const float* cw = p.ssm_conv_w + (size_t)j2 * 3 * 3072;
    const float* cb = p.ssm_conv_b + (size_t)j2 * 3072;
    float* sin_ = smf;
    float* sout = smf + 66 * 65;
    const int nCt = 3072 / 64, nRt = MT / 64;
    for (int t = blockIdx.x; t < nCt * nRt; t += gridDim.x) {
        const int rt = t / nCt, ct = t - rt * nCt;
        const int r0 = rt * 64, c0 = ct * 64;
        const bool first = r0 < ML ? ((r0 & (SEQ - 1)) == 0) : (((r0 - ML) & (CTX - 1)) == 0);
        const bool last = r0 < ML ? (((r0 + 64) & (SEQ - 1)) == 0) : ((((r0 + 64) - ML) & (CTX - 1)) == 0);
        lds_sync();
        for (int e = tid; e < 66 * 8; e += 256) {
            const int rr = e >> 3, c8 = (e & 7) * 8;
            const int row = r0 - 1 + rr;
            u32x4 v = (u32x4){0u, 0u, 0u, 0u};
            if (!((rr == 0 && first) || (rr == 65 && last))) v = *(const u32x4*)(xbc + (size_t)row * 3072 + c0 + c8);
            float* d = sin_ + rr * 65 + c8;
            d[0] = __uint_as_float(v.x << 16); d[1] = __uint_as_float(v.x & 0xffff0000u);
            d[2] = __uint_as_float(v.y << 16); d[3] = __uint_as_float(v.y & 0xffff0000u);
            d[4] = __uint_as_float(v.z << 16); d[5] = __uint_as_float(v.z & 0xffff0000u);
            d[6] = __uint_as_float(v.w << 16); d[7] = __uint_as_float(v.w & 0xffff0000u);
        }
        lds_sync();
        {
            const int c = tid & 63;
            const float w0 = cw[c0 + c], w1 = cw[3072 + c0 + c], w2 = cw[2 * 3072 + c0 + c], bb = cb[c0 + c];
#pragma unroll
            for (int k = 0; k < 16; ++k) {
                const int tt = (tid >> 6) + k * 4;
                const float v = w0 * sin_[tt * 65 + c] + w1 * sin_[(tt + 1) * 65 + c] + w2 * sin_[(tt + 2) * 65 + c] + bb;
                sout[c * 65 + tt] = siluf(v);
            }
        }
        lds_sync();
        const int q = tid >> 2, e16 = (tid & 3) * 16;
        if (c0 >= 2048) {
            u32x4 o0, o1;
            o0.x = pack2(sout[(e16 + 0) * 65 + q], sout[(e16 + 1) * 65 + q]); o0.y = pack2(sout[(e16 + 2) * 65 + q], sout[(e16 + 3) * 65 + q]);
            o0.z = pack2(sout[(e16 + 4) * 65 + q], sout[(e16 + 5) * 65 + q]); o0.w = pack2(sout[(e16 + 6) * 65 + q], sout[(e16 + 7) * 65 + q]);
            o1.x = pack2(sout[(e16 + 8) * 65 + q], sout[(e16 + 9) * 65 + q]); o1.y = pack2(sout[(e16 + 10) * 65 + q], sout[(e16 + 11) * 65 + q]);
            o1.z = pack2(sout[(e16 + 12) * 65 + q], sout[(e16 + 13) * 65 + q]); o1.w = pack2(sout[(e16 + 14) * 65 + q], sout[(e16 + 15) * 65 + q]);
            bf16_t* dst = (c0 < 2560 ? Bn + (c0 - 2048) : Cn + (c0 - 2560)) + (size_t)(r0 + q) * 512 + e16;
            *(u32x4*)dst = o0; *(u32x4*)(dst + 8) = o1;
        }
        if (c0 < 2560) {
            const float* sp = sout + q * 65 + e16;
            u32x4 o0, o1;
            o0.x = pack2(sp[0], sp[1]); o0.y = pack2(sp[2], sp[3]); o0.z = pack2(sp[4], sp[5]); o0.w = pack2(sp[6], sp[7]);
            o1.x = pack2(sp[8], sp[9]); o1.y = pack2(sp[10], sp[11]); o1.z = pack2(sp[12], sp[13]); o1.w = pack2(sp[14], sp[15]);
            bf16_t* dst = (c0 < 2048 ? XT + (size_t)c0 * MT : BT + (size_t)(c0 - 2048) * MT) + (size_t)q * MT + r0 + e16;
            *(u32x4*)dst = o0; *(u32x4*)(dst + 8) = o1;
        }
    }
}

__device__ void ssd_diag_item(CParams& p, int j2, int row0, int h, bf16_t* smem) {
    const int tid = tid_(), lane = tid & 63, wave = tid >> 6, l16 = lane & 15, quad = lane >> 4;
    const int g = h >> 3;
    bf16_t* sB = smem;
    bf16_t* sX = sB + 128 * SST;
    float* sda = (float*)(sX + 64 * SST);
    float* sPf = sda + 256;
    float* sRb = sPf + 128;
    float* sdtf = sRb + 128;
    float* sdtb = sdtf + 128;
    const bf16_t* XT = (const bf16_t*)(p.ws + WS_XT) + (size_t)(h * 64) * MT;
    const bf16_t* Bn = (const bf16_t*)(p.ws + WS_BN) + g * 128;
    const bf16_t* Cn = (const bf16_t*)(p.ws + WS_CN) + g * 128;
    const float* DT = (const float*)(p.ws + WS_DT);
    bf16_t* Y = (bf16_t*)(p.ws + WS_YF);
    const float af = -expf(p.ssm_a_log[(j2 * 2 + 0) * 32 + h]);
    const float ab = -expf(p.ssm_a_log[(j2 * 2 + 1) * 32 + h]);
    const float dsk = p.ssm_d[j2 * 32 + h];
    lds_sync();
#pragma unroll
    for (int i = 0; i < 8; ++i) {
        const int c = tid + i * 256, r = c >> 4, kc = (c & 15) * 8;
        *(u32x4*)(sB + r * SST + kc) = *(const u32x4*)(Bn + (size_t)(row0 + r) * 512 + kc);
    }
#pragma unroll
    for (int i = 0; i < 4; ++i) {
        const int c = tid + i * 256, r = c >> 4, kc = (c & 15) * 8;
        *(u32x4*)(sX + r * SST + kc) = *(const u32x4*)(XT + (size_t)r * MT + row0 + kc);
    }
    {
        const int d = wave >> 1;
        const float d0 = DT[(size_t)(row0 + lane) * 64 + d * 32 + h], d1 = DT[(size_t)(row0 + 64 + lane) * 64 + d * 32 + h];
        const float aa = d ? ab : af;
        const f32x2 sc2 = scan128(d0 * aa, d1 * aa, lane, d);
        float* sc = d ? sRb : sPf; float* sd = d ? sdtb : sdtf;
        if ((wave & 1) == 0) { sc[lane] = sc2.x; sd[lane] = d0; } else { sc[64 + lane] = sc2.y; sd[64 + lane] = d1; }
    }
    bf16x8 cf[2][4];
#pragma unroll
    for (int i = 0; i < 2; ++i)
#pragma unroll
        for (int ks = 0; ks < 4; ++ks)
            cf[i][ks] = *(const bf16x8*)(Cn + (size_t)(row0 + wave * 32 + i * 16 + l16) * 512 + ks * 32 + quad * 8);
    lds_sync();
    float pfl[2], rbl[2];
#pragma unroll
    for (int i = 0; i < 2; ++i) { pfl[i] = sPf[wave * 32 + i * 16 + l16]; rbl[i] = sRb[wave * 32 + i * 16 + l16]; }
    f32x4 y[4][2];
#pragma unroll
    for (int pt = 0; pt < 4; ++pt)
#pragma unroll
        for (int i = 0; i < 2; ++i) y[pt][i] = (f32x4){0.f, 0.f, 0.f, 0.f};
#pragma unroll 1
    for (int sp = 0; sp < 4; ++sp) {
        f32x4 gt[2][2];
#pragma unroll
        for (int s2 = 0; s2 < 2; ++s2)
#pragma unroll
            for (int i = 0; i < 2; ++i) gt[s2][i] = (f32x4){0.f, 0.f, 0.f, 0.f};
#pragma unroll
        for (int ks = 0; ks < 4; ++ks)
#pragma unroll
            for (int s2 = 0; s2 < 2; ++s2) {
                const bf16x8 bfr = lds16(sB + (sp * 32 + s2 * 16 + l16) * SST + ks * 32 + quad * 8);
#pragma unroll
                for (int i = 0; i < 2; ++i) gt[s2][i] = mfma16(bfr, cf[i][ks], gt[s2][i]);
            }
        bf16x8 mf[2];
#pragma unroll
        for (int i = 0; i < 2; ++i) {
            const int l = wave * 32 + i * 16 + l16;
#pragma unroll
            for (int s2 = 0; s2 < 2; ++s2)
#pragma unroll
                for (int r = 0; r < 4; ++r) {
                    const int s = sp * 32 + s2 * 16 + quad * 4 + r;
                    const float arg = s < l ? (pfl[i] - sPf[s]) : (rbl[i] - sRb[s]);
                    float coef = __expf(fminf(arg, 0.f)) * (s < l ? sdtf[s] : sdtb[s]);
                    if (s == l) coef = sdtf[s] + sdtb[s];
                    gt[s2][i][r] *= coef;
                }
            mf[i] = pack8(gt[0][i], gt[1][i]);
        }
#pragma unroll
        for (int pt = 0; pt < 4; ++pt) {
            const bf16_t* xp = sX + (pt * 16 + l16) * SST + sp * 32 + quad * 4;
            const bf16x8 xf = lds8x2(xp, xp + 16);
#pragma unroll
            for (int i = 0; i < 2; ++i) y[pt][i] = mfma16(xf, mf[i], y[pt][i]);
        }
    }
#pragma unroll
    for (int i = 0; i < 2; ++i) {
        const int l = wave * 32 + i * 16 + l16;
#pragma unroll
        for (int pt = 0; pt < 4; ++pt) {
            f32x4 v = y[pt][i];
#pragma unroll
            for (int r = 0; r < 4; ++r) v[r] += dsk * bf2f(sX[(pt * 16 + quad * 4 + r) * SST + l]);
            st4bf(Y + (size_t)(row0 + l) * 2048 + h * 64 + pt * 16 + quad * 4, v[0], v[1], v[2], v[3]);
        }
    }
}

__device__ void ssd_diag_phase(CParams& p, int layer, bf16_t* smem) {
    const int j2 = layer >> 1;
    for (int t = blockIdx.x; t < (MT / 128) * 32; t += gridDim.x) {
        const int h = t & 31, chunk = t >> 5;
        ssd_diag_item(p, j2, chunk * 128, h, smem);
    }
}

struct SsdPre { u32x4 xq; u32x4 bt[2][4]; u32x4 cf[2][4]; u32x2 yold[2]; float dt0, dt1; };

__device__ __forceinline__ int ssd_row0(int b, int dir, int cc) {
    if (cc < 2) { const int ci = dir ? 1 - cc : cc; return ML + b * CTX + ci * 128; }
    const int k = cc - 2; const int ci = dir ? 63 - k : k; return b * SEQ + ci * 128;
}

__device__ __forceinline__ void ssd_prefetch(SsdPre& nx, int row0, int dir, int lane, const bf16_t* XT, const bf16_t* BT, const bf16_t* Cn, const bf16_t* Y, const float* DT) {
    nx.xq = *(const u32x4*)(XT + row0);
#pragma unroll
    for (int nt = 0; nt < 2; ++nt)
#pragma unroll
        for (int ks = 0; ks < 4; ++ks) nx.bt[nt][ks] = *(const u32x4*)(BT + (size_t)(nt * 16) * MT + row0 + ks * 32);
#pragma unroll
    for (int i = 0; i < 2; ++i)
#pragma unroll
        for (int ks = 0; ks < 4; ++ks) nx.cf[i][ks] = *(const u32x4*)(Cn + (size_t)(row0 + i * 16) * 512 + ks * 32);
#pragma unroll
    for (int i = 0; i < 2; ++i) nx.yold[i] = dir == 0 ? *(const u32x2*)(Y + (size_t)(row0 + i * 16) * 2048) : (u32x2){0u, 0u};
    nx.dt0 = DT[(size_t)(row0 + lane) * 64]; nx.dt1 = DT[(size_t)(row0 + 64 + lane) * 64];
}

__device__ void ssd_scan_item(CParams& p, int j2, int b, int dir, int h, int pq, bf16_t* smem) {
    const int tid = tid_(), lane = tid & 63, wave = tid >> 6, l16 = lane & 15, quad = lane >> 4;
    const int g = h >> 3;
    bf16_t* sX = smem;
    bf16_t* sH = sX + 16 * SST;
    float* seacs = (float*)(sH + 16 * SST);
    float* sw = seacs + 128;
    float* sdec = sw + 128;
    const bf16_t* XT = (const bf16_t*)(p.ws + WS_XT) + (size_t)(h * 64 + pq * 16 + (tid >> 4)) * MT + (tid & 15) * 8;
    const bf16_t* Cn = (const bf16_t*)(p.ws + WS_CN) + g * 128 + (size_t)(wave * 32 + l16) * 512 + quad * 8;
    const bf16_t* BT = (const bf16_t*)(p.ws + WS_BT) + (size_t)(g * 128 + wave * 32 + l16) * MT + quad * 8;
    const float* DT = (const float*)(p.ws + WS_DT) + dir * 32 + h;
    bf16_t* Y = (bf16_t*)(p.ws + (dir ? WS_YB : WS_YF)) + (size_t)(wave * 32 + l16) * 2048 + h * 64 + pq * 16 + quad * 4;
    const float a = -expf(p.ssm_a_log[(j2 * 2 + dir) * 32 + h]);
    f32x4 st[2];
    st[0] = (f32x4){0.f, 0.f, 0.f, 0.f}; st[1] = (f32x4){0.f, 0.f, 0.f, 0.f};
    SsdPre nx1;
    ssd_prefetch(nx1, ssd_row0(b, dir, 0), dir, lane, XT, BT, Cn, Y, DT);
#pragma unroll 1
    for (int cc = 0; cc < 66; ++cc) {
        const int row0 = ssd_row0(b, dir, cc);
        const SsdPre cu = nx1;
        lds_sync();
        *(u32x4*)(sX + (tid >> 4) * SST + (tid & 15) * 8) = cu.xq;
#pragma unroll
        for (int nt = 0; nt < 2; ++nt) st4bf(sH + l16 * SST + wave * 32 + nt * 16 + quad * 4, st[nt][0], st[nt][1], st[nt][2], st[nt][3]);
        if (wave < 2) {
            const f32x2 sc2 = scan128(cu.dt0 * a, cu.dt1 * a, lane, dir);
            const float total = dir == 0 ? __shfl(sc2.y, 63) : __shfl(sc2.x, 0);
            if (wave == 0) { seacs[lane] = __expf(sc2.x); sw[lane] = cu.dt0 * __expf(total - sc2.x); if (lane == 0) sdec[0] = __expf(total); }
            else { seacs[64 + lane] = __expf(sc2.y); sw[64 + lane] = cu.dt1 * __expf(total - sc2.y); }
        }
        lds_sync();
        if (cc + 1 < 66) ssd_prefetch(nx1, ssd_row0(b, dir, cc + 1), dir, lane, XT, BT, Cn, Y, DT);
        f32x4 yo[2];
        yo[0] = (f32x4){0.f, 0.f, 0.f, 0.f}; yo[1] = (f32x4){0.f, 0.f, 0.f, 0.f};
#pragma unroll
        for (int ks = 0; ks < 4; ++ks) {
            const bf16x8 hf = lds16(sH + l16 * SST + ks * 32 + quad * 8);
#pragma unroll
            for (int i = 0; i < 2; ++i) yo[i] = mfma16(hf, __builtin_bit_cast(bf16x8, cu.cf[i][ks]), yo[i]);
        }
#pragma unroll
        for (int i = 0; i < 2; ++i) {
            const float e = seacs[wave * 32 + i * 16 + l16];
            const float o0 = __uint_as_float(cu.yold[i].x << 16), o1 = __uint_as_float(cu.yold[i].x & 0xffff0000u);
            const float o2 = __uint_as_float(cu.yold[i].y << 16), o3 = __uint_as_float(cu.yold[i].y & 0xffff0000u);
            st4bf(Y + (size_t)(row0 + i * 16) * 2048, yo[i][0] * e + o0, yo[i][1] * e + o1, yo[i][2] * e + o2, yo[i][3] * e + o3);
        }
        {
            const float dec = sdec[0];
            st[0] *= dec; st[1] *= dec;
#pragma unroll
            for (int ks = 0; ks < 4; ++ks) {
                const f32x4 w0 = *(const f32x4*)(sw + ks * 32 + quad * 8), w1 = *(const f32x4*)(sw + ks * 32 + quad * 8 + 4);
                const u32x4 raw = *(const u32x4*)(sX + l16 * SST + ks * 32 + quad * 8);
                u32x4 xs;
                xs.x = pack2(__uint_as_float(raw.x << 16) * w0[0], __uint_as_float(raw.x & 0xffff0000u) * w0[1]);
                xs.y = pack2(__uint_as_float(raw.y << 16) * w0[2], __uint_as_float(raw.y & 0xffff0000u) * w0[3]);
                xs.z = pack2(__uint_as_float(raw.z << 16) * w1[0], __uint_as_float(raw.z & 0xffff0000u) * w1[1]);
                xs.w = pack2(__uint_as_float(raw.w << 16) * w1[2], __uint_as_float(raw.w & 0xffff0000u) * w1[3]);
                const bf16x8 xbf = __builtin_bit_cast(bf16x8, xs);
#pragma unroll
                for (int nt = 0; nt < 2; ++nt) st[nt] = mfma16(__builtin_bit_cast(bf16x8, cu.bt[nt][ks]), xbf, st[nt]);
            }
        }
    }
}

__device__ void ssd_scan_phase(CParams& p, int layer, bf16_t* smem) {
    const int j2 = layer >> 1;
    for (int t = blockIdx.x; t < NB * 2 * 32 * 4; t += gridDim.x) {
        const int pq = t & 3, h = (t >> 2) & 31, dir = (t >> 7) & 1, b = t >> 8;
        ssd_scan_item(p, j2, b, dir, h, pq, smem);
    }
}

__device__ void finish_phase(CParams& p, int layer) {
    const int j2 = layer >> 1, lane = tid_() & 63, wave = tid_() >> 6;
    bf16_t* yf = (bf16_t*)(p.ws + WS_YF); const bf16_t* yb = (const bf16_t*)(p.ws + WS_YB); const bf16_t* z = (const bf16_t*)(p.ws + WS_Z);
    const float* gn = p.ssm_norm_g + (size_t)j2 * 2048;
    for (int row = blockIdx.x * 4 + wave; row < MT; row += gridDim.x * 4) {
#pragma unroll
        for (int g = 0; g < 4; ++g) {
            const size_t off = (size_t)row * 2048 + g * 512 + lane * 8;
            const u32x4 a = *(const u32x4*)(yf + off), bq = *(const u32x4*)(yb + off), zq = *(const u32x4*)(z + off);
            const unsigned aw[4] = {a.x, a.y, a.z, a.w}, bw[4] = {bq.x, bq.y, bq.z, bq.w}, zw[4] = {zq.x, zq.y, zq.z, zq.w};
            float v[8]; float ss = 0.f;
#pragma unroll
            for (int k = 0; k < 4; ++k) {
                v[2 * k] = (__uint_as_float(aw[k] << 16) + __uint_as_float(bw[k] << 16)) * __uint_as_float(zw[k] << 16);
                v[2 * k + 1] = (__uint_as_float(aw[k] & 0xffff0000u) + __uint_as_float(bw[k] & 0xffff0000u)) * __uint_as_float(zw[k] & 0xffff0000u);
                ss += v[2 * k] * v[2 * k] + v[2 * k + 1] * v[2 * k + 1];
            }
#pragma unroll
            for (int o = 1; o < 64; o <<= 1) ss += __shfl_xor(ss, o);
            const float rstd = rsqrtf(ss * (1.f / 512.f) + EPS);
            const f32x4 g0 = *(const f32x4*)(gn + g * 512 + lane * 8), g1 = *(const f32x4*)(gn + g * 512 + lane * 8 + 4);
            u32x4 o4;
            o4.x = pack2(v[0] * rstd * g0[0], v[1] * rstd * g0[1]); o4.y = pack2(v[2] * rstd * g0[2], v[3] * rstd * g0[3]);
            o4.z = pack2(v[4] * rstd * g1[0], v[5] * rstd * g1[1]); o4.w = pack2(v[6] * rstd * g1[2], v[7] * rstd * g1[3]);
            *(u32x4*)(yf + off) = o4;
        }
    }
}

__global__ void __launch_bounds__(256, 2) hybrid_fwd(Params p) {
    extern __shared__ __attribute__((aligned(16))) unsigned char lds[];
    cg::grid_group grid = cg::this_grid();
    bf16_t* smem = (bf16_t*)lds; float* smf = (float*)lds;
    volatile LAS unsigned* bst = (volatile LAS unsigned*)(lds + LDS_BYTES - 16);
    if (threadIdx.x == 0) { bst[0] = 0u; bst[1] = 0u; }
    __syncthreads();
    const XcdBarrier xb = xcd_barrier_post((unsigned*)(p.ws + WS_BAR), bst);
    enum { C_NORM1 = 0, C_MIXIN, C_ATTN, C_MIXOUT, C_NORM2, C_FFNIN, C_FFNOUT, C_SSMIN, C_CONV, C_SSD, C_FINISH, C_SSMOUT, C_PRO, C_SSDB };
    const unsigned long long evc = 0x6543210ull;
    const unsigned long long odc = 0x654BAD9870ull;
    for (int ph = 0; ph < 35; ++ph) {
        int code, layer;
        if (ph == 0) { code = C_PRO; layer = 0; }
        else {
            const int q = ph - 1, pair = q / 17, r = q - pair * 17;
            if (r < 7) { layer = 2 * pair; code = (int)((evc >> (4 * r)) & 15); }
            else { layer = 2 * pair + 1; code = (int)((odc >> (4 * (r - 7))) & 15); }
        }
        CParams* kp = (CParams*)__builtin_amdgcn_kernarg_segment_ptr();
        asm volatile("" : "+s"(kp));
        CParams& q = *kp;
#define PHASE(c) asm volatile("" : "+s"(code)); if (code == (c))
        PHASE(C_PRO) prologue(q, smf);
        PHASE(C_NORM1) { if (layer > 0) convert_layer_weights(q, layer, smf); norm_phase(q, layer, 0); }
        PHASE(C_NORM2) norm_phase(q, layer, 1);
        PHASE(C_MIXIN) gemm_phase<G_MIXIN>(q, layer, smem);
        PHASE(C_ATTN) attn_sg_phase(q, layer, smem);
        PHASE(C_MIXOUT) gemm_phase<G_MIXOUT>(q, layer, smem);
        PHASE(C_FFNIN) gemm_phase<G_FFNIN>(q, layer, smem);
        PHASE(C_FFNOUT) gemm_phase<G_FFNOUT>(q, layer, smem);
        PHASE(C_SSMIN) gemm_phase<G_SSMIN>(q, layer, smem);
        PHASE(C_CONV) conv_phase(q, layer, smf);
        PHASE(C_SSD) ssd_diag_phase(q, layer, smem);
        PHASE(C_SSDB) ssd_scan_phase(q, layer, smem);
        PHASE(C_FINISH) finish_phase(q, layer);
        PHASE(C_SSMOUT) gemm_phase<G_SSMOUT>(q, layer, smem);
#undef PHASE
        if (ph == 0) grid.sync(); else xcd_barrier(xb);
    }
}

extern "C" void kernel_launch(void* const* d_in, const int* in_sizes, int n_in, void* d_out, int out_size, void* d_ws, size_t ws_size, hipStream_t stream) {
    static int grid_blocks = 0;
    if (grid_blocks == 0) {
        if (ws_size < WS_TOTAL) { fprintf(stderr, "kernel_launch: workspace too small: %zu < %zu\n", ws_size, (size_t)WS_TOTAL); grid_blocks = -1; return; }
        int dev = 0, cus = 0, per_cu = 0;
        hipGetDevice(&dev);
        hipDeviceGetAttribute(&cus, hipDeviceAttributeMultiprocessorCount, dev);
        if (hipFuncSetAttribute((const void*)hybrid_fwd, hipFuncAttributeMaxDynamicSharedMemorySize, LDS_BYTES) != hipSuccess) { fprintf(stderr, "kernel_launch: hipFuncSetAttribute failed\n"); }
        if (hipOccupancyMaxActiveBlocksPerMultiprocessor(&per_cu, (const void*)hybrid_fwd, 256, LDS_BYTES) != hipSuccess || per_cu < 1) { fprintf(stderr, "kernel_launch: occupancy query failed (%d)\n", per_cu); per_cu = 1; }
        if (per_cu > 2) per_cu = 2;
        (void)hipGetLastError();
        grid_blocks = cus * per_cu;
    }
    if (grid_blocks < 0) return;
    if (hipMemsetAsync((char*)d_ws + WS_BAR, 0, XCD_BAR_WORDS * sizeof(unsigned), stream) != hipSuccess) { fprintf(stderr, "kernel_launch: hipMemsetAsync failed\n"); return; }
    Params p{};
    const float** f = (const float**)&p;
    for (int i = 0; i < 25; ++i) f[i] = (const float*)d_in[i];
    p.out = (float*)d_out; p.ws = (unsigned char*)d_ws;
    void* args[] = {&p};
    hipError_t e = hipLaunchCooperativeKernel((const void*)hybrid_fwd, dim3(grid_blocks), dim3(256), args, LDS_BYTES, stream);
    if (e != hipSuccess) fprintf(stderr, "cooperative launch failed: %s (grid %d)\n", hipGetErrorString(e), grid_blocks);
}
```

```cpp
#include <hip/hip_runtime.h>
#include <hip/hip_cooperative_groups.h>
#include <cstdio>
#include <cstdint>
namespace cg = cooperative_groups;

typedef unsigned short bf16_t;
typedef short bf16x8 __attribute__((ext_vector_type(8)));
typedef short bf16x4 __attribute__((ext_vector_type(4)));
typedef float f32x4 __attribute__((ext_vector_type(4)));
typedef unsigned u32x4 __attribute__((ext_vector_type(4)));
typedef unsigned u32x2 __attribute__((ext_vector_type(2)));

constexpr int D = 1024, NB = 2, SEQ = 8192, CTX = 256;
constexpr int ML = NB * SEQ;
constexpr int MC = NB * CTX;
constexpr int MT = ML + MC;
constexpr int TALL = CTX + SEQ;
constexpr int FFH = 2816;
constexpr int MIXIN = 1792;
constexpr int SSMIN = 5184, SSMIN_PAD = 5248;
constexpr int SSI = 2048;
constexpr float EPS = 1e-6f;

constexpr size_t MB = 1024 * 1024;
constexpr size_t WS_MOD = 0;
constexpr size_t WS_ROPE = 1 * MB;
constexpr size_t WS_XCTX = 3 * MB;
constexpr size_t WS_SGW = 5 * MB + 512 * 1024;
constexpr size_t WS_BAR = 7 * MB;
constexpr size_t WS_WT = 8 * MB;
constexpr size_t WT_FFNIN = 0;
constexpr size_t WT_FFNOUT = WT_FFNIN + (size_t)5632 * 1024 * 2;
constexpr size_t WT_MIXIN = WT_FFNOUT + (size_t)1024 * 2816 * 2;
constexpr size_t WT_MIXOUT = WT_MIXIN + (size_t)SSMIN_PAD * 1024 * 2;
constexpr size_t WT_END = WT_MIXOUT + (size_t)1024 * 2048 * 2;
constexpr size_t WS_R0 = WS_WT + ((WT_END + MB - 1) / MB) * MB;
constexpr size_t SZ_XBC = (size_t)MT * 3072 * 2;
constexpr size_t SZ_HN = (size_t)MT * 1024 * 2;
constexpr size_t WS_XBC = WS_R0;
constexpr size_t WS_HN = WS_XBC + SZ_XBC;
constexpr size_t WS_YF = WS_XBC;
constexpr size_t WS_YB = WS_YF + (size_t)MT * 2048 * 2;
constexpr size_t WS_R1 = WS_HN + SZ_HN;
constexpr size_t WS_Z = WS_R1;
constexpr size_t WS_XT = WS_Z + (size_t)MT * 2048 * 2;
constexpr size_t WS_BN = WS_XT + (size_t)MT * 2048 * 2;
constexpr size_t WS_CN = WS_BN + (size_t)MT * 512 * 2;
constexpr size_t WS_BT = WS_CN + (size_t)MT * 512 * 2;
constexpr size_t WS_DT = WS_BT + (size_t)MT * 512 * 2;
constexpr size_t WS_END_ODD = WS_DT + (size_t)MT * 64 * 4;
constexpr size_t WS_Q = WS_R1;
constexpr size_t WS_K = WS_Q + (size_t)MT * 512 * 2;
constexpr size_t WS_VT = WS_K + (size_t)MT * 128 * 2;
constexpr size_t WS_U = WS_VT + (size_t)MT * 128 * 2;
constexpr size_t WS_GVT = WS_U + (size_t)MT * 512 * 2;
constexpr size_t WS_AS = WS_GVT + (size_t)MT * 512 * 2;
constexpr size_t WS_HID = WS_R1;
constexpr size_t WS_TOTAL = WS_END_ODD;
static_assert(WS_TOTAL < (size_t)400 * MB, "workspace too large");
static_assert(WS_AS + (size_t)MT * 1024 * 2 <= WS_END_ODD, "even buffers fit");
static_assert(WS_HID + (size_t)MT * FFH * 2 <= WS_END_ODD, "hid fits");

constexpr int LDS_BYTES = 73728;
constexpr int GST = 72;
constexpr int SST = 136;

struct Params {
    const float* x; const float* c; const float* ctx; const float* c_ctx;
    const float* ada_w; const float* ada_b; const float* norm1_g; const float* norm2_g;
    const float* ffn_w_in; const float* ffn_w_out; const float* mix_w_in; const float* mix_w_out;
    const float* q_norm_g; const float* k_norm_g; const float* sgu_norm_g; const float* sgu_w; const float* sgu_b;
    const float* ssm_w_in; const float* ssm_conv_w; const float* ssm_conv_b; const float* ssm_dt_bias;
    const float* ssm_a_log; const float* ssm_d; const float* ssm_norm_g; const float* ssm_w_out;
    float* out; unsigned char* ws;
};

typedef const __attribute__((address_space(4))) Params CParams;

__device__ __forceinline__ int tid_() { int t = threadIdx.x; asm volatile("" : "+v"(t)); return t; }
__device__ __forceinline__ bf16_t f2bf(float f) {
    unsigned u = __float_as_uint(f);
    u += 0x7fffu + ((u >> 16) & 1u);
    return (bf16_t)(u >> 16);
}
__device__ __forceinline__ float bf2f(bf16_t h) { return __uint_as_float(((unsigned)h) << 16); }
__device__ __forceinline__ unsigned pack2(float a, float b) { unsigned r; asm volatile("v_cvt_pk_bf16_f32 %0, %1, %2" : "=v"(r) : "v"(a), "v"(b)); return r; }
__device__ __forceinline__ float siluf(float v) { return v / (1.f + __expf(-v)); }
__device__ __forceinline__ float geluf(float v) {
    const float u = 0.7978845608028654f * (v + 0.044715f * v * v * v);
    return v / (1.f + __expf(-2.f * u));
}
__device__ __forceinline__ float softplusf(float v) { return v > 20.f ? v : log1pf(expf(v)); }
__device__ __forceinline__ int seg_of(int row) { return row < SEQ ? 0 : (row < ML ? 1 : 2); }
__device__ __forceinline__ float* xrow(CParams& p, int row) {
    return row < ML ? p.out + (size_t)row * D : (float*)(p.ws + WS_XCTX) + (size_t)(row - ML) * D;
}
__device__ __forceinline__ void lds_sync() {
    __builtin_amdgcn_fence(__ATOMIC_RELEASE, "workgroup", "local");
    __builtin_amdgcn_s_barrier();
    __builtin_amdgcn_fence(__ATOMIC_ACQUIRE, "workgroup", "local");
}
typedef float f32x2 __attribute__((ext_vector_type(2)));
__device__ __forceinline__ f32x2 scan128(float s0, float s1, int lane, int dir) {
    if (dir == 0) {
#pragma unroll
        for (int o = 1; o < 64; o <<= 1) { const float t0 = __shfl_up(s0, o), t1 = __shfl_up(s1, o); s0 += lane >= o ? t0 : 0.f; s1 += lane >= o ? t1 : 0.f; }
        s1 += __shfl(s0, 63);
    } else {
#pragma unroll
        for (int o = 1; o < 64; o <<= 1) { const float t0 = __shfl_down(s0, o), t1 = __shfl_down(s1, o); s0 += lane + o < 64 ? t0 : 0.f; s1 += lane + o < 64 ? t1 : 0.f; }
        s0 += __shfl(s1, 0);
    }
    return (f32x2){s0, s1};
}
__device__ __forceinline__ f32x4 mfma16(bf16x8 a, bf16x8 b, f32x4 c) { return __builtin_amdgcn_mfma_f32_16x16x32_bf16(a, b, c, 0, 0, 0); }
__device__ __forceinline__ bf16x8 lds16(const bf16_t* p) { return *(const bf16x8*)p; }
__device__ __forceinline__ bf16x8 lds8x2(const bf16_t* p0, const bf16_t* p1) {
    const bf16x4 a = *(const bf16x4*)p0, b = *(const bf16x4*)p1;
    bf16x8 r; r[0] = a[0]; r[1] = a[1]; r[2] = a[2]; r[3] = a[3]; r[4] = b[0]; r[5] = b[1]; r[6] = b[2]; r[7] = b[3];
    return r;
}
__device__ __forceinline__ bf16x8 pack8(f32x4 a, f32x4 b) {
    u32x4 w; w.x = pack2(a[0], a[1]); w.y = pack2(a[2], a[3]); w.z = pack2(b[0], b[1]); w.w = pack2(b[2], b[3]);
    return __builtin_bit_cast(bf16x8, w);
}
__device__ __forceinline__ void st4bf(bf16_t* dst, float a, float b, float c, float d) {
    u32x2 w; w.x = pack2(a, b); w.y = pack2(c, d); *(u32x2*)dst = w;
}


#define XB_TMO      128
#define XB_XCNT(j)  (256  + 64 * (j))
#define XB_XSUB(j)  (1280 + 64 * (j))
#define XB_XGEN(j)  (2304 + 64 * (j))
#define XB_TOP      3328
#define XB_TOPGEN   3392
#define XCD_BAR_WORDS 3456
#define XB_SPIN_CAP (1u << 18)
#define LAS __attribute__((address_space(3)))
__device__ __forceinline__ unsigned xb_ld(unsigned* p)              { return __hip_atomic_load(p, __ATOMIC_RELAXED, __HIP_MEMORY_SCOPE_AGENT); }
__device__ __forceinline__ unsigned xb_add(unsigned* p, unsigned v) { return __hip_atomic_fetch_add(p, v, __ATOMIC_RELAXED, __HIP_MEMORY_SCOPE_AGENT); }
__device__ __forceinline__ unsigned xb_xcc_id() { return (unsigned)__builtin_amdgcn_s_getreg((3 << 11) | 20) & 0xFu; }
#define XB_SPIN(cond, bar) do { unsigned _sp = 0; while (cond) { __builtin_amdgcn_s_sleep(1); \
    if ((++_sp & 255u) == 0u) { if (xb_ld(&(bar)[XB_TMO])) break; if (_sp > XB_SPIN_CAP) { atomicAdd(&(bar)[XB_TMO], 1u); break; } } } } while (0)
struct XcdBarrier { unsigned* bar; unsigned x; volatile LAS unsigned* st; };
__device__ __forceinline__ XcdBarrier xcd_barrier_post(unsigned* bar, volatile LAS unsigned* st) {
    XcdBarrier b; b.bar = bar; b.x = xb_xcc_id(); b.st = st;
    if (threadIdx.x == 0) (void)xb_add(&bar[XB_XCNT(b.x)], 1u);
    return b;
}
__device__ __forceinline__ void xcd_barrier_complete(unsigned* bar, unsigned x, unsigned& nloc, unsigned& nx) {
    const unsigned G = gridDim.x * gridDim.y * gridDim.z;
    unsigned sum, cnt, mine, sp = 0u;
    for (;;) {
        sum = 0u; cnt = 0u; mine = 0u;
#pragma unroll
        for (unsigned j = 0; j < 16; ++j) { const unsigned c = xb_ld(&bar[XB_XCNT(j)]); sum += c; cnt += (c > 0u) ? 1u : 0u; mine = (j == x) ? c : mine; }
        if (sum == G) break;
        __builtin_amdgcn_s_sleep(1);
        if ((++sp & 255u) == 0u) { if (xb_ld(&bar[XB_TMO])) break; if (sp > XB_SPIN_CAP) { atomicAdd(&bar[XB_TMO], 1u); break; } }
    }
    nloc = mine > 0u ? mine : 1u; nx = cnt > 0u ? cnt : 1u;
}
__device__ __forceinline__ void xcd_barrier(const XcdBarrier& b) {
    asm volatile("s_waitcnt vmcnt(0)" ::: "memory");
    __syncthreads();
    if (threadIdx.x == 0) {
        unsigned* bar = b.bar;
        __builtin_amdgcn_s_waitcnt(0);
        unsigned nloc = b.st[0], nx = b.st[1];
        if (nloc == 0u) { xcd_barrier_complete(bar, b.x, nloc, nx); b.st[0] = nloc; b.st[1] = nx; }
        const unsigned old = xb_add(&bar[XB_XSUB(b.x)], 1u);
        const unsigned gen = old / nloc;
        if (old + 1u == (gen + 1u) * nloc) {
            __builtin_amdgcn_fence(__ATOMIC_RELEASE, "agent");
            asm volatile("s_waitcnt vmcnt(0)" ::: "memory");
            const unsigned og = xb_add(&bar[XB_TOP], 1u);
            const unsigned tg = og / nx;
            if (og + 1u == (tg + 1u) * nx) xb_add(&bar[XB_TOPGEN], 1u);
            else XB_SPIN(xb_ld(&bar[XB_TOPGEN]) == tg, bar);
            __builtin_amdgcn_fence(__ATOMIC_ACQUIRE, "agent");
            xb_add(&bar[XB_XGEN(b.x)], 1u);
            asm volatile("s_waitcnt vmcnt(0)" ::: "memory");
        } else {
            XB_SPIN(xb_ld(&bar[XB_XGEN(b.x)]) == gen, bar);
            __builtin_amdgcn_fence(__ATOMIC_ACQUIRE, "agent");
            asm volatile("s_waitcnt vmcnt(0)" ::: "memory");
        }
    }
    __syncthreads();
}

template <int MI, int lda, int ldw, int K>
__device__ __forceinline__ void gemm_tile(const bf16_t* __restrict__ A, const bf16_t* __restrict__ W,
                                          f32x4 (&acc)[MI][8], bf16_t* sW) {
    const int tid = tid_(), lane = tid & 63, wave = tid >> 6, l16 = lane & 15, quad = lane >> 4;
    const int srow = tid >> 3, skc = (tid & 7) * 8;
    const bf16_t* ap = A + (size_t)(wave * 16 * MI + l16) * lda + quad * 8;
    const bf16_t* wp = W + (size_t)srow * ldw + skc;
    const bf16_t* wr = sW + l16 * GST + quad * 8;
    u32x4 ra[MI][2], rw[4];
#pragma unroll
    for (int i = 0; i < 4; ++i) rw[i] = *(const u32x4*)(wp + (size_t)(i * 32) * ldw);
#pragma unroll
    for (int i = 0; i < MI; ++i)
#pragma unroll
        for (int ks = 0; ks < 2; ++ks) ra[i][ks] = *(const u32x4*)(ap + (size_t)(i * 16) * lda + ks * 32);
#pragma unroll
    for (int i = 0; i < MI; ++i)
#pragma unroll
        for (int j = 0; j < 8; ++j) acc[i][j] = (f32x4){0.f, 0.f, 0.f, 0.f};
    constexpr int nk = K >> 6;
#pragma unroll 1
    for (int kt = 0; kt < nk; ++kt) {
        lds_sync();
#pragma unroll
        for (int i = 0; i < 4; ++i) *(u32x4*)(sW + (srow + i * 32) * GST + skc) = rw[i];
        lds_sync();
        const int k0 = (kt + 1 < nk ? kt + 1 : kt) << 6;
#pragma unroll
        for (int i = 0; i < 4; ++i) rw[i] = *(const u32x4*)(wp + (size_t)(i * 32) * ldw + k0);
        bf16x8 wa[4], wb[4];
#pragma unroll
        for (int j = 0; j < 4; ++j) wa[j] = lds16(wr + (j * 16) * GST);
#pragma unroll
        for (int j = 0; j < 4; ++j) wb[j] = lds16(wr + ((j + 4) * 16) * GST);
        __builtin_amdgcn_sched_barrier(0);
#pragma unroll
        for (int j = 0; j < 4; ++j)
#pragma unroll
            for (int i = 0; i < MI; ++i) acc[i][j] = mfma16(wa[j], __builtin_bit_cast(bf16x8, ra[i][0]), acc[i][j]);
        __builtin_amdgcn_sched_barrier(0);
#pragma unroll
        for (int j = 0; j < 4; ++j) wa[j] = lds16(wr + (j * 16) * GST + 32);
        __builtin_amdgcn_sched_barrier(0);
#pragma unroll
        for (int j = 0; j < 4; ++j)
#pragma unroll
            for (int i = 0; i < MI; ++i) acc[i][j + 4] = mfma16(wb[j], __builtin_bit_cast(bf16x8, ra[i][0]), acc[i][j + 4]);
        __builtin_amdgcn_sched_barrier(0);
#pragma unroll
        for (int i = 0; i < MI; ++i) ra[i][0] = *(const u32x4*)(ap + (size_t)(i * 16) * lda + k0);
#pragma unroll
        for (int j = 0; j < 4; ++j) wb[j] = lds16(wr + ((j + 4) * 16) * GST + 32);
        __builtin_amdgcn_sched_barrier(0);
#pragma unroll
        for (int j = 0; j < 4; ++j)
#pragma unroll
            for (int i = 0; i < MI; ++i) acc[i][j] = mfma16(wa[j], __builtin_bit_cast(bf16x8, ra[i][1]), acc[i][j]);
        __builtin_amdgcn_sched_barrier(0);
#pragma unroll
        for (int j = 0; j < 4; ++j)
#pragma unroll
            for (int i = 0; i < MI; ++i) acc[i][j + 4] = mfma16(wb[j], __builtin_bit_cast(bf16x8, ra[i][1]), acc[i][j + 4]);
        __builtin_amdgcn_sched_barrier(0);
#pragma unroll
        for (int i = 0; i < MI; ++i) ra[i][1] = *(const u32x4*)(ap + (size_t)(i * 16) * lda + k0 + 32);
    }
}

template <int MI>
__device__ __forceinline__ void epi_resid(CParams& p, int m0, int n0, const f32x4 (&acc)[MI][8], const float* gate  ) {
    const int lane = tid_() & 63, wave = tid_() >> 6, l16 = lane & 15, quad = lane >> 4;
#pragma unroll
    for (int i = 0; i < MI; ++i) {
        const int row = m0 + wave * 16 * MI + i * 16 + l16;
        float* xr = xrow(p, row);
        const float* g = gate + (size_t)seg_of(row) * 6144;
#pragma unroll
        for (int j = 0; j < 8; ++j) {
            const int col = n0 + j * 16 + quad * 4;
            const f32x4 gv = *(const f32x4*)(g + col);
            f32x4 xv = *(f32x4*)(xr + col);
            xv += gv * acc[i][j];
            *(f32x4*)(xr + col) = xv;
        }
    }
}

template <int MI>
__device__ __forceinline__ void epi_swiglu(CParams& p, int m0, int n0, const f32x4 (&acc)[MI][8]) {
    const int lane = tid_() & 63, wave = tid_() >> 6, l16 = lane & 15, quad = lane >> 4;
    bf16_t* hid = (bf16_t*)(p.ws + WS_HID);
#pragma unroll
    for (int i = 0; i < MI; ++i) {
        const int row = m0 + wave * 16 * MI + i * 16 + l16;
#pragma unroll
        for (int jj = 0; jj < 4; ++jj) {
            const f32x4 g = acc[i][2 * jj], u = acc[i][2 * jj + 1];
            const int hc = (n0 >> 1) + jj * 16 + quad * 4;
            st4bf(hid + (size_t)row * FFH + hc, siluf(g[0]) * u[0], siluf(g[1]) * u[1], siluf(g[2]) * u[2], siluf(g[3]) * u[3]);
        }
    }
}

template <int MI>
__device__ __forceinline__ void epi_mixin(CParams& p, int j2, int m0, int tn, f32x4 (&acc)[MI][8]) {
    const int lane = tid_() & 63, wave = tid_() >> 6, l16 = lane & 15, quad = lane >> 4;
    if (tn < 5) {
        const float* gsrc = (tn < 4 ? p.q_norm_g : p.k_norm_g) + j2 * 64;
        const float* cosT = (const float*)(p.ws + WS_ROPE);
        const float* sinT = cosT + 8192 * 32;
#pragma unroll
        for (int i = 0; i < MI; ++i) {
            const int row = m0 + wave * 16 * MI + i * 16 + l16;
#pragma unroll
            for (int hh = 0; hh < 2; ++hh) {
                float ss = 0.f;
#pragma unroll
                for (int j = 0; j < 4; ++j) { const f32x4 v = acc[i][hh * 4 + j]; ss += v[0] * v[0] + v[1] * v[1] + v[2] * v[2] + v[3] * v[3]; }
                ss += __shfl_xor(ss, 16); ss += __shfl_xor(ss, 32);
                const float rstd = rsqrtf(ss * (1.f / 64.f) + EPS);
                f32x4 y[4];
#pragma unroll
                for (int j = 0; j < 4; ++j) {
                    const f32x4 gv = *(const f32x4*)(gsrc + j * 16 + quad * 4);
                    y[j] = acc[i][hh * 4 + j] * rstd * gv;
                }
                if (row < ML) {
                    const int s = row & (SEQ - 1);
#pragma unroll
                    for (int j = 0; j < 2; ++j) {
                        const f32x4 cs = *(const f32x4*)(cosT + (size_t)s * 32 + j * 16 + quad * 4);
                        const f32x4 sn = *(const f32x4*)(sinT + (size_t)s * 32 + j * 16 + quad * 4);
                        const f32x4 x1 = y[j], x2 = y[j + 2];
                        y[j] = x1 * cs - x2 * sn;
                        y[j + 2] = x2 * cs + x1 * sn;
                    }
                }
                if (tn < 4) {
                    bf16_t* q = (bf16_t*)(p.ws + WS_Q) + (size_t)row * 512 + (tn * 2 + hh) * 64;
#pragma unroll
                    for (int j = 0; j < 4; ++j) st4bf(q + j * 16 + quad * 4, y[j][0] * 0.125f, y[j][1] * 0.125f, y[j][2] * 0.125f, y[j][3] * 0.125f);
                } else {
                    const int b = row < ML ? (row >> 13) : ((row - ML) >> 8);
                    const int t = row < ML ? CTX + (row & (SEQ - 1)) : ((row - ML) & (CTX - 1));
                    bf16_t* k = (bf16_t*)(p.ws + WS_K) + ((size_t)b * TALL + t) * 128 + hh * 64;
#pragma unroll
                    for (int j = 0; j < 4; ++j) st4bf(k + j * 16 + quad * 4, y[j][0], y[j][1], y[j][2], y[j][3]);
                }
            }
        }
    } else if (tn == 5) {
        bf16_t* vt = (bf16_t*)(p.ws + WS_VT);
#pragma unroll
        for (int i = 0; i < MI; ++i) {
            const int row = m0 + wave * 16 * MI + i * 16 + l16;
            const int b = row < ML ? (row >> 13) : ((row - ML) >> 8);
            const int t = row < ML ? CTX + (row & (SEQ - 1)) : ((row - ML) & (CTX - 1));
#pragma unroll
            for (int j = 0; j < 8; ++j) {
                const int kh = j >> 2;
#pragma unroll
                for (int r = 0; r < 4; ++r) {
                    const int d = (j & 3) * 16 + quad * 4 + r;
                    vt[((size_t)(b * 2 + kh) * 64 + d) * TALL + t] = f2bf(acc[i][j][r]);
                }
            }
        }
    } else if (tn < 10) {
        bf16_t* u = (bf16_t*)(p.ws + WS_U);
#pragma unroll
        for (int i = 0; i < MI; ++i) {
            const int row = m0 + wave * 16 * MI + i * 16 + l16;
#pragma unroll
            for (int j = 0; j < 8; ++j) {
                const f32x4 v = acc[i][j];
                st4bf(u + (size_t)row * 512 + (tn - 6) * 128 + j * 16 + quad * 4, geluf(v[0]), geluf(v[1]), geluf(v[2]), geluf(v[3]));
            }
        }
    } else {
        const int g = tn - 10;
        const float* gn = p.sgu_norm_g + j2 * 512 + g * 128;
        bf16_t* gvt = (bf16_t*)(p.ws + WS_GVT);
#pragma unroll
        for (int i = 0; i < MI; ++i) {
            const int row = m0 + wave * 16 * MI + i * 16 + l16;
            float ss = 0.f;
#pragma unroll
            for (int j = 0; j < 8; ++j) {
                f32x4 v = acc[i][j];
                v[0] = geluf(v[0]); v[1] = geluf(v[1]); v[2] = geluf(v[2]); v[3] = geluf(v[3]);
                acc[i][j] = v;
                ss += v[0] * v[0] + v[1] * v[1] + v[2] * v[2] + v[3] * v[3];
            }
            ss += __shfl_xor(ss, 16); ss += __shfl_xor(ss, 32);
            const float rstd = rsqrtf(ss * (1.f / 128.f) + EPS);
            const int chunk = row >> 7, pt = row & 127;
#pragma unroll
            for (int j = 0; j < 8; ++j) {
                const f32x4 gv = *(const f32x4*)(gn + j * 16 + quad * 4);
#pragma unroll
                for (int r = 0; r < 4; ++r) {
                    const int cc = g * 128 + j * 16 + quad * 4 + r;
                    gvt[((size_t)chunk * 512 + cc) * 128 + pt] = f2bf(acc[i][j][r] * rstd * gv[r]);
                }
            }
        }
    }
}

template <int MI>
__device__ __forceinline__ void epi_ssmin(CParams& p, int j2, int m0, int tn, const f32x4 (&acc)[MI][8]) {
    const int lane = tid_() & 63, wave = tid_() >> 6, l16 = lane & 15, quad = lane >> 4;
#pragma unroll
    for (int i = 0; i < MI; ++i) {
        const int row = m0 + wave * 16 * MI + i * 16 + l16;
        if (tn < 16) {
            bf16_t* z = (bf16_t*)(p.ws + WS_Z) + (size_t)row * 2048 + tn * 128;
#pragma unroll
            for (int j = 0; j < 8; ++j) { const f32x4 v = acc[i][j]; st4bf(z + j * 16 + quad * 4, siluf(v[0]), siluf(v[1]), siluf(v[2]), siluf(v[3])); }
        } else if (tn < 40) {
            bf16_t* xb = (bf16_t*)(p.ws + WS_XBC) + (size_t)row * 3072 + (tn - 16) * 128;
#pragma unroll
            for (int j = 0; j < 8; ++j) { const f32x4 v = acc[i][j]; st4bf(xb + j * 16 + quad * 4, v[0], v[1], v[2], v[3]); }
        } else {
            float* dt = (float*)(p.ws + WS_DT) + (size_t)row * 64;
            const float* bias = p.ssm_dt_bias + j2 * 64;
#pragma unroll
            for (int j = 0; j < 4; ++j) {
                const int c = j * 16 + quad * 4;
                const f32x4 v = acc[i][j];
                f32x4 o;
                o[0] = softplusf(v[0] + bias[c + 0]); o[1] = softplusf(v[1] + bias[c + 1]);
                o[2] = softplusf(v[2] + bias[c + 2]); o[3] = softplusf(v[3] + bias[c + 3]);
                *(f32x4*)(dt + c) = o;
            }
        }
    }
}

enum { G_MIXIN = 0, G_MIXOUT, G_SSMIN, G_SSMOUT, G_FFNIN, G_FFNOUT };

template <int KIND>
__device__ void gemm_phase(CParams& p, int layer, bf16_t* smem) {
    const int j2 = layer >> 1;
    constexpr int lda = (KIND == G_SSMOUT) ? 2048 : (KIND == G_FFNOUT) ? FFH : 1024;
    constexpr int K = lda, ldw = K;
    constexpr int N = (KIND == G_MIXIN) ? MIXIN : (KIND == G_SSMIN) ? SSMIN_PAD : (KIND == G_FFNIN) ? 2 * FFH : 1024;
    constexpr size_t aoff = (KIND == G_MIXOUT) ? WS_AS : (KIND == G_SSMOUT) ? WS_YF : (KIND == G_FFNOUT) ? WS_HID : WS_HN;
    constexpr size_t woff = (KIND == G_MIXIN || KIND == G_SSMIN) ? WT_MIXIN : (KIND == G_MIXOUT || KIND == G_SSMOUT) ? WT_MIXOUT : (KIND == G_FFNIN) ? WT_FFNIN : WT_FFNOUT;
    const bf16_t* A = (const bf16_t*)(p.ws + aoff);
    const bf16_t* W = (const bf16_t*)(p.ws + WS_WT + woff);
    constexpr int MI = (KIND == G_MIXIN) ? 2 : 4;
    constexpr int nN = N >> 7, nM = MT / (64 * MI);
    const float* mod = (const float*)(p.ws + WS_MOD) + (size_t)layer * 3 * 6144;
    bf16_t* sW = smem;
    if (N == 1024) {
        const int nlat = (ML / 256) * 8, nctx = layer == 3 ? 0 : (MC / 64) * 8;
        const float* gate = mod + (KIND == G_FFNOUT ? 5 : 2) * 1024;
        for (int t = blockIdx.x; t < nlat + nctx; t += gridDim.x) {
            if (t < nlat) {
                const int u = (gridDim.x == 512) ? ((t & 7) * 64 + (t >> 3)) : t;
                const int tm = u >> 3, tn = u & 7;
                f32x4 acc[4][8];
                gemm_tile<4, lda, ldw, K>(A + (size_t)tm * 256 * lda, W + (size_t)tn * 128 * ldw, acc, sW);
                epi_resid<4>(p, tm * 256, tn * 128, acc, gate);
            } else {
                const int u = t - nlat, tm = u >> 3, tn = u & 7;
                f32x4 acc[1][8];
                gemm_tile<1, lda, ldw, K>(A + (size_t)(ML + tm * 64) * lda, W + (size_t)tn * 128 * ldw, acc, sW);
                epi_resid<1>(p, ML + tm * 64, tn * 128, acc, gate);
            }
        }
        return;
    }
    constexpr int T = nM * nN, share = (T + 7) / 8, nsc = (nN + 7) / 8;
    const int xcd = blockIdx.x & 7, slot = blockIdx.x >> 3, nslot = gridDim.x >> 3;
    for (int li = slot; li < share; li += nslot) {
        const int u = xcd * share + li;
        if (u >= T) break;
        int sc = u / (nM * 8); if (sc > nsc - 1) sc = nsc - 1;
        const int rem = u - sc * nM * 8, wd = (sc == nsc - 1) ? (nN - 8 * sc) : 8;
        const int tm = rem / wd, tn = sc * 8 + rem - tm * wd;
        f32x4 acc[MI][8];
        gemm_tile<MI, lda, ldw, K>(A + (size_t)tm * (64 * MI) * lda, W + (size_t)tn * 128 * ldw, acc, sW);
        if (KIND == G_MIXIN) epi_mixin<MI>(p, j2, tm * (64 * MI), tn, acc);
        else if (KIND == G_SSMIN) epi_ssmin<MI>(p, j2, tm * (64 * MI), tn, acc);
        else if (KIND == G_FFNIN) epi_swiglu<MI>(p, tm * (64 * MI), tn * 128, acc);
    }
}

__device__ void norm_phase(CParams& p, int layer, int which) {
    const int lane = tid_() & 63, wave = tid_() >> 6;
    const float* g = (which ? p.norm2_g : p.norm1_g) + layer * 1024;
    const float* mod = (const float*)(p.ws + WS_MOD) + (size_t)layer * 3 * 6144;
    bf16_t* hn = (bf16_t*)(p.ws + WS_HN);
    for (int row = blockIdx.x * 4 + wave; row < MT; row += gridDim.x * 4) {
        const float* xr = xrow(p, row);
        f32x4 v[4]; float ss = 0.f;
#pragma unroll
        for (int i = 0; i < 4; ++i) { v[i] = *(const f32x4*)(xr + i * 256 + lane * 4); ss += v[i][0] * v[i][0] + v[i][1] * v[i][1] + v[i][2] * v[i][2] + v[i][3] * v[i][3]; }
#pragma unroll
        for (int o = 1; o < 64; o <<= 1) ss += __shfl_xor(ss, o);
        const float rstd = rsqrtf(ss * (1.f / 1024.f) + EPS);
        const float* m = mod + (size_t)seg_of(row) * 6144 + (which ? 3 * 1024 : 0);
#pragma unroll
        for (int i = 0; i < 4; ++i) {
            const int col = i * 256 + lane * 4;
            const f32x4 gv = *(const f32x4*)(g + col), sh = *(const f32x4*)(m + col), sc = *(const f32x4*)(m + 1024 + col);
            const f32x4 y = (v[i] * rstd * gv) * (sc + 1.f) + sh;
            st4bf(hn + (size_t)row * 1024 + col, y[0], y[1], y[2], y[3]);
        }
    }
}

__device__ void convert_wt(const float* __restrict__ W, int K, int N, bf16_t* __restrict__ Wt, int mode, float* tile) {
    const int tid = tid_();
    const int nKt = K >> 6, nNt = N >> 6;
    for (int t = blockIdx.x; t < nKt * nNt; t += gridDim.x) {
        const int kt = t / nNt, nt = t - kt * nNt;
        lds_sync();
#pragma unroll
        for (int i = 0; i < 16; ++i) {
            const int kk = (tid >> 6) + i * 4, nn = tid & 63;
            tile[kk * 65 + nn] = W[(size_t)(kt * 64 + kk) * N + nt * 64 + nn];
        }
        lds_sync();
        {
            const int nn = tid >> 2, kq = (tid & 3) * 16;
            const int n = nt * 64 + nn;
            int dr = n;
            if (mode == 1) { const int hm = n < FFH ? n : n - FFH; dr = (hm >> 4) * 32 + (hm & 15) + (n < FFH ? 0 : 16); }
            u32x4 o0, o1;
            o0.x = pack2(tile[(kq + 0) * 65 + nn], tile[(kq + 1) * 65 + nn]); o0.y = pack2(tile[(kq + 2) * 65 + nn], tile[(kq + 3) * 65 + nn]);
            o0.z = pack2(tile[(kq + 4) * 65 + nn], tile[(kq + 5) * 65 + nn]); o0.w = pack2(tile[(kq + 6) * 65 + nn], tile[(kq + 7) * 65 + nn]);
            o1.x = pack2(tile[(kq + 8) * 65 + nn], tile[(kq + 9) * 65 + nn]); o1.y = pack2(tile[(kq + 10) * 65 + nn], tile[(kq + 11) * 65 + nn]);
            o1.z = pack2(tile[(kq + 12) * 65 + nn], tile[(kq + 13) * 65 + nn]); o1.w = pack2(tile[(kq + 14) * 65 + nn], tile[(kq + 15) * 65 + nn]);
            bf16_t* dst = Wt + (size_t)dr * K + kt * 64 + kq;
            *(u32x4*)dst = o0; *(u32x4*)(dst + 8) = o1;
        }
    }
}

__device__ void convert_layer_weights(CParams& p, int layer, float* tile) {
    unsigned char* wt = p.ws + WS_WT;
    const int j2 = layer >> 1;
    convert_wt(p.ffn_w_in + (size_t)layer * 1024 * 2 * FFH, 1024, 2 * FFH, (bf16_t*)(wt + WT_FFNIN), 1, tile);
    convert_wt(p.ffn_w_out + (size_t)layer * FFH * 1024, FFH, 1024, (bf16_t*)(wt + WT_FFNOUT), 0, tile);
    if ((layer & 1) == 0) {
        convert_wt(p.mix_w_in + (size_t)j2 * 1024 * MIXIN, 1024, MIXIN, (bf16_t*)(wt + WT_MIXIN), 0, tile);
        convert_wt(p.mix_w_out + (size_t)j2 * 1024 * 1024, 1024, 1024, (bf16_t*)(wt + WT_MIXOUT), 0, tile);
    } else {
        convert_wt(p.ssm_w_in + (size_t)j2 * 1024 * SSMIN, 1024, SSMIN, (bf16_t*)(wt + WT_MIXIN), 0, tile);
        convert_wt(p.ssm_w_out + (size_t)j2 * SSI * 1024, SSI, 1024, (bf16_t*)(wt + WT_MIXOUT), 0, tile);
        bf16_t* padp = (bf16_t*)(wt + WT_MIXIN) + (size_t)SSMIN * 1024;
        for (int i = blockIdx.x * 256 + tid_(); i < (SSMIN_PAD - SSMIN) * 1024; i += gridDim.x * 256) padp[i] = 0;
    }
}

__device__ void prologue(CParams& p, float* smf) {
    const int tid = tid_();
    const size_t gtid = (size_t)blockIdx.x * 256 + tid, gsz = (size_t)gridDim.x * 256;
    {
        const f32x4* s = (const f32x4*)p.x; f32x4* d = (f32x4*)p.out;
        for (size_t i = gtid; i < (size_t)ML * D / 4; i += gsz) d[i] = s[i];
        const f32x4* s2 = (const f32x4*)p.ctx; f32x4* d2 = (f32x4*)(p.ws + WS_XCTX);
        for (size_t i = gtid; i < (size_t)MC * D / 4; i += gsz) d2[i] = s2[i];
    }
    {
        float* cosT = (float*)(p.ws + WS_ROPE); float* sinT = cosT + 8192 * 32;
        for (size_t i = gtid; i < (size_t)8192 * 32; i += gsz) {
            const int s = (int)(i >> 5), j = (int)(i & 31), f = j & 15;
            const float inv = powf(10000.f, -(float)f / 16.f);
            const float pos = (float)(j < 16 ? (s >> 6) : (s & 63));
            const float ang = pos * inv;
            cosT[i] = cosf(ang); sinT[i] = sinf(ang);
        }
    }
    {
        bf16_t* sgw = (bf16_t*)(p.ws + WS_SGW);
        for (size_t i = gtid; i < (size_t)2 * 4 * 128 * 128; i += gsz) sgw[i] = f2bf(p.sgu_w[i]);
    }
    {
        float* sc = smf;
        float* red = smf + 3 * 1024;
        lds_sync();
        for (int i = tid; i < 3 * 1024; i += 256) {
            const int sgi = i >> 10, k = i & 1023;
            const float v = sgi < 2 ? p.c[sgi * 1024 + k] : p.c_ctx[k];
            sc[i] = siluf(v);
        }
        lds_sync();
        float* mod = (float*)(p.ws + WS_MOD);
        const int cl = tid & 63, kg = tid >> 6;
        for (int wi = blockIdx.x; wi < 4 * 96; wi += gridDim.x) {
            const int layer = wi / 96, cb = wi - layer * 96;
            const float* w = p.ada_w + (size_t)layer * 1024 * 6144 + cb * 64 + cl;
            float s0 = 0.f, s1 = 0.f, s2 = 0.f;
            for (int k = kg * 256; k < kg * 256 + 256; ++k) {
                const float wv = w[(size_t)k * 6144];
                s0 += sc[k] * wv; s1 += sc[1024 + k] * wv; s2 += sc[2048 + k] * wv;
            }
            lds_sync();
            red[(kg * 3 + 0) * 64 + cl] = s0; red[(kg * 3 + 1) * 64 + cl] = s1; red[(kg * 3 + 2) * 64 + cl] = s2;
            lds_sync();
            if (tid < 192) {
                const int sgi = tid >> 6;
                const float v = red[(0 * 3 + sgi) * 64 + cl] + red[(1 * 3 + sgi) * 64 + cl] + red[(2 * 3 + sgi) * 64 + cl] + red[(3 * 3 + sgi) * 64 + cl];
                const int n = cb * 64 + cl;
                mod[((size_t)layer * 3 + sgi) * 6144 + n] = v + p.ada_b[layer * 6144 + n];
            }
        }
        lds_sync();
    }
    convert_layer_weights(p, 0, smf);
}

__device__ __forceinline__ void attn_item(CParams& p, int j2, int b, int h, int q0row, int nkeys, bf16_t* smem) {
    const int tid = tid_(), lane = tid & 63, wave = tid >> 6, l16 = lane & 15, quad = lane >> 4;
    const int kh = h >> 2;
    const bf16_t* Q = (const bf16_t*)(p.ws + WS_Q);
    const bf16_t* Kb = (const bf16_t*)(p.ws + WS_K) + (size_t)b * TALL * 128 + kh * 64;
    const bf16_t* Vb = (const bf16_t*)(p.ws + WS_VT) + (size_t)(b * 2 + kh) * 64 * TALL;
    bf16_t* sK = smem; bf16_t* sV = smem + 64 * GST;
    constexpr float LOG2E = 1.4426950408889634f;
    float mb;
    {
        float gq = fabsf(p.q_norm_g[j2 * 64 + lane]), gk = fabsf(p.k_norm_g[j2 * 64 + lane]);
#pragma unroll
        for (int o = 1; o < 64; o <<= 1) { gq = fmaxf(gq, __shfl_xor(gq, o)); gk = fmaxf(gk, __shfl_xor(gk, o)); }
        mb = 8.f * 1.02f * gq * gk * LOG2E;
    }
    bf16x8 qf[4][2];
#pragma unroll
    for (int i = 0; i < 4; ++i)
#pragma unroll
        for (int ks = 0; ks < 2; ++ks)
            qf[i][ks] = *(const bf16x8*)(Q + (size_t)(q0row + wave * 64 + i * 16 + l16) * 512 + h * 64 + ks * 32 + quad * 8);
    f32x4 o[4][4];
#pragma unroll
    for (int d = 0; d < 4; ++d)
#pragma unroll
        for (int i = 0; i < 4; ++i) o[d][i] = (f32x4){0.f, 0.f, 0.f, 0.f};
    float lrun[4] = {0.f, 0.f, 0.f, 0.f};
    const int srow = tid >> 3, skc = (tid & 7) * 8;
    u32x4 rk[2], rv[2];
#pragma unroll
    for (int i = 0; i < 2; ++i) {
        rk[i] = *(const u32x4*)(Kb + (size_t)(srow + i * 32) * 128 + skc);
        rv[i] = *(const u32x4*)(Vb + (size_t)(srow + i * 32) * TALL + skc);
    }
    const int nt = nkeys >> 6;
#pragma unroll 1
    for (int kt = 0; kt < nt; ++kt) {
        lds_sync();
#pragma unroll
        for (int i = 0; i < 2; ++i) {
            *(u32x4*)(sK + (srow + i * 32) * GST + skc) = rk[i];
            *(u32x4*)(sV + (srow + i * 32) * GST + skc) = rv[i];
        }
        lds_sync();
        {
            const int t0 = (kt + 1 < nt ? kt + 1 : kt) << 6;
#pragma unroll
            for (int i = 0; i < 2; ++i) {
                rk[i] = *(const u32x4*)(Kb + (size_t)(t0 + srow + i * 32) * 128 + skc);
                rv[i] = *(const u32x4*)(Vb + (size_t)(srow + i * 32) * TALL + t0 + skc);
            }
        }
        bf16x8 pf[2][4];
#pragma unroll
        for (int ih = 0; ih < 2; ++ih) {
            f32x4 s[4][2];
#pragma unroll
            for (int tt = 0; tt < 4; ++tt)
#pragma unroll
                for (int i = 0; i < 2; ++i) s[tt][i] = (f32x4){0.f, 0.f, 0.f, 0.f};
#pragma unroll
            for (int ks = 0; ks < 2; ++ks)
#pragma unroll
                for (int tt = 0; tt < 4; ++tt) {
                    const bf16x8 kf = lds16(sK + (tt * 16 + l16) * GST + ks * 32 + quad * 8);
#pragma unroll
                    for (int i = 0; i < 2; ++i) s[tt][i] = mfma16(kf, qf[ih * 2 + i][ks], s[tt][i]);
                }
#pragma unroll
            for (int i = 0; i < 2; ++i) {
                float ls = 0.f;
#pragma unroll
                for (int tt = 0; tt < 4; ++tt) {
#pragma unroll
                    for (int r = 0; r < 4; ++r) { const float e = __builtin_amdgcn_exp2f(s[tt][i][r] * LOG2E - mb); s[tt][i][r] = e; ls += e; }
                }
                lrun[ih * 2 + i] += ls;
#pragma unroll
                for (int ksp = 0; ksp < 2; ++ksp) pf[ksp][ih * 2 + i] = pack8(s[2 * ksp][i], s[2 * ksp + 1][i]);
            }
        }
#pragma unroll
        for (int ksp = 0; ksp < 2; ++ksp)
#pragma unroll
            for (int d = 0; d < 4; ++d) {
                const bf16_t* vp = sV + (d * 16 + l16) * GST + ksp * 32 + quad * 4;
                const bf16x8 vf = lds8x2(vp, vp + 16);
#pragma unroll
                for (int i = 0; i < 4; ++i) o[d][i] = mfma16(vf, pf[ksp][i], o[d][i]);
            }
    }
    bf16_t* as = (bf16_t*)(p.ws + WS_AS);
#pragma unroll
    for (int i = 0; i < 4; ++i) {
        float l = lrun[i];
        l += __shfl_xor(l, 16); l += __shfl_xor(l, 32);
        const float inv = 1.f / l;
        const int row = q0row + wave * 64 + i * 16 + l16;
#pragma unroll
        for (int d = 0; d < 4; ++d)
            st4bf(as + (size_t)row * 1024 + h * 64 + d * 16 + quad * 4, o[d][i][0] * inv, o[d][i][1] * inv, o[d][i][2] * inv, o[d][i][3] * inv);
    }
}

__device__ void sg_item(CParams& p, int j2, int chunk, int g, bf16_t* smem) {
    const int lane = tid_() & 63, wave = tid_() >> 6, l16 = lane & 15, quad = lane >> 4;
    const bf16_t* A = (const bf16_t*)(p.ws + WS_SGW) + (size_t)(j2 * 4 + g) * 128 * 128;
    const bf16_t* W = (const bf16_t*)(p.ws + WS_GVT) + ((size_t)chunk * 512 + g * 128) * 128;
    f32x4 acc[2][8];
    gemm_tile<2, 128, 128, 128>(A, W, acc, smem);
    const bf16_t* u = (const bf16_t*)(p.ws + WS_U);
    bf16_t* as = (bf16_t*)(p.ws + WS_AS);
    const float* bs = p.sgu_b + (size_t)(j2 * 4 + g) * 128;
#pragma unroll
    for (int i = 0; i < 2; ++i) {
        const int pt = wave * 32 + i * 16 + l16;
        const int row = chunk * 128 + pt;
        const float bias = bs[pt];
#pragma unroll
        for (int j = 0; j < 8; ++j) {
            const int c = g * 128 + j * 16 + quad * 4;
            const u32x2 uw = *(const u32x2*)(u + (size_t)row * 512 + c);
            const float u0 = __uint_as_float(uw.x << 16), u1 = __uint_as_float(uw.x & 0xffff0000u);
            const float u2 = __uint_as_float(uw.y << 16), u3 = __uint_as_float(uw.y & 0xffff0000u);
            const f32x4 v = acc[i][j];
            st4bf(as + (size_t)row * 1024 + 512 + c, u0 * (v[0] + bias), u1 * (v[1] + bias), u2 * (v[2] + bias), u3 * (v[3] + bias));
        }
    }
}

__device__ void attn_sg_phase(CParams& p, int layer, bf16_t* smem) {
    const int j2 = layer >> 1;
    const int nA = NB * 8 * 32, nS = (MT / 128) * 4, nC = NB * 8;
    for (int t = blockIdx.x; t < nA + nS + nC; t += gridDim.x) {
        if (t < nA) {
            const int xcd = t & 7, li = t >> 3;
            const int bh = xcd * 2 + (li >> 5), qb = li & 31;
            attn_item(p, j2, bh >> 3, bh & 7, (bh >> 3) * SEQ + qb * 256, TALL, smem);
        } else if (t < nA + nS) {
            const int u = t - nA;
            sg_item(p, j2, u >> 2, u & 3, smem);
        } else {
            const int u = t - nA - nS;
            const int h = u & 7, b = u >> 3;
            attn_item(p, j2, b, h, ML + b * CTX, CTX, smem);
        }
    }
}

__device__ void conv_phase(CParams& p, int layer, float* smf) {
    const int j2 = layer >> 1, tid = tid_();
    const bf16_t* xbc = (const bf16_t*)(p.ws + WS_XBC);
    bf16_t* XT = (bf16_t*)(p.ws + WS_XT); bf16_t* Bn = (bf16_t*)(p.ws + WS_BN); bf16_t* Cn = (bf16_t*)(p.ws + WS_CN); bf16_t* BT = (bf16_t*)(p.ws + WS_BT);
    const float* cw = p.ssm_conv_w + (size_t)j2 * 3 * 3072;
    const float* cb = p.ssm_conv_b + (size_t)j2 * 3072;
    float* sin_ = smf;
    float* sout = smf + 66 * 65;
    const int nCt = 3072 / 64, nRt = MT / 64;
    for (int t = blockIdx.x; t < nCt * nRt; t += gridDim.x) {
        const int rt = t / nCt, ct = t - rt * nCt;
        const int r0 = rt * 64, c0 = ct * 64;
        const bool first = r0 < ML ? ((r0 & (SEQ - 1)) == 0) : (((r0 - ML) & (CTX - 1)) == 0);
        const bool last = r0 < ML ? (((r0 + 64) & (SEQ - 1)) == 0) : ((((r0 + 64) - ML) & (CTX - 1)) == 0);
        lds_sync();
        for (int e = tid; e < 66 * 8; e += 256) {
            const int rr = e >> 3, c8 = (e & 7) * 8;
            const int row = r0 - 1 + rr;
            u32x4 v = (u32x4){0u, 0u, 0u, 0u};
            if (!((rr == 0 && first) || (rr == 65 && last))) v = *(const u32x4*)(xbc + (size_t)row * 3072 + c0 + c8);
            float* d = sin_ + rr * 65 + c8;
            d[0] = __uint_as_float(v.x << 16); d[1] = __uint_as_float(v.x & 0xffff0000u);
            d[2] = __uint_as_float(v.y << 16); d[3] = __uint_as_float(v.y & 0xffff0000u);
            d[4] = __uint_as_float(v.z << 16); d[5] = __uint_as_float(v.z & 0xffff0000u);
            d[6] = __uint_as_float(v.w << 16); d[7] = __uint_as_float(v.w & 0xffff0000u);
        }
        lds_sync();
        {
            const int c = tid & 63;
            const float w0 = cw[c0 + c], w1 = cw[3072 + c0 + c], w2 = cw[2 * 3072 + c0 + c], bb = cb[c0 + c];
#pragma unroll
            for (int k = 0; k < 16; ++k) {
                const int tt = (tid >> 6) + k * 4;
                const float v = w0 * sin_[tt * 65 + c] + w1 * sin_[(tt + 1) * 65 + c] + w2 * sin_[(tt + 2) * 65 + c] + bb;
                sout[c * 65 + tt] = siluf(v);
            }
        }
        lds_sync();
        const int q = tid >> 2, e16 = (tid & 3) * 16;
        if (c0 >= 2048) {
            u32x4 o0, o1;
            o0.x = pack2(sout[(e16 + 0) * 65 + q], sout[(e16 + 1) * 65 + q]); o0.y = pack2(sout[(e16 + 2) * 65 + q], sout[(e16 + 3) * 65 + q]);
            o0.z = pack2(sout[(e16 + 4) * 65 + q], sout[(e16 + 5) * 65 + q]); o0.w = pack2(sout[(e16 + 6) * 65 + q], sout[(e16 + 7) * 65 + q]);
            o1.x = pack2(sout[(e16 + 8) * 65 + q], sout[(e16 + 9) * 65 + q]); o1.y = pack2(sout[(e16 + 10) * 65 + q], sout[(e16 + 11) * 65 + q]);
            o1.z = pack2(sout[(e16 + 12) * 65 + q], sout[(e16 + 13) * 65 + q]); o1.w = pack2(sout[(e16 + 14) * 65 + q], sout[(e16 + 15) * 65 + q]);
            bf16_t* dst = (c0 < 2560 ? Bn + (c0 - 2048) : Cn + (c0 - 2560)) + (size_t)(r0 + q) * 512 + e16;
            *(u32x4*)dst = o0; *(u32x4*)(dst + 8) = o1;
        }
        if (c0 < 2560) {
            const float* sp = sout + q * 65 + e16;
            u32x4 o0, o1;
            o0.x = pack2(sp[0], sp[1]); o0.y = pack2(sp[2], sp[3]); o0.z = pack2(sp[4], sp[5]); o0.w = pack2(sp[6], sp[7]);
            o1.x = pack2(sp[8], sp[9]); o1.y = pack2(sp[10], sp[11]); o1.z = pack2(sp[12], sp[13]); o1.w = pack2(sp[14], sp[15]);
            bf16_t* dst = (c0 < 2048 ? XT + (size_t)c0 * MT : BT + (size_t)(c0 - 2048) * MT) + (size_t)q * MT + r0 + e16;
            *(u32x4*)dst = o0; *(u32x4*)(dst + 8) = o1;
        }
    }
}

__device__ void ssd_diag_item(CParams& p, int j2, int row0, int h, bf16_t* smem) {
    const int tid = tid_(), lane = tid & 63, wave = tid >> 6, l16 = lane & 15, quad = lane >> 4;
    const int g = h >> 3;
    bf16_t* sB = smem;
    bf16_t* sX = sB + 128 * SST;
    float* sda = (float*)(sX + 64 * SST);
    float* sPf = sda + 256;
    float* sRb = sPf + 128;
    float* sdtf = sRb + 128;
    float* sdtb = sdtf + 128;
    const bf16_t* XT = (const bf16_t*)(p.ws + WS_XT) + (size_t)(h * 64) * MT;
    const bf16_t* Bn = (const bf16_t*)(p.ws + WS_BN) + g * 128;
    const bf16_t* Cn = (const bf16_t*)(p.ws + WS_CN) + g * 128;
    const float* DT = (const float*)(p.ws + WS_DT);
    bf16_t* Y = (bf16_t*)(p.ws + WS_YF);
    const float af = -expf(p.ssm_a_log[(j2 * 2 + 0) * 32 + h]);
    const float ab = -expf(p.ssm_a_log[(j2 * 2 + 1) * 32 + h]);
    const float dsk = p.ssm_d[j2 * 32 + h];
    lds_sync();
#pragma unroll
    for (int i = 0; i < 8; ++i) {
        const int c = tid + i * 256, r = c >> 4, kc = (c & 15) * 8;
        *(u32x4*)(sB + r * SST + kc) = *(const u32x4*)(Bn + (size_t)(row0 + r) * 512 + kc);
    }
#pragma unroll
    for (int i = 0; i < 4; ++i) {
        const int c = tid + i * 256, r = c >> 4, kc = (c & 15) * 8;
        *(u32x4*)(sX + r * SST + kc) = *(const u32x4*)(XT + (size_t)r * MT + row0 + kc);
    }
    {
        const int d = wave >> 1;
        const float d0 = DT[(size_t)(row0 + lane) * 64 + d * 32 + h], d1 = DT[(size_t)(row0 + 64 + lane) * 64 + d * 32 + h];
        const float aa = d ? ab : af;
        const f32x2 sc2 = scan128(d0 * aa, d1 * aa, lane, d);
        float* sc = d ? sRb : sPf; float* sd = d ? sdtb : sdtf;
        if ((wave & 1) == 0) { sc[lane] = sc2.x; sd[lane] = d0; } else { sc[64 + lane] = sc2.y; sd[64 + lane] = d1; }
    }
    bf16x8 cf[2][4];
#pragma unroll
    for (int i = 0; i < 2; ++i)
#pragma unroll
        for (int ks = 0; ks < 4; ++ks)
            cf[i][ks] = *(const bf16x8*)(Cn + (size_t)(row0 + wave * 32 + i * 16 + l16) * 512 + ks * 32 + quad * 8);
    lds_sync();
    float pfl[2], rbl[2];
#pragma unroll
    for (int i = 0; i < 2; ++i) { pfl[i] = sPf[wave * 32 + i * 16 + l16]; rbl[i] = sRb[wave * 32 + i * 16 + l16]; }
    f32x4 y[4][2];
#pragma unroll
    for (int pt = 0; pt < 4; ++pt)
#pragma unroll
        for (int i = 0; i < 2; ++i) y[pt][i] = (f32x4){0.f, 0.f, 0.f, 0.f};
#pragma unroll 1
    for (int sp = 0; sp < 4; ++sp) {
        f32x4 gt[2][2];
#pragma unroll
        for (int s2 = 0; s2 < 2; ++s2)
#pragma unroll
            for (int i = 0; i < 2; ++i) gt[s2][i] = (f32x4){0.f, 0.f, 0.f, 0.f};
#pragma unroll
        for (int ks = 0; ks < 4; ++ks)
#pragma unroll
            for (int s2 = 0; s2 < 2; ++s2) {
                const bf16x8 bfr = lds16(sB + (sp * 32 + s2 * 16 + l16) * SST + ks * 32 + quad * 8);
#pragma unroll
                for (int i = 0; i < 2; ++i) gt[s2][i] = mfma16(bfr, cf[i][ks], gt[s2][i]);
            }
        bf16x8 mf[2];
#pragma unroll
        for (int i = 0; i < 2; ++i) {
            const int l = wave * 32 + i * 16 + l16;
#pragma unroll
            for (int s2 = 0; s2 < 2; ++s2)
#pragma unroll
                for (int r = 0; r < 4; ++r) {
                    const int s = sp * 32 + s2 * 16 + quad * 4 + r;
                    const float arg = s < l ? (pfl[i] - sPf[s]) : (rbl[i] - sRb[s]);
                    float coef = __expf(fminf(arg, 0.f)) * (s < l ? sdtf[s] : sdtb[s]);
                    if (s == l) coef = sdtf[s] + sdtb[s];
                    gt[s2][i][r] *= coef;
                }
            mf[i] = pack8(gt[0][i], gt[1][i]);
        }
#pragma unroll
        for (int pt = 0; pt < 4; ++pt) {
            const bf16_t* xp = sX + (pt * 16 + l16) * SST + sp * 32 + quad * 4;
            const bf16x8 xf = lds8x2(xp, xp + 16);
#pragma unroll
            for (int i = 0; i < 2; ++i) y[pt][i] = mfma16(xf, mf[i], y[pt][i]);
        }
    }
#pragma unroll
    for (int i = 0; i < 2; ++i) {
        const int l = wave * 32 + i * 16 + l16;
#pragma unroll
        for (int pt = 0; pt < 4; ++pt) {
            f32x4 v = y[pt][i];
#pragma unroll
            for (int r = 0; r < 4; ++r) v[r] += dsk * bf2f(sX[(pt * 16 + quad * 4 + r) * SST + l]);
            st4bf(Y + (size_t)(row0 + l) * 2048 + h * 64 + pt * 16 + quad * 4, v[0], v[1], v[2], v[3]);
        }
    }
}

__device__ void ssd_diag_phase(CParams& p, int layer, bf16_t* smem) {
    const int j2 = layer >> 1;
    for (int t = blockIdx.x; t < (MT / 128) * 32; t += gridDim.x) {
        const int h = t & 31, chunk = t >> 5;
        ssd_diag_item(p, j2, chunk * 128, h, smem);
    }
}

struct SsdPre { u32x4 xq; u32x4 bt[2][4]; u32x4 cf[2][4]; u32x2 yold[2]; float dt0, dt1; };

__device__ __forceinline__ int ssd_row0(int b, int dir, int cc) {
    if (cc < 2) { const int ci = dir ? 1 - cc : cc; return ML + b * CTX + ci * 128; }
    const int k = cc - 2; const int ci = dir ? 63 - k : k; return b * SEQ + ci * 128;
}

__device__ __forceinline__ void ssd_scan_item(CParams& p, int j2, int b, int dir, int h, int pq, bf16_t* smem) {
    const int tid = tid_(), lane = tid & 63, wave = tid >> 6, l16 = lane & 15, quad = lane >> 4;
    const int g = h >> 3;
    bf16_t* sX = smem;
    bf16_t* sH = sX + 16 * SST;
    float* seacs = (float*)(sH + 16 * SST);
    float* sw = seacs + 128;
    float* sdec = sw + 128;
    const bf16_t* XT = (const bf16_t*)(p.ws + WS_XT) + (size_t)(h * 64 + pq * 16 + (tid >> 4)) * MT + (tid & 15) * 8;
    const bf16_t* Cn = (const bf16_t*)(p.ws + WS_CN) + g * 128 + (size_t)(wave * 32 + l16) * 512 + quad * 8;
    const bf16_t* BT = (const bf16_t*)(p.ws + WS_BT) + (size_t)(g * 128 + wave * 32 + l16) * MT + quad * 8;
    const float* DT = (const float*)(p.ws + WS_DT) + dir * 32 + h;
    bf16_t* Y = (bf16_t*)(p.ws + (dir ? WS_YB : WS_YF)) + (size_t)(wave * 32 + l16) * 2048 + h * 64 + pq * 16 + quad * 4;
    const float a = -expf(p.ssm_a_log[(j2 * 2 + dir) * 32 + h]);
    f32x4 st[2];
    st[0] = (f32x4){0.f, 0.f, 0.f, 0.f}; st[1] = (f32x4){0.f, 0.f, 0.f, 0.f};
    SsdPre S0, S1;
    auto load_small = [&](SsdPre& S, int r) __attribute__((always_inline)) {
        S.xq = *(const u32x4*)(XT + r);
        S.dt0 = DT[(size_t)(r + lane) * 64]; S.dt1 = DT[(size_t)(r + 64 + lane) * 64];
    };
    auto load_cf = [&](SsdPre& S, int r) __attribute__((always_inline)) {
#pragma unroll
        for (int i = 0; i < 2; ++i)
#pragma unroll
            for (int ks = 0; ks < 4; ++ks) S.cf[i][ks] = *(const u32x4*)(Cn + (size_t)(r + i * 16) * 512 + ks * 32);
    };
    auto load_yold = [&](SsdPre& S, int r) __attribute__((always_inline)) {
#pragma unroll
        for (int i = 0; i < 2; ++i) S.yold[i] = dir == 0 ? *(const u32x2*)(Y + (size_t)(r + i * 16) * 2048) : (u32x2){0u, 0u};
    };
    auto load_bt = [&](SsdPre& S, int r) __attribute__((always_inline)) {
#pragma unroll
        for (int nt = 0; nt < 2; ++nt)
#pragma unroll
            for (int ks = 0; ks < 4; ++ks) S.bt[nt][ks] = *(const u32x4*)(BT + (size_t)(nt * 16) * MT + r + ks * 32);
    };
    {
        const int r0 = ssd_row0(b, dir, 0), r1 = ssd_row0(b, dir, 1);
        load_small(S0, r0); load_cf(S0, r0); load_yold(S0, r0); load_bt(S0, r0);
        load_small(S1, r1); load_cf(S1, r1); load_yold(S1, r1); load_bt(S1, r1);
    }
    auto body = [&](SsdPre& S, int cc) __attribute__((always_inline)) {
        const int row0 = ssd_row0(b, dir, cc);
        const int row2 = ssd_row0(b, dir, cc + 2 < 66 ? cc + 2 : 65);
        lds_sync();
        *(u32x4*)(sX + (tid >> 4) * SST + (tid & 15) * 8) = S.xq;
#pragma unroll
        for (int nt = 0; nt < 2; ++nt) st4bf(sH + l16 * SST + wave * 32 + nt * 16 + quad * 4, st[nt][0], st[nt][1], st[nt][2], st[nt][3]);
        if (wave < 2) {
            const f32x2 sc2 = scan128(S.dt0 * a, S.dt1 * a, lane, dir);
            const float total = dir == 0 ? __shfl(sc2.y, 63) : __shfl(sc2.x, 0);
            if (wave == 0) { seacs[lane] = __expf(sc2.x); sw[lane] = S.dt0 * __expf(total - sc2.x); if (lane == 0) sdec[0] = __expf(total); }
            else { seacs[64 + lane] = __expf(sc2.y); sw[64 + lane] = S.dt1 * __expf(total - sc2.y); }
        }
        lds_sync();
        load_small(S, row2);
        f32x4 yo[2];
        yo[0] = (f32x4){0.f, 0.f, 0.f, 0.f}; yo[1] = (f32x4){0.f, 0.f, 0.f, 0.f};
#pragma unroll
        for (int ks = 0; ks < 4; ++ks) {
            const bf16x8 hf = lds16(sH + l16 * SST + ks * 32 + quad * 8);
#pragma unroll
            for (int i = 0; i < 2; ++i) yo[i] = mfma16(hf, __builtin_bit_cast(bf16x8, S.cf[i][ks]), yo[i]);
        }
        __builtin_amdgcn_sched_barrier(0);
        load_cf(S, row2);
#pragma unroll
        for (int i = 0; i < 2; ++i) {
            const float e = seacs[wave * 32 + i * 16 + l16];
            const float o0 = __uint_as_float(S.yold[i].x << 16), o1 = __uint_as_float(S.yold[i].x & 0xffff0000u);
            const float o2 = __uint_as_float(S.yold[i].y << 16), o3 = __uint_as_float(S.yold[i].y & 0xffff0000u);
            st4bf(Y + (size_t)(row0 + i * 16) * 2048, yo[i][0] * e + o0, yo[i][1] * e + o1, yo[i][2] * e + o2, yo[i][3] * e + o3);
        }
        __builtin_amdgcn_sched_barrier(0);
        load_yold(S, row2);
        {
            const float dec = sdec[0];
            st[0] *= dec; st[1] *= dec;
#pragma unroll
            for (int ks = 0; ks < 4; ++ks) {
                const f32x4 w0 = *(const f32x4*)(sw + ks * 32 + quad * 8), w1 = *(const f32x4*)(sw + ks * 32 + quad * 8 + 4);
                const u32x4 raw = *(const u32x4*)(sX + l16 * SST + ks * 32 + quad * 8);
                u32x4 xs;
                xs.x = pack2(__uint_as_float(raw.x << 16) * w0[0], __uint_as_float(raw.x & 0xffff0000u) * w0[1]);
                xs.y = pack2(__uint_as_float(raw.y << 16) * w0[2], __uint_as_float(raw.y & 0xffff0000u) * w0[3]);
                xs.z = pack2(__uint_as_float(raw.z << 16) * w1[0], __uint_as_float(raw.z & 0xffff0000u) * w1[1]);
                xs.w = pack2(__uint_as_float(raw.w << 16) * w1[2], __uint_as_float(raw.w & 0xffff0000u) * w1[3]);
                const bf16x8 xbf = __builtin_bit_cast(bf16x8, xs);
#pragma unroll
                for (int nt = 0; nt < 2; ++nt) st[nt] = mfma16(__builtin_bit_cast(bf16x8, S.bt[nt][ks]), xbf, st[nt]);
            }
        }
        __builtin_amdgcn_sched_barrier(0);
        load_bt(S, row2);
    };
#pragma unroll 1
    for (int cc = 0; cc < 66; cc += 2) {
        body(S0, cc);
        body(S1, cc + 1);
    }
}

__device__ void ssd_scan_phase(CParams& p, int layer, bf16_t* smem) {
    const int j2 = layer >> 1;
    for (int t = blockIdx.x; t < NB * 2 * 32 * 4; t += gridDim.x) {
        const int xcd = t & 7, li = t >> 3, gi = xcd * 2 + (li >> 5);
        const int pq = li & 3, h = (gi & 3) * 8 + ((li & 31) >> 2), dir = (gi >> 2) & 1, b = gi >> 3;
        ssd_scan_item(p, j2, b, dir, h, pq, smem);
    }
}

__device__ void finish_phase(CParams& p, int layer) {
    const int j2 = layer >> 1, lane = tid_() & 63, wave = tid_() >> 6;
    bf16_t* yf = (bf16_t*)(p.ws + WS_YF); const bf16_t* yb = (const bf16_t*)(p.ws + WS_YB); const bf16_t* z = (const bf16_t*)(p.ws + WS_Z);
    const float* gn = p.ssm_norm_g + (size_t)j2 * 2048;
    for (int row = blockIdx.x * 4 + wave; row < MT; row += gridDim.x * 4) {
#pragma unroll
        for (int g = 0; g < 4; ++g) {
            const size_t off = (size_t)row * 2048 + g * 512 + lane * 8;
            const u32x4 a = *(const u32x4*)(yf + off), bq = *(const u32x4*)(yb + off), zq = *(const u32x4*)(z + off);
            const unsigned aw[4] = {a.x, a.y, a.z, a.w}, bw[4] = {bq.x, bq.y, bq.z, bq.w}, zw[4] = {zq.x, zq.y, zq.z, zq.w};
            float v[8]; float ss = 0.f;
#pragma unroll
            for (int k = 0; k < 4; ++k) {
                v[2 * k] = (__uint_as_float(aw[k] << 16) + __uint_as_float(bw[k] << 16)) * __uint_as_float(zw[k] << 16);
                v[2 * k + 1] = (__uint_as_float(aw[k] & 0xffff0000u) + __uint_as_float(bw[k] & 0xffff0000u)) * __uint_as_float(zw[k] & 0xffff0000u);
                ss += v[2 * k] * v[2 * k] + v[2 * k + 1] * v[2 * k + 1];
            }
#pragma unroll
            for (int o = 1; o < 64; o <<= 1) ss += __shfl_xor(ss, o);
            const float rstd = rsqrtf(ss * (1.f / 512.f) + EPS);
            const f32x4 g0 = *(const f32x4*)(gn + g * 512 + lane * 8), g1 = *(const f32x4*)(gn + g * 512 + lane * 8 + 4);
            u32x4 o4;
            o4.x = pack2(v[0] * rstd * g0[0], v[1] * rstd * g0[1]); o4.y = pack2(v[2] * rstd * g0[2], v[3] * rstd * g0[3]);
            o4.z = pack2(v[4] * rstd * g1[0], v[5] * rstd * g1[1]); o4.w = pack2(v[6] * rstd * g1[2], v[7] * rstd * g1[3]);
            *(u32x4*)(yf + off) = o4;
        }
    }
}

__global__ void __launch_bounds__(256, 2) hybrid_fwd(Params p) {
    extern __shared__ __attribute__((aligned(16))) unsigned char lds[];
    cg::grid_group grid = cg::this_grid();
    bf16_t* smem = (bf16_t*)lds; float* smf = (float*)lds;
    volatile LAS unsigned* bst = (volatile LAS unsigned*)(lds + LDS_BYTES - 16);
    if (threadIdx.x == 0) { bst[0] = 0u; bst[1] = 0u; }
    __syncthreads();
    const XcdBarrier xb = xcd_barrier_post((unsigned*)(p.ws + WS_BAR), bst);
    enum { C_NORM1 = 0, C_MIXIN, C_ATTN, C_MIXOUT, C_NORM2, C_FFNIN, C_FFNOUT, C_SSMIN, C_CONV, C_SSD, C_FINISH, C_SSMOUT, C_PRO, C_SSDB };
    const unsigned long long evc = 0x6543210ull;
    const unsigned long long odc = 0x654BAD9870ull;
    for (int ph = 0; ph < 35; ++ph) {
        int code, layer;
        if (ph == 0) { code = C_PRO; layer = 0; }
        else {
            const int q = ph - 1, pair = q / 17, r = q - pair * 17;
            if (r < 7) { layer = 2 * pair; code = (int)((evc >> (4 * r)) & 15); }
            else { layer = 2 * pair + 1; code = (int)((odc >> (4 * (r - 7))) & 15); }
        }
        CParams* kp = (CParams*)__builtin_amdgcn_kernarg_segment_ptr();
        asm volatile("" : "+s"(kp));
        CParams& q = *kp;
#define PHASE(c) asm volatile("" : "+s"(code)); if (code == (c))
        PHASE(C_PRO) prologue(q, smf);
        PHASE(C_NORM1) { if (layer > 0) convert_layer_weights(q, layer, smf); norm_phase(q, layer, 0); }
        PHASE(C_NORM2) norm_phase(q, layer, 1);
        PHASE(C_MIXIN) gemm_phase<G_MIXIN>(q, layer, smem);
        PHASE(C_ATTN) attn_sg_phase(q, layer, smem);
        PHASE(C_MIXOUT) gemm_phase<G_MIXOUT>(q, layer, smem);
        PHASE(C_FFNIN) gemm_phase<G_FFNIN>(q, layer, smem);
        PHASE(C_FFNOUT) gemm_phase<G_FFNOUT>(q, layer, smem);
        PHASE(C_SSMIN) gemm_phase<G_SSMIN>(q, layer, smem);
        PHASE(C_CONV) conv_phase(q, layer, smf);
        PHASE(C_SSD) ssd_diag_phase(q, layer, smem);
        PHASE(C_SSDB) ssd_scan_phase(q, layer, smem);
        PHASE(C_FINISH) finish_phase(q, layer);
        PHASE(C_SSMOUT) gemm_phase<G_SSMOUT>(q, layer, smem);
#undef PHASE
        if (ph == 0) grid.sync(); else xcd_barrier(xb);
    }
}

extern "C" void kernel_launch(void* const* d_in, const int* in_sizes, int n_in, void* d_out, int out_size, void* d_ws, size_t ws_size, hipStream_t stream) {
    static int grid_blocks = 0;
    if (grid_blocks == 0) {
        if (ws_size < WS_TOTAL) { fprintf(stderr, "kernel_launch: workspace too small: %zu < %zu\n", ws_size, (size_t)WS_TOTAL); grid_blocks = -1; return; }
        int dev = 0, cus = 0, per_cu = 0;
        hipGetDevice(&dev);
        hipDeviceGetAttribute(&cus, hipDeviceAttributeMultiprocessorCount, dev);
        if (hipFuncSetAttribute((const void*)hybrid_fwd, hipFuncAttributeMaxDynamicSharedMemorySize, LDS_BYTES) != hipSuccess) { fprintf(stderr, "kernel_launch: hipFuncSetAttribute failed\n"); }
        if (hipOccupancyMaxActiveBlocksPerMultiprocessor(&per_cu, (const void*)hybrid_fwd, 256, LDS_BYTES) != hipSuccess || per_cu < 1) { fprintf(stderr, "kernel_launch: occupancy query failed (%d)\n", per_cu); per_cu = 1; }
        if (per_cu > 2) per_cu = 2;
        (void)hipGetLastError();
        grid_blocks = cus * per_cu;
    }
    if (grid_blocks < 0) return;
    if (hipMemsetAsync((char*)d_ws + WS_BAR, 0, XCD_BAR_WORDS * sizeof(unsigned), stream) != hipSuccess) { fprintf(stderr, "kernel_launch: hipMemsetAsync failed\n"); return; }
    Params p{};
    const float** f = (const float**)&p;
    for (int i = 0; i < 25; ++i) f[i] = (const float*)d_in[i];
    p.out = (float*)d_out; p.ws = (unsigned char*)d_ws;
    void* args[] = {&p};
    hipError_t e = hipLaunchCooperativeKernel((const void*)hybrid_fwd, dim3(grid_blocks), dim3(256), args, LDS_BYTES, stream);
    if (e != hipSuccess) fprintf(stderr, "cooperative launch failed: %s (grid %d)\n", hipGetErrorString(e), grid_blocks);
}
```

```cpp
#include <hip/hip_runtime.h>
#include <hip/hip_cooperative_groups.h>
#include <cstdio>
#include <cstdint>
namespace cg = cooperative_groups;

typedef unsigned short bf16_t;
typedef short bf16x8 __attribute__((ext_vector_type(8)));
typedef short bf16x4 __attribute__((ext_vector_type(4)));
typedef float f32x4 __attribute__((ext_vector_type(4)));
typedef unsigned u32x4 __attribute__((ext_vector_type(4)));
typedef unsigned u32x2 __attribute__((ext_vector_type(2)));

constexpr int D = 1024, NB = 2, SEQ = 8192, CTX = 256;
constexpr int ML = NB * SEQ;
constexpr int MC = NB * CTX;
constexpr int MT = ML + MC;
constexpr int TALL = CTX + SEQ;
constexpr int FFH = 2816;
constexpr int MIXIN = 1792;
constexpr int SSMIN = 5184, SSMIN_PAD = 5248;
constexpr int SSI = 2048;
constexpr float EPS = 1e-6f;

constexpr size_t MB = 1024 * 1024;
constexpr size_t WS_MOD = 0;
constexpr size_t WS_ROPE = 1 * MB;
constexpr size_t WS_XCTX = 3 * MB;
constexpr size_t WS_SGW = 5 * MB + 512 * 1024;
constexpr size_t WS_BAR = 7 * MB;
constexpr size_t WS_WT = 8 * MB;
constexpr size_t WT_FFNIN = 0;
constexpr size_t WT_FFNOUT = WT_FFNIN + (size_t)5632 * 1024 * 2;
constexpr size_t WT_MIXIN = WT_FFNOUT + (size_t)1024 * 2816 * 2;
constexpr size_t WT_MIXOUT = WT_MIXIN + (size_t)SSMIN_PAD * 1024 * 2;
constexpr size_t WT_END = WT_MIXOUT + (size_t)1024 * 2048 * 2;
constexpr size_t WS_R0 = WS_WT + ((WT_END + MB - 1) / MB) * MB;
constexpr size_t SZ_XBC = (size_t)MT * 3072 * 2;
constexpr size_t SZ_HN = (size_t)MT * 1024 * 2;
constexpr size_t WS_XBC = WS_R0;
constexpr size_t WS_HN = WS_XBC + SZ_XBC;
constexpr size_t WS_YF = WS_XBC;
constexpr size_t WS_YB = WS_YF + (size_t)MT * 2048 * 2;
constexpr size_t WS_R1 = WS_HN + SZ_HN;
constexpr size_t WS_Z = WS_R1;
constexpr size_t WS_XT = WS_Z + (size_t)MT * 2048 * 2;
constexpr size_t WS_BN = WS_XT + (size_t)MT * 2048 * 2;
constexpr size_t WS_CN = WS_BN + (size_t)MT * 512 * 2;
constexpr size_t WS_BT = WS_CN + (size_t)MT * 512 * 2;
constexpr size_t WS_DT = WS_BT + (size_t)MT * 512 * 2;
constexpr size_t WS_END_ODD = WS_DT + (size_t)MT * 64 * 4;
constexpr size_t WS_Q = WS_R1;
constexpr size_t WS_K = WS_Q + (size_t)MT * 512 * 2;
constexpr size_t WS_VT = WS_K + (size_t)MT * 128 * 2;
constexpr size_t WS_U = WS_VT + (size_t)MT * 128 * 2;
constexpr size_t WS_GVT = WS_U + (size_t)MT * 512 * 2;
constexpr size_t WS_AS = WS_GVT + (size_t)MT * 512 * 2;
constexpr size_t WS_HID = WS_R1;
constexpr size_t WS_TOTAL = WS_END_ODD;
static_assert(WS_TOTAL < (size_t)400 * MB, "workspace too large");
static_assert(WS_AS + (size_t)MT * 1024 * 2 <= WS_END_ODD, "even buffers fit");
static_assert(WS_HID + (size_t)MT * FFH * 2 <= WS_END_ODD, "hid fits");

constexpr int LDS_BYTES = 73728;
constexpr int GST = 72;
constexpr int SST = 136;

struct Params {
    const float* x; const float* c; const float* ctx; const float* c_ctx;
    const float* ada_w; const float* ada_b; const float* norm1_g; const float* norm2_g;
    const float* ffn_w_in; const float* ffn_w_out; const float* mix_w_in; const float* mix_w_out;
    const float* q_norm_g; const float* k_norm_g; const float* sgu_norm_g; const float* sgu_w; const float* sgu_b;
    const float* ssm_w_in; const float* ssm_conv_w; const float* ssm_conv_b; const float* ssm_dt_bias;
    const float* ssm_a_log; const float* ssm_d; const float* ssm_norm_g; const float* ssm_w_out;
    float* out; unsigned char* ws;
};

typedef const __attribute__((address_space(4))) Params CParams;

__device__ __forceinline__ int tid_() { int t = threadIdx.x; asm volatile("" : "+v"(t)); return t; }
__device__ __forceinline__ bf16_t f2bf(float f) {
    unsigned u = __float_as_uint(f);
    u += 0x7fffu + ((u >> 16) & 1u);
    return (bf16_t)(u >> 16);
}
__device__ __forceinline__ float bf2f(bf16_t h) { return __uint_as_float(((unsigned)h) << 16); }
__device__ __forceinline__ unsigned pack2(float a, float b) { unsigned r; asm volatile("v_cvt_pk_bf16_f32 %0, %1, %2" : "=v"(r) : "v"(a), "v"(b)); return r; }
__device__ __forceinline__ float siluf(float v) { return v / (1.f + __expf(-v)); }
__device__ __forceinline__ float geluf(float v) {
    const float u = 0.7978845608028654f * (v + 0.044715f * v * v * v);
    return v / (1.f + __expf(-2.f * u));
}
__device__ __forceinline__ float softplusf(float v) { return v > 20.f ? v : log1pf(expf(v)); }
__device__ __forceinline__ int seg_of(int row) { return row < SEQ ? 0 : (row < ML ? 1 : 2); }
__device__ __forceinline__ float* xrow(CParams& p, int row) {
    return row < ML ? p.out + (size_t)row * D : (float*)(p.ws + WS_XCTX) + (size_t)(row - ML) * D;
}
__device__ __forceinline__ void lds_sync() {
    __builtin_amdgcn_fence(__ATOMIC_RELEASE, "workgroup", "local");
    __builtin_amdgcn_s_barrier();
    __builtin_amdgcn_fence(__ATOMIC_ACQUIRE, "workgroup", "local");
}
typedef float f32x2 __attribute__((ext_vector_type(2)));
__device__ __forceinline__ f32x2 scan128(float s0, float s1, int lane, int dir) {
    if (dir == 0) {
#pragma unroll
        for (int o = 1; o < 64; o <<= 1) { const float t0 = __shfl_up(s0, o), t1 = __shfl_up(s1, o); s0 += lane >= o ? t0 : 0.f; s1 += lane >= o ? t1 : 0.f; }
        s1 += __shfl(s0, 63);
    } else {
#pragma unroll
        for (int o = 1; o < 64; o <<= 1) { const float t0 = __shfl_down(s0, o), t1 = __shfl_down(s1, o); s0 += lane + o < 64 ? t0 : 0.f; s1 += lane + o < 64 ? t1 : 0.f; }
        s0 += __shfl(s1, 0);
    }
    return (f32x2){s0, s1};
}
__device__ __forceinline__ f32x4 mfma16(bf16x8 a, bf16x8 b, f32x4 c) { return __builtin_amdgcn_mfma_f32_16x16x32_bf16(a, b, c, 0, 0, 0); }
__device__ __forceinline__ bf16x8 lds16(const bf16_t* p) { return *(const bf16x8*)p; }
__device__ __forceinline__ bf16x8 lds8x2(const bf16_t* p0, const bf16_t* p1) {
    const bf16x4 a = *(const bf16x4*)p0, b = *(const bf16x4*)p1;
    bf16x8 r; r[0] = a[0]; r[1] = a[1]; r[2] = a[2]; r[3] = a[3]; r[4] = b[0]; r[5] = b[1]; r[6] = b[2]; r[7] = b[3];
    return r;
}
__device__ __forceinline__ bf16x8 pack8(f32x4 a, f32x4 b) {
    u32x4 w; w.x = pack2(a[0], a[1]); w.y = pack2(a[2], a[3]); w.z = pack2(b[0], b[1]); w.w = pack2(b[2], b[3]);
    return __builtin_bit_cast(bf16x8, w);
}
__device__ __forceinline__ void st4bf(bf16_t* dst, float a, float b, float c, float d) {
    u32x2 w; w.x = pack2(a, b); w.y = pack2(c, d); *(u32x2*)dst = w;
}


#define XB_TMO      128
#define XB_XCNT(j)  (256  + 64 * (j))
#define XB_XSUB(j)  (1280 + 64 * (j))
#define XB_XGEN(j)  (2304 + 64 * (j))
#define XB_TOP      3328
#define XB_TOPGEN   3392
#define XCD_BAR_WORDS 3456
#define XB_SPIN_CAP (1u << 18)
#define LAS __attribute__((address_space(3)))
__device__ __forceinline__ unsigned xb_ld(unsigned* p)              { return __hip_atomic_load(p, __ATOMIC_RELAXED, __HIP_MEMORY_SCOPE_AGENT); }
__device__ __forceinline__ unsigned xb_add(unsigned* p, unsigned v) { return __hip_atomic_fetch_add(p, v, __ATOMIC_RELAXED, __HIP_MEMORY_SCOPE_AGENT); }
__device__ __forceinline__ unsigned xb_xcc_id() { return (unsigned)__builtin_amdgcn_s_getreg((3 << 11) | 20) & 0xFu; }
#define XB_SPIN(cond, bar) do { unsigned _sp = 0; while (cond) { __builtin_amdgcn_s_sleep(1); \
    if ((++_sp & 255u) == 0u) { if (xb_ld(&(bar)[XB_TMO])) break; if (_sp > XB_SPIN_CAP) { atomicAdd(&(bar)[XB_TMO], 1u); break; } } } } while (0)
struct XcdBarrier { unsigned* bar; unsigned x; volatile LAS unsigned* st; };
__device__ __forceinline__ XcdBarrier xcd_barrier_post(unsigned* bar, volatile LAS unsigned* st) {
    XcdBarrier b; b.bar = bar; b.x = xb_xcc_id(); b.st = st;
    if (threadIdx.x == 0) (void)xb_add(&bar[XB_XCNT(b.x)], 1u);
    return b;
}
__device__ __forceinline__ void xcd_barrier_complete(unsigned* bar, unsigned x, unsigned& nloc, unsigned& nx) {
    const unsigned G = gridDim.x * gridDim.y * gridDim.z;
    unsigned sum, cnt, mine, sp = 0u;
    for (;;) {
        sum = 0u; cnt = 0u; mine = 0u;
#pragma unroll
        for (unsigned j = 0; j < 16; ++j) { const unsigned c = xb_ld(&bar[XB_XCNT(j)]); sum += c; cnt += (c > 0u) ? 1u : 0u; mine = (j == x) ? c : mine; }
        if (sum == G) break;
        __builtin_amdgcn_s_sleep(1);
        if ((++sp & 255u) == 0u) { if (xb_ld(&bar[XB_TMO])) break; if (sp > XB_SPIN_CAP) { atomicAdd(&bar[XB_TMO], 1u); break; } }
    }
    nloc = mine > 0u ? mine : 1u; nx = cnt > 0u ? cnt : 1u;
}
__device__ __forceinline__ void xcd_barrier(const XcdBarrier& b) {
    asm volatile("s_waitcnt vmcnt(0)" ::: "memory");
    __syncthreads();
    if (threadIdx.x == 0) {
        unsigned* bar = b.bar;
        __builtin_amdgcn_s_waitcnt(0);
        unsigned nloc = b.st[0], nx = b.st[1];
        if (nloc == 0u) { xcd_barrier_complete(bar, b.x, nloc, nx); b.st[0] = nloc; b.st[1] = nx; }
        const unsigned old = xb_add(&bar[XB_XSUB(b.x)], 1u);
        const unsigned gen = old / nloc;
        if (old + 1u == (gen + 1u) * nloc) {
            __builtin_amdgcn_fence(__ATOMIC_RELEASE, "agent");
            asm volatile("s_waitcnt vmcnt(0)" ::: "memory");
            const unsigned og = xb_add(&bar[XB_TOP], 1u);
            const unsigned tg = og / nx;
            if (og + 1u == (tg + 1u) * nx) xb_add(&bar[XB_TOPGEN], 1u);
            else XB_SPIN(xb_ld(&bar[XB_TOPGEN]) == tg, bar);
            __builtin_amdgcn_fence(__ATOMIC_ACQUIRE, "agent");
            xb_add(&bar[XB_XGEN(b.x)], 1u);
            asm volatile("s_waitcnt vmcnt(0)" ::: "memory");
        } else {
            XB_SPIN(xb_ld(&bar[XB_XGEN(b.x)]) == gen, bar);
            __builtin_amdgcn_fence(__ATOMIC_ACQUIRE, "agent");
            asm volatile("s_waitcnt vmcnt(0)" ::: "memory");
        }
    }
    __syncthreads();
}

__device__ __forceinline__ size_t frag_off(int row, int col, int K) {
    return ((size_t)(row >> 4) * (K >> 5) + (col >> 5)) * 512 + ((row & 15) + 16 * ((col & 31) >> 3)) * 8 + (col & 7);
}

template <int MI, int lda, int ldw, int K, int FRAG = 0>
__device__ __forceinline__ void gemm_tile(const bf16_t* __restrict__ A, const bf16_t* __restrict__ W,
                                          f32x4 (&acc)[MI][8], bf16_t* sW) {
    const int tid = tid_(), lane = tid & 63, wave = tid >> 6, l16 = lane & 15, quad = lane >> 4;
    const int srow = tid >> 3, skc = (tid & 7) * 8;
    constexpr int ASI = FRAG ? (K / 32) * 512 : 16 * lda;
    constexpr int ASK = FRAG ? 512 : 32;
    const bf16_t* ap = FRAG ? A + (size_t)(wave * MI) * ASI + lane * 8 : A + (size_t)(wave * 16 * MI + l16) * lda + quad * 8;
    const bf16_t* wp = W + (size_t)srow * ldw + skc;
    const bf16_t* wr = sW + l16 * GST + quad * 8;
    u32x4 ra[MI][2], rw[4];
#pragma unroll
    for (int i = 0; i < 4; ++i) rw[i] = *(const u32x4*)(wp + (size_t)(i * 32) * ldw);
#pragma unroll
    for (int i = 0; i < MI; ++i)
#pragma unroll
        for (int ks = 0; ks < 2; ++ks) ra[i][ks] = *(const u32x4*)(ap + (size_t)i * ASI + ks * ASK);
#pragma unroll
    for (int i = 0; i < MI; ++i)
#pragma unroll
        for (int j = 0; j < 8; ++j) acc[i][j] = (f32x4){0.f, 0.f, 0.f, 0.f};
    constexpr int nk = K >> 6;
#pragma unroll 1
    for (int kt = 0; kt < nk; ++kt) {
        lds_sync();
#pragma unroll
        for (int i = 0; i < 4; ++i) *(u32x4*)(sW + (srow + i * 32) * GST + skc) = rw[i];
        lds_sync();
        const int k0 = (kt + 1 < nk ? kt + 1 : kt) << 6;
        const int ka = FRAG ? (k0 >> 5) * 512 : k0;
#pragma unroll
        for (int i = 0; i < 4; ++i) rw[i] = *(const u32x4*)(wp + (size_t)(i * 32) * ldw + k0);
        bf16x8 wa[4], wb[4];
#pragma unroll
        for (int j = 0; j < 4; ++j) wa[j] = lds16(wr + (j * 16) * GST);
#pragma unroll
        for (int j = 0; j < 4; ++j) wb[j] = lds16(wr + ((j + 4) * 16) * GST);
        __builtin_amdgcn_sched_barrier(0);
#pragma unroll
        for (int j = 0; j < 4; ++j)
#pragma unroll
            for (int i = 0; i < MI; ++i) acc[i][j] = mfma16(wa[j], __builtin_bit_cast(bf16x8, ra[i][0]), acc[i][j]);
        __builtin_amdgcn_sched_barrier(0);
#pragma unroll
        for (int j = 0; j < 4; ++j) wa[j] = lds16(wr + (j * 16) * GST + 32);
        __builtin_amdgcn_sched_barrier(0);
#pragma unroll
        for (int j = 0; j < 4; ++j)
#pragma unroll
            for (int i = 0; i < MI; ++i) acc[i][j + 4] = mfma16(wb[j], __builtin_bit_cast(bf16x8, ra[i][0]), acc[i][j + 4]);
        __builtin_amdgcn_sched_barrier(0);
#pragma unroll
        for (int i = 0; i < MI; ++i) ra[i][0] = *(const u32x4*)(ap + (size_t)i * ASI + ka);
#pragma unroll
        for (int j = 0; j < 4; ++j) wb[j] = lds16(wr + ((j + 4) * 16) * GST + 32);
        __builtin_amdgcn_sched_barrier(0);
#pragma unroll
        for (int j = 0; j < 4; ++j)
#pragma unroll
            for (int i = 0; i < MI; ++i) acc[i][j] = mfma16(wa[j], __builtin_bit_cast(bf16x8, ra[i][1]), acc[i][j]);
        __builtin_amdgcn_sched_barrier(0);
#pragma unroll
        for (int j = 0; j < 4; ++j)
#pragma unroll
            for (int i = 0; i < MI; ++i) acc[i][j + 4] = mfma16(wb[j], __builtin_bit_cast(bf16x8, ra[i][1]), acc[i][j + 4]);
        __builtin_amdgcn_sched_barrier(0);
#pragma unroll
        for (int i = 0; i < MI; ++i) ra[i][1] = *(const u32x4*)(ap + (size_t)i * ASI + ka + ASK);
    }
}

template <int MI>
__device__ __forceinline__ void epi_resid(CParams& p, int m0, int n0, const f32x4 (&acc)[MI][8], const float* gate  ) {
    const int lane = tid_() & 63, wave = tid_() >> 6, l16 = lane & 15, quad = lane >> 4;
#pragma unroll
    for (int i = 0; i < MI; ++i) {
        const int row = m0 + wave * 16 * MI + i * 16 + l16;
        float* xr = xrow(p, row);
        const float* g = gate + (size_t)seg_of(row) * 6144;
#pragma unroll
        for (int j = 0; j < 8; ++j) {
            const int col = n0 + j * 16 + quad * 4;
            const f32x4 gv = *(const f32x4*)(g + col);
            f32x4 xv = *(f32x4*)(xr + col);
            xv += gv * acc[i][j];
            *(f32x4*)(xr + col) = xv;
        }
    }
}

template <int MI>
__device__ __forceinline__ void epi_swiglu(CParams& p, int m0, int n0, const f32x4 (&acc)[MI][8]) {
    const int lane = tid_() & 63, wave = tid_() >> 6, l16 = lane & 15, quad = lane >> 4;
    bf16_t* hid = (bf16_t*)(p.ws + WS_HID);
#pragma unroll
    for (int i = 0; i < MI; ++i) {
        const int row = m0 + wave * 16 * MI + i * 16 + l16;
#pragma unroll
        for (int jj = 0; jj < 4; ++jj) {
            const f32x4 g = acc[i][2 * jj], u = acc[i][2 * jj + 1];
            const int hc = (n0 >> 1) + jj * 16 + quad * 4;
            const size_t off = ((size_t)(row >> 4) * (FFH / 32) + (hc >> 5)) * 512 + ((row & 15) + 16 * ((hc & 31) >> 3)) * 8 + (hc & 7);
            st4bf(hid + off, siluf(g[0]) * u[0], siluf(g[1]) * u[1], siluf(g[2]) * u[2], siluf(g[3]) * u[3]);
        }
    }
}

template <int MI>
__device__ __forceinline__ void epi_mixin(CParams& p, int j2, int m0, int tn, f32x4 (&acc)[MI][8]) {
    const int lane = tid_() & 63, wave = tid_() >> 6, l16 = lane & 15, quad = lane >> 4;
    if (tn < 5) {
        const float* gsrc = (tn < 4 ? p.q_norm_g : p.k_norm_g) + j2 * 64;
        const float* cosT = (const float*)(p.ws + WS_ROPE);
        const float* sinT = cosT + 8192 * 32;
#pragma unroll
        for (int i = 0; i < MI; ++i) {
            const int row = m0 + wave * 16 * MI + i * 16 + l16;
#pragma unroll
            for (int hh = 0; hh < 2; ++hh) {
                float ss = 0.f;
#pragma unroll
                for (int j = 0; j < 4; ++j) { const f32x4 v = acc[i][hh * 4 + j]; ss += v[0] * v[0] + v[1] * v[1] + v[2] * v[2] + v[3] * v[3]; }
                ss += __shfl_xor(ss, 16); ss += __shfl_xor(ss, 32);
                const float rstd = rsqrtf(ss * (1.f / 64.f) + EPS);
                f32x4 y[4];
#pragma unroll
                for (int j = 0; j < 4; ++j) {
                    const f32x4 gv = *(const f32x4*)(gsrc + j * 16 + quad * 4);
                    y[j] = acc[i][hh * 4 + j] * rstd * gv;
                }
                if (row < ML) {
                    const int s = row & (SEQ - 1);
#pragma unroll
                    for (int j = 0; j < 2; ++j) {
                        const f32x4 cs = *(const f32x4*)(cosT + (size_t)s * 32 + j * 16 + quad * 4);
                        const f32x4 sn = *(const f32x4*)(sinT + (size_t)s * 32 + j * 16 + quad * 4);
                        const f32x4 x1 = y[j], x2 = y[j + 2];
                        y[j] = x1 * cs - x2 * sn;
                        y[j + 2] = x2 * cs + x1 * sn;
                    }
                }
                if (tn < 4) {
                    bf16_t* q = (bf16_t*)(p.ws + WS_Q) + (size_t)row * 512 + (tn * 2 + hh) * 64;
#pragma unroll
                    for (int j = 0; j < 4; ++j) st4bf(q + j * 16 + quad * 4, y[j][0] * 0.125f, y[j][1] * 0.125f, y[j][2] * 0.125f, y[j][3] * 0.125f);
                } else {
                    const int b = row < ML ? (row >> 13) : ((row - ML) >> 8);
                    const int t = row < ML ? CTX + (row & (SEQ - 1)) : ((row - ML) & (CTX - 1));
                    bf16_t* k = (bf16_t*)(p.ws + WS_K) + ((size_t)b * TALL + t) * 128 + hh * 64;
#pragma unroll
                    for (int j = 0; j < 4; ++j) st4bf(k + j * 16 + quad * 4, y[j][0], y[j][1], y[j][2], y[j][3]);
                }
            }
        }
    } else if (tn == 5) {
        bf16_t* vt = (bf16_t*)(p.ws + WS_VT);
#pragma unroll
        for (int i = 0; i < MI; ++i) {
            const int row = m0 + wave * 16 * MI + i * 16 + l16;
            const int b = row < ML ? (row >> 13) : ((row - ML) >> 8);
            const int t = row < ML ? CTX + (row & (SEQ - 1)) : ((row - ML) & (CTX - 1));
#pragma unroll
            for (int j = 0; j < 8; ++j) {
                const int kh = j >> 2;
#pragma unroll
                for (int r = 0; r < 4; ++r) {
                    const int d = (j & 3) * 16 + quad * 4 + r;
                    vt[((size_t)(b * 2 + kh) * 64 + d) * TALL + t] = f2bf(acc[i][j][r]);
                }
            }
        }
    } else if (tn < 10) {
        bf16_t* u = (bf16_t*)(p.ws + WS_U);
#pragma unroll
        for (int i = 0; i < MI; ++i) {
            const int row = m0 + wave * 16 * MI + i * 16 + l16;
#pragma unroll
            for (int j = 0; j < 8; ++j) {
                const f32x4 v = acc[i][j];
                st4bf(u + (size_t)row * 512 + (tn - 6) * 128 + j * 16 + quad * 4, geluf(v[0]), geluf(v[1]), geluf(v[2]), geluf(v[3]));
            }
        }
    } else {
        const int g = tn - 10;
        const float* gn = p.sgu_norm_g + j2 * 512 + g * 128;
        bf16_t* gvt = (bf16_t*)(p.ws + WS_GVT);
#pragma unroll
        for (int i = 0; i < MI; ++i) {
            const int row = m0 + wave * 16 * MI + i * 16 + l16;
            float ss = 0.f;
#pragma unroll
            for (int j = 0; j < 8; ++j) {
                f32x4 v = acc[i][j];
                v[0] = geluf(v[0]); v[1] = geluf(v[1]); v[2] = geluf(v[2]); v[3] = geluf(v[3]);
                acc[i][j] = v;
                ss += v[0] * v[0] + v[1] * v[1] + v[2] * v[2] + v[3] * v[3];
            }
            ss += __shfl_xor(ss, 16); ss += __shfl_xor(ss, 32);
            const float rstd = rsqrtf(ss * (1.f / 128.f) + EPS);
            const int chunk = row >> 7, pt = row & 127;
#pragma unroll
            for (int j = 0; j < 8; ++j) {
                const f32x4 gv = *(const f32x4*)(gn + j * 16 + quad * 4);
#pragma unroll
                for (int r = 0; r < 4; ++r) {
                    const int cc = g * 128 + j * 16 + quad * 4 + r;
                    gvt[((size_t)chunk * 512 + cc) * 128 + pt] = f2bf(acc[i][j][r] * rstd * gv[r]);
                }
            }
        }
    }
}

template <int MI>
__device__ __forceinline__ void epi_ssmin(CParams& p, int j2, int m0, int tn, const f32x4 (&acc)[MI][8]) {
    const int lane = tid_() & 63, wave = tid_() >> 6, l16 = lane & 15, quad = lane >> 4;
#pragma unroll
    for (int i = 0; i < MI; ++i) {
        const int row = m0 + wave * 16 * MI + i * 16 + l16;
        if (tn < 16) {
            bf16_t* z = (bf16_t*)(p.ws + WS_Z) + (size_t)row * 2048 + tn * 128;
#pragma unroll
            for (int j = 0; j < 8; ++j) { const f32x4 v = acc[i][j]; st4bf(z + j * 16 + quad * 4, siluf(v[0]), siluf(v[1]), siluf(v[2]), siluf(v[3])); }
        } else if (tn < 40) {
            bf16_t* xb = (bf16_t*)(p.ws + WS_XBC) + (size_t)row * 3072 + (tn - 16) * 128;
#pragma unroll
            for (int j = 0; j < 8; ++j) { const f32x4 v = acc[i][j]; st4bf(xb + j * 16 + quad * 4, v[0], v[1], v[2], v[3]); }
        } else {
            float* dt = (float*)(p.ws + WS_DT) + (size_t)row * 64;
            const float* bias = p.ssm_dt_bias + j2 * 64;
#pragma unroll
            for (int j = 0; j < 4; ++j) {
                const int c = j * 16 + quad * 4;
                const f32x4 v = acc[i][j];
                f32x4 o;
                o[0] = softplusf(v[0] + bias[c + 0]); o[1] = softplusf(v[1] + bias[c + 1]);
                o[2] = softplusf(v[2] + bias[c + 2]); o[3] = softplusf(v[3] + bias[c + 3]);
                *(f32x4*)(dt + c) = o;
            }
        }
    }
}

enum { G_MIXIN = 0, G_MIXOUT, G_SSMIN, G_SSMOUT, G_FFNIN, G_FFNOUT };

template <int KIND>
__device__ void gemm_phase(CParams& p, int layer, bf16_t* smem) {
    const int j2 = layer >> 1;
    constexpr int lda = (KIND == G_SSMOUT) ? 2048 : (KIND == G_FFNOUT) ? FFH : 1024;
    constexpr int K = lda, ldw = K;
    constexpr int N = (KIND == G_MIXIN) ? MIXIN : (KIND == G_SSMIN) ? SSMIN_PAD : (KIND == G_FFNIN) ? 2 * FFH : 1024;
    constexpr size_t aoff = (KIND == G_MIXOUT) ? WS_AS : (KIND == G_SSMOUT) ? WS_YF : (KIND == G_FFNOUT) ? WS_HID : WS_HN;
    constexpr size_t woff = (KIND == G_MIXIN || KIND == G_SSMIN) ? WT_MIXIN : (KIND == G_MIXOUT || KIND == G_SSMOUT) ? WT_MIXOUT : (KIND == G_FFNIN) ? WT_FFNIN : WT_FFNOUT;
    const bf16_t* A = (const bf16_t*)(p.ws + aoff);
    const bf16_t* W = (const bf16_t*)(p.ws + WS_WT + woff);
    constexpr int MI = (KIND == G_MIXIN) ? 2 : 4;
    constexpr int FRAG = (KIND == G_SSMOUT) ? 0 : 1;
    constexpr int nN = N >> 7, nM = MT / (64 * MI);
    const float* mod = (const float*)(p.ws + WS_MOD) + (size_t)layer * 3 * 6144;
    bf16_t* sW = smem;
    if (N == 1024) {
        const int nlat = (ML / 256) * 8, nctx = layer == 3 ? 0 : (MC / 64) * 8;
        const float* gate = mod + (KIND == G_FFNOUT ? 5 : 2) * 1024;
        for (int t = blockIdx.x; t < nlat + nctx; t += gridDim.x) {
            if (t < nlat) {
                const int u = (gridDim.x == 512) ? ((t & 7) * 64 + (t >> 3)) : t;
                const int tm = u >> 3, tn = u & 7;
                f32x4 acc[4][8];
                gemm_tile<4, lda, ldw, K, FRAG>(A + (size_t)tm * 256 * lda, W + (size_t)tn * 128 * ldw, acc, sW);
                epi_resid<4>(p, tm * 256, tn * 128, acc, gate);
            } else {
                const int u = t - nlat, tm = u >> 3, tn = u & 7;
                f32x4 acc[1][8];
                gemm_tile<1, lda, ldw, K, FRAG>(A + (size_t)(ML + tm * 64) * lda, W + (size_t)tn * 128 * ldw, acc, sW);
                epi_resid<1>(p, ML + tm * 64, tn * 128, acc, gate);
            }
        }
        return;
    }
    constexpr int T = nM * nN, share = (T + 7) / 8, nsc = (nN + 7) / 8;
    const int xcd = blockIdx.x & 7, slot = blockIdx.x >> 3, nslot = gridDim.x >> 3;
    for (int li = slot; li < share; li += nslot) {
        const int u = xcd * share + li;
        if (u >= T) break;
        int sc = u / (nM * 8); if (sc > nsc - 1) sc = nsc - 1;
        const int rem = u - sc * nM * 8, wd = (sc == nsc - 1) ? (nN - 8 * sc) : 8;
        const int tm = rem / wd, tn = sc * 8 + rem - tm * wd;
        f32x4 acc[MI][8];
        gemm_tile<MI, lda, ldw, K, FRAG>(A + (size_t)tm * (64 * MI) * lda, W + (size_t)tn * 128 * ldw, acc, sW);
        if (KIND == G_MIXIN) epi_mixin<MI>(p, j2, tm * (64 * MI), tn, acc);
        else if (KIND == G_SSMIN) epi_ssmin<MI>(p, j2, tm * (64 * MI), tn, acc);
        else if (KIND == G_FFNIN) epi_swiglu<MI>(p, tm * (64 * MI), tn * 128, acc);
    }
}

__device__ void norm_phase(CParams& p, int layer, int which) {
    const int lane = tid_() & 63, wave = tid_() >> 6, l16 = lane & 15, quad = lane >> 4;
    const float* g = (which ? p.norm2_g : p.norm1_g) + layer * 1024;
    const float* mod = (const float*)(p.ws + WS_MOD) + (size_t)layer * 3 * 6144;
    bf16_t* hn = (bf16_t*)(p.ws + WS_HN);
    for (int tr = blockIdx.x * 4 + wave; tr < MT / 16; tr += gridDim.x * 4) {
        const int row0 = tr * 16;
        float myr = 0.f;
#pragma unroll 4
        for (int r = 0; r < 16; ++r) {
            const float* xr = xrow(p, row0 + r);
            float ss = 0.f;
#pragma unroll
            for (int i = 0; i < 4; ++i) { const f32x4 v = *(const f32x4*)(xr + i * 256 + lane * 4); ss += v[0] * v[0] + v[1] * v[1] + v[2] * v[2] + v[3] * v[3]; }
#pragma unroll
            for (int o = 1; o < 64; o <<= 1) ss += __shfl_xor(ss, o);
            const float rs = rsqrtf(ss * (1.f / 1024.f) + EPS);
            myr = (l16 == r) ? rs : myr;
        }
        const float* m = mod + (size_t)seg_of(row0) * 6144 + (which ? 3 * 1024 : 0);
        const float* xr = xrow(p, row0 + l16) + quad * 8;
        bf16_t* dst = hn + (size_t)tr * 32 * 512 + lane * 8;
#pragma unroll 4
        for (int kb = 0; kb < 32; ++kb) {
            const int col = kb * 32 + quad * 8;
            const f32x4 v0 = *(const f32x4*)(xr + kb * 32), v1 = *(const f32x4*)(xr + kb * 32 + 4);
            const f32x4 g0 = *(const f32x4*)(g + col), g1 = *(const f32x4*)(g + col + 4);
            const f32x4 sh0 = *(const f32x4*)(m + col), sh1 = *(const f32x4*)(m + col + 4);
            const f32x4 sc0 = *(const f32x4*)(m + 1024 + col), sc1 = *(const f32x4*)(m + 1024 + col + 4);
            const f32x4 y0 = (v0 * myr * g0) * (sc0 + 1.f) + sh0, y1 = (v1 * myr * g1) * (sc1 + 1.f) + sh1;
            u32x4 o; o.x = pack2(y0[0], y0[1]); o.y = pack2(y0[2], y0[3]); o.z = pack2(y1[0], y1[1]); o.w = pack2(y1[2], y1[3]);
            *(u32x4*)(dst + (size_t)kb * 512) = o;
        }
    }
}

__device__ void convert_wt(const float* __restrict__ W, int K, int N, bf16_t* __restrict__ Wt, int mode, float* tile) {
    const int tid = tid_();
    const int nKt = K >> 6, nNt = N >> 6;
    for (int t = blockIdx.x; t < nKt * nNt; t += gridDim.x) {
        const int kt = t / nNt, nt = t - kt * nNt;
        lds_sync();
#pragma unroll
        for (int i = 0; i < 16; ++i) {
            const int kk = (tid >> 6) + i * 4, nn = tid & 63;
            tile[kk * 65 + nn] = W[(size_t)(kt * 64 + kk) * N + nt * 64 + nn];
        }
        lds_sync();
        {
            const int nn = tid >> 2, kq = (tid & 3) * 16;
            const int n = nt * 64 + nn;
            int dr = n;
            if (mode == 1) { const int hm = n < FFH ? n : n - FFH; dr = (hm >> 4) * 32 + (hm & 15) + (n < FFH ? 0 : 16); }
            u32x4 o0, o1;
            o0.x = pack2(tile[(kq + 0) * 65 + nn], tile[(kq + 1) * 65 + nn]); o0.y = pack2(tile[(kq + 2) * 65 + nn], tile[(kq + 3) * 65 + nn]);
            o0.z = pack2(tile[(kq + 4) * 65 + nn], tile[(kq + 5) * 65 + nn]); o0.w = pack2(tile[(kq + 6) * 65 + nn], tile[(kq + 7) * 65 + nn]);
            o1.x = pack2(tile[(kq + 8) * 65 + nn], tile[(kq + 9) * 65 + nn]); o1.y = pack2(tile[(kq + 10) * 65 + nn], tile[(kq + 11) * 65 + nn]);
            o1.z = pack2(tile[(kq + 12) * 65 + nn], tile[(kq + 13) * 65 + nn]); o1.w = pack2(tile[(kq + 14) * 65 + nn], tile[(kq + 15) * 65 + nn]);
            bf16_t* dst = Wt + (size_t)dr * K + kt * 64 + kq;
            *(u32x4*)dst = o0; *(u32x4*)(dst + 8) = o1;
        }
    }
}

__device__ void convert_layer_weights(CParams& p, int layer, float* tile) {
    unsigned char* wt = p.ws + WS_WT;
    const int j2 = layer >> 1;
    convert_wt(p.ffn_w_in + (size_t)layer * 1024 * 2 * FFH, 1024, 2 * FFH, (bf16_t*)(wt + WT_FFNIN), 1, tile);
    convert_wt(p.ffn_w_out + (size_t)layer * FFH * 1024, FFH, 1024, (bf16_t*)(wt + WT_FFNOUT), 0, tile);
    if ((layer & 1) == 0) {
        convert_wt(p.mix_w_in + (size_t)j2 * 1024 * MIXIN, 1024, MIXIN, (bf16_t*)(wt + WT_MIXIN), 0, tile);
        convert_wt(p.mix_w_out + (size_t)j2 * 1024 * 1024, 1024, 1024, (bf16_t*)(wt + WT_MIXOUT), 0, tile);
    } else {
        convert_wt(p.ssm_w_in + (size_t)j2 * 1024 * SSMIN, 1024, SSMIN, (bf16_t*)(wt + WT_MIXIN), 0, tile);
        convert_wt(p.ssm_w_out + (size_t)j2 * SSI * 1024, SSI, 1024, (bf16_t*)(wt + WT_MIXOUT), 0, tile);
        bf16_t* padp = (bf16_t*)(wt + WT_MIXIN) + (size_t)SSMIN * 1024;
        for (int i = blockIdx.x * 256 + tid_(); i < (SSMIN_PAD - SSMIN) * 1024; i += gridDim.x * 256) padp[i] = 0;
    }
}

__device__ void prologue(CParams& p, float* smf) {
    const int tid = tid_();
    const size_t gtid = (size_t)blockIdx.x * 256 + tid, gsz = (size_t)gridDim.x * 256;
    {
        const f32x4* s = (const f32x4*)p.x; f32x4* d = (f32x4*)p.out;
        for (size_t i = gtid; i < (size_t)ML * D / 4; i += gsz) d[i] = s[i];
        const f32x4* s2 = (const f32x4*)p.ctx; f32x4* d2 = (f32x4*)(p.ws + WS_XCTX);
        for (size_t i = gtid; i < (size_t)MC * D / 4; i += gsz) d2[i] = s2[i];
    }
    {
        float* cosT = (float*)(p.ws + WS_ROPE); float* sinT = cosT + 8192 * 32;
        for (size_t i = gtid; i < (size_t)8192 * 32; i += gsz) {
            const int s = (int)(i >> 5), j = (int)(i & 31), f = j & 15;
            const float inv = powf(10000.f, -(float)f / 16.f);
            const float pos = (float)(j < 16 ? (s >> 6) : (s & 63));
            const float ang = pos * inv;
            cosT[i] = cosf(ang); sinT[i] = sinf(ang);
        }
    }
    {
        bf16_t* sgw = (bf16_t*)(p.ws + WS_SGW);
        for (size_t i = gtid; i < (size_t)2 * 4 * 128 * 128; i += gsz) sgw[i] = f2bf(p.sgu_w[i]);
    }
    {
        float* sc = smf;
        float* red = smf + 3 * 1024;
        lds_sync();
        for (int i = tid; i < 3 * 1024; i += 256) {
            const int sgi = i >> 10, k = i & 1023;
            const float v = sgi < 2 ? p.c[sgi * 1024 + k] : p.c_ctx[k];
            sc[i] = siluf(v);
        }
        lds_sync();
        float* mod = (float*)(p.ws + WS_MOD);
        const int cl = tid & 63, kg = tid >> 6;
        for (int wi = blockIdx.x; wi < 4 * 96; wi += gridDim.x) {
            const int layer = wi / 96, cb = wi - layer * 96;
            const float* w = p.ada_w + (size_t)layer * 1024 * 6144 + cb * 64 + cl;
            float s0 = 0.f, s1 = 0.f, s2 = 0.f;
            for (int k = kg * 256; k < kg * 256 + 256; ++k) {
                const float wv = w[(size_t)k * 6144];
                s0 += sc[k] * wv; s1 += sc[1024 + k] * wv; s2 += sc[2048 + k] * wv;
            }
            lds_sync();
            red[(kg * 3 + 0) * 64 + cl] = s0; red[(kg * 3 + 1) * 64 + cl] = s1; red[(kg * 3 + 2) * 64 + cl] = s2;
            lds_sync();
            if (tid < 192) {
                const int sgi = tid >> 6;
                const float v = red[(0 * 3 + sgi) * 64 + cl] + red[(1 * 3 + sgi) * 64 + cl] + red[(2 * 3 + sgi) * 64 + cl] + red[(3 * 3 + sgi) * 64 + cl];
                const int n = cb * 64 + cl;
                mod[((size_t)layer * 3 + sgi) * 6144 + n] = v + p.ada_b[layer * 6144 + n];
            }
        }
        lds_sync();
    }
    convert_layer_weights(p, 0, smf);
}

__device__ __forceinline__ void attn_item(CParams& p, int j2, int b, int h, int q0row, int nkeys, bf16_t* smem) {
    const int tid = tid_(), lane = tid & 63, wave = tid >> 6, l16 = lane & 15, quad = lane >> 4;
    const int kh = h >> 2;
    const bf16_t* Q = (const bf16_t*)(p.ws + WS_Q);
    const bf16_t* Kb = (const bf16_t*)(p.ws + WS_K) + (size_t)b * TALL * 128 + kh * 64;
    const bf16_t* Vb = (const bf16_t*)(p.ws + WS_VT) + (size_t)(b * 2 + kh) * 64 * TALL;
    bf16_t* sK = smem; bf16_t* sV = smem + 64 * GST;
    constexpr float LOG2E = 1.4426950408889634f;
    float mb;
    {
        float gq = fabsf(p.q_norm_g[j2 * 64 + lane]), gk = fabsf(p.k_norm_g[j2 * 64 + lane]);
#pragma unroll
        for (int o = 1; o < 64; o <<= 1) { gq = fmaxf(gq, __shfl_xor(gq, o)); gk = fmaxf(gk, __shfl_xor(gk, o)); }
        mb = 8.f * 1.02f * gq * gk * LOG2E;
    }
    bf16x8 qf[4][2];
#pragma unroll
    for (int i = 0; i < 4; ++i)
#pragma unroll
        for (int ks = 0; ks < 2; ++ks)
            qf[i][ks] = *(const bf16x8*)(Q + (size_t)(q0row + wave * 64 + i * 16 + l16) * 512 + h * 64 + ks * 32 + quad * 8);
    f32x4 o[4][4];
#pragma unroll
    for (int d = 0; d < 4; ++d)
#pragma unroll
        for (int i = 0; i < 4; ++i) o[d][i] = (f32x4){0.f, 0.f, 0.f, 0.f};
    float lrun[4] = {0.f, 0.f, 0.f, 0.f};
    const int srow = tid >> 3, skc = (tid & 7) * 8;
    u32x4 rk[2], rv[2];
#pragma unroll
    for (int i = 0; i < 2; ++i) {
        rk[i] = *(const u32x4*)(Kb + (size_t)(srow + i * 32) * 128 + skc);
        rv[i] = *(const u32x4*)(Vb + (size_t)(srow + i * 32) * TALL + skc);
    }
    const int nt = nkeys >> 6;
#pragma unroll 1
    for (int kt = 0; kt < nt; ++kt) {
        lds_sync();
#pragma unroll
        for (int i = 0; i < 2; ++i) {
            *(u32x4*)(sK + (srow + i * 32) * GST + skc) = rk[i];
            *(u32x4*)(sV + (srow + i * 32) * GST + skc) = rv[i];
        }
        lds_sync();
        {
            const int t0 = (kt + 1 < nt ? kt + 1 : kt) << 6;
#pragma unroll
            for (int i = 0; i < 2; ++i) {
                rk[i] = *(const u32x4*)(Kb + (size_t)(t0 + srow + i * 32) * 128 + skc);
                rv[i] = *(const u32x4*)(Vb + (size_t)(srow + i * 32) * TALL + t0 + skc);
            }
        }
        bf16x8 pf[2][4];
#pragma unroll
        for (int ih = 0; ih < 2; ++ih) {
            f32x4 s[4][2];
#pragma unroll
            for (int tt = 0; tt < 4; ++tt)
#pragma unroll
                for (int i = 0; i < 2; ++i) s[tt][i] = (f32x4){0.f, 0.f, 0.f, 0.f};
#pragma unroll
            for (int ks = 0; ks < 2; ++ks)
#pragma unroll
                for (int tt = 0; tt < 4; ++tt) {
                    const bf16x8 kf = lds16(sK + (tt * 16 + l16) * GST + ks * 32 + quad * 8);
#pragma unroll
                    for (int i = 0; i < 2; ++i) s[tt][i] = mfma16(kf, qf[ih * 2 + i][ks], s[tt][i]);
                }
#pragma unroll
            for (int i = 0; i < 2; ++i) {
                float ls = 0.f;
#pragma unroll
                for (int tt = 0; tt < 4; ++tt) {
#pragma unroll
                    for (int r = 0; r < 4; ++r) { const float e = __builtin_amdgcn_exp2f(s[tt][i][r] * LOG2E - mb); s[tt][i][r] = e; ls += e; }
                }
                lrun[ih * 2 + i] += ls;
#pragma unroll
                for (int ksp = 0; ksp < 2; ++ksp) pf[ksp][ih * 2 + i] = pack8(s[2 * ksp][i], s[2 * ksp + 1][i]);
            }
        }
#pragma unroll
        for (int ksp = 0; ksp < 2; ++ksp)
#pragma unroll
            for (int d = 0; d < 4; ++d) {
                const bf16_t* vp = sV + (d * 16 + l16) * GST + ksp * 32 + quad * 4;
                const bf16x8 vf = lds8x2(vp, vp + 16);
#pragma unroll
                for (int i = 0; i < 4; ++i) o[d][i] = mfma16(vf, pf[ksp][i], o[d][i]);
            }
    }
    bf16_t* as = (bf16_t*)(p.ws + WS_AS);
#pragma unroll
    for (int i = 0; i < 4; ++i) {
        float l = lrun[i];
        l += __shfl_xor(l, 16); l += __shfl_xor(l, 32);
        const float inv = 1.f / l;
        const int row = q0row + wave * 64 + i * 16 + l16;
#pragma unroll
        for (int d = 0; d < 4; ++d)
            st4bf(as + frag_off(row, h * 64 + d * 16 + quad * 4, 1024), o[d][i][0] * inv, o[d][i][1] * inv, o[d][i][2] * inv, o[d][i][3] * inv);
    }
}

__device__ void sg_item(CParams& p, int j2, int chunk, int g, bf16_t* smem) {
    const int lane = tid_() & 63, wave = tid_() >> 6, l16 = lane & 15, quad = lane >> 4;
    const bf16_t* A = (const bf16_t*)(p.ws + WS_SGW) + (size_t)(j2 * 4 + g) * 128 * 128;
    const bf16_t* W = (const bf16_t*)(p.ws + WS_GVT) + ((size_t)chunk * 512 + g * 128) * 128;
    f32x4 acc[2][8];
    gemm_tile<2, 128, 128, 128>(A, W, acc, smem);
    const bf16_t* u = (const bf16_t*)(p.ws + WS_U);
    bf16_t* as = (bf16_t*)(p.ws + WS_AS);
    const float* bs = p.sgu_b + (size_t)(j2 * 4 + g) * 128;
#pragma unroll
    for (int i = 0; i < 2; ++i) {
        const int pt = wave * 32 + i * 16 + l16;
        const int row = chunk * 128 + pt;
        const float bias = bs[pt];
#pragma unroll
        for (int j = 0; j < 8; ++j) {
            const int c = g * 128 + j * 16 + quad * 4;
            const u32x2 uw = *(const u32x2*)(u + (size_t)row * 512 + c);
            const float u0 = __uint_as_float(uw.x << 16), u1 = __uint_as_float(uw.x & 0xffff0000u);
            const float u2 = __uint_as_float(uw.y << 16), u3 = __uint_as_float(uw.y & 0xffff0000u);
            const f32x4 v = acc[i][j];
            st4bf(as + frag_off(row, 512 + c, 1024), u0 * (v[0] + bias), u1 * (v[1] + bias), u2 * (v[2] + bias), u3 * (v[3] + bias));
        }
    }
}

__device__ void attn_sg_phase(CParams& p, int layer, bf16_t* smem) {
    const int j2 = layer >> 1;
    const int nA = NB * 8 * 32, nS = (MT / 128) * 4, nC = NB * 8;
    for (int t = blockIdx.x; t < nA + nS + nC; t += gridDim.x) {
        if (t < nA) {
            const int xcd = t & 7, li = t >> 3;
            const int bh = xcd * 2 + (li >> 5), qb = li & 31;
            attn_item(p, j2, bh >> 3, bh & 7, (bh >> 3) * SEQ + qb * 256, TALL, smem);
        } else if (t < nA + nS) {
            const int u = t - nA;
            sg_item(p, j2, u >> 2, u & 3, smem);
        } else {
            const int u = t - nA - nS;
            const int h = u & 7, b = u >> 3;
            attn_item(p, j2, b, h, ML + b * CTX, CTX, smem);
        }
    }
}

__device__ void conv_phase(CParams& p, int layer, float* smf) {
    const int j2 = layer >> 1, tid = tid_();
    const bf16_t* xbc = (const bf16_t*)(p.ws + WS_XBC);
    bf16_t* XT = (bf16_t*)(p.ws + WS_XT); bf16_t* Bn = (bf16_t*)(p.ws + WS_BN); bf16_t* Cn = (bf16_t*)(p.ws + WS_CN); bf16_t* BT = (bf16_t*)(p.ws + WS_BT);
    const float* cw = p.ssm_conv_w + (size_t)j2 * 3 * 3072;
    const float* cb = p.ssm_conv_b + (size_t)j2 * 3072;
    float* sin_ = smf;
    float* sout = smf + 66 * 65;
    const int nCt = 3072 / 64, nRt = MT / 64;
    for (int t = blockIdx.x; t < nCt * nRt; t += gridDim.x) {
        const int rt = t / nCt, ct = t - rt * nCt;
        const int r0 = rt * 64, c0 = ct * 64;
        const bool first = r0 < ML ? ((r0 & (SEQ - 1)) == 0) : (((r0 - ML) & (CTX - 1)) == 0);
        const bool last = r0 < ML ? (((r0 + 64) & (SEQ - 1)) == 0) : ((((r0 + 64) - ML) & (CTX - 1)) == 0);
        lds_sync();
        for (int e = tid; e < 66 * 8; e += 256) {
            const int rr = e >> 3, c8 = (e & 7) * 8;
            const int row = r0 - 1 + rr;
            u32x4 v = (u32x4){0u, 0u, 0u, 0u};
            if (!((rr == 0 && first) || (rr == 65 && last))) v = *(const u32x4*)(xbc + (size_t)row * 3072 + c0 + c8);
            float* d = sin_ + rr * 65 + c8;
            d[0] = __uint_as_float(v.x << 16); d[1] = __uint_as_float(v.x & 0xffff0000u);
            d[2] = __uint_as_float(v.y << 16); d[3] = __uint_as_float(v.y & 0xffff0000u);
            d[4] = __uint_as_float(v.z << 16); d[5] = __uint_as_float(v.z & 0xffff0000u);
            d[6] = __uint_as_float(v.w << 16); d[7] = __uint_as_float(v.w & 0xffff0000u);
        }
        lds_sync();
        {
            const int c = tid & 63;
            const float w0 = cw[c0 + c], w1 = cw[3072 + c0 + c], w2 = cw[2 * 3072 + c0 + c], bb = cb[c0 + c];
#pragma unroll
            for (int k = 0; k < 16; ++k) {
                const int tt = (tid >> 6) + k * 4;
                const float v = w0 * sin_[tt * 65 + c] + w1 * sin_[(tt + 1) * 65 + c] + w2 * sin_[(tt + 2) * 65 + c] + bb;
                sout[c * 65 + tt] = siluf(v);
            }
        }
        lds_sync();
        const int q = tid >> 2, e16 = (tid & 3) * 16;
        if (c0 >= 2048) {
            u32x4 o0, o1;
            o0.x = pack2(sout[(e16 + 0) * 65 + q], sout[(e16 + 1) * 65 + q]); o0.y = pack2(sout[(e16 + 2) * 65 + q], sout[(e16 + 3) * 65 + q]);
            o0.z = pack2(sout[(e16 + 4) * 65 + q], sout[(e16 + 5) * 65 + q]); o0.w = pack2(sout[(e16 + 6) * 65 + q], sout[(e16 + 7) * 65 + q]);
            o1.x = pack2(sout[(e16 + 8) * 65 + q], sout[(e16 + 9) * 65 + q]); o1.y = pack2(sout[(e16 + 10) * 65 + q], sout[(e16 + 11) * 65 + q]);
            o1.z = pack2(sout[(e16 + 12) * 65 + q], sout[(e16 + 13) * 65 + q]); o1.w = pack2(sout[(e16 + 14) * 65 + q], sout[(e16 + 15) * 65 + q]);
            if (c0 < 2560) {
                bf16_t* dst = Bn + (c0 - 2048) + (size_t)(r0 + q) * 512 + e16;
                *(u32x4*)dst = o0; *(u32x4*)(dst + 8) = o1;
            } else {
                *(u32x4*)(Cn + frag_off(r0 + q, c0 - 2560 + e16, 512)) = o0;
                *(u32x4*)(Cn + frag_off(r0 + q, c0 - 2560 + e16 + 8, 512)) = o1;
            }
        }
        if (c0 < 2560) {
            const float* sp = sout + q * 65 + e16;
            u32x4 o0, o1;
            o0.x = pack2(sp[0], sp[1]); o0.y = pack2(sp[2], sp[3]); o0.z = pack2(sp[4], sp[5]); o0.w = pack2(sp[6], sp[7]);
            o1.x = pack2(sp[8], sp[9]); o1.y = pack2(sp[10], sp[11]); o1.z = pack2(sp[12], sp[13]); o1.w = pack2(sp[14], sp[15]);
            if (c0 < 2048) {
                bf16_t* dst = XT + (size_t)(c0 + q) * MT + r0 + e16;
                *(u32x4*)dst = o0; *(u32x4*)(dst + 8) = o1;
            } else {
                *(u32x4*)(BT + frag_off(c0 - 2048 + q, r0 + e16, MT)) = o0;
                *(u32x4*)(BT + frag_off(c0 - 2048 + q, r0 + e16 + 8, MT)) = o1;
            }
        }
    }
}

__device__ void ssd_diag_item(CParams& p, int j2, int row0, int h, bf16_t* smem) {
    const int tid = tid_(), lane = tid & 63, wave = tid >> 6, l16 = lane & 15, quad = lane >> 4;
    const int g = h >> 3;
    bf16_t* sB = smem;
    bf16_t* sX = sB + 128 * SST;
    float* sda = (float*)(sX + 64 * SST);
    float* sPf = sda + 256;
    float* sRb = sPf + 128;
    float* sdtf = sRb + 128;
    float* sdtb = sdtf + 128;
    const bf16_t* XT = (const bf16_t*)(p.ws + WS_XT) + (size_t)(h * 64) * MT;
    const bf16_t* Bn = (const bf16_t*)(p.ws + WS_BN) + g * 128;
    const bf16_t* Cn = (const bf16_t*)(p.ws + WS_CN) + (size_t)(g * 4) * 512;
    const float* DT = (const float*)(p.ws + WS_DT);
    bf16_t* Y = (bf16_t*)(p.ws + WS_YF);
    const float af = -expf(p.ssm_a_log[(j2 * 2 + 0) * 32 + h]);
    const float ab = -expf(p.ssm_a_log[(j2 * 2 + 1) * 32 + h]);
    const float dsk = p.ssm_d[j2 * 32 + h];
    lds_sync();
#pragma unroll
    for (int i = 0; i < 8; ++i) {
        const int c = tid + i * 256, r = c >> 4, kc = (c & 15) * 8;
        *(u32x4*)(sB + r * SST + kc) = *(const u32x4*)(Bn + (size_t)(row0 + r) * 512 + kc);
    }
#pragma unroll
    for (int i = 0; i < 4; ++i) {
        const int c = tid + i * 256, r = c >> 4, kc = (c & 15) * 8;
        *(u32x4*)(sX + r * SST + kc) = *(const u32x4*)(XT + (size_t)r * MT + row0 + kc);
    }
    {
        const int d = wave >> 1;
        const float d0 = DT[(size_t)(row0 + lane) * 64 + d * 32 + h], d1 = DT[(size_t)(row0 + 64 + lane) * 64 + d * 32 + h];
        const float aa = d ? ab : af;
        const f32x2 sc2 = scan128(d0 * aa, d1 * aa, lane, d);
        float* sc = d ? sRb : sPf; float* sd = d ? sdtb : sdtf;
        if ((wave & 1) == 0) { sc[lane] = sc2.x; sd[lane] = d0; } else { sc[64 + lane] = sc2.y; sd[64 + lane] = d1; }
    }
    bf16x8 cf[2][4];
#pragma unroll
    for (int i = 0; i < 2; ++i)
#pragma unroll
        for (int ks = 0; ks < 4; ++ks)
            cf[i][ks] = *(const bf16x8*)(Cn + ((size_t)((row0 >> 4) + wave * 2 + i) * 16 + ks) * 512 + lane * 8);
    lds_sync();
    float pfl[2], rbl[2];
#pragma unroll
    for (int i = 0; i < 2; ++i) { pfl[i] = sPf[wave * 32 + i * 16 + l16]; rbl[i] = sRb[wave * 32 + i * 16 + l16]; }
    f32x4 y[4][2];
#pragma unroll
    for (int pt = 0; pt < 4; ++pt)
#pragma unroll
        for (int i = 0; i < 2; ++i) y[pt][i] = (f32x4){0.f, 0.f, 0.f, 0.f};
#pragma unroll 1
    for (int sp = 0; sp < 4; ++sp) {
        f32x4 gt[2][2];
#pragma unroll
        for (int s2 = 0; s2 < 2; ++s2)
#pragma unroll
            for (int i = 0; i < 2; ++i) gt[s2][i] = (f32x4){0.f, 0.f, 0.f, 0.f};
#pragma unroll
        for (int ks = 0; ks < 4; ++ks)
#pragma unroll
            for (int s2 = 0; s2 < 2; ++s2) {
                const bf16x8 bfr = lds16(sB + (sp * 32 + s2 * 16 + l16) * SST + ks * 32 + quad * 8);
#pragma unroll
                for (int i = 0; i < 2; ++i) gt[s2][i] = mfma16(bfr, cf[i][ks], gt[s2][i]);
            }
        bf16x8 mf[2];
#pragma unroll
        for (int i = 0; i < 2; ++i) {
            const int l = wave * 32 + i * 16 + l16;
#pragma unroll
            for (int s2 = 0; s2 < 2; ++s2)
#pragma unroll
                for (int r = 0; r < 4; ++r) {
                    const int s = sp * 32 + s2 * 16 + quad * 4 + r;
                    const float arg = s < l ? (pfl[i] - sPf[s]) : (rbl[i] - sRb[s]);
                    float coef = __expf(fminf(arg, 0.f)) * (s < l ? sdtf[s] : sdtb[s]);
                    if (s == l) coef = sdtf[s] + sdtb[s];
                    gt[s2][i][r] *= coef;
                }
            mf[i] = pack8(gt[0][i], gt[1][i]);
        }
#pragma unroll
        for (int pt = 0; pt < 4; ++pt) {
            const bf16_t* xp = sX + (pt * 16 + l16) * SST + sp * 32 + quad * 4;
            const bf16x8 xf = lds8x2(xp, xp + 16);
#pragma unroll
            for (int i = 0; i < 2; ++i) y[pt][i] = mfma16(xf, mf[i], y[pt][i]);
        }
    }
#pragma unroll
    for (int i = 0; i < 2; ++i) {
        const int l = wave * 32 + i * 16 + l16;
#pragma unroll
        for (int pt = 0; pt < 4; ++pt) {
            f32x4 v = y[pt][i];
#pragma unroll
            for (int r = 0; r < 4; ++r) v[r] += dsk * bf2f(sX[(pt * 16 + quad * 4 + r) * SST + l]);
            st4bf(Y + (size_t)(row0 + l) * 2048 + h * 64 + pt * 16 + quad * 4, v[0], v[1], v[2], v[3]);
        }
    }
}

__device__ void ssd_diag_phase(CParams& p, int layer, bf16_t* smem) {
    const int j2 = layer >> 1;
    for (int t = blockIdx.x; t < (MT / 128) * 32; t += gridDim.x) {
        const int h = t & 31, chunk = t >> 5;
        ssd_diag_item(p, j2, chunk * 128, h, smem);
    }
}

struct SsdPre { u32x4 xq; u32x4 bt[2][4]; u32x4 cf[2][4]; u32x2 yold[2]; float dt0, dt1; };

__device__ __forceinline__ int ssd_row0(int b, int dir, int cc) {
    if (cc < 2) { const int ci = dir ? 1 - cc : cc; return ML + b * CTX + ci * 128; }
    const int k = cc - 2; const int ci = dir ? 63 - k : k; return b * SEQ + ci * 128;
}

__device__ __forceinline__ void ssd_scan_item(CParams& p, int j2, int b, int dir, int h, int pq, bf16_t* smem) {
    const int tid = tid_(), lane = tid & 63, wave = tid >> 6, l16 = lane & 15, quad = lane >> 4;
    const int g = h >> 3;
    bf16_t* sX = smem;
    bf16_t* sH = sX + 16 * SST;
    float* seacs = (float*)(sH + 16 * SST);
    float* sw = seacs + 128;
    float* sdec = sw + 128;
    const bf16_t* XT = (const bf16_t*)(p.ws + WS_XT) + (size_t)(h * 64 + pq * 16 + (tid >> 4)) * MT + (tid & 15) * 8;
    const bf16_t* Cn = (const bf16_t*)(p.ws + WS_CN) + ((size_t)(wave * 2) * 16 + g * 4) * 512 + lane * 8;
    const bf16_t* BT = (const bf16_t*)(p.ws + WS_BT) + (size_t)(g * 8 + wave * 2) * (MT / 32) * 512 + lane * 8;
    const float* DT = (const float*)(p.ws + WS_DT) + dir * 32 + h;
    bf16_t* Y = (bf16_t*)(p.ws + (dir ? WS_YB : WS_YF)) + (size_t)(wave * 32 + l16) * 2048 + h * 64 + pq * 16 + quad * 4;
    const float a = -expf(p.ssm_a_log[(j2 * 2 + dir) * 32 + h]);
    f32x4 st[2];
    st[0] = (f32x4){0.f, 0.f, 0.f, 0.f}; st[1] = (f32x4){0.f, 0.f, 0.f, 0.f};
    SsdPre S0, S1;
    auto load_small = [&](SsdPre& S, int r) __attribute__((always_inline)) {
        S.xq = *(const u32x4*)(XT + r);
        S.dt0 = DT[(size_t)(r + lane) * 64]; S.dt1 = DT[(size_t)(r + 64 + lane) * 64];
    };
    auto load_cf = [&](SsdPre& S, int r) __attribute__((always_inline)) {
#pragma unroll
        for (int i = 0; i < 2; ++i)
#pragma unroll
            for (int ks = 0; ks < 4; ++ks) S.cf[i][ks] = *(const u32x4*)(Cn + ((size_t)((r >> 4) + i) * 16 + ks) * 512);
    };
    auto load_yold = [&](SsdPre& S, int r) __attribute__((always_inline)) {
#pragma unroll
        for (int i = 0; i < 2; ++i) S.yold[i] = dir == 0 ? *(const u32x2*)(Y + (size_t)(r + i * 16) * 2048) : (u32x2){0u, 0u};
    };
    auto load_bt = [&](SsdPre& S, int r) __attribute__((always_inline)) {
#pragma unroll
        for (int nt = 0; nt < 2; ++nt)
#pragma unroll
            for (int ks = 0; ks < 4; ++ks) S.bt[nt][ks] = *(const u32x4*)(BT + ((size_t)nt * (MT / 32) + (r >> 5) + ks) * 512);
    };
    {
        const int r0 = ssd_row0(b, dir, 0), r1 = ssd_row0(b, dir, 1);
        load_small(S0, r0); load_cf(S0, r0); load_yold(S0, r0); load_bt(S0, r0);
        load_small(S1, r1); load_cf(S1, r1); load_yold(S1, r1); load_bt(S1, r1);
    }
    auto body = [&](SsdPre& S, int cc) __attribute__((always_inline)) {
        const int row0 = ssd_row0(b, dir, cc);
        const int row2 = ssd_row0(b, dir, cc + 2 < 66 ? cc + 2 : 65);
        lds_sync();
        *(u32x4*)(sX + (tid >> 4) * SST + (tid & 15) * 8) = S.xq;
#pragma unroll
        for (int nt = 0; nt < 2; ++nt) st4bf(sH + l16 * SST + wave * 32 + nt * 16 + quad * 4, st[nt][0], st[nt][1], st[nt][2], st[nt][3]);
        if (wave < 2) {
            const f32x2 sc2 = scan128(S.dt0 * a, S.dt1 * a, lane, dir);
            const float total = dir == 0 ? __shfl(sc2.y, 63) : __shfl(sc2.x, 0);
            if (wave == 0) { seacs[lane] = __expf(sc2.x); sw[lane] = S.dt0 * __expf(total - sc2.x); if (lane == 0) sdec[0] = __expf(total); }
            else { seacs[64 + lane] = __expf(sc2.y); sw[64 + lane] = S.dt1 * __expf(total - sc2.y); }
        }
        lds_sync();
        load_small(S, row2);
        f32x4 yo[2];
        yo[0] = (f32x4){0.f, 0.f, 0.f, 0.f}; yo[1] = (f32x4){0.f, 0.f, 0.f, 0.f};
#pragma unroll
        for (int ks = 0; ks < 4; ++ks) {
            const bf16x8 hf = lds16(sH + l16 * SST + ks * 32 + quad * 8);
#pragma unroll
            for (int i = 0; i < 2; ++i) yo[i] = mfma16(hf, __builtin_bit_cast(bf16x8, S.cf[i][ks]), yo[i]);
        }
        __builtin_amdgcn_sched_barrier(0);
        load_cf(S, row2);
#pragma unroll
        for (int i = 0; i < 2; ++i) {
            const float e = seacs[wave * 32 + i * 16 + l16];
            const float o0 = __uint_as_float(S.yold[i].x << 16), o1 = __uint_as_float(S.yold[i].x & 0xffff0000u);
            const float o2 = __uint_as_float(S.yold[i].y << 16), o3 = __uint_as_float(S.yold[i].y & 0xffff0000u);
            st4bf(Y + (size_t)(row0 + i * 16) * 2048, yo[i][0] * e + o0, yo[i][1] * e + o1, yo[i][2] * e + o2, yo[i][3] * e + o3);
        }
        __builtin_amdgcn_sched_barrier(0);
        load_yold(S, row2);
        {
            const float dec = sdec[0];
            st[0] *= dec; st[1] *= dec;
#pragma unroll
            for (int ks = 0; ks < 4; ++ks) {
                const f32x4 w0 = *(const f32x4*)(sw + ks * 32 + quad * 8), w1 = *(const f32x4*)(sw + ks * 32 + quad * 8 + 4);
                const u32x4 raw = *(const u32x4*)(sX + l16 * SST + ks * 32 + quad * 8);
                u32x4 xs;
                xs.x = pack2(__uint_as_float(raw.x << 16) * w0[0], __uint_as_float(raw.x & 0xffff0000u) * w0[1]);
                xs.y = pack2(__uint_as_float(raw.y << 16) * w0[2], __uint_as_float(raw.y & 0xffff0000u) * w0[3]);
                xs.z = pack2(__uint_as_float(raw.z << 16) * w1[0], __uint_as_float(raw.z & 0xffff0000u) * w1[1]);
                xs.w = pack2(__uint_as_float(raw.w << 16) * w1[2], __uint_as_float(raw.w & 0xffff0000u) * w1[3]);
                const bf16x8 xbf = __builtin_bit_cast(bf16x8, xs);
#pragma unroll
                for (int nt = 0; nt < 2; ++nt) st[nt] = mfma16(__builtin_bit_cast(bf16x8, S.bt[nt][ks]), xbf, st[nt]);
            }
        }
        __builtin_amdgcn_sched_barrier(0);
        load_bt(S, row2);
    };
#pragma unroll 1
    for (int cc = 0; cc < 66; cc += 2) {
        body(S0, cc);
        body(S1, cc + 1);
    }
}

__device__ void ssd_scan_phase(CParams& p, int layer, bf16_t* smem) {
    const int j2 = layer >> 1;
    for (int t = blockIdx.x; t < NB * 2 * 32 * 4; t += gridDim.x) {
        const int xcd = t & 7, li = t >> 3, gi = xcd * 2 + (li >> 5);
        const int pq = li & 3, h = (gi & 3) * 8 + ((li & 31) >> 2), dir = (gi >> 2) & 1, b = gi >> 3;
        ssd_scan_item(p, j2, b, dir, h, pq, smem);
    }
}

__device__ void finish_phase(CParams& p, int layer) {
    const int j2 = layer >> 1, lane = tid_() & 63, wave = tid_() >> 6;
    bf16_t* yf = (bf16_t*)(p.ws + WS_YF); const bf16_t* yb = (const bf16_t*)(p.ws + WS_YB); const bf16_t* z = (const bf16_t*)(p.ws + WS_Z);
    const float* gn = p.ssm_norm_g + (size_t)j2 * 2048;
    for (int row = blockIdx.x * 4 + wave; row < MT; row += gridDim.x * 4) {
#pragma unroll
        for (int g = 0; g < 4; ++g) {
            const size_t off = (size_t)row * 2048 + g * 512 + lane * 8;
            const u32x4 a = *(const u32x4*)(yf + off), bq = *(const u32x4*)(yb + off), zq = *(const u32x4*)(z + off);
            const unsigned aw[4] = {a.x, a.y, a.z, a.w}, bw[4] = {bq.x, bq.y, bq.z, bq.w}, zw[4] = {zq.x, zq.y, zq.z, zq.w};
            float v[8]; float ss = 0.f;
#pragma unroll
            for (int k = 0; k < 4; ++k) {
                v[2 * k] = (__uint_as_float(aw[k] << 16) + __uint_as_float(bw[k] << 16)) * __uint_as_float(zw[k] << 16);
                v[2 * k + 1] = (__uint_as_float(aw[k] & 0xffff0000u) + __uint_as_float(bw[k] & 0xffff0000u)) * __uint_as_float(zw[k] & 0xffff0000u);
                ss += v[2 * k] * v[2 * k] + v[2 * k + 1] * v[2 * k + 1];
            }
#pragma unroll
            for (int o = 1; o < 64; o <<= 1) ss += __shfl_xor(ss, o);
            const float rstd = rsqrtf(ss * (1.f / 512.f) + EPS);
            const f32x4 g0 = *(const f32x4*)(gn + g * 512 + lane * 8), g1 = *(const f32x4*)(gn + g * 512 + lane * 8 + 4);
            u32x4 o4;
            o4.x = pack2(v[0] * rstd * g0[0], v[1] * rstd * g0[1]); o4.y = pack2(v[2] * rstd * g0[2], v[3] * rstd * g0[3]);
            o4.z = pack2(v[4] * rstd * g1[0], v[5] * rstd * g1[1]); o4.w = pack2(v[6] * rstd * g1[2], v[7] * rstd * g1[3]);
            *(u32x4*)(yf + off) = o4;
        }
    }
}

__global__ void __launch_bounds__(256, 2) hybrid_fwd(Params p) {
    extern __shared__ __attribute__((aligned(16))) unsigned char lds[];
    cg::grid_group grid = cg::this_grid();
    bf16_t* smem = (bf16_t*)lds; float* smf = (float*)lds;
    volatile LAS unsigned* bst = (volatile LAS unsigned*)(lds + LDS_BYTES - 16);
    if (threadIdx.x == 0) { bst[0] = 0u; bst[1] = 0u; }
    __syncthreads();
    const XcdBarrier xb = xcd_barrier_post((unsigned*)(p.ws + WS_BAR), bst);
    enum { C_NORM1 = 0, C_MIXIN, C_ATTN, C_MIXOUT, C_NORM2, C_FFNIN, C_FFNOUT, C_SSMIN, C_CONV, C_SSD, C_FINISH, C_SSMOUT, C_PRO, C_SSDB };
    const unsigned long long evc = 0x6543210ull;
    const unsigned long long odc = 0x654BAD9870ull;
    for (int ph = 0; ph < 35; ++ph) {
        int code, layer;
        if (ph == 0) { code = C_PRO; layer = 0; }
        else {
            const int q = ph - 1, pair = q / 17, r = q - pair * 17;
            if (r < 7) { layer = 2 * pair; code = (int)((evc >> (4 * r)) & 15); }
            else { layer = 2 * pair + 1; code = (int)((odc >> (4 * (r - 7))) & 15); }
        }
        CParams* kp = (CParams*)__builtin_amdgcn_kernarg_segment_ptr();
        asm volatile("" : "+s"(kp));
        CParams& q = *kp;
#define PHASE(c) asm volatile("" : "+s"(code)); if (code == (c))
        PHASE(C_PRO) prologue(q, smf);
        PHASE(C_NORM1) { if (layer > 0) convert_layer_weights(q, layer, smf); norm_phase(q, layer, 0); }
        PHASE(C_NORM2) norm_phase(q, layer, 1);
        PHASE(C_MIXIN) gemm_phase<G_MIXIN>(q, layer, smem);
        PHASE(C_ATTN) attn_sg_phase(q, layer, smem);
        PHASE(C_MIXOUT) gemm_phase<G_MIXOUT>(q, layer, smem);
        PHASE(C_FFNIN) gemm_phase<G_FFNIN>(q, layer, smem);
        PHASE(C_FFNOUT) gemm_phase<G_FFNOUT>(q, layer, smem);
        PHASE(C_SSMIN) gemm_phase<G_SSMIN>(q, layer, smem);
        PHASE(C_CONV) conv_phase(q, layer, smf);
        PHASE(C_SSD) ssd_diag_phase(q, layer, smem);
        PHASE(C_SSDB) ssd_scan_phase(q, layer, smem);
        PHASE(C_FINISH) finish_phase(q, layer);
        PHASE(C_SSMOUT) gemm_phase<G_SSMOUT>(q, layer, smem);
#undef PHASE
        if (ph == 0) grid.sync(); else xcd_barrier(xb);
    }
}

extern "C" void kernel_launch(void* const* d_in, const int* in_sizes, int n_in, void* d_out, int out_size, void* d_ws, size_t ws_size, hipStream_t stream) {
    static int grid_blocks = 0;
    if (grid_blocks == 0) {
        if (ws_size < WS_TOTAL) { fprintf(stderr, "kernel_launch: workspace too small: %zu < %zu\n", ws_size, (size_t)WS_TOTAL); grid_blocks = -1; return; }
        int dev = 0, cus = 0, per_cu = 0;
        hipGetDevice(&dev);
        hipDeviceGetAttribute(&cus, hipDeviceAttributeMultiprocessorCount, dev);
        if (hipFuncSetAttribute((const void*)hybrid_fwd, hipFuncAttributeMaxDynamicSharedMemorySize, LDS_BYTES) != hipSuccess) { fprintf(stderr, "kernel_launch: hipFuncSetAttribute failed\n"); }
        if (hipOccupancyMaxActiveBlocksPerMultiprocessor(&per_cu, (const void*)hybrid_fwd, 256, LDS_BYTES) != hipSuccess || per_cu < 1) { fprintf(stderr, "kernel_launch: occupancy query failed (%d)\n", per_cu); per_cu = 1; }
        if (per_cu > 2) per_cu = 2;
        (void)hipGetLastError();
        grid_blocks = cus * per_cu;
    }
    if (grid_blocks < 0) return;
    if (hipMemsetAsync((char*)d_ws + WS_BAR, 0, XCD_BAR_WORDS * sizeof(unsigned), stream) != hipSuccess) { fprintf(stderr, "kernel_launch: hipMemsetAsync failed\n"); return; }
    Params p{};
    const float** f = (const float**)&p;
    for (int i = 0; i < 25; ++i) f[i] = (const float*)d_in[i];
    p.out = (float*)d_out; p.ws = (unsigned char*)d_ws;
    void* args[] = {&p};
    hipError_t e = hipLaunchCooperativeKernel((const void*)hybrid_fwd, dim3(grid_blocks), dim3(256), args, LDS_BYTES, stream);
    if (e != hipSuccess) fprintf(stderr, "cooperative launch failed: %s (grid %d)\n", hipGetErrorString(e), grid_blocks);
}
```

```cpp
#include <hip/hip_runtime.h>
#include <hip/hip_cooperative_groups.h>
#include <cstdio>
#include <cstdint>
namespace cg = cooperative_groups;

typedef unsigned short bf16_t;
typedef short bf16x8 __attribute__((ext_vector_type(8)));
typedef short bf16x4 __attribute__((ext_vector_type(4)));
typedef float f32x4 __attribute__((ext_vector_type(4)));
typedef unsigned u32x4 __attribute__((ext_vector_type(4)));
typedef unsigned u32x2 __attribute__((ext_vector_type(2)));

constexpr int D = 1024, NB = 2, SEQ = 8192, CTX = 256;
constexpr int ML = NB * SEQ;
constexpr int MC = NB * CTX;
constexpr int MT = ML + MC;
constexpr int TALL = CTX + SEQ;
constexpr int FFH = 2816;
constexpr int MIXIN = 1792;
constexpr int SSMIN = 5184, SSMIN_PAD = 5248;
constexpr int SSI = 2048;
constexpr float EPS = 1e-6f;
constexpr float QSCALE = 0.125f * 1.4426950408889634f;

constexpr size_t MB = 1024 * 1024;
constexpr size_t WS_MOD = 0;
constexpr size_t WS_ROPE = 1 * MB;
constexpr size_t WS_XCTX = 3 * MB;
constexpr size_t WS_SGW = 5 * MB + 512 * 1024;
constexpr size_t WS_BAR = 7 * MB;
constexpr size_t WS_WT = 8 * MB;
constexpr size_t WT_FFNIN = 0;
constexpr size_t WT_FFNOUT = WT_FFNIN + (size_t)5632 * 1024 * 2;
constexpr size_t WT_MIXIN = WT_FFNOUT + (size_t)1024 * 2816 * 2;
constexpr size_t WT_MIXOUT = WT_MIXIN + (size_t)SSMIN_PAD * 1024 * 2;
constexpr size_t WT_END = WT_MIXOUT + (size_t)1024 * 2048 * 2;
constexpr size_t WS_R0 = WS_WT + ((WT_END + MB - 1) / MB) * MB;
constexpr size_t SZ_XBC = (size_t)MT * 3072 * 2;
constexpr size_t SZ_HN = (size_t)MT * 1024 * 2;
constexpr size_t WS_XBC = WS_R0;
constexpr size_t WS_HN = WS_XBC + SZ_XBC;
constexpr size_t WS_YF = WS_XBC;
constexpr size_t WS_YB = WS_YF + (size_t)MT * 2048 * 2;
constexpr size_t WS_R1 = WS_HN + SZ_HN;
constexpr size_t WS_Z = WS_R1;
constexpr size_t WS_XT = WS_Z + (size_t)MT * 2048 * 2;
constexpr size_t WS_BN = WS_XT + (size_t)MT * 2048 * 2;
constexpr size_t WS_CN = WS_BN + (size_t)MT * 512 * 2;
constexpr size_t WS_BT = WS_CN + (size_t)MT * 512 * 2;
constexpr size_t WS_DT = WS_BT + (size_t)MT * 512 * 2;
constexpr size_t WS_END_ODD = WS_DT + (size_t)MT * 64 * 4;
constexpr size_t WS_Q = WS_R1;
constexpr size_t WS_K = WS_Q + (size_t)MT * 512 * 2;
constexpr size_t WS_VT = WS_K + (size_t)MT * 128 * 2;
constexpr size_t WS_U = WS_VT + (size_t)MT * 128 * 2;
constexpr size_t WS_GVT = WS_U + (size_t)MT * 512 * 2;
constexpr size_t WS_AS = WS_GVT + (size_t)MT * 512 * 2;
constexpr size_t WS_HID = WS_R1;
constexpr size_t WS_TOTAL = WS_END_ODD;
static_assert(WS_TOTAL < (size_t)400 * MB, "workspace too large");
static_assert(WS_AS + (size_t)MT * 1024 * 2 <= WS_END_ODD, "even buffers fit");
static_assert(WS_HID + (size_t)MT * FFH * 2 <= WS_END_ODD, "hid fits");

constexpr int LDS_BYTES = 73728;
constexpr int GST = 72;
constexpr int SST = 136;

struct Params {
    const float* x; const float* c; const float* ctx; const float* c_ctx;
    const float* ada_w; const float* ada_b; const float* norm1_g; const float* norm2_g;
    const float* ffn_w_in; const float* ffn_w_out; const float* mix_w_in; const float* mix_w_out;
    const float* q_norm_g; const float* k_norm_g; const float* sgu_norm_g; const float* sgu_w; const float* sgu_b;
    const float* ssm_w_in; const float* ssm_conv_w; const float* ssm_conv_b; const float* ssm_dt_bias;
    const float* ssm_a_log; const float* ssm_d; const float* ssm_norm_g; const float* ssm_w_out;
    float* out; unsigned char* ws;
};

typedef const __attribute__((address_space(4))) Params CParams;

__device__ __forceinline__ int tid_() { int t = threadIdx.x; asm volatile("" : "+v"(t)); return t; }
__device__ __forceinline__ bf16_t f2bf(float f) {
    unsigned u = __float_as_uint(f);
    u += 0x7fffu + ((u >> 16) & 1u);
    return (bf16_t)(u >> 16);
}
__device__ __forceinline__ float bf2f(bf16_t h) { return __uint_as_float(((unsigned)h) << 16); }
__device__ __forceinline__ unsigned pack2(float a, float b) { unsigned r; asm volatile("v_cvt_pk_bf16_f32 %0, %1, %2" : "=v"(r) : "v"(a), "v"(b)); return r; }
__device__ __forceinline__ float siluf(float v) { return v / (1.f + __expf(-v)); }
__device__ __forceinline__ float geluf(float v) {
    const float u = 0.7978845608028654f * (v + 0.044715f * v * v * v);
    return v / (1.f + __expf(-2.f * u));
}
__device__ __forceinline__ float softplusf(float v) { return v > 20.f ? v : log1pf(expf(v)); }
__device__ __forceinline__ int seg_of(int row) { return row < SEQ ? 0 : (row < ML ? 1 : 2); }
__device__ __forceinline__ float* xrow(CParams& p, int row) {
    return row < ML ? p.out + (size_t)row * D : (float*)(p.ws + WS_XCTX) + (size_t)(row - ML) * D;
}
__device__ __forceinline__ void lds_sync() {
    __builtin_amdgcn_fence(__ATOMIC_RELEASE, "workgroup", "local");
    __builtin_amdgcn_s_barrier();
    __builtin_amdgcn_fence(__ATOMIC_ACQUIRE, "workgroup", "local");
}
typedef float f32x2 __attribute__((ext_vector_type(2)));
__device__ __forceinline__ f32x2 scan128(float s0, float s1, int lane, int dir) {
    if (dir == 0) {
#pragma unroll
        for (int o = 1; o < 64; o <<= 1) { const float t0 = __shfl_up(s0, o), t1 = __shfl_up(s1, o); s0 += lane >= o ? t0 : 0.f; s1 += lane >= o ? t1 : 0.f; }
        s1 += __shfl(s0, 63);
    } else {
#pragma unroll
        for (int o = 1; o < 64; o <<= 1) { const float t0 = __shfl_down(s0, o), t1 = __shfl_down(s1, o); s0 += lane + o < 64 ? t0 : 0.f; s1 += lane + o < 64 ? t1 : 0.f; }
        s0 += __shfl(s1, 0);
    }
    return (f32x2){s0, s1};
}
__device__ __forceinline__ f32x4 mfma16(bf16x8 a, bf16x8 b, f32x4 c) { return __builtin_amdgcn_mfma_f32_16x16x32_bf16(a, b, c, 0, 0, 0); }
__device__ __forceinline__ bf16x8 lds16(const bf16_t* p) { return *(const bf16x8*)p; }
__device__ __forceinline__ bf16x8 lds8x2(const bf16_t* p0, const bf16_t* p1) {
    const bf16x4 a = *(const bf16x4*)p0, b = *(const bf16x4*)p1;
    bf16x8 r; r[0] = a[0]; r[1] = a[1]; r[2] = a[2]; r[3] = a[3]; r[4] = b[0]; r[5] = b[1]; r[6] = b[2]; r[7] = b[3];
    return r;
}
__device__ __forceinline__ bf16x8 pack8(f32x4 a, f32x4 b) {
    u32x4 w; w.x = pack2(a[0], a[1]); w.y = pack2(a[2], a[3]); w.z = pack2(b[0], b[1]); w.w = pack2(b[2], b[3]);
    return __builtin_bit_cast(bf16x8, w);
}
__device__ __forceinline__ void st4bf(bf16_t* dst, float a, float b, float c, float d) {
    u32x2 w; w.x = pack2(a, b); w.y = pack2(c, d); *(u32x2*)dst = w;
}


#define XB_TMO      128
#define XB_XCNT(j)  (256  + 64 * (j))
#define XB_XSUB(j)  (1280 + 64 * (j))
#define XB_XGEN(j)  (2304 + 64 * (j))
#define XB_TOP      3328
#define XB_TOPGEN   3392
#define XCD_BAR_WORDS 3456
#define XB_SPIN_CAP (1u << 18)
#define LAS __attribute__((address_space(3)))
__device__ __forceinline__ unsigned xb_ld(unsigned* p)              { return __hip_atomic_load(p, __ATOMIC_RELAXED, __HIP_MEMORY_SCOPE_AGENT); }
__device__ __forceinline__ unsigned xb_add(unsigned* p, unsigned v) { return __hip_atomic_fetch_add(p, v, __ATOMIC_RELAXED, __HIP_MEMORY_SCOPE_AGENT); }
__device__ __forceinline__ unsigned xb_xcc_id() { return (unsigned)__builtin_amdgcn_s_getreg((3 << 11) | 20) & 0xFu; }
#define XB_SPIN(cond, bar) do { unsigned _sp = 0; while (cond) { __builtin_amdgcn_s_sleep(1); \
    if ((++_sp & 255u) == 0u) { if (xb_ld(&(bar)[XB_TMO])) break; if (_sp > XB_SPIN_CAP) { atomicAdd(&(bar)[XB_TMO], 1u); break; } } } } while (0)
struct XcdBarrier { unsigned* bar; unsigned x; volatile LAS unsigned* st; };
__device__ __forceinline__ XcdBarrier xcd_barrier_post(unsigned* bar, volatile LAS unsigned* st) {
    XcdBarrier b; b.bar = bar; b.x = xb_xcc_id(); b.st = st;
    if (threadIdx.x == 0) (void)xb_add(&bar[XB_XCNT(b.x)], 1u);
    return b;
}
__device__ __forceinline__ void xcd_barrier_complete(unsigned* bar, unsigned x, unsigned& nloc, unsigned& nx) {
    const unsigned G = gridDim.x * gridDim.y * gridDim.z;
    unsigned sum, cnt, mine, sp = 0u;
    for (;;) {
        sum = 0u; cnt = 0u; mine = 0u;
#pragma unroll
        for (unsigned j = 0; j < 16; ++j) { const unsigned c = xb_ld(&bar[XB_XCNT(j)]); sum += c; cnt += (c > 0u) ? 1u : 0u; mine = (j == x) ? c : mine; }
        if (sum == G) break;
        __builtin_amdgcn_s_sleep(1);
        if ((++sp & 255u) == 0u) { if (xb_ld(&bar[XB_TMO])) break; if (sp > XB_SPIN_CAP) { atomicAdd(&bar[XB_TMO], 1u); break; } }
    }
    nloc = mine > 0u ? mine : 1u; nx = cnt > 0u ? cnt : 1u;
}
__device__ __forceinline__ void xcd_barrier(const XcdBarrier& b) {
    asm volatile("s_waitcnt vmcnt(0)" ::: "memory");
    __syncthreads();
    if (threadIdx.x == 0) {
        unsigned* bar = b.bar;
        __builtin_amdgcn_s_waitcnt(0);
        unsigned nloc = b.st[0], nx = b.st[1];
        if (nloc == 0u) { xcd_barrier_complete(bar, b.x, nloc, nx); b.st[0] = nloc; b.st[1] = nx; }
        const unsigned old = xb_add(&bar[XB_XSUB(b.x)], 1u);
        const unsigned gen = old / nloc;
        if (old + 1u == (gen + 1u) * nloc) {
            __builtin_amdgcn_fence(__ATOMIC_RELEASE, "agent");
            asm volatile("s_waitcnt vmcnt(0)" ::: "memory");
            const unsigned og = xb_add(&bar[XB_TOP], 1u);
            const unsigned tg = og / nx;
            if (og + 1u == (tg + 1u) * nx) xb_add(&bar[XB_TOPGEN], 1u);
            else XB_SPIN(xb_ld(&bar[XB_TOPGEN]) == tg, bar);
            __builtin_amdgcn_fence(__ATOMIC_ACQUIRE, "agent");
            xb_add(&bar[XB_XGEN(b.x)], 1u);
            asm volatile("s_waitcnt vmcnt(0)" ::: "memory");
        } else {
            XB_SPIN(xb_ld(&bar[XB_XGEN(b.x)]) == gen, bar);
            __builtin_amdgcn_fence(__ATOMIC_ACQUIRE, "agent");
            asm volatile("s_waitcnt vmcnt(0)" ::: "memory");
        }
    }
    __syncthreads();
}

__device__ __forceinline__ size_t frag_off(int row, int col, int K) {
    return ((size_t)(row >> 4) * (K >> 5) + (col >> 5)) * 512 + ((row & 15) + 16 * ((col & 31) >> 3)) * 8 + (col & 7);
}

template <int MI, int lda, int ldw, int K, int FRAG = 0>
__device__ __forceinline__ void gemm_tile(const bf16_t* __restrict__ A, const bf16_t* __restrict__ W,
                                          f32x4 (&acc)[MI][8], bf16_t* sW) {
    const int tid = tid_(), lane = tid & 63, wave = tid >> 6, l16 = lane & 15, quad = lane >> 4;
    const int srow = tid >> 3, skc = (tid & 7) * 8;
    constexpr int ASI = FRAG ? (K / 32) * 512 : 16 * lda;
    constexpr int ASK = FRAG ? 512 : 32;
    const bf16_t* ap = FRAG ? A + (size_t)(wave * MI) * ASI + lane * 8 : A + (size_t)(wave * 16 * MI + l16) * lda + quad * 8;
    const bf16_t* wp = W + (size_t)srow * ldw + skc;
    const bf16_t* wr = sW + l16 * GST + quad * 8;
    u32x4 ra[MI][2], rw[4];
#pragma unroll
    for (int i = 0; i < 4; ++i) rw[i] = *(const u32x4*)(wp + (size_t)(i * 32) * ldw);
#pragma unroll
    for (int i = 0; i < MI; ++i)
#pragma unroll
        for (int ks = 0; ks < 2; ++ks) ra[i][ks] = *(const u32x4*)(ap + (size_t)i * ASI + ks * ASK);
#pragma unroll
    for (int i = 0; i < MI; ++i)
#pragma unroll
        for (int j = 0; j < 8; ++j) acc[i][j] = (f32x4){0.f, 0.f, 0.f, 0.f};
    constexpr int nk = K >> 6;
#pragma unroll 1
    for (int kt = 0; kt < nk; ++kt) {
        lds_sync();
#pragma unroll
        for (int i = 0; i < 4; ++i) *(u32x4*)(sW + (srow + i * 32) * GST + skc) = rw[i];
        lds_sync();
        const int k0 = (kt + 1 < nk ? kt + 1 : kt) << 6;
        const int ka = FRAG ? (k0 >> 5) * 512 : k0;
#pragma unroll
        for (int i = 0; i < 4; ++i) rw[i] = *(const u32x4*)(wp + (size_t)(i * 32) * ldw + k0);
        bf16x8 wa[4], wb[4];
#pragma unroll
        for (int j = 0; j < 4; ++j) wa[j] = lds16(wr + (j * 16) * GST);
#pragma unroll
        for (int j = 0; j < 4; ++j) wb[j] = lds16(wr + ((j + 4) * 16) * GST);
        __builtin_amdgcn_sched_barrier(0);
#pragma unroll
        for (int j = 0; j < 4; ++j)
#pragma unroll
            for (int i = 0; i < MI; ++i) acc[i][j] = mfma16(wa[j], __builtin_bit_cast(bf16x8, ra[i][0]), acc[i][j]);
        __builtin_amdgcn_sched_barrier(0);
#pragma unroll
        for (int j = 0; j < 4; ++j) wa[j] = lds16(wr + (j * 16) * GST + 32);
        __builtin_amdgcn_sched_barrier(0);
#pragma unroll
        for (int j = 0; j < 4; ++j)
#pragma unroll
            for (int i = 0; i < MI; ++i) acc[i][j + 4] = mfma16(wb[j], __builtin_bit_cast(bf16x8, ra[i][0]), acc[i][j + 4]);
        __builtin_amdgcn_sched_barrier(0);
#pragma unroll
        for (int i = 0; i < MI; ++i) ra[i][0] = *(const u32x4*)(ap + (size_t)i * ASI + ka);
#pragma unroll
        for (int j = 0; j < 4; ++j) wb[j] = lds16(wr + ((j + 4) * 16) * GST + 32);
        __builtin_amdgcn_sched_barrier(0);
#pragma unroll
        for (int j = 0; j < 4; ++j)
#pragma unroll
            for (int i = 0; i < MI; ++i) acc[i][j] = mfma16(wa[j], __builtin_bit_cast(bf16x8, ra[i][1]), acc[i][j]);
        __builtin_amdgcn_sched_barrier(0);
#pragma unroll
        for (int j = 0; j < 4; ++j)
#pragma unroll
            for (int i = 0; i < MI; ++i) acc[i][j + 4] = mfma16(wb[j], __builtin_bit_cast(bf16x8, ra[i][1]), acc[i][j + 4]);
        __builtin_amdgcn_sched_barrier(0);
#pragma unroll
        for (int i = 0; i < MI; ++i) ra[i][1] = *(const u32x4*)(ap + (size_t)i * ASI + ka + ASK);
    }
}

template <int MI>
__device__ __forceinline__ void epi_resid(CParams& p, int m0, int n0, const f32x4 (&acc)[MI][8], const float* gate  ) {
    const int lane = tid_() & 63, wave = tid_() >> 6, l16 = lane & 15, quad = lane >> 4;
#pragma unroll
    for (int i = 0; i < MI; ++i) {
        const int row = m0 + wave * 16 * MI + i * 16 + l16;
        float* xr = xrow(p, row);
        const float* g = gate + (size_t)seg_of(row) * 6144;
#pragma unroll
        for (int j = 0; j < 8; ++j) {
            const int col = n0 + j * 16 + quad * 4;
            const f32x4 gv = *(const f32x4*)(g + col);
            f32x4 xv = *(f32x4*)(xr + col);
            xv += gv * acc[i][j];
            *(f32x4*)(xr + col) = xv;
        }
    }
}

template <int MI>
__device__ __forceinline__ void epi_swiglu(CParams& p, int m0, int n0, const f32x4 (&acc)[MI][8]) {
    const int lane = tid_() & 63, wave = tid_() >> 6, l16 = lane & 15, quad = lane >> 4;
    bf16_t* hid = (bf16_t*)(p.ws + WS_HID);
#pragma unroll
    for (int i = 0; i < MI; ++i) {
        const int row = m0 + wave * 16 * MI + i * 16 + l16;
#pragma unroll
        for (int jj = 0; jj < 4; ++jj) {
            const f32x4 g = acc[i][2 * jj], u = acc[i][2 * jj + 1];
            const int hc = (n0 >> 1) + jj * 16 + quad * 4;
            const size_t off = ((size_t)(row >> 4) * (FFH / 32) + (hc >> 5)) * 512 + ((row & 15) + 16 * ((hc & 31) >> 3)) * 8 + (hc & 7);
            st4bf(hid + off, siluf(g[0]) * u[0], siluf(g[1]) * u[1], siluf(g[2]) * u[2], siluf(g[3]) * u[3]);
        }
    }
}

template <int MI>
__device__ __forceinline__ void epi_mixin(CParams& p, int j2, int m0, int tn, f32x4 (&acc)[MI][8]) {
    const int lane = tid_() & 63, wave = tid_() >> 6, l16 = lane & 15, quad = lane >> 4;
    if (tn < 5) {
        const float* gsrc = (tn < 4 ? p.q_norm_g : p.k_norm_g) + j2 * 64;
        const float* cosT = (const float*)(p.ws + WS_ROPE);
        const float* sinT = cosT + 8192 * 32;
#pragma unroll
        for (int i = 0; i < MI; ++i) {
            const int row = m0 + wave * 16 * MI + i * 16 + l16;
#pragma unroll
            for (int hh = 0; hh < 2; ++hh) {
                float ss = 0.f;
#pragma unroll
                for (int j = 0; j < 4; ++j) { const f32x4 v = acc[i][hh * 4 + j]; ss += v[0] * v[0] + v[1] * v[1] + v[2] * v[2] + v[3] * v[3]; }
                ss += __shfl_xor(ss, 16); ss += __shfl_xor(ss, 32);
                const float rstd = rsqrtf(ss * (1.f / 64.f) + EPS);
                f32x4 y[4];
#pragma unroll
                for (int j = 0; j < 4; ++j) {
                    const f32x4 gv = *(const f32x4*)(gsrc + j * 16 + quad * 4);
                    y[j] = acc[i][hh * 4 + j] * rstd * gv;
                }
                if (row < ML) {
                    const int s = row & (SEQ - 1);
#pragma unroll
                    for (int j = 0; j < 2; ++j) {
                        const f32x4 cs = *(const f32x4*)(cosT + (size_t)s * 32 + j * 16 + quad * 4);
                        const f32x4 sn = *(const f32x4*)(sinT + (size_t)s * 32 + j * 16 + quad * 4);
                        const f32x4 x1 = y[j], x2 = y[j + 2];
                        y[j] = x1 * cs - x2 * sn;
                        y[j + 2] = x2 * cs + x1 * sn;
                    }
                }
                if (tn < 4) {
                    bf16_t* q = (bf16_t*)(p.ws + WS_Q) + (size_t)row * 512 + (tn * 2 + hh) * 64;
#pragma unroll
                    for (int j = 0; j < 4; ++j) st4bf(q + j * 16 + quad * 4, y[j][0] * QSCALE, y[j][1] * QSCALE, y[j][2] * QSCALE, y[j][3] * QSCALE);
                } else {
                    const int b = row < ML ? (row >> 13) : ((row - ML) >> 8);
                    const int t = row < ML ? CTX + (row & (SEQ - 1)) : ((row - ML) & (CTX - 1));
                    bf16_t* k = (bf16_t*)(p.ws + WS_K) + ((size_t)b * TALL + t) * 128 + hh * 64;
#pragma unroll
                    for (int j = 0; j < 4; ++j) st4bf(k + j * 16 + quad * 4, y[j][0], y[j][1], y[j][2], y[j][3]);
                }
            }
        }
    } else if (tn == 5) {
        bf16_t* vt = (bf16_t*)(p.ws + WS_VT);
#pragma unroll
        for (int i = 0; i < MI; ++i) {
            const int row = m0 + wave * 16 * MI + i * 16 + l16;
            const int b = row < ML ? (row >> 13) : ((row - ML) >> 8);
            const int t = row < ML ? CTX + (row & (SEQ - 1)) : ((row - ML) & (CTX - 1));
#pragma unroll
            for (int j = 0; j < 8; ++j) {
                const int kh = j >> 2;
#pragma unroll
                for (int r = 0; r < 4; ++r) {
                    const int d = (j & 3) * 16 + quad * 4 + r;
                    vt[((size_t)(b * 2 + kh) * 64 + d) * TALL + t] = f2bf(acc[i][j][r]);
                }
            }
        }
    } else if (tn < 10) {
        bf16_t* u = (bf16_t*)(p.ws + WS_U);
#pragma unroll
        for (int i = 0; i < MI; ++i) {
            const int row = m0 + wave * 16 * MI + i * 16 + l16;
#pragma unroll
            for (int j = 0; j < 8; ++j) {
                const f32x4 v = acc[i][j];
                st4bf(u + (size_t)row * 512 + (tn - 6) * 128 + j * 16 + quad * 4, geluf(v[0]), geluf(v[1]), geluf(v[2]), geluf(v[3]));
            }
        }
    } else {
        const int g = tn - 10;
        const float* gn = p.sgu_norm_g + j2 * 512 + g * 128;
        bf16_t* gvt = (bf16_t*)(p.ws + WS_GVT);
#pragma unroll
        for (int i = 0; i < MI; ++i) {
            const int row = m0 + wave * 16 * MI + i * 16 + l16;
            float ss = 0.f;
#pragma unroll
            for (int j = 0; j < 8; ++j) {
                f32x4 v = acc[i][j];
                v[0] = geluf(v[0]); v[1] = geluf(v[1]); v[2] = geluf(v[2]); v[3] = geluf(v[3]);
                acc[i][j] = v;
                ss += v[0] * v[0] + v[1] * v[1] + v[2] * v[2] + v[3] * v[3];
            }
            ss += __shfl_xor(ss, 16); ss += __shfl_xor(ss, 32);
            const float rstd = rsqrtf(ss * (1.f / 128.f) + EPS);
            const int chunk = row >> 7, pt = row & 127;
#pragma unroll
            for (int j = 0; j < 8; ++j) {
                const f32x4 gv = *(const f32x4*)(gn + j * 16 + quad * 4);
#pragma unroll
                for (int r = 0; r < 4; ++r) {
                    const int cc = g * 128 + j * 16 + quad * 4 + r;
                    gvt[((size_t)chunk * 512 + cc) * 128 + pt] = f2bf(acc[i][j][r] * rstd * gv[r]);
                }
            }
        }
    }
}

template <int MI>
__device__ __forceinline__ void epi_ssmin(CParams& p, int j2, int m0, int tn, const f32x4 (&acc)[MI][8]) {
    const int lane = tid_() & 63, wave = tid_() >> 6, l16 = lane & 15, quad = lane >> 4;
#pragma unroll
    for (int i = 0; i < MI; ++i) {
        const int row = m0 + wave * 16 * MI + i * 16 + l16;
        if (tn < 16) {
            bf16_t* z = (bf16_t*)(p.ws + WS_Z);
#pragma unroll
            for (int j = 0; j < 8; ++j) { const f32x4 v = acc[i][j]; st4bf(z + frag_off(row, tn * 128 + j * 16 + quad * 4, 2048), siluf(v[0]), siluf(v[1]), siluf(v[2]), siluf(v[3])); }
        } else if (tn < 40) {
            bf16_t* xb = (bf16_t*)(p.ws + WS_XBC) + (size_t)row * 3072 + (tn - 16) * 128;
#pragma unroll
            for (int j = 0; j < 8; ++j) { const f32x4 v = acc[i][j]; st4bf(xb + j * 16 + quad * 4, v[0], v[1], v[2], v[3]); }
        } else {
            float* dt = (float*)(p.ws + WS_DT) + (size_t)row * 64;
            const float* bias = p.ssm_dt_bias + j2 * 64;
#pragma unroll
            for (int j = 0; j < 4; ++j) {
                const int c = j * 16 + quad * 4;
                const f32x4 v = acc[i][j];
                f32x4 o;
                o[0] = softplusf(v[0] + bias[c + 0]); o[1] = softplusf(v[1] + bias[c + 1]);
                o[2] = softplusf(v[2] + bias[c + 2]); o[3] = softplusf(v[3] + bias[c + 3]);
                *(f32x4*)(dt + c) = o;
            }
        }
    }
}

enum { G_MIXIN = 0, G_MIXOUT, G_SSMIN, G_SSMOUT, G_FFNIN, G_FFNOUT };

template <int KIND>
__device__ void gemm_phase(CParams& p, int layer, bf16_t* smem) {
    const int j2 = layer >> 1;
    constexpr int lda = (KIND == G_SSMOUT) ? 2048 : (KIND == G_FFNOUT) ? FFH : 1024;
    constexpr int K = lda, ldw = K;
    constexpr int N = (KIND == G_MIXIN) ? MIXIN : (KIND == G_SSMIN) ? SSMIN_PAD : (KIND == G_FFNIN) ? 2 * FFH : 1024;
    constexpr size_t aoff = (KIND == G_MIXOUT) ? WS_AS : (KIND == G_SSMOUT) ? WS_YF : (KIND == G_FFNOUT) ? WS_HID : WS_HN;
    constexpr size_t woff = (KIND == G_MIXIN || KIND == G_SSMIN) ? WT_MIXIN : (KIND == G_MIXOUT || KIND == G_SSMOUT) ? WT_MIXOUT : (KIND == G_FFNIN) ? WT_FFNIN : WT_FFNOUT;
    const bf16_t* A = (const bf16_t*)(p.ws + aoff);
    const bf16_t* W = (const bf16_t*)(p.ws + WS_WT + woff);
    constexpr int MI = (KIND == G_MIXIN) ? 2 : 4;
    constexpr int FRAG = 1;
    constexpr int nN = N >> 7, nM = MT / (64 * MI);
    const float* mod = (const float*)(p.ws + WS_MOD) + (size_t)layer * 3 * 6144;
    bf16_t* sW = smem;
    if (N == 1024) {
        const int nlat = (ML / 256) * 8, nctx = layer == 3 ? 0 : (MC / 64) * 8;
        const float* gate = mod + (KIND == G_FFNOUT ? 5 : 2) * 1024;
        for (int t = blockIdx.x; t < nlat + nctx; t += gridDim.x) {
            if (t < nlat) {
                const int u = (gridDim.x == 512) ? ((t & 7) * 64 + (t >> 3)) : t;
                const int tm = u >> 3, tn = u & 7;
                f32x4 acc[4][8];
                gemm_tile<4, lda, ldw, K, FRAG>(A + (size_t)tm * 256 * lda, W + (size_t)tn * 128 * ldw, acc, sW);
                epi_resid<4>(p, tm * 256, tn * 128, acc, gate);
            } else {
                const int u = t - nlat, tm = u >> 3, tn = u & 7;
                f32x4 acc[1][8];
                gemm_tile<1, lda, ldw, K, FRAG>(A + (size_t)(ML + tm * 64) * lda, W + (size_t)tn * 128 * ldw, acc, sW);
                epi_resid<1>(p, ML + tm * 64, tn * 128, acc, gate);
            }
        }
        return;
    }
    constexpr int T = nM * nN, share = (T + 7) / 8, nsc = (nN + 7) / 8;
    const int xcd = blockIdx.x & 7, slot = blockIdx.x >> 3, nslot = gridDim.x >> 3;
    for (int li = slot; li < share; li += nslot) {
        const int u = xcd * share + li;
        if (u >= T) break;
        int sc = u / (nM * 8); if (sc > nsc - 1) sc = nsc - 1;
        const int rem = u - sc * nM * 8, wd = (sc == nsc - 1) ? (nN - 8 * sc) : 8;
        const int tm = rem / wd, tn = sc * 8 + rem - tm * wd;
        f32x4 acc[MI][8];
        gemm_tile<MI, lda, ldw, K, FRAG>(A + (size_t)tm * (64 * MI) * lda, W + (size_t)tn * 128 * ldw, acc, sW);
        if (KIND == G_MIXIN) epi_mixin<MI>(p, j2, tm * (64 * MI), tn, acc);
        else if (KIND == G_SSMIN) epi_ssmin<MI>(p, j2, tm * (64 * MI), tn, acc);
        else if (KIND == G_FFNIN) epi_swiglu<MI>(p, tm * (64 * MI), tn * 128, acc);
    }
}

__device__ void norm_phase(CParams& p, int layer, int which) {
    const int lane = tid_() & 63, wave = tid_() >> 6, l16 = lane & 15, quad = lane >> 4;
    const float* g = (which ? p.norm2_g : p.norm1_g) + layer * 1024;
    const float* mod = (const float*)(p.ws + WS_MOD) + (size_t)layer * 3 * 6144;
    bf16_t* hn = (bf16_t*)(p.ws + WS_HN);
    for (int tr = blockIdx.x * 4 + wave; tr < MT / 16; tr += gridDim.x * 4) {
        const int row0 = tr * 16;
        float myr = 0.f;
#pragma unroll 4
        for (int r = 0; r < 16; ++r) {
            const float* xr = xrow(p, row0 + r);
            float ss = 0.f;
#pragma unroll
            for (int i = 0; i < 4; ++i) { const f32x4 v = *(const f32x4*)(xr + i * 256 + lane * 4); ss += v[0] * v[0] + v[1] * v[1] + v[2] * v[2] + v[3] * v[3]; }
#pragma unroll
            for (int o = 1; o < 64; o <<= 1) ss += __shfl_xor(ss, o);
            const float rs = rsqrtf(ss * (1.f / 1024.f) + EPS);
            myr = (l16 == r) ? rs : myr;
        }
        const float* m = mod + (size_t)seg_of(row0) * 6144 + (which ? 3 * 1024 : 0);
        const float* xr = xrow(p, row0 + l16) + quad * 8;
        bf16_t* dst = hn + (size_t)tr * 32 * 512 + lane * 8;
#pragma unroll 4
        for (int kb = 0; kb < 32; ++kb) {
            const int col = kb * 32 + quad * 8;
            const f32x4 v0 = *(const f32x4*)(xr + kb * 32), v1 = *(const f32x4*)(xr + kb * 32 + 4);
            const f32x4 g0 = *(const f32x4*)(g + col), g1 = *(const f32x4*)(g + col + 4);
            const f32x4 sh0 = *(const f32x4*)(m + col), sh1 = *(const f32x4*)(m + col + 4);
            const f32x4 sc0 = *(const f32x4*)(m + 1024 + col), sc1 = *(const f32x4*)(m + 1024 + col + 4);
            const f32x4 y0 = (v0 * myr * g0) * (sc0 + 1.f) + sh0, y1 = (v1 * myr * g1) * (sc1 + 1.f) + sh1;
            u32x4 o; o.x = pack2(y0[0], y0[1]); o.y = pack2(y0[2], y0[3]); o.z = pack2(y1[0], y1[1]); o.w = pack2(y1[2], y1[3]);
            *(u32x4*)(dst + (size_t)kb * 512) = o;
        }
    }
}

__device__ void convert_wt(const float* __restrict__ W, int K, int N, bf16_t* __restrict__ Wt, int mode, float* tile) {
    const int tid = tid_();
    const int nKt = K >> 6, nNt = N >> 6;
    for (int t = blockIdx.x; t < nKt * nNt; t += gridDim.x) {
        const int kt = t / nNt, nt = t - kt * nNt;
        lds_sync();
#pragma unroll
        for (int i = 0; i < 16; ++i) {
            const int kk = (tid >> 6) + i * 4, nn = tid & 63;
            tile[kk * 65 + nn] = W[(size_t)(kt * 64 + kk) * N + nt * 64 + nn];
        }
        lds_sync();
        {
            const int nn = tid >> 2, kq = (tid & 3) * 16;
            const int n = nt * 64 + nn;
            int dr = n;
            if (mode == 1) { const int hm = n < FFH ? n : n - FFH; dr = (hm >> 4) * 32 + (hm & 15) + (n < FFH ? 0 : 16); }
            u32x4 o0, o1;
            o0.x = pack2(tile[(kq + 0) * 65 + nn], tile[(kq + 1) * 65 + nn]); o0.y = pack2(tile[(kq + 2) * 65 + nn], tile[(kq + 3) * 65 + nn]);
            o0.z = pack2(tile[(kq + 4) * 65 + nn], tile[(kq + 5) * 65 + nn]); o0.w = pack2(tile[(kq + 6) * 65 + nn], tile[(kq + 7) * 65 + nn]);
            o1.x = pack2(tile[(kq + 8) * 65 + nn], tile[(kq + 9) * 65 + nn]); o1.y = pack2(tile[(kq + 10) * 65 + nn], tile[(kq + 11) * 65 + nn]);
            o1.z = pack2(tile[(kq + 12) * 65 + nn], tile[(kq + 13) * 65 + nn]); o1.w = pack2(tile[(kq + 14) * 65 + nn], tile[(kq + 15) * 65 + nn]);
            bf16_t* dst = Wt + (size_t)dr * K + kt * 64 + kq;
            *(u32x4*)dst = o0; *(u32x4*)(dst + 8) = o1;
        }
    }
}

__device__ void convert_layer_weights(CParams& p, int layer, float* tile) {
    unsigned char* wt = p.ws + WS_WT;
    const int j2 = layer >> 1;
    convert_wt(p.ffn_w_in + (size_t)layer * 1024 * 2 * FFH, 1024, 2 * FFH, (bf16_t*)(wt + WT_FFNIN), 1, tile);
    convert_wt(p.ffn_w_out + (size_t)layer * FFH * 1024, FFH, 1024, (bf16_t*)(wt + WT_FFNOUT), 0, tile);
    if ((layer & 1) == 0) {
        convert_wt(p.mix_w_in + (size_t)j2 * 1024 * MIXIN, 1024, MIXIN, (bf16_t*)(wt + WT_MIXIN), 0, tile);
        convert_wt(p.mix_w_out + (size_t)j2 * 1024 * 1024, 1024, 1024, (bf16_t*)(wt + WT_MIXOUT), 0, tile);
    } else {
        convert_wt(p.ssm_w_in + (size_t)j2 * 1024 * SSMIN, 1024, SSMIN, (bf16_t*)(wt + WT_MIXIN), 0, tile);
        convert_wt(p.ssm_w_out + (size_t)j2 * SSI * 1024, SSI, 1024, (bf16_t*)(wt + WT_MIXOUT), 0, tile);
        bf16_t* padp = (bf16_t*)(wt + WT_MIXIN) + (size_t)SSMIN * 1024;
        for (int i = blockIdx.x * 256 + tid_(); i < (SSMIN_PAD - SSMIN) * 1024; i += gridDim.x * 256) padp[i] = 0;
    }
}

__device__ void prologue(CParams& p, float* smf) {
    const int tid = tid_();
    const size_t gtid = (size_t)blockIdx.x * 256 + tid, gsz = (size_t)gridDim.x * 256;
    {
        const f32x4* s = (const f32x4*)p.x; f32x4* d = (f32x4*)p.out;
        for (size_t i = gtid; i < (size_t)ML * D / 4; i += gsz) d[i] = s[i];
        const f32x4* s2 = (const f32x4*)p.ctx; f32x4* d2 = (f32x4*)(p.ws + WS_XCTX);
        for (size_t i = gtid; i < (size_t)MC * D / 4; i += gsz) d2[i] = s2[i];
    }
    {
        float* cosT = (float*)(p.ws + WS_ROPE); float* sinT = cosT + 8192 * 32;
        for (size_t i = gtid; i < (size_t)8192 * 32; i += gsz) {
            const int s = (int)(i >> 5), j = (int)(i & 31), f = j & 15;
            const float inv = powf(10000.f, -(float)f / 16.f);
            const float pos = (float)(j < 16 ? (s >> 6) : (s & 63));
            const float ang = pos * inv;
            cosT[i] = cosf(ang); sinT[i] = sinf(ang);
        }
    }
    {
        bf16_t* sgw = (bf16_t*)(p.ws + WS_SGW);
        for (size_t i = gtid; i < (size_t)2 * 4 * 128 * 128; i += gsz) sgw[i] = f2bf(p.sgu_w[i]);
    }
    {
        float* sc = smf;
        float* red = smf + 3 * 1024;
        lds_sync();
        for (int i = tid; i < 3 * 1024; i += 256) {
            const int sgi = i >> 10, k = i & 1023;
            const float v = sgi < 2 ? p.c[sgi * 1024 + k] : p.c_ctx[k];
            sc[i] = siluf(v);
        }
        lds_sync();
        float* mod = (float*)(p.ws + WS_MOD);
        const int cl = tid & 63, kg = tid >> 6;
        for (int wi = blockIdx.x; wi < 4 * 96; wi += gridDim.x) {
            const int layer = wi / 96, cb = wi - layer * 96;
            const float* w = p.ada_w + (size_t)layer * 1024 * 6144 + cb * 64 + cl;
            float s0 = 0.f, s1 = 0.f, s2 = 0.f;
            for (int k = kg * 256; k < kg * 256 + 256; ++k) {
                const float wv = w[(size_t)k * 6144];
                s0 += sc[k] * wv; s1 += sc[1024 + k] * wv; s2 += sc[2048 + k] * wv;
            }
            lds_sync();
            red[(kg * 3 + 0) * 64 + cl] = s0; red[(kg * 3 + 1) * 64 + cl] = s1; red[(kg * 3 + 2) * 64 + cl] = s2;
            lds_sync();
            if (tid < 192) {
                const int sgi = tid >> 6;
                const float v = red[(0 * 3 + sgi) * 64 + cl] + red[(1 * 3 + sgi) * 64 + cl] + red[(2 * 3 + sgi) * 64 + cl] + red[(3 * 3 + sgi) * 64 + cl];
                const int n = cb * 64 + cl;
                mod[((size_t)layer * 3 + sgi) * 6144 + n] = v + p.ada_b[layer * 6144 + n];
            }
        }
        lds_sync();
    }
    convert_layer_weights(p, 0, smf);
}

__device__ __forceinline__ void attn_item(CParams& p, int j2, int b, int h, int q0row, int nkeys, bf16_t* smem) {
    const int tid = tid_(), lane = tid & 63, wave = tid >> 6, l16 = lane & 15, quad = lane >> 4;
    const int kh = h >> 2;
    const bf16_t* Q = (const bf16_t*)(p.ws + WS_Q);
    const bf16_t* Kb = (const bf16_t*)(p.ws + WS_K) + (size_t)b * TALL * 128 + kh * 64;
    const bf16_t* Vb = (const bf16_t*)(p.ws + WS_VT) + (size_t)(b * 2 + kh) * 64 * TALL;
    bf16_t* sK = smem; bf16_t* sV = smem + 64 * GST;
    constexpr float LOG2E = 1.4426950408889634f;
    float mb;
    {
        float gq = fabsf(p.q_norm_g[j2 * 64 + lane]), gk = fabsf(p.k_norm_g[j2 * 64 + lane]);
#pragma unroll
        for (int o = 1; o < 64; o <<= 1) { gq = fmaxf(gq, __shfl_xor(gq, o)); gk = fmaxf(gk, __shfl_xor(gk, o)); }
        mb = 8.f * 1.02f * gq * gk * LOG2E;
    }
    bf16x8 qf[4][2];
#pragma unroll
    for (int i = 0; i < 4; ++i)
#pragma unroll
        for (int ks = 0; ks < 2; ++ks)
            qf[i][ks] = *(const bf16x8*)(Q + (size_t)(q0row + wave * 64 + i * 16 + l16) * 512 + h * 64 + ks * 32 + quad * 8);
    f32x4 o[5][4];
#pragma unroll
    for (int d = 0; d < 5; ++d)
#pragma unroll
        for (int i = 0; i < 4; ++i) o[d][i] = (f32x4){0.f, 0.f, 0.f, 0.f};
    lds_sync();
    {
        const int r = 64 + (tid >> 4);
        u32x2 one; one.x = r == 64 ? 0x3F803F80u : 0u; one.y = one.x;
        *(u32x2*)(sV + r * GST + (tid & 15) * 4) = one;
    }
    const int srow = tid >> 3, skc = (tid & 7) * 8;
    u32x4 rk[2], rv[2];
#pragma unroll
    for (int i = 0; i < 2; ++i) {
        rk[i] = *(const u32x4*)(Kb + (size_t)(srow + i * 32) * 128 + skc);
        rv[i] = *(const u32x4*)(Vb + (size_t)(srow + i * 32) * TALL + skc);
    }
    const int nt = nkeys >> 6;
#pragma unroll 1
    for (int kt = 0; kt < nt; ++kt) {
        lds_sync();
#pragma unroll
        for (int i = 0; i < 2; ++i) {
            *(u32x4*)(sK + (srow + i * 32) * GST + skc) = rk[i];
            *(u32x4*)(sV + (srow + i * 32) * GST + skc) = rv[i];
        }
        lds_sync();
        {
            const int t0 = (kt + 1 < nt ? kt + 1 : kt) << 6;
#pragma unroll
            for (int i = 0; i < 2; ++i) {
                rk[i] = *(const u32x4*)(Kb + (size_t)(t0 + srow + i * 32) * 128 + skc);
                rv[i] = *(const u32x4*)(Vb + (size_t)(srow + i * 32) * TALL + t0 + skc);
            }
        }
        bf16x8 pf[2][4];
#pragma unroll
        for (int ih = 0; ih < 2; ++ih) {
            f32x4 s[4][2];
#pragma unroll
            for (int tt = 0; tt < 4; ++tt)
#pragma unroll
                for (int i = 0; i < 2; ++i) s[tt][i] = (f32x4){-mb, -mb, -mb, -mb};
#pragma unroll
            for (int ks = 0; ks < 2; ++ks)
#pragma unroll
                for (int tt = 0; tt < 4; ++tt) {
                    const bf16x8 kf = lds16(sK + (tt * 16 + l16) * GST + ks * 32 + quad * 8);
#pragma unroll
                    for (int i = 0; i < 2; ++i) s[tt][i] = mfma16(kf, qf[ih * 2 + i][ks], s[tt][i]);
                }
#pragma unroll
            for (int i = 0; i < 2; ++i) {
#pragma unroll
                for (int tt = 0; tt < 4; ++tt) {
#pragma unroll
                    for (int r = 0; r < 4; ++r) s[tt][i][r] = __builtin_amdgcn_exp2f(s[tt][i][r]);
                }
#pragma unroll
                for (int ksp = 0; ksp < 2; ++ksp) pf[ksp][ih * 2 + i] = pack8(s[2 * ksp][i], s[2 * ksp + 1][i]);
            }
        }
#pragma unroll
        for (int ksp = 0; ksp < 2; ++ksp)
#pragma unroll
            for (int d = 0; d < 5; ++d) {
                const bf16_t* vp = sV + (d * 16 + l16) * GST + ksp * 32 + quad * 4;
                const bf16x8 vf = lds8x2(vp, vp + 16);
#pragma unroll
                for (int i = 0; i < 4; ++i) o[d][i] = mfma16(vf, pf[ksp][i], o[d][i]);
            }
    }
    bf16_t* as = (bf16_t*)(p.ws + WS_AS);
#pragma unroll
    for (int i = 0; i < 4; ++i) {
        const float l = __shfl(o[4][i][0], l16);
        const float inv = 1.f / l;
        const int row = q0row + wave * 64 + i * 16 + l16;
#pragma unroll
        for (int d = 0; d < 4; ++d)
            st4bf(as + frag_off(row, h * 64 + d * 16 + quad * 4, 1024), o[d][i][0] * inv, o[d][i][1] * inv, o[d][i][2] * inv, o[d][i][3] * inv);
    }
}

__device__ void sg_item(CParams& p, int j2, int chunk, int g, bf16_t* smem) {
    const int lane = tid_() & 63, wave = tid_() >> 6, l16 = lane & 15, quad = lane >> 4;
    const bf16_t* A = (const bf16_t*)(p.ws + WS_SGW) + (size_t)(j2 * 4 + g) * 128 * 128;
    const bf16_t* W = (const bf16_t*)(p.ws + WS_GVT) + ((size_t)chunk * 512 + g * 128) * 128;
    f32x4 acc[2][8];
    gemm_tile<2, 128, 128, 128>(A, W, acc, smem);
    const bf16_t* u = (const bf16_t*)(p.ws + WS_U);
    bf16_t* as = (bf16_t*)(p.ws + WS_AS);
    const float* bs = p.sgu_b + (size_t)(j2 * 4 + g) * 128;
#pragma unroll
    for (int i = 0; i < 2; ++i) {
        const int pt = wave * 32 + i * 16 + l16;
        const int row = chunk * 128 + pt;
        const float bias = bs[pt];
#pragma unroll
        for (int j = 0; j < 8; ++j) {
            const int c = g * 128 + j * 16 + quad * 4;
            const u32x2 uw = *(const u32x2*)(u + (size_t)row * 512 + c);
            const float u0 = __uint_as_float(uw.x << 16), u1 = __uint_as_float(uw.x & 0xffff0000u);
            const float u2 = __uint_as_float(uw.y << 16), u3 = __uint_as_float(uw.y & 0xffff0000u);
            const f32x4 v = acc[i][j];
            st4bf(as + frag_off(row, 512 + c, 1024), u0 * (v[0] + bias), u1 * (v[1] + bias), u2 * (v[2] + bias), u3 * (v[3] + bias));
        }
    }
}

__device__ void attn_sg_phase(CParams& p, int layer, bf16_t* smem) {
    const int j2 = layer >> 1;
    const int nA = NB * 8 * 32, nS = (MT / 128) * 4, nC = NB * 8;
    for (int t = blockIdx.x; t < nA + nS + nC; t += gridDim.x) {
        if (t < nA) {
            const int xcd = t & 7, li = t >> 3;
            const int bh = xcd * 2 + (li >> 5), qb = li & 31;
            attn_item(p, j2, bh >> 3, bh & 7, (bh >> 3) * SEQ + qb * 256, TALL, smem);
        } else if (t < nA + nS) {
            const int u = t - nA;
            sg_item(p, j2, u >> 2, u & 3, smem);
        } else {
            const int u = t - nA - nS;
            const int h = u & 7, b = u >> 3;
            attn_item(p, j2, b, h, ML + b * CTX, CTX, smem);
        }
    }
}

__device__ void conv_phase(CParams& p, int layer, float* smf) {
    const int j2 = layer >> 1, tid = tid_();
    const bf16_t* xbc = (const bf16_t*)(p.ws + WS_XBC);
    bf16_t* XT = (bf16_t*)(p.ws + WS_XT); bf16_t* Bn = (bf16_t*)(p.ws + WS_BN); bf16_t* Cn = (bf16_t*)(p.ws + WS_CN); bf16_t* BT = (bf16_t*)(p.ws + WS_BT);
    const float* cw = p.ssm_conv_w + (size_t)j2 * 3 * 3072;
    const float* cb = p.ssm_conv_b + (size_t)j2 * 3072;
    float* sin_ = smf;
    float* sout = smf + 66 * 65;
    const int nCt = 3072 / 64, nRt = MT / 64;
    for (int t = blockIdx.x; t < nCt * nRt; t += gridDim.x) {
        const int rt = t / nCt, ct = t - rt * nCt;
        const int r0 = rt * 64, c0 = ct * 64;
        const bool first = r0 < ML ? ((r0 & (SEQ - 1)) == 0) : (((r0 - ML) & (CTX - 1)) == 0);
        const bool last = r0 < ML ? (((r0 + 64) & (SEQ - 1)) == 0) : ((((r0 + 64) - ML) & (CTX - 1)) == 0);
        lds_sync();
        for (int e = tid; e < 66 * 8; e += 256) {
            const int rr = e >> 3, c8 = (e & 7) * 8;
            const int row = r0 - 1 + rr;
            u32x4 v = (u32x4){0u, 0u, 0u, 0u};
            if (!((rr == 0 && first) || (rr == 65 && last))) v = *(const u32x4*)(xbc + (size_t)row * 3072 + c0 + c8);
            float* d = sin_ + rr * 65 + c8;
            d[0] = __uint_as_float(v.x << 16); d[1] = __uint_as_float(v.x & 0xffff0000u);
            d[2] = __uint_as_float(v.y << 16); d[3] = __uint_as_float(v.y & 0xffff0000u);
            d[4] = __uint_as_float(v.z << 16); d[5] = __uint_as_float(v.z & 0xffff0000u);
            d[6] = __uint_as_float(v.w << 16); d[7] = __uint_as_float(v.w & 0xffff0000u);
        }
        lds_sync();
        {
            const int c = tid & 63;
            const float w0 = cw[c0 + c], w1 = cw[3072 + c0 + c], w2 = cw[2 * 3072 + c0 + c], bb = cb[c0 + c];
#pragma unroll
            for (int k = 0; k < 16; ++k) {
                const int tt = (tid >> 6) + k * 4;
                const float v = w0 * sin_[tt * 65 + c] + w1 * sin_[(tt + 1) * 65 + c] + w2 * sin_[(tt + 2) * 65 + c] + bb;
                sout[c * 65 + tt] = siluf(v);
            }
        }
        lds_sync();
        const int q = tid >> 2, e16 = (tid & 3) * 16;
        if (c0 >= 2048) {
            u32x4 o0, o1;
            o0.x = pack2(sout[(e16 + 0) * 65 + q], sout[(e16 + 1) * 65 + q]); o0.y = pack2(sout[(e16 + 2) * 65 + q], sout[(e16 + 3) * 65 + q]);
            o0.z = pack2(sout[(e16 + 4) * 65 + q], sout[(e16 + 5) * 65 + q]); o0.w = pack2(sout[(e16 + 6) * 65 + q], sout[(e16 + 7) * 65 + q]);
            o1.x = pack2(sout[(e16 + 8) * 65 + q], sout[(e16 + 9) * 65 + q]); o1.y = pack2(sout[(e16 + 10) * 65 + q], sout[(e16 + 11) * 65 + q]);
            o1.z = pack2(sout[(e16 + 12) * 65 + q], sout[(e16 + 13) * 65 + q]); o1.w = pack2(sout[(e16 + 14) * 65 + q], sout[(e16 + 15) * 65 + q]);
            if (c0 < 2560) {
                bf16_t* dst = Bn + (c0 - 2048) + (size_t)(r0 + q) * 512 + e16;
                *(u32x4*)dst = o0; *(u32x4*)(dst + 8) = o1;
            } else {
                *(u32x4*)(Cn + frag_off(r0 + q, c0 - 2560 + e16, 512)) = o0;
                *(u32x4*)(Cn + frag_off(r0 + q, c0 - 2560 + e16 + 8, 512)) = o1;
            }
        }
        if (c0 < 2560) {
            const float* sp = sout + q * 65 + e16;
            u32x4 o0, o1;
            o0.x = pack2(sp[0], sp[1]); o0.y = pack2(sp[2], sp[3]); o0.z = pack2(sp[4], sp[5]); o0.w = pack2(sp[6], sp[7]);
            o1.x = pack2(sp[8], sp[9]); o1.y = pack2(sp[10], sp[11]); o1.z = pack2(sp[12], sp[13]); o1.w = pack2(sp[14], sp[15]);
            if (c0 < 2048) {
                bf16_t* dst = XT + (size_t)(c0 + q) * MT + r0 + e16;
                *(u32x4*)dst = o0; *(u32x4*)(dst + 8) = o1;
            } else {
                *(u32x4*)(BT + frag_off(c0 - 2048 + q, r0 + e16, MT)) = o0;
                *(u32x4*)(BT + frag_off(c0 - 2048 + q, r0 + e16 + 8, MT)) = o1;
            }
        }
    }
}

__device__ void ssd_diag_item(CParams& p, int j2, int row0, int h, bf16_t* smem) {
    const int tid = tid_(), lane = tid & 63, wave = tid >> 6, l16 = lane & 15, quad = lane >> 4;
    const int g = h >> 3;
    bf16_t* sB = smem;
    bf16_t* sX = sB + 128 * SST;
    float* sda = (float*)(sX + 64 * SST);
    float* sPf = sda + 256;
    float* sRb = sPf + 128;
    float* sdtf = sRb + 128;
    float* sdtb = sdtf + 128;
    const bf16_t* XT = (const bf16_t*)(p.ws + WS_XT) + (size_t)(h * 64) * MT;
    const bf16_t* Bn = (const bf16_t*)(p.ws + WS_BN) + g * 128;
    const bf16_t* Cn = (const bf16_t*)(p.ws + WS_CN) + (size_t)(g * 4) * 512;
    const float* DT = (const float*)(p.ws + WS_DT);
    bf16_t* Y = (bf16_t*)(p.ws + WS_YF);
    const float af = -expf(p.ssm_a_log[(j2 * 2 + 0) * 32 + h]);
    const float ab = -expf(p.ssm_a_log[(j2 * 2 + 1) * 32 + h]);
    const float dsk = p.ssm_d[j2 * 32 + h];
    lds_sync();
#pragma unroll
    for (int i = 0; i < 8; ++i) {
        const int c = tid + i * 256, r = c >> 4, kc = (c & 15) * 8;
        *(u32x4*)(sB + r * SST + kc) = *(const u32x4*)(Bn + (size_t)(row0 + r) * 512 + kc);
    }
#pragma unroll
    for (int i = 0; i < 4; ++i) {
        const int c = tid + i * 256, r = c >> 4, kc = (c & 15) * 8;
        *(u32x4*)(sX + r * SST + kc) = *(const u32x4*)(XT + (size_t)r * MT + row0 + kc);
    }
    {
        const int d = wave >> 1;
        const float d0 = DT[(size_t)(row0 + lane) * 64 + d * 32 + h], d1 = DT[(size_t)(row0 + 64 + lane) * 64 + d * 32 + h];
        const float aa = d ? ab : af;
        const f32x2 sc2 = scan128(d0 * aa, d1 * aa, lane, d);
        float* sc = d ? sRb : sPf; float* sd = d ? sdtb : sdtf;
        if ((wave & 1) == 0) { sc[lane] = sc2.x; sd[lane] = d0; } else { sc[64 + lane] = sc2.y; sd[64 + lane] = d1; }
    }
    bf16x8 cf[2][4];
#pragma unroll
    for (int i = 0; i < 2; ++i)
#pragma unroll
        for (int ks = 0; ks < 4; ++ks)
            cf[i][ks] = *(const bf16x8*)(Cn + ((size_t)((row0 >> 4) + wave * 2 + i) * 16 + ks) * 512 + lane * 8);
    lds_sync();
    float pfl[2], rbl[2];
#pragma unroll
    for (int i = 0; i < 2; ++i) { pfl[i] = sPf[wave * 32 + i * 16 + l16]; rbl[i] = sRb[wave * 32 + i * 16 + l16]; }
    f32x4 y[4][2];
#pragma unroll
    for (int pt = 0; pt < 4; ++pt)
#pragma unroll
        for (int i = 0; i < 2; ++i) y[pt][i] = (f32x4){0.f, 0.f, 0.f, 0.f};
#pragma unroll 1
    for (int sp = 0; sp < 4; ++sp) {
        f32x4 gt[2][2];
#pragma unroll
        for (int s2 = 0; s2 < 2; ++s2)
#pragma unroll
            for (int i = 0; i < 2; ++i) gt[s2][i] = (f32x4){0.f, 0.f, 0.f, 0.f};
#pragma unroll
        for (int ks = 0; ks < 4; ++ks)
#pragma unroll
            for (int s2 = 0; s2 < 2; ++s2) {
                const bf16x8 bfr = lds16(sB + (sp * 32 + s2 * 16 + l16) * SST + ks * 32 + quad * 8);
#pragma unroll
                for (int i = 0; i < 2; ++i) gt[s2][i] = mfma16(bfr, cf[i][ks], gt[s2][i]);
            }
        bf16x8 mf[2];
#pragma unroll
        for (int i = 0; i < 2; ++i) {
            const int l = wave * 32 + i * 16 + l16;
#pragma unroll
            for (int s2 = 0; s2 < 2; ++s2)
#pragma unroll
                for (int r = 0; r < 4; ++r) {
                    const int s = sp * 32 + s2 * 16 + quad * 4 + r;
                    const float arg = s < l ? (pfl[i] - sPf[s]) : (rbl[i] - sRb[s]);
                    float coef = __expf(fminf(arg, 0.f)) * (s < l ? sdtf[s] : sdtb[s]);
                    if (s == l) coef = sdtf[s] + sdtb[s];
                    gt[s2][i][r] *= coef;
                }
            mf[i] = pack8(gt[0][i], gt[1][i]);
        }
#pragma unroll
        for (int pt = 0; pt < 4; ++pt) {
            const bf16_t* xp = sX + (pt * 16 + l16) * SST + sp * 32 + quad * 4;
            const bf16x8 xf = lds8x2(xp, xp + 16);
#pragma unroll
            for (int i = 0; i < 2; ++i) y[pt][i] = mfma16(xf, mf[i], y[pt][i]);
        }
    }
#pragma unroll
    for (int i = 0; i < 2; ++i) {
        const int l = wave * 32 + i * 16 + l16;
#pragma unroll
        for (int pt = 0; pt < 4; ++pt) {
            f32x4 v = y[pt][i];
#pragma unroll
            for (int r = 0; r < 4; ++r) v[r] += dsk * bf2f(sX[(pt * 16 + quad * 4 + r) * SST + l]);
            st4bf(Y + frag_off(row0 + l, h * 64 + pt * 16 + quad * 4, 2048), v[0], v[1], v[2], v[3]);
        }
    }
}

__device__ void ssd_diag_phase(CParams& p, int layer, bf16_t* smem) {
    const int j2 = layer >> 1;
    for (int t = blockIdx.x; t < (MT / 128) * 32; t += gridDim.x) {
        const int h = t & 31, chunk = t >> 5;
        ssd_diag_item(p, j2, chunk * 128, h, smem);
    }
}

struct SsdPre { u32x4 xq; u32x4 bt[2][4]; u32x4 cf[2][4]; u32x2 yold[2]; float dt0, dt1; };

__device__ __forceinline__ int ssd_row0(int b, int dir, int cc) {
    if (cc < 2) { const int ci = dir ? 1 - cc : cc; return ML + b * CTX + ci * 128; }
    const int k = cc - 2; const int ci = dir ? 63 - k : k; return b * SEQ + ci * 128;
}

__device__ __forceinline__ void ssd_scan_item(CParams& p, int j2, int b, int dir, int h, int pq, bf16_t* smem) {
    const int tid = tid_(), lane = tid & 63, wave = tid >> 6, l16 = lane & 15, quad = lane >> 4;
    const int g = h >> 3;
    bf16_t* sX = smem;
    bf16_t* sH = sX + 16 * SST;
    float* seacs = (float*)(sH + 16 * SST);
    float* sw = seacs + 128;
    float* sdec = sw + 128;
    const bf16_t* XT = (const bf16_t*)(p.ws + WS_XT) + (size_t)(h * 64 + pq * 16 + (tid >> 4)) * MT + (tid & 15) * 8;
    const bf16_t* Cn = (const bf16_t*)(p.ws + WS_CN) + ((size_t)(wave * 2) * 16 + g * 4) * 512 + lane * 8;
    const bf16_t* BT = (const bf16_t*)(p.ws + WS_BT) + (size_t)(g * 8 + wave * 2) * (MT / 32) * 512 + lane * 8;
    const float* DT = (const float*)(p.ws + WS_DT) + dir * 32 + h;
    bf16_t* Y = (bf16_t*)(p.ws + (dir ? WS_YB : WS_YF)) + frag_off(wave * 32 + l16, h * 64 + pq * 16 + quad * 4, 2048);
    const float a = -expf(p.ssm_a_log[(j2 * 2 + dir) * 32 + h]);
    f32x4 st[2];
    st[0] = (f32x4){0.f, 0.f, 0.f, 0.f}; st[1] = (f32x4){0.f, 0.f, 0.f, 0.f};
    SsdPre S0, S1;
    auto load_small = [&](SsdPre& S, int r) __attribute__((always_inline)) {
        S.xq = *(const u32x4*)(XT + r);
        S.dt0 = DT[(size_t)(r + lane) * 64]; S.dt1 = DT[(size_t)(r + 64 + lane) * 64];
    };
    auto load_cf = [&](SsdPre& S, int r) __attribute__((always_inline)) {
#pragma unroll
        for (int i = 0; i < 2; ++i)
#pragma unroll
            for (int ks = 0; ks < 4; ++ks) S.cf[i][ks] = *(const u32x4*)(Cn + ((size_t)((r >> 4) + i) * 16 + ks) * 512);
    };
    auto load_yold = [&](SsdPre& S, int r) __attribute__((always_inline)) {
#pragma unroll
        for (int i = 0; i < 2; ++i) S.yold[i] = dir == 0 ? *(const u32x2*)(Y + (size_t)((r >> 4) + i) * (64 * 512)) : (u32x2){0u, 0u};
    };
    auto load_bt = [&](SsdPre& S, int r) __attribute__((always_inline)) {
#pragma unroll
        for (int nt = 0; nt < 2; ++nt)
#pragma unroll
            for (int ks = 0; ks < 4; ++ks) S.bt[nt][ks] = *(const u32x4*)(BT + ((size_t)nt * (MT / 32) + (r >> 5) + ks) * 512);
    };
    {
        const int r0 = ssd_row0(b, dir, 0), r1 = ssd_row0(b, dir, 1);
        load_small(S0, r0); load_cf(S0, r0); load_yold(S0, r0); load_bt(S0, r0);
        load_small(S1, r1); load_cf(S1, r1); load_yold(S1, r1); load_bt(S1, r1);
    }
    auto body = [&](SsdPre& S, int cc) __attribute__((always_inline)) {
        const int row0 = ssd_row0(b, dir, cc);
        const int row2 = ssd_row0(b, dir, cc + 2 < 66 ? cc + 2 : 65);
        lds_sync();
        *(u32x4*)(sX + (tid >> 4) * SST + (tid & 15) * 8) = S.xq;
#pragma unroll
        for (int nt = 0; nt < 2; ++nt) st4bf(sH + l16 * SST + wave * 32 + nt * 16 + quad * 4, st[nt][0], st[nt][1], st[nt][2], st[nt][3]);
        if (wave < 2) {
            const f32x2 sc2 = scan128(S.dt0 * a, S.dt1 * a, lane, dir);
            const float total = dir == 0 ? __shfl(sc2.y, 63) : __shfl(sc2.x, 0);
            if (wave == 0) { seacs[lane] = __expf(sc2.x); sw[lane] = S.dt0 * __expf(total - sc2.x); if (lane == 0) sdec[0] = __expf(total); }
            else { seacs[64 + lane] = __expf(sc2.y); sw[64 + lane] = S.dt1 * __expf(total - sc2.y); }
        }
        lds_sync();
        load_small(S, row2);
        f32x4 yo[2];
        yo[0] = (f32x4){0.f, 0.f, 0.f, 0.f}; yo[1] = (f32x4){0.f, 0.f, 0.f, 0.f};
#pragma unroll
        for (int ks = 0; ks < 4; ++ks) {
            const bf16x8 hf = lds16(sH + l16 * SST + ks * 32 + quad * 8);
#pragma unroll
            for (int i = 0; i < 2; ++i) yo[i] = mfma16(hf, __builtin_bit_cast(bf16x8, S.cf[i][ks]), yo[i]);
        }
        __builtin_amdgcn_sched_barrier(0);
        load_cf(S, row2);
#pragma unroll
        for (int i = 0; i < 2; ++i) {
            const float e = seacs[wave * 32 + i * 16 + l16];
            const float o0 = __uint_as_float(S.yold[i].x << 16), o1 = __uint_as_float(S.yold[i].x & 0xffff0000u);
            const float o2 = __uint_as_float(S.yold[i].y << 16), o3 = __uint_as_float(S.yold[i].y & 0xffff0000u);
            st4bf(Y + (size_t)((row0 >> 4) + i) * (64 * 512), yo[i][0] * e + o0, yo[i][1] * e + o1, yo[i][2] * e + o2, yo[i][3] * e + o3);
        }
        __builtin_amdgcn_sched_barrier(0);
        load_yold(S, row2);
        {
            const float dec = sdec[0];
            st[0] *= dec; st[1] *= dec;
#pragma unroll
            for (int ks = 0; ks < 4; ++ks) {
                const f32x4 w0 = *(const f32x4*)(sw + ks * 32 + quad * 8), w1 = *(const f32x4*)(sw + ks * 32 + quad * 8 + 4);
                const u32x4 raw = *(const u32x4*)(sX + l16 * SST + ks * 32 + quad * 8);
                u32x4 xs;
                xs.x = pack2(__uint_as_float(raw.x << 16) * w0[0], __uint_as_float(raw.x & 0xffff0000u) * w0[1]);
                xs.y = pack2(__uint_as_float(raw.y << 16) * w0[2], __uint_as_float(raw.y & 0xffff0000u) * w0[3]);
                xs.z = pack2(__uint_as_float(raw.z << 16) * w1[0], __uint_as_float(raw.z & 0xffff0000u) * w1[1]);
                xs.w = pack2(__uint_as_float(raw.w << 16) * w1[2], __uint_as_float(raw.w & 0xffff0000u) * w1[3]);
                const bf16x8 xbf = __builtin_bit_cast(bf16x8, xs);
#pragma unroll
                for (int nt = 0; nt < 2; ++nt) st[nt] = mfma16(__builtin_bit_cast(bf16x8, S.bt[nt][ks]), xbf, st[nt]);
            }
        }
        __builtin_amdgcn_sched_barrier(0);
        load_bt(S, row2);
    };
#pragma unroll 1
    for (int cc = 0; cc < 66; cc += 2) {
        body(S0, cc);
        body(S1, cc + 1);
    }
}

__device__ void ssd_scan_phase(CParams& p, int layer, bf16_t* smem) {
    const int j2 = layer >> 1;
    for (int t = blockIdx.x; t < NB * 2 * 32 * 4; t += gridDim.x) {
        const int xcd = t & 7, li = t >> 3, gi = xcd * 2 + (li >> 5);
        const int pq = li & 3, h = (gi & 3) * 8 + ((li & 31) >> 2), dir = (gi >> 2) & 1, b = gi >> 3;
        ssd_scan_item(p, j2, b, dir, h, pq, smem);
    }
}

__device__ void finish_phase(CParams& p, int layer) {
    const int j2 = layer >> 1, lane = tid_() & 63, wave = tid_() >> 6, quad = lane >> 4;
    bf16_t* yf = (bf16_t*)(p.ws + WS_YF); const bf16_t* yb = (const bf16_t*)(p.ws + WS_YB); const bf16_t* z = (const bf16_t*)(p.ws + WS_Z);
    const float* gn = p.ssm_norm_g + (size_t)j2 * 2048;
    for (int tr = blockIdx.x * 4 + wave; tr < MT / 16; tr += gridDim.x * 4) {
        const size_t base = (size_t)tr * 64 * 512 + lane * 8;
#pragma unroll 1
        for (int g = 0; g < 4; ++g) {
            float ss = 0.f;
#pragma unroll 4
            for (int kk = 0; kk < 16; ++kk) {
                const size_t off = base + (size_t)(g * 16 + kk) * 512;
                const u32x4 a = *(const u32x4*)(yf + off), bq = *(const u32x4*)(yb + off), zq = *(const u32x4*)(z + off);
                const unsigned aw[4] = {a.x, a.y, a.z, a.w}, bw[4] = {bq.x, bq.y, bq.z, bq.w}, zw[4] = {zq.x, zq.y, zq.z, zq.w};
#pragma unroll
                for (int k = 0; k < 4; ++k) {
                    const float v0 = (__uint_as_float(aw[k] << 16) + __uint_as_float(bw[k] << 16)) * __uint_as_float(zw[k] << 16);
                    const float v1 = (__uint_as_float(aw[k] & 0xffff0000u) + __uint_as_float(bw[k] & 0xffff0000u)) * __uint_as_float(zw[k] & 0xffff0000u);
                    ss += v0 * v0 + v1 * v1;
                }
            }
            ss += __shfl_xor(ss, 16); ss += __shfl_xor(ss, 32);
            const float rstd = rsqrtf(ss * (1.f / 512.f) + EPS);
#pragma unroll 4
            for (int kk = 0; kk < 16; ++kk) {
                const size_t off = base + (size_t)(g * 16 + kk) * 512;
                const u32x4 a = *(const u32x4*)(yf + off), bq = *(const u32x4*)(yb + off), zq = *(const u32x4*)(z + off);
                const unsigned aw[4] = {a.x, a.y, a.z, a.w}, bw[4] = {bq.x, bq.y, bq.z, bq.w}, zw[4] = {zq.x, zq.y, zq.z, zq.w};
                const int col = (g * 16 + kk) * 32 + quad * 8;
                const f32x4 g0 = *(const f32x4*)(gn + col), g1 = *(const f32x4*)(gn + col + 4);
                const float gg[8] = {g0[0], g0[1], g0[2], g0[3], g1[0], g1[1], g1[2], g1[3]};
                unsigned ow[4];
#pragma unroll
                for (int k = 0; k < 4; ++k) {
                    const float v0 = (__uint_as_float(aw[k] << 16) + __uint_as_float(bw[k] << 16)) * __uint_as_float(zw[k] << 16);
                    const float v1 = (__uint_as_float(aw[k] & 0xffff0000u) + __uint_as_float(bw[k] & 0xffff0000u)) * __uint_as_float(zw[k] & 0xffff0000u);
                    ow[k] = pack2(v0 * rstd * gg[2 * k], v1 * rstd * gg[2 * k + 1]);
                }
                u32x4 o4; o4.x = ow[0]; o4.y = ow[1]; o4.z = ow[2]; o4.w = ow[3];
                *(u32x4*)(yf + off) = o4;
            }
        }
    }
}

__global__ void __launch_bounds__(256, 2) hybrid_fwd(Params p) {
    extern __shared__ __attribute__((aligned(16))) unsigned char lds[];
    cg::grid_group grid = cg::this_grid();
    bf16_t* smem = (bf16_t*)lds; float* smf = (float*)lds;
    volatile LAS unsigned* bst = (volatile LAS unsigned*)(lds + LDS_BYTES - 16);
    if (threadIdx.x == 0) { bst[0] = 0u; bst[1] = 0u; }
    __syncthreads();
    const XcdBarrier xb = xcd_barrier_post((unsigned*)(p.ws + WS_BAR), bst);
    enum { C_NORM1 = 0, C_MIXIN, C_ATTN, C_MIXOUT, C_NORM2, C_FFNIN, C_FFNOUT, C_SSMIN, C_CONV, C_SSD, C_FINISH, C_SSMOUT, C_PRO, C_SSDB };
    const unsigned long long evc = 0x6543210ull;
    const unsigned long long odc = 0x654BAD9870ull;
    for (int ph = 0; ph < 35; ++ph) {
        int code, layer;
        if (ph == 0) { code = C_PRO; layer = 0; }
        else {
            const int q = ph - 1, pair = q / 17, r = q - pair * 17;
            if (r < 7) { layer = 2 * pair; code = (int)((evc >> (4 * r)) & 15); }
            else { layer = 2 * pair + 1; code = (int)((odc >> (4 * (r - 7))) & 15); }
        }
        CParams* kp = (CParams*)__builtin_amdgcn_kernarg_segment_ptr();
        asm volatile("" : "+s"(kp));
        CParams& q = *kp;
#define PHASE(c) asm volatile("" : "+s"(code)); if (code == (c))
        PHASE(C_PRO) prologue(q, smf);
        PHASE(C_NORM1) { if (layer > 0) convert_layer_weights(q, layer, smf); norm_phase(q, layer, 0); }
        PHASE(C_NORM2) norm_phase(q, layer, 1);
        PHASE(C_MIXIN) gemm_phase<G_MIXIN>(q, layer, smem);
        PHASE(C_ATTN) attn_sg_phase(q, layer, smem);
        PHASE(C_MIXOUT) gemm_phase<G_MIXOUT>(q, layer, smem);
        PHASE(C_FFNIN) gemm_phase<G_FFNIN>(q, layer, smem);
        PHASE(C_FFNOUT) gemm_phase<G_FFNOUT>(q, layer, smem);
        PHASE(C_SSMIN) gemm_phase<G_SSMIN>(q, layer, smem);
        PHASE(C_CONV) conv_phase(q, layer, smf);
        PHASE(C_SSD) ssd_diag_phase(q, layer, smem);
        PHASE(C_SSDB) ssd_scan_phase(q, layer, smem);
        PHASE(C_FINISH) finish_phase(q, layer);
        PHASE(C_SSMOUT) gemm_phase<G_SSMOUT>(q, layer, smem);
#undef PHASE
        if (ph == 0) grid.sync(); else xcd_barrier(xb);
    }
}

extern "C" void kernel_launch(void* const* d_in, const int* in_sizes, int n_in, void* d_out, int out_size, void* d_ws, size_t ws_size, hipStream_t stream) {
    static int grid_blocks = 0;
    if (grid_blocks == 0) {
        if (ws_size < WS_TOTAL) { fprintf(stderr, "kernel_launch: workspace too small: %zu < %zu\n", ws_size, (size_t)WS_TOTAL); grid_blocks = -1; return; }
        int dev = 0, cus = 0, per_cu = 0;
        hipGetDevice(&dev);
        hipDeviceGetAttribute(&cus, hipDeviceAttributeMultiprocessorCount, dev);
        if (hipFuncSetAttribute((const void*)hybrid_fwd, hipFuncAttributeMaxDynamicSharedMemorySize, LDS_BYTES) != hipSuccess) { fprintf(stderr, "kernel_launch: hipFuncSetAttribute failed\n"); }
        if (hipOccupancyMaxActiveBlocksPerMultiprocessor(&per_cu, (const void*)hybrid_fwd, 256, LDS_BYTES) != hipSuccess || per_cu < 1) { fprintf(stderr, "kernel_launch: occupancy query failed (%d)\n", per_cu); per_cu = 1; }
        if (per_cu > 2) per_cu = 2;
        (void)hipGetLastError();
        grid_blocks = cus * per_cu;
    }
    if (grid_blocks < 0) return;
    if (hipMemsetAsync((char*)d_ws + WS_BAR, 0, XCD_BAR_WORDS * sizeof(unsigned), stream) != hipSuccess) { fprintf(stderr, "kernel_launch: hipMemsetAsync failed\n"); return; }
    Params p{};
    const float** f = (const float**)&p;
    for (int i = 0; i < 25; ++i) f[i] = (const float*)d_in[i];
    p.out = (float*)d_out; p.ws = (unsigned char*)d_ws;
    void* args[] = {&p};
    hipError_t e = hipLaunchCooperativeKernel((const void*)hybrid_fwd, dim3(grid_blocks), dim3(256), args, LDS_BYTES, stream);
    if (e != hipSuccess) fprintf(stderr, "cooperative launch failed: %s (grid %d)\n", hipGetErrorString(e), grid_blocks);
}
```

```cpp
#include <hip/hip_runtime.h>
#include <hip/hip_cooperative_groups.h>
#include <cstdio>
#include <cstdint>
namespace cg = cooperative_groups;

typedef unsigned short bf16_t;
typedef short bf16x8 __attribute__((ext_vector_type(8)));
typedef short bf16x4 __attribute__((ext_vector_type(4)));
typedef float f32x4 __attribute__((ext_vector_type(4)));
typedef unsigned u32x4 __attribute__((ext_vector_type(4)));
typedef unsigned u32x2 __attribute__((ext_vector_type(2)));

constexpr int D = 1024, NB = 2, SEQ = 8192, CTX = 256;
constexpr int ML = NB * SEQ;
constexpr int MC = NB * CTX;
constexpr int MT = ML + MC;
constexpr int TALL = CTX + SEQ;
constexpr int FFH = 2816;
constexpr int MIXIN = 1792;
constexpr int SSMIN = 5184, SSMIN_PAD = 5248;
constexpr int SSI = 2048;
constexpr float EPS = 1e-6f;
constexpr float QSCALE = 0.125f * 1.4426950408889634f;

constexpr size_t MB = 1024 * 1024;
constexpr size_t WS_MOD = 0;
constexpr size_t WS_ROPE = 1 * MB;
constexpr size_t WS_XCTX = 3 * MB;
constexpr size_t WS_SGW = 5 * MB + 512 * 1024;
constexpr size_t WS_BAR = 7 * MB;
constexpr size_t WS_WT = 8 * MB;
constexpr size_t WT_FFNIN = 0;
constexpr size_t WT_FFNOUT = WT_FFNIN + (size_t)5632 * 1024 * 2;
constexpr size_t WT_MIXIN = WT_FFNOUT + (size_t)1024 * 2816 * 2;
constexpr size_t WT_MIXOUT = WT_MIXIN + (size_t)SSMIN_PAD * 1024 * 2;
constexpr size_t WT_END = WT_MIXOUT + (size_t)1024 * 2048 * 2;
constexpr size_t WS_R0 = WS_WT + ((WT_END + MB - 1) / MB) * MB;
constexpr size_t SZ_XBC = (size_t)MT * 3072 * 2;
constexpr size_t SZ_HN = (size_t)MT * 1024 * 2;
constexpr size_t WS_XBC = WS_R0;
constexpr size_t WS_HN = WS_XBC + SZ_XBC;
constexpr size_t WS_YF = WS_XBC;
constexpr size_t WS_YB = WS_YF + (size_t)MT * 2048 * 2;
constexpr size_t WS_R1 = WS_HN + SZ_HN;
constexpr size_t WS_Z = WS_R1;
constexpr size_t WS_XT = WS_Z + (size_t)MT * 2048 * 2;
constexpr size_t WS_BN = WS_XT + (size_t)MT * 2048 * 2;
constexpr size_t WS_CN = WS_BN + (size_t)MT * 512 * 2;
constexpr size_t WS_BT = WS_CN + (size_t)MT * 512 * 2;
constexpr size_t WS_DT = WS_BT + (size_t)MT * 512 * 2;
constexpr size_t WS_END_ODD = WS_DT + (size_t)MT * 64 * 4;
constexpr size_t WS_Q = WS_R1;
constexpr size_t WS_K = WS_Q + (size_t)MT * 512 * 2;
constexpr size_t WS_VT = WS_K + (size_t)MT * 128 * 2;
constexpr size_t WS_U = WS_VT + (size_t)MT * 128 * 2;
constexpr size_t WS_GVT = WS_U + (size_t)MT * 512 * 2;
constexpr size_t WS_AS = WS_GVT + (size_t)MT * 512 * 2;
constexpr size_t WS_HID = WS_R1;
constexpr size_t WS_TOTAL = WS_END_ODD;
static_assert(WS_TOTAL < (size_t)400 * MB, "workspace too large");
static_assert(WS_AS + (size_t)MT * 1024 * 2 <= WS_END_ODD, "even buffers fit");
static_assert(WS_HID + (size_t)MT * FFH * 2 <= WS_END_ODD, "hid fits");

constexpr int LDS_BYTES = 73728;
constexpr int GST = 72;
constexpr int SST = 136;

struct Params {
    const float* x; const float* c; const float* ctx; const float* c_ctx;
    const float* ada_w; const float* ada_b; const float* norm1_g; const float* norm2_g;
    const float* ffn_w_in; const float* ffn_w_out; const float* mix_w_in; const float* mix_w_out;
    const float* q_norm_g; const float* k_norm_g; const float* sgu_norm_g; const float* sgu_w; const float* sgu_b;
    const float* ssm_w_in; const float* ssm_conv_w; const float* ssm_conv_b; const float* ssm_dt_bias;
    const float* ssm_a_log; const float* ssm_d; const float* ssm_norm_g; const float* ssm_w_out;
    float* out; unsigned char* ws;
};

typedef const __attribute__((address_space(4))) Params CParams;

__device__ __forceinline__ int tid_() { int t = threadIdx.x; asm volatile("" : "+v"(t)); return t; }
__device__ __forceinline__ bf16_t f2bf(float f) {
    unsigned u = __float_as_uint(f);
    u += 0x7fffu + ((u >> 16) & 1u);
    return (bf16_t)(u >> 16);
}
__device__ __forceinline__ float bf2f(bf16_t h) { return __uint_as_float(((unsigned)h) << 16); }
__device__ __forceinline__ unsigned pack2(float a, float b) { unsigned r; asm volatile("v_cvt_pk_bf16_f32 %0, %1, %2" : "=v"(r) : "v"(a), "v"(b)); return r; }
__device__ __forceinline__ float siluf(float v) { return v / (1.f + __expf(-v)); }
__device__ __forceinline__ float geluf(float v) {
    const float u = 0.7978845608028654f * (v + 0.044715f * v * v * v);
    return v / (1.f + __expf(-2.f * u));
}
__device__ __forceinline__ float softplusf(float v) { return v > 20.f ? v : log1pf(expf(v)); }
__device__ __forceinline__ int seg_of(int row) { return row < SEQ ? 0 : (row < ML ? 1 : 2); }
__device__ __forceinline__ float* xrow(CParams& p, int row) {
    return row < ML ? p.out + (size_t)row * D : (float*)(p.ws + WS_XCTX) + (size_t)(row - ML) * D;
}
__device__ __forceinline__ void lds_sync() {
    __builtin_amdgcn_fence(__ATOMIC_RELEASE, "workgroup", "local");
    __builtin_amdgcn_s_barrier();
    __builtin_amdgcn_fence(__ATOMIC_ACQUIRE, "workgroup", "local");
}
typedef float f32x2 __attribute__((ext_vector_type(2)));
__device__ __forceinline__ f32x2 scan128(float s0, float s1, int lane, int dir) {
    if (dir == 0) {
#pragma unroll
        for (int o = 1; o < 64; o <<= 1) { const float t0 = __shfl_up(s0, o), t1 = __shfl_up(s1, o); s0 += lane >= o ? t0 : 0.f; s1 += lane >= o ? t1 : 0.f; }
        s1 += __shfl(s0, 63);
    } else {
#pragma unroll
        for (int o = 1; o < 64; o <<= 1) { const float t0 = __shfl_down(s0, o), t1 = __shfl_down(s1, o); s0 += lane + o < 64 ? t0 : 0.f; s1 += lane + o < 64 ? t1 : 0.f; }
        s0 += __shfl(s1, 0);
    }
    return (f32x2){s0, s1};
}
__device__ __forceinline__ f32x4 mfma16(bf16x8 a, bf16x8 b, f32x4 c) { return __builtin_amdgcn_mfma_f32_16x16x32_bf16(a, b, c, 0, 0, 0); }
__device__ __forceinline__ bf16x8 lds16(const bf16_t* p) { return *(const bf16x8*)p; }
__device__ __forceinline__ bf16x8 lds8x2(const bf16_t* p0, const bf16_t* p1) {
    const bf16x4 a = *(const bf16x4*)p0, b = *(const bf16x4*)p1;
    bf16x8 r; r[0] = a[0]; r[1] = a[1]; r[2] = a[2]; r[3] = a[3]; r[4] = b[0]; r[5] = b[1]; r[6] = b[2]; r[7] = b[3];
    return r;
}
__device__ __forceinline__ bf16x8 pack8(f32x4 a, f32x4 b) {
    u32x4 w; w.x = pack2(a[0], a[1]); w.y = pack2(a[2], a[3]); w.z = pack2(b[0], b[1]); w.w = pack2(b[2], b[3]);
    return __builtin_bit_cast(bf16x8, w);
}
__device__ __forceinline__ void st4bf(bf16_t* dst, float a, float b, float c, float d) {
    u32x2 w; w.x = pack2(a, b); w.y = pack2(c, d); *(u32x2*)dst = w;
}


#define XB_TMO      128
#define XB_XCNT(j)  (256  + 64 * (j))
#define XB_XSUB(j)  (1280 + 64 * (j))
#define XB_XGEN(j)  (2304 + 64 * (j))
#define XB_TOP      3328
#define XB_TOPGEN   3392
#define XCD_BAR_WORDS 3456
#define XB_SPIN_CAP (1u << 18)
#define LAS __attribute__((address_space(3)))
__device__ __forceinline__ unsigned xb_ld(unsigned* p)              { return __hip_atomic_load(p, __ATOMIC_RELAXED, __HIP_MEMORY_SCOPE_AGENT); }
__device__ __forceinline__ unsigned xb_add(unsigned* p, unsigned v) { return __hip_atomic_fetch_add(p, v, __ATOMIC_RELAXED, __HIP_MEMORY_SCOPE_AGENT); }
__device__ __forceinline__ unsigned xb_xcc_id() { return (unsigned)__builtin_amdgcn_s_getreg((3 << 11) | 20) & 0xFu; }
#define XB_SPIN(cond, bar) do { unsigned _sp = 0; while (cond) { __builtin_amdgcn_s_sleep(1); \
    if ((++_sp & 255u) == 0u) { if (xb_ld(&(bar)[XB_TMO])) break; if (_sp > XB_SPIN_CAP) { atomicAdd(&(bar)[XB_TMO], 1u); break; } } } } while (0)
struct XcdBarrier { unsigned* bar; unsigned x; volatile LAS unsigned* st; };
__device__ __forceinline__ XcdBarrier xcd_barrier_post(unsigned* bar, volatile LAS unsigned* st) {
    XcdBarrier b; b.bar = bar; b.x = xb_xcc_id(); b.st = st;
    if (threadIdx.x == 0) (void)xb_add(&bar[XB_XCNT(b.x)], 1u);
    return b;
}
__device__ __forceinline__ void xcd_barrier_complete(unsigned* bar, unsigned x, unsigned& nloc, unsigned& nx) {
    const unsigned G = gridDim.x * gridDim.y * gridDim.z;
    unsigned sum, cnt, mine, sp = 0u;
    for (;;) {
        sum = 0u; cnt = 0u; mine = 0u;
#pragma unroll
        for (unsigned j = 0; j < 16; ++j) { const unsigned c = xb_ld(&bar[XB_XCNT(j)]); sum += c; cnt += (c > 0u) ? 1u : 0u; mine = (j == x) ? c : mine; }
        if (sum == G) break;
        __builtin_amdgcn_s_sleep(1);
        if ((++sp & 255u) == 0u) { if (xb_ld(&bar[XB_TMO])) break; if (sp > XB_SPIN_CAP) { atomicAdd(&bar[XB_TMO], 1u); break; } }
    }
    nloc = mine > 0u ? mine : 1u; nx = cnt > 0u ? cnt : 1u;
}
__device__ __forceinline__ void xcd_barrier(const XcdBarrier& b) {
    asm volatile("s_waitcnt vmcnt(0)" ::: "memory");
    __syncthreads();
    if (threadIdx.x == 0) {
        unsigned* bar = b.bar;
        __builtin_amdgcn_s_waitcnt(0);
        unsigned nloc = b.st[0], nx = b.st[1];
        if (nloc == 0u) { xcd_barrier_complete(bar, b.x, nloc, nx); b.st[0] = nloc; b.st[1] = nx; }
        const unsigned old = xb_add(&bar[XB_XSUB(b.x)], 1u);
        const unsigned gen = old / nloc;
        if (old + 1u == (gen + 1u) * nloc) {
            __builtin_amdgcn_fence(__ATOMIC_RELEASE, "agent");
            asm volatile("s_waitcnt vmcnt(0)" ::: "memory");
            const unsigned og = xb_add(&bar[XB_TOP], 1u);
            const unsigned tg = og / nx;
            if (og + 1u == (tg + 1u) * nx) xb_add(&bar[XB_TOPGEN], 1u);
            else XB_SPIN(xb_ld(&bar[XB_TOPGEN]) == tg, bar);
            __builtin_amdgcn_fence(__ATOMIC_ACQUIRE, "agent");
            xb_add(&bar[XB_XGEN(b.x)], 1u);
            asm volatile("s_waitcnt vmcnt(0)" ::: "memory");
        } else {
            XB_SPIN(xb_ld(&bar[XB_XGEN(b.x)]) == gen, bar);
            __builtin_amdgcn_fence(__ATOMIC_ACQUIRE, "agent");
            asm volatile("s_waitcnt vmcnt(0)" ::: "memory");
        }
    }
    __syncthreads();
}

__device__ __forceinline__ size_t frag_off(int row, int col, int K) {
    return ((size_t)(row >> 4) * (K >> 5) + (col >> 5)) * 512 + ((row & 15) + 16 * ((col & 31) >> 3)) * 8 + (col & 7);
}

template <int MI, int lda, int ldw, int K, int FRAG = 0>
__device__ __forceinline__ void gemm_tile(const bf16_t* __restrict__ A, const bf16_t* __restrict__ W,
                                          f32x4 (&acc)[MI][8], bf16_t* sW) {
    const int tid = tid_(), lane = tid & 63, wave = tid >> 6, l16 = lane & 15, quad = lane >> 4;
    const int srow = tid >> 3, skc = (tid & 7) * 8;
    constexpr int ASI = FRAG ? (K / 32) * 512 : 16 * lda;
    constexpr int ASK = FRAG ? 512 : 32;
    const bf16_t* ap = FRAG ? A + (size_t)(wave * MI) * ASI + lane * 8 : A + (size_t)(wave * 16 * MI + l16) * lda + quad * 8;
    const bf16_t* wp = W + (size_t)srow * ldw + skc;
    const bf16_t* wr = sW + l16 * GST + quad * 8;
    u32x4 ra[MI][2], rw[4];
#pragma unroll
    for (int i = 0; i < 4; ++i) rw[i] = *(const u32x4*)(wp + (size_t)(i * 32) * ldw);
#pragma unroll
    for (int i = 0; i < MI; ++i)
#pragma unroll
        for (int ks = 0; ks < 2; ++ks) ra[i][ks] = *(const u32x4*)(ap + (size_t)i * ASI + ks * ASK);
#pragma unroll
    for (int i = 0; i < MI; ++i)
#pragma unroll
        for (int j = 0; j < 8; ++j) acc[i][j] = (f32x4){0.f, 0.f, 0.f, 0.f};
    constexpr int nk = K >> 6;
#pragma unroll 1
    for (int kt = 0; kt < nk; ++kt) {
        lds_sync();
#pragma unroll
        for (int i = 0; i < 4; ++i) *(u32x4*)(sW + (srow + i * 32) * GST + skc) = rw[i];
        lds_sync();
        const int k0 = (kt + 1 < nk ? kt + 1 : kt) << 6;
        const int ka = FRAG ? (k0 >> 5) * 512 : k0;
#pragma unroll
        for (int i = 0; i < 4; ++i) rw[i] = *(const u32x4*)(wp + (size_t)(i * 32) * ldw + k0);
        bf16x8 wa[4], wb[4];
#pragma unroll
        for (int j = 0; j < 4; ++j) wa[j] = lds16(wr + (j * 16) * GST);
#pragma unroll
        for (int j = 0; j < 4; ++j) wb[j] = lds16(wr + ((j + 4) * 16) * GST);
        __builtin_amdgcn_sched_barrier(0);
#pragma unroll
        for (int j = 0; j < 4; ++j)
#pragma unroll
            for (int i = 0; i < MI; ++i) acc[i][j] = mfma16(wa[j], __builtin_bit_cast(bf16x8, ra[i][0]), acc[i][j]);
        __builtin_amdgcn_sched_barrier(0);
#pragma unroll
        for (int j = 0; j < 4; ++j) wa[j] = lds16(wr + (j * 16) * GST + 32);
        __builtin_amdgcn_sched_barrier(0);
#pragma unroll
        for (int j = 0; j < 4; ++j)
#pragma unroll
            for (int i = 0; i < MI; ++i) acc[i][j + 4] = mfma16(wb[j], __builtin_bit_cast(bf16x8, ra[i][0]), acc[i][j + 4]);
        __builtin_amdgcn_sched_barrier(0);
#pragma unroll
        for (int i = 0; i < MI; ++i) ra[i][0] = *(const u32x4*)(ap + (size_t)i * ASI + ka);
#pragma unroll
        for (int j = 0; j < 4; ++j) wb[j] = lds16(wr + ((j + 4) * 16) * GST + 32);
        __builtin_amdgcn_sched_barrier(0);
#pragma unroll
        for (int j = 0; j < 4; ++j)
#pragma unroll
            for (int i = 0; i < MI; ++i) acc[i][j] = mfma16(wa[j], __builtin_bit_cast(bf16x8, ra[i][1]), acc[i][j]);
        __builtin_amdgcn_sched_barrier(0);
#pragma unroll
        for (int j = 0; j < 4; ++j)
#pragma unroll
            for (int i = 0; i < MI; ++i) acc[i][j + 4] = mfma16(wb[j], __builtin_bit_cast(bf16x8, ra[i][1]), acc[i][j + 4]);
        __builtin_amdgcn_sched_barrier(0);
#pragma unroll
        for (int i = 0; i < MI; ++i) ra[i][1] = *(const u32x4*)(ap + (size_t)i * ASI + ka + ASK);
    }
}

template <int MI>
__device__ __forceinline__ void epi_resid(CParams& p, int m0, int n0, const f32x4 (&acc)[MI][8], const float* gate  ) {
    const int lane = tid_() & 63, wave = tid_() >> 6, l16 = lane & 15, quad = lane >> 4;
#pragma unroll
    for (int i = 0; i < MI; ++i) {
        const int row = m0 + wave * 16 * MI + i * 16 + l16;
        float* xr = xrow(p, row);
        const float* g = gate + (size_t)seg_of(row) * 6144;
#pragma unroll
        for (int j = 0; j < 8; ++j) {
            const int col = n0 + j * 16 + quad * 4;
            const f32x4 gv = *(const f32x4*)(g + col);
            f32x4 xv = *(f32x4*)(xr + col);
            xv += gv * acc[i][j];
            *(f32x4*)(xr + col) = xv;
        }
    }
}

template <int MI>
__device__ __forceinline__ void epi_swiglu(CParams& p, int m0, int n0, const f32x4 (&acc)[MI][8]) {
    const int lane = tid_() & 63, wave = tid_() >> 6, l16 = lane & 15, quad = lane >> 4;
    bf16_t* hid = (bf16_t*)(p.ws + WS_HID);
#pragma unroll
    for (int i = 0; i < MI; ++i) {
        const int row = m0 + wave * 16 * MI + i * 16 + l16;
#pragma unroll
        for (int jj = 0; jj < 4; ++jj) {
            const f32x4 g = acc[i][2 * jj], u = acc[i][2 * jj + 1];
            const int hc = (n0 >> 1) + jj * 16 + quad * 4;
            const size_t off = ((size_t)(row >> 4) * (FFH / 32) + (hc >> 5)) * 512 + ((row & 15) + 16 * ((hc & 31) >> 3)) * 8 + (hc & 7);
            st4bf(hid + off, siluf(g[0]) * u[0], siluf(g[1]) * u[1], siluf(g[2]) * u[2], siluf(g[3]) * u[3]);
        }
    }
}

template <int MI>
__device__ __forceinline__ void epi_mixin(CParams& p, int j2, int m0, int tn, f32x4 (&acc)[MI][8]) {
    const int lane = tid_() & 63, wave = tid_() >> 6, l16 = lane & 15, quad = lane >> 4;
    if (tn < 5) {
        const float* gsrc = (tn < 4 ? p.q_norm_g : p.k_norm_g) + j2 * 64;
        const float* cosT = (const float*)(p.ws + WS_ROPE);
        const float* sinT = cosT + 8192 * 32;
#pragma unroll
        for (int i = 0; i < MI; ++i) {
            const int row = m0 + wave * 16 * MI + i * 16 + l16;
#pragma unroll
            for (int hh = 0; hh < 2; ++hh) {
                float ss = 0.f;
#pragma unroll
                for (int j = 0; j < 4; ++j) { const f32x4 v = acc[i][hh * 4 + j]; ss += v[0] * v[0] + v[1] * v[1] + v[2] * v[2] + v[3] * v[3]; }
                ss += __shfl_xor(ss, 16); ss += __shfl_xor(ss, 32);
                const float rstd = rsqrtf(ss * (1.f / 64.f) + EPS);
                f32x4 y[4];
#pragma unroll
                for (int j = 0; j < 4; ++j) {
                    const f32x4 gv = *(const f32x4*)(gsrc + j * 16 + quad * 4);
                    y[j] = acc[i][hh * 4 + j] * rstd * gv;
                }
                if (row < ML) {
                    const int s = row & (SEQ - 1);
#pragma unroll
                    for (int j = 0; j < 2; ++j) {
                        const f32x4 cs = *(const f32x4*)(cosT + (size_t)s * 32 + j * 16 + quad * 4);
                        const f32x4 sn = *(const f32x4*)(sinT + (size_t)s * 32 + j * 16 + quad * 4);
                        const f32x4 x1 = y[j], x2 = y[j + 2];
                        y[j] = x1 * cs - x2 * sn;
                        y[j + 2] = x2 * cs + x1 * sn;
                    }
                }
                if (tn < 4) {
                    bf16_t* q = (bf16_t*)(p.ws + WS_Q) + (size_t)row * 512 + (tn * 2 + hh) * 64;
#pragma unroll
                    for (int j = 0; j < 4; ++j) st4bf(q + j * 16 + quad * 4, y[j][0] * QSCALE, y[j][1] * QSCALE, y[j][2] * QSCALE, y[j][3] * QSCALE);
                } else {
                    const int b = row < ML ? (row >> 13) : ((row - ML) >> 8);
                    const int t = row < ML ? CTX + (row & (SEQ - 1)) : ((row - ML) & (CTX - 1));
                    bf16_t* k = (bf16_t*)(p.ws + WS_K) + ((size_t)b * TALL + t) * 128 + hh * 64;
#pragma unroll
                    for (int j = 0; j < 4; ++j) st4bf(k + j * 16 + quad * 4, y[j][0], y[j][1], y[j][2], y[j][3]);
                }
            }
        }
    } else if (tn == 5) {
        bf16_t* vt = (bf16_t*)(p.ws + WS_VT);
#pragma unroll
        for (int i = 0; i < MI; ++i) {
            const int row = m0 + wave * 16 * MI + i * 16 + l16;
            const int b = row < ML ? (row >> 13) : ((row - ML) >> 8);
            const int t = row < ML ? CTX + (row & (SEQ - 1)) : ((row - ML) & (CTX - 1));
#pragma unroll
            for (int j = 0; j < 8; ++j) {
                const int kh = j >> 2;
#pragma unroll
                for (int r = 0; r < 4; ++r) {
                    const int d = (j & 3) * 16 + quad * 4 + r;
                    vt[((size_t)(b * 2 + kh) * 64 + d) * TALL + t] = f2bf(acc[i][j][r]);
                }
            }
        }
    } else if (tn < 10) {
        bf16_t* u = (bf16_t*)(p.ws + WS_U);
#pragma unroll
        for (int i = 0; i < MI; ++i) {
            const int row = m0 + wave * 16 * MI + i * 16 + l16;
#pragma unroll
            for (int j = 0; j < 8; ++j) {
                const f32x4 v = acc[i][j];
                st4bf(u + (size_t)row * 512 + (tn - 6) * 128 + j * 16 + quad * 4, geluf(v[0]), geluf(v[1]), geluf(v[2]), geluf(v[3]));
            }
        }
    } else {
        const int g = tn - 10;
        const float* gn = p.sgu_norm_g + j2 * 512 + g * 128;
        bf16_t* gvt = (bf16_t*)(p.ws + WS_GVT);
#pragma unroll
        for (int i = 0; i < MI; ++i) {
            const int row = m0 + wave * 16 * MI + i * 16 + l16;
            float ss = 0.f;
#pragma unroll
            for (int j = 0; j < 8; ++j) {
                f32x4 v = acc[i][j];
                v[0] = geluf(v[0]); v[1] = geluf(v[1]); v[2] = geluf(v[2]); v[3] = geluf(v[3]);
                acc[i][j] = v;
                ss += v[0] * v[0] + v[1] * v[1] + v[2] * v[2] + v[3] * v[3];
            }
            ss += __shfl_xor(ss, 16); ss += __shfl_xor(ss, 32);
            const float rstd = rsqrtf(ss * (1.f / 128.f) + EPS);
            const int chunk = row >> 7, pt = row & 127;
#pragma unroll
            for (int j = 0; j < 8; ++j) {
                const f32x4 gv = *(const f32x4*)(gn + j * 16 + quad * 4);
#pragma unroll
                for (int r = 0; r < 4; ++r) {
                    const int cc = g * 128 + j * 16 + quad * 4 + r;
                    gvt[((size_t)chunk * 512 + cc) * 128 + pt] = f2bf(acc[i][j][r] * rstd * gv[r]);
                }
            }
        }
    }
}

template <int MI>
__device__ __forceinline__ void epi_ssmin(CParams& p, int j2, int m0, int tn, const f32x4 (&acc)[MI][8]) {
    const int lane = tid_() & 63, wave = tid_() >> 6, l16 = lane & 15, quad = lane >> 4;
#pragma unroll
    for (int i = 0; i < MI; ++i) {
        const int row = m0 + wave * 16 * MI + i * 16 + l16;
        if (tn < 16) {
            bf16_t* z = (bf16_t*)(p.ws + WS_Z);
#pragma unroll
            for (int j = 0; j < 8; ++j) { const f32x4 v = acc[i][j]; st4bf(z + frag_off(row, tn * 128 + j * 16 + quad * 4, 2048), siluf(v[0]), siluf(v[1]), siluf(v[2]), siluf(v[3])); }
        } else if (tn < 40) {
            bf16_t* xb = (bf16_t*)(p.ws + WS_XBC) + (size_t)row * 3072 + (tn - 16) * 128;
#pragma unroll
            for (int j = 0; j < 8; ++j) { const f32x4 v = acc[i][j]; st4bf(xb + j * 16 + quad * 4, v[0], v[1], v[2], v[3]); }
        } else {
            float* dt = (float*)(p.ws + WS_DT) + (size_t)row * 64;
            const float* bias = p.ssm_dt_bias + j2 * 64;
#pragma unroll
            for (int j = 0; j < 4; ++j) {
                const int c = j * 16 + quad * 4;
                const f32x4 v = acc[i][j];
                f32x4 o;
                o[0] = softplusf(v[0] + bias[c + 0]); o[1] = softplusf(v[1] + bias[c + 1]);
                o[2] = softplusf(v[2] + bias[c + 2]); o[3] = softplusf(v[3] + bias[c + 3]);
                *(f32x4*)(dt + c) = o;
            }
        }
    }
}

enum { G_MIXIN = 0, G_MIXOUT, G_SSMIN, G_SSMOUT, G_FFNIN, G_FFNOUT };

template <int KIND>
__device__ void gemm_phase(CParams& p, int layer, bf16_t* smem) {
    const int j2 = layer >> 1;
    constexpr int lda = (KIND == G_SSMOUT) ? 2048 : (KIND == G_FFNOUT) ? FFH : 1024;
    constexpr int K = lda, ldw = K;
    constexpr int N = (KIND == G_MIXIN) ? MIXIN : (KIND == G_SSMIN) ? SSMIN_PAD : (KIND == G_FFNIN) ? 2 * FFH : 1024;
    constexpr size_t aoff = (KIND == G_MIXOUT) ? WS_AS : (KIND == G_SSMOUT) ? WS_YF : (KIND == G_FFNOUT) ? WS_HID : WS_HN;
    constexpr size_t woff = (KIND == G_MIXIN || KIND == G_SSMIN) ? WT_MIXIN : (KIND == G_MIXOUT || KIND == G_SSMOUT) ? WT_MIXOUT : (KIND == G_FFNIN) ? WT_FFNIN : WT_FFNOUT;
    const bf16_t* A = (const bf16_t*)(p.ws + aoff);
    const bf16_t* W = (const bf16_t*)(p.ws + WS_WT + woff);
    constexpr int MI = (KIND == G_MIXIN) ? 2 : 4;
    constexpr int FRAG = 1;
    constexpr int nN = N >> 7, nM = MT / (64 * MI);
    const float* mod = (const float*)(p.ws + WS_MOD) + (size_t)layer * 3 * 6144;
    bf16_t* sW = smem;
    if (N == 1024) {
        const int nlat = (ML / 256) * 8, nctx = layer == 3 ? 0 : (MC / 64) * 8;
        const float* gate = mod + (KIND == G_FFNOUT ? 5 : 2) * 1024;
        for (int t = blockIdx.x; t < nlat + nctx; t += gridDim.x) {
            if (t < nlat) {
                const int u = (gridDim.x == 512) ? ((t & 7) * 64 + (t >> 3)) : t;
                const int tm = u >> 3, tn = u & 7;
                f32x4 acc[4][8];
                gemm_tile<4, lda, ldw, K, FRAG>(A + (size_t)tm * 256 * lda, W + (size_t)tn * 128 * ldw, acc, sW);
                epi_resid<4>(p, tm * 256, tn * 128, acc, gate);
            } else {
                const int u = t - nlat, tm = u >> 3, tn = u & 7;
                f32x4 acc[1][8];
                gemm_tile<1, lda, ldw, K, FRAG>(A + (size_t)(ML + tm * 64) * lda, W + (size_t)tn * 128 * ldw, acc, sW);
                epi_resid<1>(p, ML + tm * 64, tn * 128, acc, gate);
            }
        }
        return;
    }
    constexpr int T = nM * nN, share = (T + 7) / 8, nsc = (nN + 7) / 8;
    const int xcd = blockIdx.x & 7, slot = blockIdx.x >> 3, nslot = gridDim.x >> 3;
    for (int li = slot; li < share; li += nslot) {
        const int u = xcd * share + li;
        if (u >= T) break;
        int sc = u / (nM * 8); if (sc > nsc - 1) sc = nsc - 1;
        const int rem = u - sc * nM * 8, wd = (sc == nsc - 1) ? (nN - 8 * sc) : 8;
        const int tm = rem / wd, tn = sc * 8 + rem - tm * wd;
        f32x4 acc[MI][8];
        gemm_tile<MI, lda, ldw, K, FRAG>(A + (size_t)tm * (64 * MI) * lda, W + (size_t)tn * 128 * ldw, acc, sW);
        if (KIND == G_MIXIN) epi_mixin<MI>(p, j2, tm * (64 * MI), tn, acc);
        else if (KIND == G_SSMIN) epi_ssmin<MI>(p, j2, tm * (64 * MI), tn, acc);
        else if (KIND == G_FFNIN) epi_swiglu<MI>(p, tm * (64 * MI), tn * 128, acc);
    }
}

__device__ void norm_phase(CParams& p, int layer, int which) {
    const int lane = tid_() & 63, wave = tid_() >> 6, l16 = lane & 15, quad = lane >> 4;
    const float* g = (which ? p.norm2_g : p.norm1_g) + layer * 1024;
    const float* mod = (const float*)(p.ws + WS_MOD) + (size_t)layer * 3 * 6144;
    bf16_t* hn = (bf16_t*)(p.ws + WS_HN);
    for (int tr = blockIdx.x * 4 + wave; tr < MT / 16; tr += gridDim.x * 4) {
        const int row0 = tr * 16;
        float myr = 0.f;
#pragma unroll 4
        for (int r = 0; r < 16; ++r) {
            const float* xr = xrow(p, row0 + r);
            float ss = 0.f;
#pragma unroll
            for (int i = 0; i < 4; ++i) { const f32x4 v = *(const f32x4*)(xr + i * 256 + lane * 4); ss += v[0] * v[0] + v[1] * v[1] + v[2] * v[2] + v[3] * v[3]; }
#pragma unroll
            for (int o = 1; o < 64; o <<= 1) ss += __shfl_xor(ss, o);
            const float rs = rsqrtf(ss * (1.f / 1024.f) + EPS);
            myr = (l16 == r) ? rs : myr;
        }
        const float* m = mod + (size_t)seg_of(row0) * 6144 + (which ? 3 * 1024 : 0);
        const float* xr = xrow(p, row0 + l16) + quad * 8;
        bf16_t* dst = hn + (size_t)tr * 32 * 512 + lane * 8;
#pragma unroll 4
        for (int kb = 0; kb < 32; ++kb) {
            const int col = kb * 32 + quad * 8;
            const f32x4 v0 = *(const f32x4*)(xr + kb * 32), v1 = *(const f32x4*)(xr + kb * 32 + 4);
            const f32x4 g0 = *(const f32x4*)(g + col), g1 = *(const f32x4*)(g + col + 4);
            const f32x4 sh0 = *(const f32x4*)(m + col), sh1 = *(const f32x4*)(m + col + 4);
            const f32x4 sc0 = *(const f32x4*)(m + 1024 + col), sc1 = *(const f32x4*)(m + 1024 + col + 4);
            const f32x4 y0 = (v0 * myr * g0) * (sc0 + 1.f) + sh0, y1 = (v1 * myr * g1) * (sc1 + 1.f) + sh1;
            u32x4 o; o.x = pack2(y0[0], y0[1]); o.y = pack2(y0[2], y0[3]); o.z = pack2(y1[0], y1[1]); o.w = pack2(y1[2], y1[3]);
            *(u32x4*)(dst + (size_t)kb * 512) = o;
        }
    }
}

__device__ void convert_wt(const float* __restrict__ W, int K, int N, bf16_t* __restrict__ Wt, int mode, float* tile) {
    const int tid = tid_();
    const int nKt = K >> 6, nNt = N >> 6;
    for (int t = blockIdx.x; t < nKt * nNt; t += gridDim.x) {
        const int kt = t / nNt, nt = t - kt * nNt;
        lds_sync();
#pragma unroll
        for (int i = 0; i < 16; ++i) {
            const int kk = (tid >> 6) + i * 4, nn = tid & 63;
            tile[kk * 65 + nn] = W[(size_t)(kt * 64 + kk) * N + nt * 64 + nn];
        }
        lds_sync();
        {
            const int nn = tid >> 2, kq = (tid & 3) * 16;
            const int n = nt * 64 + nn;
            int dr = n;
            if (mode == 1) { const int hm = n < FFH ? n : n - FFH; dr = (hm >> 4) * 32 + (hm & 15) + (n < FFH ? 0 : 16); }
            u32x4 o0, o1;
            o0.x = pack2(tile[(kq + 0) * 65 + nn], tile[(kq + 1) * 65 + nn]); o0.y = pack2(tile[(kq + 2) * 65 + nn], tile[(kq + 3) * 65 + nn]);
            o0.z = pack2(tile[(kq + 4) * 65 + nn], tile[(kq + 5) * 65 + nn]); o0.w = pack2(tile[(kq + 6) * 65 + nn], tile[(kq + 7) * 65 + nn]);
            o1.x = pack2(tile[(kq + 8) * 65 + nn], tile[(kq + 9) * 65 + nn]); o1.y = pack2(tile[(kq + 10) * 65 + nn], tile[(kq + 11) * 65 + nn]);
            o1.z = pack2(tile[(kq + 12) * 65 + nn], tile[(kq + 13) * 65 + nn]); o1.w = pack2(tile[(kq + 14) * 65 + nn], tile[(kq + 15) * 65 + nn]);
            bf16_t* dst = Wt + (size_t)dr * K + kt * 64 + kq;
            *(u32x4*)dst = o0; *(u32x4*)(dst + 8) = o1;
        }
    }
}

__device__ void convert_layer_weights(CParams& p, int layer, float* tile) {
    unsigned char* wt = p.ws + WS_WT;
    const int j2 = layer >> 1;
    convert_wt(p.ffn_w_in + (size_t)layer * 1024 * 2 * FFH, 1024, 2 * FFH, (bf16_t*)(wt + WT_FFNIN), 1, tile);
    convert_wt(p.ffn_w_out + (size_t)layer * FFH * 1024, FFH, 1024, (bf16_t*)(wt + WT_FFNOUT), 0, tile);
    if ((layer & 1) == 0) {
        convert_wt(p.mix_w_in + (size_t)j2 * 1024 * MIXIN, 1024, MIXIN, (bf16_t*)(wt + WT_MIXIN), 0, tile);
        convert_wt(p.mix_w_out + (size_t)j2 * 1024 * 1024, 1024, 1024, (bf16_t*)(wt + WT_MIXOUT), 0, tile);
    } else {
        convert_wt(p.ssm_w_in + (size_t)j2 * 1024 * SSMIN, 1024, SSMIN, (bf16_t*)(wt + WT_MIXIN), 0, tile);
        convert_wt(p.ssm_w_out + (size_t)j2 * SSI * 1024, SSI, 1024, (bf16_t*)(wt + WT_MIXOUT), 0, tile);
        bf16_t* padp = (bf16_t*)(wt + WT_MIXIN) + (size_t)SSMIN * 1024;
        for (int i = blockIdx.x * 256 + tid_(); i < (SSMIN_PAD - SSMIN) * 1024; i += gridDim.x * 256) padp[i] = 0;
    }
}

__device__ void prologue(CParams& p, float* smf) {
    const int tid = tid_();
    const size_t gtid = (size_t)blockIdx.x * 256 + tid, gsz = (size_t)gridDim.x * 256;
    {
        const f32x4* s = (const f32x4*)p.x; f32x4* d = (f32x4*)p.out;
        for (size_t i = gtid; i < (size_t)ML * D / 4; i += gsz) d[i] = s[i];
        const f32x4* s2 = (const f32x4*)p.ctx; f32x4* d2 = (f32x4*)(p.ws + WS_XCTX);
        for (size_t i = gtid; i < (size_t)MC * D / 4; i += gsz) d2[i] = s2[i];
    }
    {
        float* cosT = (float*)(p.ws + WS_ROPE); float* sinT = cosT + 8192 * 32;
        for (size_t i = gtid; i < (size_t)8192 * 32; i += gsz) {
            const int s = (int)(i >> 5), j = (int)(i & 31), f = j & 15;
            const float inv = powf(10000.f, -(float)f / 16.f);
            const float pos = (float)(j < 16 ? (s >> 6) : (s & 63));
            const float ang = pos * inv;
            cosT[i] = cosf(ang); sinT[i] = sinf(ang);
        }
    }
    {
        bf16_t* sgw = (bf16_t*)(p.ws + WS_SGW);
        for (size_t i = gtid; i < (size_t)2 * 4 * 128 * 128; i += gsz) sgw[i] = f2bf(p.sgu_w[i]);
    }
    {
        float* sc = smf;
        float* red = smf + 3 * 1024;
        lds_sync();
        for (int i = tid; i < 3 * 1024; i += 256) {
            const int sgi = i >> 10, k = i & 1023;
            const float v = sgi < 2 ? p.c[sgi * 1024 + k] : p.c_ctx[k];
            sc[i] = siluf(v);
        }
        lds_sync();
        float* mod = (float*)(p.ws + WS_MOD);
        const int cl = tid & 63, kg = tid >> 6;
        for (int wi = blockIdx.x; wi < 4 * 96; wi += gridDim.x) {
            const int layer = wi / 96, cb = wi - layer * 96;
            const float* w = p.ada_w + (size_t)layer * 1024 * 6144 + cb * 64 + cl;
            float s0 = 0.f, s1 = 0.f, s2 = 0.f;
            for (int k = kg * 256; k < kg * 256 + 256; ++k) {
                const float wv = w[(size_t)k * 6144];
                s0 += sc[k] * wv; s1 += sc[1024 + k] * wv; s2 += sc[2048 + k] * wv;
            }
            lds_sync();
            red[(kg * 3 + 0) * 64 + cl] = s0; red[(kg * 3 + 1) * 64 + cl] = s1; red[(kg * 3 + 2) * 64 + cl] = s2;
            lds_sync();
            if (tid < 192) {
                const int sgi = tid >> 6;
                const float v = red[(0 * 3 + sgi) * 64 + cl] + red[(1 * 3 + sgi) * 64 + cl] + red[(2 * 3 + sgi) * 64 + cl] + red[(3 * 3 + sgi) * 64 + cl];
                const int n = cb * 64 + cl;
                mod[((size_t)layer * 3 + sgi) * 6144 + n] = v + p.ada_b[layer * 6144 + n];
            }
        }
        lds_sync();
    }
    convert_layer_weights(p, 0, smf);
}

__device__ __forceinline__ void attn_item(CParams& p, int j2, int b, int h, int q0row, int nkeys, bf16_t* smem) {
    const int tid = tid_(), lane = tid & 63, wave = tid >> 6, l16 = lane & 15, quad = lane >> 4;
    const int kh = h >> 2;
    const bf16_t* Q = (const bf16_t*)(p.ws + WS_Q);
    const bf16_t* Kb = (const bf16_t*)(p.ws + WS_K) + (size_t)b * TALL * 128 + kh * 64;
    const bf16_t* Vb = (const bf16_t*)(p.ws + WS_VT) + (size_t)(b * 2 + kh) * 64 * TALL;
    bf16_t* sK = smem; bf16_t* sV = smem + 64 * GST;
    constexpr float LOG2E = 1.4426950408889634f;
    float mb;
    {
        float gq = fabsf(p.q_norm_g[j2 * 64 + lane]), gk = fabsf(p.k_norm_g[j2 * 64 + lane]);
#pragma unroll
        for (int o = 1; o < 64; o <<= 1) { gq = fmaxf(gq, __shfl_xor(gq, o)); gk = fmaxf(gk, __shfl_xor(gk, o)); }
        mb = 8.f * 1.02f * gq * gk * LOG2E;
    }
    bf16x8 qf[4][2];
#pragma unroll
    for (int i = 0; i < 4; ++i)
#pragma unroll
        for (int ks = 0; ks < 2; ++ks)
            qf[i][ks] = *(const bf16x8*)(Q + (size_t)(q0row + wave * 64 + i * 16 + l16) * 512 + h * 64 + ks * 32 + quad * 8);
    f32x4 o[5][4];
#pragma unroll
    for (int d = 0; d < 5; ++d)
#pragma unroll
        for (int i = 0; i < 4; ++i) o[d][i] = (f32x4){0.f, 0.f, 0.f, 0.f};
    lds_sync();
    {
        const int r = 64 + (tid >> 4);
        u32x2 one; one.x = r == 64 ? 0x3F803F80u : 0u; one.y = one.x;
        *(u32x2*)(sV + r * GST + (tid & 15) * 4) = one;
    }
    const int srow = tid >> 3, skc = (tid & 7) * 8;
    u32x4 rk[2], rv[2];
#pragma unroll
    for (int i = 0; i < 2; ++i) {
        rk[i] = *(const u32x4*)(Kb + (size_t)(srow + i * 32) * 128 + skc);
        rv[i] = *(const u32x4*)(Vb + (size_t)(srow + i * 32) * TALL + skc);
    }
    const int nt = nkeys >> 6;
#pragma unroll 1
    for (int kt = 0; kt < nt; ++kt) {
        lds_sync();
#pragma unroll
        for (int i = 0; i < 2; ++i) {
            *(u32x4*)(sK + (srow + i * 32) * GST + skc) = rk[i];
            *(u32x4*)(sV + (srow + i * 32) * GST + skc) = rv[i];
        }
        lds_sync();
        {
            const int t0 = (kt + 1 < nt ? kt + 1 : kt) << 6;
#pragma unroll
            for (int i = 0; i < 2; ++i) {
                rk[i] = *(const u32x4*)(Kb + (size_t)(t0 + srow + i * 32) * 128 + skc);
                rv[i] = *(const u32x4*)(Vb + (size_t)(srow + i * 32) * TALL + t0 + skc);
            }
        }
        bf16x8 pf[2][4];
#pragma unroll
        for (int ih = 0; ih < 2; ++ih) {
            f32x4 s[4][2];
#pragma unroll
            for (int tt = 0; tt < 4; ++tt)
#pragma unroll
                for (int i = 0; i < 2; ++i) s[tt][i] = (f32x4){-mb, -mb, -mb, -mb};
#pragma unroll
            for (int ks = 0; ks < 2; ++ks)
#pragma unroll
                for (int tt = 0; tt < 4; ++tt) {
                    const bf16x8 kf = lds16(sK + (tt * 16 + l16) * GST + ks * 32 + quad * 8);
#pragma unroll
                    for (int i = 0; i < 2; ++i) s[tt][i] = mfma16(kf, qf[ih * 2 + i][ks], s[tt][i]);
                }
#pragma unroll
            for (int i = 0; i < 2; ++i) {
#pragma unroll
                for (int tt = 0; tt < 4; ++tt) {
#pragma unroll
                    for (int r = 0; r < 4; ++r) s[tt][i][r] = __builtin_amdgcn_exp2f(s[tt][i][r]);
                }
#pragma unroll
                for (int ksp = 0; ksp < 2; ++ksp) pf[ksp][ih * 2 + i] = pack8(s[2 * ksp][i], s[2 * ksp + 1][i]);
            }
        }
#pragma unroll
        for (int ksp = 0; ksp < 2; ++ksp)
#pragma unroll
            for (int d = 0; d < 5; ++d) {
                const bf16_t* vp = sV + (d * 16 + l16) * GST + ksp * 32 + quad * 4;
                const bf16x8 vf = lds8x2(vp, vp + 16);
#pragma unroll
                for (int i = 0; i < 4; ++i) o[d][i] = mfma16(vf, pf[ksp][i], o[d][i]);
            }
    }
    bf16_t* as = (bf16_t*)(p.ws + WS_AS);
#pragma unroll
    for (int i = 0; i < 4; ++i) {
        const float l = __shfl(o[4][i][0], l16);
        const float inv = 1.f / l;
        const int row = q0row + wave * 64 + i * 16 + l16;
#pragma unroll
        for (int d = 0; d < 4; ++d)
            st4bf(as + frag_off(row, h * 64 + d * 16 + quad * 4, 1024), o[d][i][0] * inv, o[d][i][1] * inv, o[d][i][2] * inv, o[d][i][3] * inv);
    }
}

__device__ void sg_item(CParams& p, int j2, int chunk, int g, bf16_t* smem) {
    const int lane = tid_() & 63, wave = tid_() >> 6, l16 = lane & 15, quad = lane >> 4;
    const bf16_t* A = (const bf16_t*)(p.ws + WS_SGW) + (size_t)(j2 * 4 + g) * 128 * 128;
    const bf16_t* W = (const bf16_t*)(p.ws + WS_GVT) + ((size_t)chunk * 512 + g * 128) * 128;
    f32x4 acc[2][8];
    gemm_tile<2, 128, 128, 128>(A, W, acc, smem);
    const bf16_t* u = (const bf16_t*)(p.ws + WS_U);
    bf16_t* as = (bf16_t*)(p.ws + WS_AS);
    const float* bs = p.sgu_b + (size_t)(j2 * 4 + g) * 128;
#pragma unroll
    for (int i = 0; i < 2; ++i) {
        const int pt = wave * 32 + i * 16 + l16;
        const int row = chunk * 128 + pt;
        const float bias = bs[pt];
#pragma unroll
        for (int j = 0; j < 8; ++j) {
            const int c = g * 128 + j * 16 + quad * 4;
            const u32x2 uw = *(const u32x2*)(u + (size_t)row * 512 + c);
            const float u0 = __uint_as_float(uw.x << 16), u1 = __uint_as_float(uw.x & 0xffff0000u);
            const float u2 = __uint_as_float(uw.y << 16), u3 = __uint_as_float(uw.y & 0xffff0000u);
            const f32x4 v = acc[i][j];
            st4bf(as + frag_off(row, 512 + c, 1024), u0 * (v[0] + bias), u1 * (v[1] + bias), u2 * (v[2] + bias), u3 * (v[3] + bias));
        }
    }
}

__device__ void attn_sg_phase(CParams& p, int layer, bf16_t* smem) {
    const int j2 = layer >> 1;
    const int nA = NB * 8 * 32, nS = (MT / 128) * 4, nC = NB * 8;
    for (int t = blockIdx.x; t < nA + nS + nC; t += gridDim.x) {
        if (t < nA) {
            const int xcd = t & 7, li = t >> 3;
            const int bh = xcd * 2 + (li >> 5), qb = li & 31;
            attn_item(p, j2, bh >> 3, bh & 7, (bh >> 3) * SEQ + qb * 256, TALL, smem);
        } else if (t < nA + nS) {
            const int u = t - nA;
            sg_item(p, j2, u >> 2, u & 3, smem);
        } else {
            const int u = t - nA - nS;
            const int h = u & 7, b = u >> 3;
            attn_item(p, j2, b, h, ML + b * CTX, CTX, smem);
        }
    }
}

__device__ void conv_phase(CParams& p, int layer, float* smf) {
    const int j2 = layer >> 1, tid = tid_();
    const bf16_t* xbc = (const bf16_t*)(p.ws + WS_XBC);
    bf16_t* XT = (bf16_t*)(p.ws + WS_XT); bf16_t* Bn = (bf16_t*)(p.ws + WS_BN); bf16_t* Cn = (bf16_t*)(p.ws + WS_CN); bf16_t* BT = (bf16_t*)(p.ws + WS_BT);
    const float* cw = p.ssm_conv_w + (size_t)j2 * 3 * 3072;
    const float* cb = p.ssm_conv_b + (size_t)j2 * 3072;
    float* sin_ = smf;
    float* sout = smf + 66 * 65;
    const int nCt = 3072 / 64, nRt = MT / 64;
    for (int t = blockIdx.x; t < nCt * nRt; t += gridDim.x) {
        const int rt = t / nCt, ct = t - rt * nCt;
        const int r0 = rt * 64, c0 = ct * 64;
        const bool first = r0 < ML ? ((r0 & (SEQ - 1)) == 0) : (((r0 - ML) & (CTX - 1)) == 0);
        const bool last = r0 < ML ? (((r0 + 64) & (SEQ - 1)) == 0) : ((((r0 + 64) - ML) & (CTX - 1)) == 0);
        lds_sync();
        for (int e = tid; e < 66 * 8; e += 256) {
            const int rr = e >> 3, c8 = (e & 7) * 8;
            const int row = r0 - 1 + rr;
            u32x4 v = (u32x4){0u, 0u, 0u, 0u};
            if (!((rr == 0 && first) || (rr == 65 && last))) v = *(const u32x4*)(xbc + (size_t)row * 3072 + c0 + c8);
            float* d = sin_ + rr * 65 + c8;
            d[0] = __uint_as_float(v.x << 16); d[1] = __uint_as_float(v.x & 0xffff0000u);
            d[2] = __uint_as_float(v.y << 16); d[3] = __uint_as_float(v.y & 0xffff0000u);
            d[4] = __uint_as_float(v.z << 16); d[5] = __uint_as_float(v.z & 0xffff0000u);
            d[6] = __uint_as_float(v.w << 16); d[7] = __uint_as_float(v.w & 0xffff0000u);
        }
        lds_sync();
        {
            const int c = tid & 63;
            const float w0 = cw[c0 + c], w1 = cw[3072 + c0 + c], w2 = cw[2 * 3072 + c0 + c], bb = cb[c0 + c];
#pragma unroll
            for (int k = 0; k < 16; ++k) {
                const int tt = (tid >> 6) + k * 4;
                const float v = w0 * sin_[tt * 65 + c] + w1 * sin_[(tt + 1) * 65 + c] + w2 * sin_[(tt + 2) * 65 + c] + bb;
                sout[c * 65 + tt] = siluf(v);
            }
        }
        lds_sync();
        const int q = tid >> 2, e16 = (tid & 3) * 16;
        if (c0 >= 2048) {
            u32x4 o0, o1;
            o0.x = pack2(sout[(e16 + 0) * 65 + q], sout[(e16 + 1) * 65 + q]); o0.y = pack2(sout[(e16 + 2) * 65 + q], sout[(e16 + 3) * 65 + q]);
            o0.z = pack2(sout[(e16 + 4) * 65 + q], sout[(e16 + 5) * 65 + q]); o0.w = pack2(sout[(e16 + 6) * 65 + q], sout[(e16 + 7) * 65 + q]);
            o1.x = pack2(sout[(e16 + 8) * 65 + q], sout[(e16 + 9) * 65 + q]); o1.y = pack2(sout[(e16 + 10) * 65 + q], sout[(e16 + 11) * 65 + q]);
            o1.z = pack2(sout[(e16 + 12) * 65 + q], sout[(e16 + 13) * 65 + q]); o1.w = pack2(sout[(e16 + 14) * 65 + q], sout[(e16 + 15) * 65 + q]);
            if (c0 < 2560) {
                bf16_t* dst = Bn + (c0 - 2048) + (size_t)(r0 + q) * 512 + e16;
                *(u32x4*)dst = o0; *(u32x4*)(dst + 8) = o1;
            } else {
                *(u32x4*)(Cn + frag_off(r0 + q, c0 - 2560 + e16, 512)) = o0;
                *(u32x4*)(Cn + frag_off(r0 + q, c0 - 2560 + e16 + 8, 512)) = o1;
            }
        }
        if (c0 < 2560) {
            const float* sp = sout + q * 65 + e16;
            u32x4 o0, o1;
            o0.x = pack2(sp[0], sp[1]); o0.y = pack2(sp[2], sp[3]); o0.z = pack2(sp[4], sp[5]); o0.w = pack2(sp[6], sp[7]);
            o1.x = pack2(sp[8], sp[9]); o1.y = pack2(sp[10], sp[11]); o1.z = pack2(sp[12], sp[13]); o1.w = pack2(sp[14], sp[15]);
            if (c0 < 2048) {
                bf16_t* dst = XT + (size_t)(c0 + q) * MT + r0 + e16;
                *(u32x4*)dst = o0; *(u32x4*)(dst + 8) = o1;
            } else {
                *(u32x4*)(BT + frag_off(c0 - 2048 + q, r0 + e16, MT)) = o0;
                *(u32x4*)(BT + frag_off(c0 - 2048 + q, r0 + e16 + 8, MT)) = o1;
            }
        }
    }
}

__device__ void ssd_diag_item(CParams& p, int j2, int row0, int h, bf16_t* smem) {
    const int tid = tid_(), lane = tid & 63, wave = tid >> 6, l16 = lane & 15, quad = lane >> 4;
    const int g = h >> 3;
    bf16_t* sB = smem;
    bf16_t* sX = sB + 128 * SST;
    float* sda = (float*)(sX + 64 * SST);
    float* sPf = sda + 256;
    float* sRb = sPf + 128;
    float* sdtf = sRb + 128;
    float* sdtb = sdtf + 128;
    const bf16_t* XT = (const bf16_t*)(p.ws + WS_XT) + (size_t)(h * 64) * MT;
    const bf16_t* Bn = (const bf16_t*)(p.ws + WS_BN) + g * 128;
    const bf16_t* Cn = (const bf16_t*)(p.ws + WS_CN) + (size_t)(g * 4) * 512;
    const float* DT = (const float*)(p.ws + WS_DT);
    bf16_t* Y = (bf16_t*)(p.ws + WS_YF);
    const float af = -expf(p.ssm_a_log[(j2 * 2 + 0) * 32 + h]);
    const float ab = -expf(p.ssm_a_log[(j2 * 2 + 1) * 32 + h]);
    const float dsk = p.ssm_d[j2 * 32 + h];
    lds_sync();
#pragma unroll
    for (int i = 0; i < 8; ++i) {
        const int c = tid + i * 256, r = c >> 4, kc = (c & 15) * 8;
        *(u32x4*)(sB + r * SST + kc) = *(const u32x4*)(Bn + (size_t)(row0 + r) * 512 + kc);
    }
#pragma unroll
    for (int i = 0; i < 4; ++i) {
        const int c = tid + i * 256, r = c >> 4, kc = (c & 15) * 8;
        *(u32x4*)(sX + r * SST + kc) = *(const u32x4*)(XT + (size_t)r * MT + row0 + kc);
    }
    {
        const int d = wave >> 1;
        const float d0 = DT[(size_t)(row0 + lane) * 64 + d * 32 + h], d1 = DT[(size_t)(row0 + 64 + lane) * 64 + d * 32 + h];
        const float aa = d ? ab : af;
        const f32x2 sc2 = scan128(d0 * aa, d1 * aa, lane, d);
        float* sc = d ? sRb : sPf; float* sd = d ? sdtb : sdtf;
        if ((wave & 1) == 0) { sc[lane] = sc2.x; sd[lane] = d0; } else { sc[64 + lane] = sc2.y; sd[64 + lane] = d1; }
    }
    bf16x8 cf[2][4];
#pragma unroll
    for (int i = 0; i < 2; ++i)
#pragma unroll
        for (int ks = 0; ks < 4; ++ks)
            cf[i][ks] = *(const bf16x8*)(Cn + ((size_t)((row0 >> 4) + wave * 2 + i) * 16 + ks) * 512 + lane * 8);
    lds_sync();
    float pfl[2], rbl[2];
#pragma unroll
    for (int i = 0; i < 2; ++i) { pfl[i] = sPf[wave * 32 + i * 16 + l16]; rbl[i] = sRb[wave * 32 + i * 16 + l16]; }
    f32x4 y[4][2];
#pragma unroll
    for (int pt = 0; pt < 4; ++pt)
#pragma unroll
        for (int i = 0; i < 2; ++i) y[pt][i] = (f32x4){0.f, 0.f, 0.f, 0.f};
#pragma unroll 1
    for (int sp = 0; sp < 4; ++sp) {
        f32x4 gt[2][2];
#pragma unroll
        for (int s2 = 0; s2 < 2; ++s2)
#pragma unroll
            for (int i = 0; i < 2; ++i) gt[s2][i] = (f32x4){0.f, 0.f, 0.f, 0.f};
#pragma unroll
        for (int ks = 0; ks < 4; ++ks)
#pragma unroll
            for (int s2 = 0; s2 < 2; ++s2) {
                const bf16x8 bfr = lds16(sB + (sp * 32 + s2 * 16 + l16) * SST + ks * 32 + quad * 8);
#pragma unroll
                for (int i = 0; i < 2; ++i) gt[s2][i] = mfma16(bfr, cf[i][ks], gt[s2][i]);
            }
        bf16x8 mf[2];
#pragma unroll
        for (int i = 0; i < 2; ++i) {
            const int l = wave * 32 + i * 16 + l16;
#pragma unroll
            for (int s2 = 0; s2 < 2; ++s2)
#pragma unroll
                for (int r = 0; r < 4; ++r) {
                    const int s = sp * 32 + s2 * 16 + quad * 4 + r;
                    const float arg = s < l ? (pfl[i] - sPf[s]) : (rbl[i] - sRb[s]);
                    float coef = __expf(fminf(arg, 0.f)) * (s < l ? sdtf[s] : sdtb[s]);
                    if (s == l) coef = sdtf[s] + sdtb[s];
                    gt[s2][i][r] *= coef;
                }
            mf[i] = pack8(gt[0][i], gt[1][i]);
        }
#pragma unroll
        for (int pt = 0; pt < 4; ++pt) {
            const bf16_t* xp = sX + (pt * 16 + l16) * SST + sp * 32 + quad * 4;
            const bf16x8 xf = lds8x2(xp, xp + 16);
#pragma unroll
            for (int i = 0; i < 2; ++i) y[pt][i] = mfma16(xf, mf[i], y[pt][i]);
        }
    }
#pragma unroll
    for (int i = 0; i < 2; ++i) {
        const int l = wave * 32 + i * 16 + l16;
#pragma unroll
        for (int pt = 0; pt < 4; ++pt) {
            f32x4 v = y[pt][i];
#pragma unroll
            for (int r = 0; r < 4; ++r) v[r] += dsk * bf2f(sX[(pt * 16 + quad * 4 + r) * SST + l]);
            st4bf(Y + frag_off(row0 + l, h * 64 + pt * 16 + quad * 4, 2048), v[0], v[1], v[2], v[3]);
        }
    }
}

__device__ void ssd_diag_phase(CParams& p, int layer, bf16_t* smem) {
    const int j2 = layer >> 1;
    for (int t = blockIdx.x; t < (MT / 128) * 32; t += gridDim.x) {
        const int h = t & 31, chunk = t >> 5;
        ssd_diag_item(p, j2, chunk * 128, h, smem);
    }
}

struct SsdPre { u32x4 xq; u32x4 bt[2][4]; u32x4 cf[2][4]; u32x2 yold[2]; float dt0, dt1; };

__device__ __forceinline__ int ssd_row0(int b, int dir, int cc) {
    if (cc < 2) { const int ci = dir ? 1 - cc : cc; return ML + b * CTX + ci * 128; }
    const int k = cc - 2; const int ci = dir ? 63 - k : k; return b * SEQ + ci * 128;
}

__device__ __forceinline__ void ssd_scan_item(CParams& p, int j2, int b, int dir, int h, int pq, bf16_t* smem) {
    const int tid = tid_(), lane = tid & 63, wave = tid >> 6, l16 = lane & 15, quad = lane >> 4;
    const int g = h >> 3;
    bf16_t* sX = smem;
    bf16_t* sH = sX + 16 * SST;
    float* seacs = (float*)(sH + 16 * SST);
    float* sw = seacs + 128;
    float* sdec = sw + 128;
    const bf16_t* XT = (const bf16_t*)(p.ws + WS_XT) + (size_t)(h * 64 + pq * 16 + (tid >> 4)) * MT + (tid & 15) * 8;
    const bf16_t* Cn = (const bf16_t*)(p.ws + WS_CN) + ((size_t)(wave * 2) * 16 + g * 4) * 512 + lane * 8;
    const bf16_t* BT = (const bf16_t*)(p.ws + WS_BT) + (size_t)(g * 8 + wave * 2) * (MT / 32) * 512 + lane * 8;
    const float* DT = (const float*)(p.ws + WS_DT) + dir * 32 + h;
    bf16_t* Y = (bf16_t*)(p.ws + (dir ? WS_YB : WS_YF)) + frag_off(wave * 32 + l16, h * 64 + pq * 16 + quad * 4, 2048);
    const float a = -expf(p.ssm_a_log[(j2 * 2 + dir) * 32 + h]);
    f32x4 st[2];
    st[0] = (f32x4){0.f, 0.f, 0.f, 0.f}; st[1] = (f32x4){0.f, 0.f, 0.f, 0.f};
    SsdPre S0, S1;
    auto load_small = [&](SsdPre& S, int r) __attribute__((always_inline)) {
        S.xq = *(const u32x4*)(XT + r);
        S.dt0 = DT[(size_t)(r + lane) * 64]; S.dt1 = DT[(size_t)(r + 64 + lane) * 64];
    };
    auto load_cf = [&](SsdPre& S, int r) __attribute__((always_inline)) {
#pragma unroll
        for (int i = 0; i < 2; ++i)
#pragma unroll
            for (int ks = 0; ks < 4; ++ks) S.cf[i][ks] = *(const u32x4*)(Cn + ((size_t)((r >> 4) + i) * 16 + ks) * 512);
    };
    auto load_yold = [&](SsdPre& S, int r) __attribute__((always_inline)) {
#pragma unroll
        for (int i = 0; i < 2; ++i) S.yold[i] = dir == 0 ? *(const u32x2*)(Y + (size_t)((r >> 4) + i) * (64 * 512)) : (u32x2){0u, 0u};
    };
    auto load_bt = [&](SsdPre& S, int r) __attribute__((always_inline)) {
#pragma unroll
        for (int nt = 0; nt < 2; ++nt)
#pragma unroll
            for (int ks = 0; ks < 4; ++ks) S.bt[nt][ks] = *(const u32x4*)(BT + ((size_t)nt * (MT / 32) + (r >> 5) + ks) * 512);
    };
    {
        const int r0 = ssd_row0(b, dir, 0), r1 = ssd_row0(b, dir, 1);
        load_small(S0, r0); load_cf(S0, r0); load_yold(S0, r0); load_bt(S0, r0);
        load_small(S1, r1); load_cf(S1, r1); load_yold(S1, r1); load_bt(S1, r1);
    }
    auto body = [&](SsdPre& S, int cc) __attribute__((always_inline)) {
        const int row0 = ssd_row0(b, dir, cc);
        const int row2 = ssd_row0(b, dir, cc + 2 < 66 ? cc + 2 : 65);
        lds_sync();
        *(u32x4*)(sX + (tid >> 4) * SST + (tid & 15) * 8) = S.xq;
#pragma unroll
        for (int nt = 0; nt < 2; ++nt) st4bf(sH + l16 * SST + wave * 32 + nt * 16 + quad * 4, st[nt][0], st[nt][1], st[nt][2], st[nt][3]);
        if (wave < 2) {
            const f32x2 sc2 = scan128(S.dt0 * a, S.dt1 * a, lane, dir);
            const float total = dir == 0 ? __shfl(sc2.y, 63) : __shfl(sc2.x, 0);
            if (wave == 0) { seacs[lane] = __expf(sc2.x); sw[lane] = S.dt0 * __expf(total - sc2.x); if (lane == 0) sdec[0] = __expf(total); }
            else { seacs[64 + lane] = __expf(sc2.y); sw[64 + lane] = S.dt1 * __expf(total - sc2.y); }
        }
        lds_sync();
        load_small(S, row2);
        f32x4 yo[2];
        yo[0] = (f32x4){0.f, 0.f, 0.f, 0.f}; yo[1] = (f32x4){0.f, 0.f, 0.f, 0.f};
#pragma unroll
        for (int ks = 0; ks < 4; ++ks) {
            const bf16x8 hf = lds16(sH + l16 * SST + ks * 32 + quad * 8);
#pragma unroll
            for (int i = 0; i < 2; ++i) yo[i] = mfma16(hf, __builtin_bit_cast(bf16x8, S.cf[i][ks]), yo[i]);
        }
        __builtin_amdgcn_sched_barrier(0);
        load_cf(S, row2);
#pragma unroll
        for (int i = 0; i < 2; ++i) {
            const float e = seacs[wave * 32 + i * 16 + l16];
            const float o0 = __uint_as_float(S.yold[i].x << 16), o1 = __uint_as_float(S.yold[i].x & 0xffff0000u);
            const float o2 = __uint_as_float(S.yold[i].y << 16), o3 = __uint_as_float(S.yold[i].y & 0xffff0000u);
            st4bf(Y + (size_t)((row0 >> 4) + i) * (64 * 512), yo[i][0] * e + o0, yo[i][1] * e + o1, yo[i][2] * e + o2, yo[i][3] * e + o3);
        }
        __builtin_amdgcn_sched_barrier(0);
        load_yold(S, row2);
        {
            const float dec = sdec[0];
            st[0] *= dec; st[1] *= dec;
#pragma unroll
            for (int ks = 0; ks < 4; ++ks) {
                const f32x4 w0 = *(const f32x4*)(sw + ks * 32 + quad * 8), w1 = *(const f32x4*)(sw + ks * 32 + quad * 8 + 4);
                const u32x4 raw = *(const u32x4*)(sX + l16 * SST + ks * 32 + quad * 8);
                u32x4 xs;
                xs.x = pack2(__uint_as_float(raw.x << 16) * w0[0], __uint_as_float(raw.x & 0xffff0000u) * w0[1]);
                xs.y = pack2(__uint_as_float(raw.y << 16) * w0[2], __uint_as_float(raw.y & 0xffff0000u) * w0[3]);
                xs.z = pack2(__uint_as_float(raw.z << 16) * w1[0], __uint_as_float(raw.z & 0xffff0000u) * w1[1]);
                xs.w = pack2(__uint_as_float(raw.w << 16) * w1[2], __uint_as_float(raw.w & 0xffff0000u) * w1[3]);
                const bf16x8 xbf = __builtin_bit_cast(bf16x8, xs);
#pragma unroll
                for (int nt = 0; nt < 2; ++nt) st[nt] = mfma16(__builtin_bit_cast(bf16x8, S.bt[nt][ks]), xbf, st[nt]);
            }
        }
        __builtin_amdgcn_sched_barrier(0);
        load_bt(S, row2);
    };
#pragma unroll 1
    for (int cc = 0; cc < 66; cc += 2) {
        body(S0, cc);
        body(S1, cc + 1);
    }
}

__device__ void ssd_scan_phase(CParams& p, int layer, bf16_t* smem) {
    const int j2 = layer >> 1;
    for (int t = blockIdx.x; t < NB * 2 * 32 * 4; t += gridDim.x) {
        const int xcd = t & 7, li = t >> 3, gi = xcd * 2 + (li >> 5);
        const int pq = li & 3, h = (gi & 3) * 8 + ((li & 31) >> 2), dir = (gi >> 2) & 1, b = gi >> 3;
        ssd_scan_item(p, j2, b, dir, h, pq, smem);
    }
}

__device__ void finish_phase(CParams& p, int layer) {
    const int j2 = layer >> 1, lane = tid_() & 63, wave = tid_() >> 6, quad = lane >> 4;
    bf16_t* yf = (bf16_t*)(p.ws + WS_YF); const bf16_t* yb = (const bf16_t*)(p.ws + WS_YB); const bf16_t* z = (const bf16_t*)(p.ws + WS_Z);
    const float* gn = p.ssm_norm_g + (size_t)j2 * 2048;
    for (int tr = blockIdx.x * 4 + wave; tr < MT / 16; tr += gridDim.x * 4) {
        const size_t base = (size_t)tr * 64 * 512 + lane * 8;
#pragma unroll 1
        for (int g = 0; g < 4; ++g) {
            float ss = 0.f;
#pragma unroll 4
            for (int kk = 0; kk < 16; ++kk) {
                const size_t off = base + (size_t)(g * 16 + kk) * 512;
                const u32x4 a = *(const u32x4*)(yf + off), bq = *(const u32x4*)(yb + off), zq = *(const u32x4*)(z + off);
                const unsigned aw[4] = {a.x, a.y, a.z, a.w}, bw[4] = {bq.x, bq.y, bq.z, bq.w}, zw[4] = {zq.x, zq.y, zq.z, zq.w};
#pragma unroll
                for (int k = 0; k < 4; ++k) {
                    const float v0 = (__uint_as_float(aw[k] << 16) + __uint_as_float(bw[k] << 16)) * __uint_as_float(zw[k] << 16);
                    const float v1 = (__uint_as_float(aw[k] & 0xffff0000u) + __uint_as_float(bw[k] & 0xffff0000u)) * __uint_as_float(zw[k] & 0xffff0000u);
                    ss += v0 * v0 + v1 * v1;
                }
            }
            ss += __shfl_xor(ss, 16); ss += __shfl_xor(ss, 32);
            const float rstd = rsqrtf(ss * (1.f / 512.f) + EPS);
#pragma unroll 4
            for (int kk = 0; kk < 16; ++kk) {
                const size_t off = base + (size_t)(g * 16 + kk) * 512;
                const u32x4 a = *(const u32x4*)(yf + off), bq = *(const u32x4*)(yb + off), zq = *(const u32x4*)(z + off);
                const unsigned aw[4] = {a.x, a.y, a.z, a.w}, bw[4] = {bq.x, bq.y, bq.z, bq.w}, zw[4] = {zq.x, zq.y, zq.z, zq.w};
                const int col = (g * 16 + kk) * 32 + quad * 8;
                const f32x4 g0 = *(const f32x4*)(gn + col), g1 = *(const f32x4*)(gn + col + 4);
                const float gg[8] = {g0[0], g0[1], g0[2], g0[3], g1[0], g1[1], g1[2], g1[3]};
                unsigned ow[4];
#pragma unroll
                for (int k = 0; k < 4; ++k) {
                    const float v0 = (__uint_as_float(aw[k] << 16) + __uint_as_float(bw[k] << 16)) * __uint_as_float(zw[k] << 16);
                    const float v1 = (__uint_as_float(aw[k] & 0xffff0000u) + __uint_as_float(bw[k] & 0xffff0000u)) * __uint_as_float(zw[k] & 0xffff0000u);
                    ow[k] = pack2(v0 * rstd * gg[2 * k], v1 * rstd * gg[2 * k + 1]);
                }
                u32x4 o4; o4.x = ow[0]; o4.y = ow[1]; o4.z = ow[2]; o4.w = ow[3];
                *(u32x4*)(yf + off) = o4;
            }
        }
    }
}

__global__ void __launch_bounds__(256, 2) hybrid_fwd(Params p) {
    extern __shared__ __attribute__((aligned(16))) unsigned char lds[];
    cg::grid_group grid = cg::this_grid();
    bf16_t* smem = (bf16_t*)lds; float* smf = (float*)lds;
    volatile LAS unsigned* bst = (volatile LAS unsigned*)(lds + LDS_BYTES - 16);
    if (threadIdx.x == 0) { bst[0] = 0u; bst[1] = 0u; }
    __syncthreads();
    const XcdBarrier xb = xcd_barrier_post((unsigned*)(p.ws + WS_BAR), bst);
    enum { C_NORM1 = 0, C_MIXIN, C_ATTN, C_MIXOUT, C_NORM2, C_FFNIN, C_FFNOUT, C_SSMIN, C_CONV, C_SSD, C_FINISH, C_SSMOUT, C_PRO, C_SSDB };
    const unsigned long long evc = 0x6543210ull;
    const unsigned long long odc = 0x654BAD9870ull;
    for (int ph = 0; ph < 35; ++ph) {
        int code, layer;
        if (ph == 0) { code = C_PRO; layer = 0; }
        else {
            const int q = ph - 1, pair = q / 17, r = q - pair * 17;
            if (r < 7) { layer = 2 * pair; code = (int)((evc >> (4 * r)) & 15); }
            else { layer = 2 * pair + 1; code = (int)((odc >> (4 * (r - 7))) & 15); }
        }
        CParams* kp = (CParams*)__builtin_amdgcn_kernarg_segment_ptr();
        asm volatile("" : "+s"(kp));
        CParams& q = *kp;
#define PHASE(c) asm volatile("" : "+s"(code)); if (code == (c))
        PHASE(C_PRO) prologue(q, smf);
        PHASE(C_NORM1) { if (layer > 0) convert_layer_weights(q, layer, smf); norm_phase(q, layer, 0); }
        PHASE(C_NORM2) norm_phase(q, layer, 1);
        PHASE(C_MIXIN) gemm_phase<G_MIXIN>(q, layer, smem);
        PHASE(C_ATTN) attn_sg_phase(q, layer, smem);
        PHASE(C_MIXOUT) gemm_phase<G_MIXOUT>(q, layer, smem);
        PHASE(C_FFNIN) gemm_phase<G_FFNIN>(q, layer, smem);
        PHASE(C_FFNOUT) gemm_phase<G_FFNOUT>(q, layer, smem);
        PHASE(C_SSMIN) gemm_phase<G_SSMIN>(q, layer, smem);
        PHASE(C_CONV) conv_phase(q, layer, smf);
        PHASE(C_SSD) ssd_diag_phase(q, layer, smem);
        PHASE(C_SSDB) ssd_scan_phase(q, layer, smem);
        PHASE(C_FINISH) finish_phase(q, layer);
        PHASE(C_SSMOUT) gemm_phase<G_SSMOUT>(q, layer, smem);
#undef PHASE
        if (q.out == nullptr) grid.sync();
        xcd_barrier(xb);
    }
}

extern "C" void kernel_launch(void* const* d_in, const int* in_sizes, int n_in, void* d_out, int out_size, void* d_ws, size_t ws_size, hipStream_t stream) {
    static int grid_blocks = 0;
    if (grid_blocks == 0) {
        if (ws_size < WS_TOTAL) { fprintf(stderr, "kernel_launch: workspace too small: %zu < %zu\n", ws_size, (size_t)WS_TOTAL); grid_blocks = -1; return; }
        int dev = 0, cus = 0, per_cu = 0;
        hipGetDevice(&dev);
        hipDeviceGetAttribute(&cus, hipDeviceAttributeMultiprocessorCount, dev);
        if (hipFuncSetAttribute((const void*)hybrid_fwd, hipFuncAttributeMaxDynamicSharedMemorySize, LDS_BYTES) != hipSuccess) { fprintf(stderr, "kernel_launch: hipFuncSetAttribute failed\n"); }
        if (hipOccupancyMaxActiveBlocksPerMultiprocessor(&per_cu, (const void*)hybrid_fwd, 256, LDS_BYTES) != hipSuccess || per_cu < 1) { fprintf(stderr, "kernel_launch: occupancy query failed (%d)\n", per_cu); per_cu = 1; }
        if (per_cu > 2) per_cu = 2;
        (void)hipGetLastError();
        grid_blocks = cus * per_cu;
    }
    if (grid_blocks < 0) return;
    if (hipMemsetAsync((char*)d_ws + WS_BAR, 0, XCD_BAR_WORDS * sizeof(unsigned), stream) != hipSuccess) { fprintf(stderr, "kernel_launch: hipMemsetAsync failed\n"); return; }
    Params p{};
    const float** f = (const float**)&p;
    for (int i = 0; i < 25; ++i) f[i] = (const float*)d_in[i];
    p.out = (float*)d_out; p.ws = (unsigned char*)d_ws;
    void* args[] = {&p};
    hipError_t e = hipLaunchCooperativeKernel((const void*)hybrid_fwd, dim3(grid_blocks), dim3(256), args, LDS_BYTES, stream);
    if (e != hipSuccess) fprintf(stderr, "cooperative launch failed: %s (grid %d)\n", hipGetErrorString(e), grid_blocks);
}
```

```cpp
#include <hip/hip_runtime.h>
#include <hip/hip_cooperative_groups.h>
#include <cstdio>
#include <cstdint>
namespace cg = cooperative_groups;

typedef unsigned short bf16_t;
typedef short bf16x8 __attribute__((ext_vector_type(8)));
typedef short bf16x4 __attribute__((ext_vector_type(4)));
typedef float f32x4 __attribute__((ext_vector_type(4)));
typedef unsigned u32x4 __attribute__((ext_vector_type(4)));
typedef unsigned u32x2 __attribute__((ext_vector_type(2)));

constexpr int D = 1024, NB = 2, SEQ = 8192, CTX = 256;
constexpr int ML = NB * SEQ;
constexpr int MC = NB * CTX;
constexpr int MT = ML + MC;
constexpr int TALL = CTX + SEQ;
constexpr int FFH = 2816;
constexpr int MIXIN = 1792;
constexpr int SSMIN = 5184, SSMIN_PAD = 5248;
constexpr int SSI = 2048;
constexpr float EPS = 1e-6f;
constexpr float QSCALE = 0.125f * 1.4426950408889634f;

constexpr size_t MB = 1024 * 1024;
constexpr size_t WS_MOD = 0;
constexpr size_t WS_ROPE = 1 * MB;
constexpr size_t WS_XCTX = 3 * MB;
constexpr size_t WS_SGW = 5 * MB + 512 * 1024;
constexpr size_t WS_BAR = 7 * MB;
constexpr size_t WS_WT = 8 * MB;
constexpr size_t WT_FFNIN = 0;
constexpr size_t WT_FFNOUT = WT_FFNIN + (size_t)5632 * 1024 * 2;
constexpr size_t WT_MIXIN = WT_FFNOUT + (size_t)1024 * 2816 * 2;
constexpr size_t WT_MIXOUT = WT_MIXIN + (size_t)SSMIN_PAD * 1024 * 2;
constexpr size_t WT_END = WT_MIXOUT + (size_t)1024 * 2048 * 2;
constexpr size_t WS_R0 = WS_WT + ((WT_END + MB - 1) / MB) * MB;
constexpr size_t SZ_XBC = (size_t)MT * 3072 * 2;
constexpr size_t SZ_HN = (size_t)MT * 1024 * 2;
constexpr size_t WS_XBC = WS_R0;
constexpr size_t WS_HN = WS_XBC + SZ_XBC;
constexpr size_t WS_YF = WS_XBC;
constexpr size_t WS_YB = WS_YF + (size_t)MT * 2048 * 2;
constexpr size_t WS_R1 = WS_HN + SZ_HN;
constexpr size_t WS_Z = WS_R1;
constexpr size_t WS_XT = WS_Z + (size_t)MT * 2048 * 2;
constexpr size_t WS_BN = WS_XT + (size_t)MT * 2048 * 2;
constexpr size_t WS_CN = WS_BN + (size_t)MT * 512 * 2;
constexpr size_t WS_BT = WS_CN + (size_t)MT * 512 * 2;
constexpr size_t WS_DT = WS_BT + (size_t)MT * 512 * 2;
constexpr size_t WS_END_ODD = WS_DT + (size_t)MT * 64 * 4;
constexpr size_t WS_Q = WS_R1;
constexpr size_t WS_K = WS_Q + (size_t)MT * 512 * 2;
constexpr size_t WS_VT = WS_K + (size_t)MT * 128 * 2;
constexpr size_t WS_U = WS_VT + (size_t)MT * 128 * 2;
constexpr size_t WS_GVT = WS_U + (size_t)MT * 512 * 2;
constexpr size_t WS_AS = WS_GVT + (size_t)MT * 512 * 2;
constexpr size_t WS_HID = WS_R1;
constexpr size_t WS_TOTAL = WS_END_ODD;
static_assert(WS_TOTAL < (size_t)400 * MB, "workspace too large");
static_assert(WS_AS + (size_t)MT * 1024 * 2 <= WS_END_ODD, "even buffers fit");
static_assert(WS_HID + (size_t)MT * FFH * 2 <= WS_END_ODD, "hid fits");

constexpr int LDS_BYTES = 73728;
constexpr int GST = 72;
constexpr int SST = 136;

struct Params {
    const float* x; const float* c; const float* ctx; const float* c_ctx;
    const float* ada_w; const float* ada_b; const float* norm1_g; const float* norm2_g;
    const float* ffn_w_in; const float* ffn_w_out; const float* mix_w_in; const float* mix_w_out;
    const float* q_norm_g; const float* k_norm_g; const float* sgu_norm_g; const float* sgu_w; const float* sgu_b;
    const float* ssm_w_in; const float* ssm_conv_w; const float* ssm_conv_b; const float* ssm_dt_bias;
    const float* ssm_a_log; const float* ssm_d; const float* ssm_norm_g; const float* ssm_w_out;
    float* out; unsigned char* ws;
};

typedef const __attribute__((address_space(4))) Params CParams;

__device__ __forceinline__ int tid_() { int t = threadIdx.x; asm volatile("" : "+v"(t)); return t; }
__device__ __forceinline__ bf16_t f2bf(float f) {
    unsigned u = __float_as_uint(f);
    u += 0x7fffu + ((u >> 16) & 1u);
    return (bf16_t)(u >> 16);
}
__device__ __forceinline__ float bf2f(bf16_t h) { return __uint_as_float(((unsigned)h) << 16); }
__device__ __forceinline__ unsigned pack2(float a, float b) { unsigned r; asm volatile("v_cvt_pk_bf16_f32 %0, %1, %2" : "=v"(r) : "v"(a), "v"(b)); return r; }
__device__ __forceinline__ float siluf(float v) { return v / (1.f + __expf(-v)); }
__device__ __forceinline__ float geluf(float v) {
    const float u = 0.7978845608028654f * (v + 0.044715f * v * v * v);
    return v / (1.f + __expf(-2.f * u));
}
__device__ __forceinline__ float softplusf(float v) { return v > 20.f ? v : log1pf(expf(v)); }
__device__ __forceinline__ int seg_of(int row) { return row < SEQ ? 0 : (row < ML ? 1 : 2); }
__device__ __forceinline__ float* xrow(CParams& p, int row) {
    return row < ML ? p.out + (size_t)row * D : (float*)(p.ws + WS_XCTX) + (size_t)(row - ML) * D;
}
__device__ __forceinline__ void lds_sync() {
    __builtin_amdgcn_fence(__ATOMIC_RELEASE, "workgroup", "local");
    __builtin_amdgcn_s_barrier();
    __builtin_amdgcn_fence(__ATOMIC_ACQUIRE, "workgroup", "local");
}
typedef float f32x2 __attribute__((ext_vector_type(2)));
__device__ __forceinline__ f32x2 scan128(float s0, float s1, int lane, int dir) {
    if (dir == 0) {
#pragma unroll
        for (int o = 1; o < 64; o <<= 1) { const float t0 = __shfl_up(s0, o), t1 = __shfl_up(s1, o); s0 += lane >= o ? t0 : 0.f; s1 += lane >= o ? t1 : 0.f; }
        s1 += __shfl(s0, 63);
    } else {
#pragma unroll
        for (int o = 1; o < 64; o <<= 1) { const float t0 = __shfl_down(s0, o), t1 = __shfl_down(s1, o); s0 += lane + o < 64 ? t0 : 0.f; s1 += lane + o < 64 ? t1 : 0.f; }
        s0 += __shfl(s1, 0);
    }
    return (f32x2){s0, s1};
}
__device__ __forceinline__ f32x4 mfma16(bf16x8 a, bf16x8 b, f32x4 c) { return __builtin_amdgcn_mfma_f32_16x16x32_bf16(a, b, c, 0, 0, 0); }
__device__ __forceinline__ bf16x8 lds16(const bf16_t* p) { return *(const bf16x8*)p; }
__device__ __forceinline__ bf16x8 lds8x2(const bf16_t* p0, const bf16_t* p1) {
    const bf16x4 a = *(const bf16x4*)p0, b = *(const bf16x4*)p1;
    bf16x8 r; r[0] = a[0]; r[1] = a[1]; r[2] = a[2]; r[3] = a[3]; r[4] = b[0]; r[5] = b[1]; r[6] = b[2]; r[7] = b[3];
    return r;
}
__device__ __forceinline__ bf16x8 pack8(f32x4 a, f32x4 b) {
    u32x4 w; w.x = pack2(a[0], a[1]); w.y = pack2(a[2], a[3]); w.z = pack2(b[0], b[1]); w.w = pack2(b[2], b[3]);
    return __builtin_bit_cast(bf16x8, w);
}
__device__ __forceinline__ void st4bf(bf16_t* dst, float a, float b, float c, float d) {
    u32x2 w; w.x = pack2(a, b); w.y = pack2(c, d); *(u32x2*)dst = w;
}


#define XB_TMO      128
#define XB_XCNT(j)  (256  + 64 * (j))
#define XB_XSUB(j)  (1280 + 64 * (j))
#define XB_XGEN(j)  (2304 + 64 * (j))
#define XB_TOP      3328
#define XB_TOPGEN   3392
#define XCD_BAR_WORDS 3456
#define XB_SPIN_CAP (1u << 18)
#define LAS __attribute__((address_space(3)))
__device__ __forceinline__ unsigned xb_ld(unsigned* p)              { return __hip_atomic_load(p, __ATOMIC_RELAXED, __HIP_MEMORY_SCOPE_AGENT); }
__device__ __forceinline__ unsigned xb_add(unsigned* p, unsigned v) { return __hip_atomic_fetch_add(p, v, __ATOMIC_RELAXED, __HIP_MEMORY_SCOPE_AGENT); }
__device__ __forceinline__ unsigned xb_xcc_id() { return (unsigned)__builtin_amdgcn_s_getreg((3 << 11) | 20) & 0xFu; }
#define XB_SPIN(cond, bar) do { unsigned _sp = 0; while (cond) { __builtin_amdgcn_s_sleep(1); \
    if ((++_sp & 255u) == 0u) { if (xb_ld(&(bar)[XB_TMO])) break; if (_sp > XB_SPIN_CAP) { atomicAdd(&(bar)[XB_TMO], 1u); break; } } } } while (0)
struct XcdBarrier { unsigned* bar; unsigned x; volatile LAS unsigned* st; };
__device__ __forceinline__ XcdBarrier xcd_barrier_post(unsigned* bar, volatile LAS unsigned* st) {
    XcdBarrier b; b.bar = bar; b.x = xb_xcc_id(); b.st = st;
    if (threadIdx.x == 0) (void)xb_add(&bar[XB_XCNT(b.x)], 1u);
    return b;
}
__device__ __forceinline__ void xcd_barrier_complete(unsigned* bar, unsigned x, unsigned& nloc, unsigned& nx) {
    const unsigned G = gridDim.x * gridDim.y * gridDim.z;
    unsigned sum, cnt, mine, sp = 0u;
    for (;;) {
        sum = 0u; cnt = 0u; mine = 0u;
#pragma unroll
        for (unsigned j = 0; j < 16; ++j) { const unsigned c = xb_ld(&bar[XB_XCNT(j)]); sum += c; cnt += (c > 0u) ? 1u : 0u; mine = (j == x) ? c : mine; }
        if (sum == G) break;
        __builtin_amdgcn_s_sleep(1);
        if ((++sp & 255u) == 0u) { if (xb_ld(&bar[XB_TMO])) break; if (sp > XB_SPIN_CAP) { atomicAdd(&bar[XB_TMO], 1u); break; } }
    }
    nloc = mine > 0u ? mine : 1u; nx = cnt > 0u ? cnt : 1u;
}
__device__ __forceinline__ void xcd_barrier(const XcdBarrier& b) {
    asm volatile("s_waitcnt vmcnt(0)" ::: "memory");
    __syncthreads();
    if (threadIdx.x == 0) {
        unsigned* bar = b.bar;
        __builtin_amdgcn_s_waitcnt(0);
        unsigned nloc = b.st[0], nx = b.st[1];
        if (nloc == 0u) { xcd_barrier_complete(bar, b.x, nloc, nx); b.st[0] = nloc; b.st[1] = nx; }
        const unsigned old = xb_add(&bar[XB_XSUB(b.x)], 1u);
        const unsigned gen = old / nloc;
        if (old + 1u == (gen + 1u) * nloc) {
            __builtin_amdgcn_fence(__ATOMIC_RELEASE, "agent");
            asm volatile("s_waitcnt vmcnt(0)" ::: "memory");
            const unsigned og = xb_add(&bar[XB_TOP], 1u);
            const unsigned tg = og / nx;
            if (og + 1u == (tg + 1u) * nx) xb_add(&bar[XB_TOPGEN], 1u);
            else XB_SPIN(xb_ld(&bar[XB_TOPGEN]) == tg, bar);
            __builtin_amdgcn_fence(__ATOMIC_ACQUIRE, "agent");
            xb_add(&bar[XB_XGEN(b.x)], 1u);
            asm volatile("s_waitcnt vmcnt(0)" ::: "memory");
        } else {
            XB_SPIN(xb_ld(&bar[XB_XGEN(b.x)]) == gen, bar);
            __builtin_amdgcn_fence(__ATOMIC_ACQUIRE, "agent");
            asm volatile("s_waitcnt vmcnt(0)" ::: "memory");
        }
    }
    __syncthreads();
}

__device__ __forceinline__ size_t frag_off(int row, int col, int K) {
    return ((size_t)(row >> 4) * (K >> 5) + (col >> 5)) * 512 + ((row & 15) + 16 * ((col & 31) >> 3)) * 8 + (col & 7);
}

template <int MI, int lda, int ldw, int K, int FRAG = 0>
__device__ __forceinline__ void gemm_tile(const bf16_t* __restrict__ A, const bf16_t* __restrict__ W,
                                          f32x4 (&acc)[MI][8], bf16_t* sW) {
    const int tid = tid_(), lane = tid & 63, wave = tid >> 6, l16 = lane & 15, quad = lane >> 4;
    const int srow = tid >> 3, skc = (tid & 7) * 8;
    constexpr int ASI = FRAG ? (K / 32) * 512 : 16 * lda;
    constexpr int ASK = FRAG ? 512 : 32;
    const bf16_t* ap = FRAG ? A + (size_t)(wave * MI) * ASI + lane * 8 : A + (size_t)(wave * 16 * MI + l16) * lda + quad * 8;
    const bf16_t* wp = W + (size_t)srow * ldw + skc;
    const bf16_t* wr = sW + l16 * GST + quad * 8;
    u32x4 ra[MI][2], rw[4];
#pragma unroll
    for (int i = 0; i < 4; ++i) rw[i] = *(const u32x4*)(wp + (size_t)(i * 32) * ldw);
#pragma unroll
    for (int i = 0; i < MI; ++i)
#pragma unroll
        for (int ks = 0; ks < 2; ++ks) ra[i][ks] = *(const u32x4*)(ap + (size_t)i * ASI + ks * ASK);
#pragma unroll
    for (int i = 0; i < MI; ++i)
#pragma unroll
        for (int j = 0; j < 8; ++j) acc[i][j] = (f32x4){0.f, 0.f, 0.f, 0.f};
    constexpr int nk = K >> 6;
#pragma unroll 1
    for (int kt = 0; kt < nk; ++kt) {
        lds_sync();
#pragma unroll
        for (int i = 0; i < 4; ++i) *(u32x4*)(sW + (srow + i * 32) * GST + skc) = rw[i];
        lds_sync();
        const int k0 = (kt + 1 < nk ? kt + 1 : kt) << 6;
        const int ka = FRAG ? (k0 >> 5) * 512 : k0;
#pragma unroll
        for (int i = 0; i < 4; ++i) rw[i] = *(const u32x4*)(wp + (size_t)(i * 32) * ldw + k0);
        bf16x8 wa[4], wb[4];
#pragma unroll
        for (int j = 0; j < 4; ++j) wa[j] = lds16(wr + (j * 16) * GST);
#pragma unroll
        for (int j = 0; j < 4; ++j) wb[j] = lds16(wr + ((j + 4) * 16) * GST);
        __builtin_amdgcn_sched_barrier(0);
        __builtin_amdgcn_s_setprio(1);
#pragma unroll
        for (int j = 0; j < 4; ++j)
#pragma unroll
            for (int i = 0; i < MI; ++i) acc[i][j] = mfma16(wa[j], __builtin_bit_cast(bf16x8, ra[i][0]), acc[i][j]);
        __builtin_amdgcn_sched_barrier(0);
#pragma unroll
        for (int j = 0; j < 4; ++j) wa[j] = lds16(wr + (j * 16) * GST + 32);
        __builtin_amdgcn_sched_barrier(0);
#pragma unroll
        for (int j = 0; j < 4; ++j)
#pragma unroll
            for (int i = 0; i < MI; ++i) acc[i][j + 4] = mfma16(wb[j], __builtin_bit_cast(bf16x8, ra[i][0]), acc[i][j + 4]);
        __builtin_amdgcn_sched_barrier(0);
#pragma unroll
        for (int i = 0; i < MI; ++i) ra[i][0] = *(const u32x4*)(ap + (size_t)i * ASI + ka);
#pragma unroll
        for (int j = 0; j < 4; ++j) wb[j] = lds16(wr + ((j + 4) * 16) * GST + 32);
        __builtin_amdgcn_sched_barrier(0);
#pragma unroll
        for (int j = 0; j < 4; ++j)
#pragma unroll
            for (int i = 0; i < MI; ++i) acc[i][j] = mfma16(wa[j], __builtin_bit_cast(bf16x8, ra[i][1]), acc[i][j]);
        __builtin_amdgcn_sched_barrier(0);
#pragma unroll
        for (int j = 0; j < 4; ++j)
#pragma unroll
            for (int i = 0; i < MI; ++i) acc[i][j + 4] = mfma16(wb[j], __builtin_bit_cast(bf16x8, ra[i][1]), acc[i][j + 4]);
        __builtin_amdgcn_s_setprio(0);
        __builtin_amdgcn_sched_barrier(0);
#pragma unroll
        for (int i = 0; i < MI; ++i) ra[i][1] = *(const u32x4*)(ap + (size_t)i * ASI + ka + ASK);
    }
}

template <int MI>
__device__ __forceinline__ void epi_resid(CParams& p, int m0, int n0, const f32x4 (&acc)[MI][8], const float* gate  ) {
    const int lane = tid_() & 63, wave = tid_() >> 6, l16 = lane & 15, quad = lane >> 4;
#pragma unroll
    for (int i = 0; i < MI; ++i) {
        const int row = m0 + wave * 16 * MI + i * 16 + l16;
        float* xr = xrow(p, row);
        const float* g = gate + (size_t)seg_of(row) * 6144;
#pragma unroll
        for (int j = 0; j < 8; ++j) {
            const int col = n0 + j * 16 + quad * 4;
            const f32x4 gv = *(const f32x4*)(g + col);
            f32x4 xv = *(f32x4*)(xr + col);
            xv += gv * acc[i][j];
            *(f32x4*)(xr + col) = xv;
        }
    }
}

template <int MI>
__device__ __forceinline__ void epi_swiglu(CParams& p, int m0, int n0, const f32x4 (&acc)[MI][8]) {
    const int lane = tid_() & 63, wave = tid_() >> 6, l16 = lane & 15, quad = lane >> 4;
    bf16_t* hid = (bf16_t*)(p.ws + WS_HID);
#pragma unroll
    for (int i = 0; i < MI; ++i) {
        const int row = m0 + wave * 16 * MI + i * 16 + l16;
#pragma unroll
        for (int jj = 0; jj < 4; ++jj) {
            const f32x4 g = acc[i][2 * jj], u = acc[i][2 * jj + 1];
            const int hc = (n0 >> 1) + jj * 16 + quad * 4;
            const size_t off = ((size_t)(row >> 4) * (FFH / 32) + (hc >> 5)) * 512 + ((row & 15) + 16 * ((hc & 31) >> 3)) * 8 + (hc & 7);
            st4bf(hid + off, siluf(g[0]) * u[0], siluf(g[1]) * u[1], siluf(g[2]) * u[2], siluf(g[3]) * u[3]);
        }
    }
}

template <int MI>
__device__ __forceinline__ void epi_mixin(CParams& p, int j2, int m0, int tn, f32x4 (&acc)[MI][8]) {
    const int lane = tid_() & 63, wave = tid_() >> 6, l16 = lane & 15, quad = lane >> 4;
    if (tn < 5) {
        const float* gsrc = (tn < 4 ? p.q_norm_g : p.k_norm_g) + j2 * 64;
        const float* cosT = (const float*)(p.ws + WS_ROPE);
        const float* sinT = cosT + 8192 * 32;
#pragma unroll
        for (int i = 0; i < MI; ++i) {
            const int row = m0 + wave * 16 * MI + i * 16 + l16;
#pragma unroll
            for (int hh = 0; hh < 2; ++hh) {
                float ss = 0.f;
#pragma unroll
                for (int j = 0; j < 4; ++j) { const f32x4 v = acc[i][hh * 4 + j]; ss += v[0] * v[0] + v[1] * v[1] + v[2] * v[2] + v[3] * v[3]; }
                ss += __shfl_xor(ss, 16); ss += __shfl_xor(ss, 32);
                const float rstd = rsqrtf(ss * (1.f / 64.f) + EPS);
                f32x4 y[4];
#pragma unroll
                for (int j = 0; j < 4; ++j) {
                    const f32x4 gv = *(const f32x4*)(gsrc + j * 16 + quad * 4);
                    y[j] = acc[i][hh * 4 + j] * rstd * gv;
                }
                if (row < ML) {
                    const int s = row & (SEQ - 1);
#pragma unroll
                    for (int j = 0; j < 2; ++j) {
                        const f32x4 cs = *(const f32x4*)(cosT + (size_t)s * 32 + j * 16 + quad * 4);
                        const f32x4 sn = *(const f32x4*)(sinT + (size_t)s * 32 + j * 16 + quad * 4);
                        const f32x4 x1 = y[j], x2 = y[j + 2];
                        y[j] = x1 * cs - x2 * sn;
                        y[j + 2] = x2 * cs + x1 * sn;
                    }
                }
                if (tn < 4) {
                    bf16_t* q = (bf16_t*)(p.ws + WS_Q) + (size_t)row * 512 + (tn * 2 + hh) * 64;
#pragma unroll
                    for (int j = 0; j < 4; ++j) st4bf(q + j * 16 + quad * 4, y[j][0] * QSCALE, y[j][1] * QSCALE, y[j][2] * QSCALE, y[j][3] * QSCALE);
                } else {
                    const int b = row < ML ? (row >> 13) : ((row - ML) >> 8);
                    const int t = row < ML ? CTX + (row & (SEQ - 1)) : ((row - ML) & (CTX - 1));
                    bf16_t* k = (bf16_t*)(p.ws + WS_K) + ((size_t)b * TALL + t) * 128 + hh * 64;
#pragma unroll
                    for (int j = 0; j < 4; ++j) st4bf(k + j * 16 + quad * 4, y[j][0], y[j][1], y[j][2], y[j][3]);
                }
            }
        }
    } else if (tn == 5) {
        bf16_t* vt = (bf16_t*)(p.ws + WS_VT);
#pragma unroll
        for (int i = 0; i < MI; ++i) {
            const int row = m0 + wave * 16 * MI + i * 16 + l16;
            const int b = row < ML ? (row >> 13) : ((row - ML) >> 8);
            const int t = row < ML ? CTX + (row & (SEQ - 1)) : ((row - ML) & (CTX - 1));
#pragma unroll
            for (int j = 0; j < 8; ++j) {
                const int kh = j >> 2;
#pragma unroll
                for (int r = 0; r < 4; ++r) {
                    const int d = (j & 3) * 16 + quad * 4 + r;
                    vt[((size_t)(b * 2 + kh) * 64 + d) * TALL + t] = f2bf(acc[i][j][r]);
                }
            }
        }
    } else if (tn < 10) {
        bf16_t* u = (bf16_t*)(p.ws + WS_U);
#pragma unroll
        for (int i = 0; i < MI; ++i) {
            const int row = m0 + wave * 16 * MI + i * 16 + l16;
#pragma unroll
            for (int j = 0; j < 8; ++j) {
                const f32x4 v = acc[i][j];
                st4bf(u + (size_t)row * 512 + (tn - 6) * 128 + j * 16 + quad * 4, geluf(v[0]), geluf(v[1]), geluf(v[2]), geluf(v[3]));
            }
        }
    } else {
        const int g = tn - 10;
        const float* gn = p.sgu_norm_g + j2 * 512 + g * 128;
        bf16_t* gvt = (bf16_t*)(p.ws + WS_GVT);
#pragma unroll
        for (int i = 0; i < MI; ++i) {
            const int row = m0 + wave * 16 * MI + i * 16 + l16;
            float ss = 0.f;
#pragma unroll
            for (int j = 0; j < 8; ++j) {
                f32x4 v = acc[i][j];
                v[0] = geluf(v[0]); v[1] = geluf(v[1]); v[2] = geluf(v[2]); v[3] = geluf(v[3]);
                acc[i][j] = v;
                ss += v[0] * v[0] + v[1] * v[1] + v[2] * v[2] + v[3] * v[3];
            }
            ss += __shfl_xor(ss, 16); ss += __shfl_xor(ss, 32);
            const float rstd = rsqrtf(ss * (1.f / 128.f) + EPS);
            const int chunk = row >> 7, pt = row & 127;
#pragma unroll
            for (int j = 0; j < 8; ++j) {
                const f32x4 gv = *(const f32x4*)(gn + j * 16 + quad * 4);
#pragma unroll
                for (int r = 0; r < 4; ++r) {
                    const int cc = g * 128 + j * 16 + quad * 4 + r;
                    gvt[((size_t)chunk * 512 + cc) * 128 + pt] = f2bf(acc[i][j][r] * rstd * gv[r]);
                }
            }
        }
    }
}

template <int MI>
__device__ __forceinline__ void epi_ssmin(CParams& p, int j2, int m0, int tn, const f32x4 (&acc)[MI][8]) {
    const int lane = tid_() & 63, wave = tid_() >> 6, l16 = lane & 15, quad = lane >> 4;
#pragma unroll
    for (int i = 0; i < MI; ++i) {
        const int row = m0 + wave * 16 * MI + i * 16 + l16;
        if (tn < 16) {
            bf16_t* z = (bf16_t*)(p.ws + WS_Z);
#pragma unroll
            for (int j = 0; j < 8; ++j) { const f32x4 v = acc[i][j]; st4bf(z + frag_off(row, tn * 128 + j * 16 + quad * 4, 2048), siluf(v[0]), siluf(v[1]), siluf(v[2]), siluf(v[3])); }
        } else if (tn < 40) {
            bf16_t* xb = (bf16_t*)(p.ws + WS_XBC) + (size_t)row * 3072 + (tn - 16) * 128;
#pragma unroll
            for (int j = 0; j < 8; ++j) { const f32x4 v = acc[i][j]; st4bf(xb + j * 16 + quad * 4, v[0], v[1], v[2], v[3]); }
        } else {
            float* dt = (float*)(p.ws + WS_DT) + (size_t)row * 64;
            const float* bias = p.ssm_dt_bias + j2 * 64;
#pragma unroll
            for (int j = 0; j < 4; ++j) {
                const int c = j * 16 + quad * 4;
                const f32x4 v = acc[i][j];
                f32x4 o;
                o[0] = softplusf(v[0] + bias[c + 0]); o[1] = softplusf(v[1] + bias[c + 1]);
                o[2] = softplusf(v[2] + bias[c + 2]); o[3] = softplusf(v[3] + bias[c + 3]);
                *(f32x4*)(dt + c) = o;
            }
        }
    }
}

enum { G_MIXIN = 0, G_MIXOUT, G_SSMIN, G_SSMOUT, G_FFNIN, G_FFNOUT };

template <int KIND>
__device__ void gemm_phase(CParams& p, int layer, bf16_t* smem) {
    const int j2 = layer >> 1;
    constexpr int lda = (KIND == G_SSMOUT) ? 2048 : (KIND == G_FFNOUT) ? FFH : 1024;
    constexpr int K = lda, ldw = K;
    constexpr int N = (KIND == G_MIXIN) ? MIXIN : (KIND == G_SSMIN) ? SSMIN_PAD : (KIND == G_FFNIN) ? 2 * FFH : 1024;
    constexpr size_t aoff = (KIND == G_MIXOUT) ? WS_AS : (KIND == G_SSMOUT) ? WS_YF : (KIND == G_FFNOUT) ? WS_HID : WS_HN;
    constexpr size_t woff = (KIND == G_MIXIN || KIND == G_SSMIN) ? WT_MIXIN : (KIND == G_MIXOUT || KIND == G_SSMOUT) ? WT_MIXOUT : (KIND == G_FFNIN) ? WT_FFNIN : WT_FFNOUT;
    const bf16_t* A = (const bf16_t*)(p.ws + aoff);
    const bf16_t* W = (const bf16_t*)(p.ws + WS_WT + woff);
    constexpr int MI = (KIND == G_MIXIN) ? 2 : 4;
    constexpr int FRAG = 1;
    constexpr int nN = N >> 7, nM = MT / (64 * MI);
    const float* mod = (const float*)(p.ws + WS_MOD) + (size_t)layer * 3 * 6144;
    bf16_t* sW = smem;
    if (N == 1024) {
        const int nlat = (ML / 256) * 8, nctx = layer == 3 ? 0 : (MC / 64) * 8;
        const float* gate = mod + (KIND == G_FFNOUT ? 5 : 2) * 1024;
        for (int t = blockIdx.x; t < nlat + nctx; t += gridDim.x) {
            if (t < nlat) {
                const int u = (gridDim.x == 512) ? ((t & 7) * 64 + (t >> 3)) : t;
                const int tm = u >> 3, tn = u & 7;
                f32x4 acc[4][8];
                gemm_tile<4, lda, ldw, K, FRAG>(A + (size_t)tm * 256 * lda, W + (size_t)tn * 128 * ldw, acc, sW);
                epi_resid<4>(p, tm * 256, tn * 128, acc, gate);
            } else {
                const int u = t - nlat, tm = u >> 3, tn = u & 7;
                f32x4 acc[1][8];
                gemm_tile<1, lda, ldw, K, FRAG>(A + (size_t)(ML + tm * 64) * lda, W + (size_t)tn * 128 * ldw, acc, sW);
                epi_resid<1>(p, ML + tm * 64, tn * 128, acc, gate);
            }
        }
        return;
    }
    constexpr int T = nM * nN, share = (T + 7) / 8, nsc = (nN + 7) / 8;
    const int xcd = blockIdx.x & 7, slot = blockIdx.x >> 3, nslot = gridDim.x >> 3;
    for (int li = slot; li < share; li += nslot) {
        const int u = xcd * share + li;
        if (u >= T) break;
        int sc = u / (nM * 8); if (sc > nsc - 1) sc = nsc - 1;
        const int rem = u - sc * nM * 8, wd = (sc == nsc - 1) ? (nN - 8 * sc) : 8;
        const int tm = rem / wd, tn = sc * 8 + rem - tm * wd;
        f32x4 acc[MI][8];
        gemm_tile<MI, lda, ldw, K, FRAG>(A + (size_t)tm * (64 * MI) * lda, W + (size_t)tn * 128 * ldw, acc, sW);
        if (KIND == G_MIXIN) epi_mixin<MI>(p, j2, tm * (64 * MI), tn, acc);
        else if (KIND == G_SSMIN) epi_ssmin<MI>(p, j2, tm * (64 * MI), tn, acc);
        else if (KIND == G_FFNIN) epi_swiglu<MI>(p, tm * (64 * MI), tn * 128, acc);
    }
}

__device__ void norm_phase(CParams& p, int layer, int which) {
    const int lane = tid_() & 63, wave = tid_() >> 6, l16 = lane & 15, quad = lane >> 4;
    const float* g = (which ? p.norm2_g : p.norm1_g) + layer * 1024;
    const float* mod = (const float*)(p.ws + WS_MOD) + (size_t)layer * 3 * 6144;
    bf16_t* hn = (bf16_t*)(p.ws + WS_HN);
    for (int tr = blockIdx.x * 4 + wave; tr < MT / 16; tr += gridDim.x * 4) {
        const int row0 = tr * 16;
        float myr = 0.f;
#pragma unroll 4
        for (int r = 0; r < 16; ++r) {
            const float* xr = xrow(p, row0 + r);
            float ss = 0.f;
#pragma unroll
            for (int i = 0; i < 4; ++i) { const f32x4 v = *(const f32x4*)(xr + i * 256 + lane * 4); ss += v[0] * v[0] + v[1] * v[1] + v[2] * v[2] + v[3] * v[3]; }
#pragma unroll
            for (int o = 1; o < 64; o <<= 1) ss += __shfl_xor(ss, o);
            const float rs = rsqrtf(ss * (1.f / 1024.f) + EPS);
            myr = (l16 == r) ? rs : myr;
        }
        const float* m = mod + (size_t)seg_of(row0) * 6144 + (which ? 3 * 1024 : 0);
        const float* xr = xrow(p, row0 + l16) + quad * 8;
        bf16_t* dst = hn + (size_t)tr * 32 * 512 + lane * 8;
#pragma unroll 4
        for (int kb = 0; kb < 32; ++kb) {
            const int col = kb * 32 + quad * 8;
            const f32x4 v0 = *(const f32x4*)(xr + kb * 32), v1 = *(const f32x4*)(xr + kb * 32 + 4);
            const f32x4 g0 = *(const f32x4*)(g + col), g1 = *(const f32x4*)(g + col + 4);
            const f32x4 sh0 = *(const f32x4*)(m + col), sh1 = *(const f32x4*)(m + col + 4);
            const f32x4 sc0 = *(const f32x4*)(m + 1024 + col), sc1 = *(const f32x4*)(m + 1024 + col + 4);
            const f32x4 y0 = (v0 * myr * g0) * (sc0 + 1.f) + sh0, y1 = (v1 * myr * g1) * (sc1 + 1.f) + sh1;
            u32x4 o; o.x = pack2(y0[0], y0[1]); o.y = pack2(y0[2], y0[3]); o.z = pack2(y1[0], y1[1]); o.w = pack2(y1[2], y1[3]);
            *(u32x4*)(dst + (size_t)kb * 512) = o;
        }
    }
}

__device__ void convert_wt(const float* __restrict__ W, int K, int N, bf16_t* __restrict__ Wt, int mode, float* tile) {
    const int tid = tid_();
    const int nKt = K >> 6, nNt = N >> 6;
    for (int t = blockIdx.x; t < nKt * nNt; t += gridDim.x) {
        const int kt = t / nNt, nt = t - kt * nNt;
        lds_sync();
#pragma unroll
        for (int i = 0; i < 16; ++i) {
            const int kk = (tid >> 6) + i * 4, nn = tid & 63;
            tile[kk * 65 + nn] = W[(size_t)(kt * 64 + kk) * N + nt * 64 + nn];
        }
        lds_sync();
        {
            const int nn = tid >> 2, kq = (tid & 3) * 16;
            const int n = nt * 64 + nn;
            int dr = n;
            if (mode == 1) { const int hm = n < FFH ? n : n - FFH; dr = (hm >> 4) * 32 + (hm & 15) + (n < FFH ? 0 : 16); }
            u32x4 o0, o1;
            o0.x = pack2(tile[(kq + 0) * 65 + nn], tile[(kq + 1) * 65 + nn]); o0.y = pack2(tile[(kq + 2) * 65 + nn], tile[(kq + 3) * 65 + nn]);
            o0.z = pack2(tile[(kq + 4) * 65 + nn], tile[(kq + 5) * 65 + nn]); o0.w = pack2(tile[(kq + 6) * 65 + nn], tile[(kq + 7) * 65 + nn]);
            o1.x = pack2(tile[(kq + 8) * 65 + nn], tile[(kq + 9) * 65 + nn]); o1.y = pack2(tile[(kq + 10) * 65 + nn], tile[(kq + 11) * 65 + nn]);
            o1.z = pack2(tile[(kq + 12) * 65 + nn], tile[(kq + 13) * 65 + nn]); o1.w = pack2(tile[(kq + 14) * 65 + nn], tile[(kq + 15) * 65 + nn]);
            bf16_t* dst = Wt + (size_t)dr * K + kt * 64 + kq;
            *(u32x4*)dst = o0; *(u32x4*)(dst + 8) = o1;
        }
    }
}

__device__ void convert_layer_weights(CParams& p, int layer, float* tile) {
    unsigned char* wt = p.ws + WS_WT;
    const int j2 = layer >> 1;
    convert_wt(p.ffn_w_in + (size_t)layer * 1024 * 2 * FFH, 1024, 2 * FFH, (bf16_t*)(wt + WT_FFNIN), 1, tile);
    convert_wt(p.ffn_w_out + (size_t)layer * FFH * 1024, FFH, 1024, (bf16_t*)(wt + WT_FFNOUT), 0, tile);
    if ((layer & 1) == 0) {
        convert_wt(p.mix_w_in + (size_t)j2 * 1024 * MIXIN, 1024, MIXIN, (bf16_t*)(wt + WT_MIXIN), 0, tile);
        convert_wt(p.mix_w_out + (size_t)j2 * 1024 * 1024, 1024, 1024, (bf16_t*)(wt + WT_MIXOUT), 0, tile);
    } else {
        convert_wt(p.ssm_w_in + (size_t)j2 * 1024 * SSMIN, 1024, SSMIN, (bf16_t*)(wt + WT_MIXIN), 0, tile);
        convert_wt(p.ssm_w_out + (size_t)j2 * SSI * 1024, SSI, 1024, (bf16_t*)(wt + WT_MIXOUT), 0, tile);
        bf16_t* padp = (bf16_t*)(wt + WT_MIXIN) + (size_t)SSMIN * 1024;
        for (int i = blockIdx.x * 256 + tid_(); i < (SSMIN_PAD - SSMIN) * 1024; i += gridDim.x * 256) padp[i] = 0;
    }
}

__device__ void prologue(CParams& p, float* smf) {
    const int tid = tid_();
    const size_t gtid = (size_t)blockIdx.x * 256 + tid, gsz = (size_t)gridDim.x * 256;
    {
        const f32x4* s = (const f32x4*)p.x; f32x4* d = (f32x4*)p.out;
        for (size_t i = gtid; i < (size_t)ML * D / 4; i += gsz) d[i] = s[i];
        const f32x4* s2 = (const f32x4*)p.ctx; f32x4* d2 = (f32x4*)(p.ws + WS_XCTX);
        for (size_t i = gtid; i < (size_t)MC * D / 4; i += gsz) d2[i] = s2[i];
    }
    {
        float* cosT = (float*)(p.ws + WS_ROPE); float* sinT = cosT + 8192 * 32;
        for (size_t i = gtid; i < (size_t)8192 * 32; i += gsz) {
            const int s = (int)(i >> 5), j = (int)(i & 31), f = j & 15;
            const float inv = powf(10000.f, -(float)f / 16.f);
            const float pos = (float)(j < 16 ? (s >> 6) : (s & 63));
            const float ang = pos * inv;
            cosT[i] = cosf(ang); sinT[i] = sinf(ang);
        }
    }
    {
        bf16_t* sgw = (bf16_t*)(p.ws + WS_SGW);
        for (size_t i = gtid; i < (size_t)2 * 4 * 128 * 128; i += gsz) sgw[i] = f2bf(p.sgu_w[i]);
    }
    {
        float* sc = smf;
        float* red = smf + 3 * 1024;
        lds_sync();
        for (int i = tid; i < 3 * 1024; i += 256) {
            const int sgi = i >> 10, k = i & 1023;
            const float v = sgi < 2 ? p.c[sgi * 1024 + k] : p.c_ctx[k];
            sc[i] = siluf(v);
        }
        lds_sync();
        float* mod = (float*)(p.ws + WS_MOD);
        const int cl = tid & 63, kg = tid >> 6;
        for (int wi = blockIdx.x; wi < 4 * 96; wi += gridDim.x) {
            const int layer = wi / 96, cb = wi - layer * 96;
            const float* w = p.ada_w + (size_t)layer * 1024 * 6144 + cb * 64 + cl;
            float s0 = 0.f, s1 = 0.f, s2 = 0.f;
            for (int k = kg * 256; k < kg * 256 + 256; ++k) {
                const float wv = w[(size_t)k * 6144];
                s0 += sc[k] * wv; s1 += sc[1024 + k] * wv; s2 += sc[2048 + k] * wv;
            }
            lds_sync();
            red[(kg * 3 + 0) * 64 + cl] = s0; red[(kg * 3 + 1) * 64 + cl] = s1; red[(kg * 3 + 2) * 64 + cl] = s2;
            lds_sync();
            if (tid < 192) {
                const int sgi = tid >> 6;
                const float v = red[(0 * 3 + sgi) * 64 + cl] + red[(1 * 3 + sgi) * 64 + cl] + red[(2 * 3 + sgi) * 64 + cl] + red[(3 * 3 + sgi) * 64 + cl];
                const int n = cb * 64 + cl;
                mod[((size_t)layer * 3 + sgi) * 6144 + n] = v + p.ada_b[layer * 6144 + n];
            }
        }
        lds_sync();
    }
    convert_layer_weights(p, 0, smf);
}

__device__ __forceinline__ void attn_item(CParams& p, int j2, int b, int h, int q0row, int nkeys, bf16_t* smem) {
    const int tid = tid_(), lane = tid & 63, wave = tid >> 6, l16 = lane & 15, quad = lane >> 4;
    const int kh = h >> 2;
    const bf16_t* Q = (const bf16_t*)(p.ws + WS_Q);
    const bf16_t* Kb = (const bf16_t*)(p.ws + WS_K) + (size_t)b * TALL * 128 + kh * 64;
    const bf16_t* Vb = (const bf16_t*)(p.ws + WS_VT) + (size_t)(b * 2 + kh) * 64 * TALL;
    bf16_t* sK = smem; bf16_t* sV = smem + 64 * GST;
    constexpr float LOG2E = 1.4426950408889634f;
    float mb;
    {
        float gq = fabsf(p.q_norm_g[j2 * 64 + lane]), gk = fabsf(p.k_norm_g[j2 * 64 + lane]);
#pragma unroll
        for (int o = 1; o < 64; o <<= 1) { gq = fmaxf(gq, __shfl_xor(gq, o)); gk = fmaxf(gk, __shfl_xor(gk, o)); }
        mb = 8.f * 1.02f * gq * gk * LOG2E;
    }
    bf16x8 qf[4][2];
#pragma unroll
    for (int i = 0; i < 4; ++i)
#pragma unroll
        for (int ks = 0; ks < 2; ++ks)
            qf[i][ks] = *(const bf16x8*)(Q + (size_t)(q0row + wave * 64 + i * 16 + l16) * 512 + h * 64 + ks * 32 + quad * 8);
    f32x4 o[5][4];
#pragma unroll
    for (int d = 0; d < 5; ++d)
#pragma unroll
        for (int i = 0; i < 4; ++i) o[d][i] = (f32x4){0.f, 0.f, 0.f, 0.f};
    lds_sync();
    {
        const int r = 64 + (tid >> 4);
        u32x2 one; one.x = r == 64 ? 0x3F803F80u : 0u; one.y = one.x;
        *(u32x2*)(sV + r * GST + (tid & 15) * 4) = one;
    }
    const int srow = tid >> 3, skc = (tid & 7) * 8;
    u32x4 rk[2], rv[2];
#pragma unroll
    for (int i = 0; i < 2; ++i) {
        rk[i] = *(const u32x4*)(Kb + (size_t)(srow + i * 32) * 128 + skc);
        rv[i] = *(const u32x4*)(Vb + (size_t)(srow + i * 32) * TALL + skc);
    }
    const int nt = nkeys >> 6;
#pragma unroll 1
    for (int kt = 0; kt < nt; ++kt) {
        lds_sync();
#pragma unroll
        for (int i = 0; i < 2; ++i) {
            *(u32x4*)(sK + (srow + i * 32) * GST + skc) = rk[i];
            *(u32x4*)(sV + (srow + i * 32) * GST + skc) = rv[i];
        }
        lds_sync();
        {
            const int t0 = (kt + 1 < nt ? kt + 1 : kt) << 6;
#pragma unroll
            for (int i = 0; i < 2; ++i) {
                rk[i] = *(const u32x4*)(Kb + (size_t)(t0 + srow + i * 32) * 128 + skc);
                rv[i] = *(const u32x4*)(Vb + (size_t)(srow + i * 32) * TALL + t0 + skc);
            }
        }
        bf16x8 pf[2][4];
#pragma unroll
        for (int ih = 0; ih < 2; ++ih) {
            f32x4 s[4][2];
#pragma unroll
            for (int tt = 0; tt < 4; ++tt)
#pragma unroll
                for (int i = 0; i < 2; ++i) s[tt][i] = (f32x4){-mb, -mb, -mb, -mb};
#pragma unroll
            for (int ks = 0; ks < 2; ++ks)
#pragma unroll
                for (int tt = 0; tt < 4; ++tt) {
                    const bf16x8 kf = lds16(sK + (tt * 16 + l16) * GST + ks * 32 + quad * 8);
#pragma unroll
                    for (int i = 0; i < 2; ++i) s[tt][i] = mfma16(kf, qf[ih * 2 + i][ks], s[tt][i]);
                }
#pragma unroll
            for (int i = 0; i < 2; ++i) {
#pragma unroll
                for (int tt = 0; tt < 4; ++tt) {
#pragma unroll
                    for (int r = 0; r < 4; ++r) s[tt][i][r] = __builtin_amdgcn_exp2f(s[tt][i][r]);
                }
#pragma unroll
                for (int ksp = 0; ksp < 2; ++ksp) pf[ksp][ih * 2 + i] = pack8(s[2 * ksp][i], s[2 * ksp + 1][i]);
            }
        }
#pragma unroll
        for (int ksp = 0; ksp < 2; ++ksp)
#pragma unroll
            for (int d = 0; d < 5; ++d) {
                const bf16_t* vp = sV + (d * 16 + l16) * GST + ksp * 32 + quad * 4;
                const bf16x8 vf = lds8x2(vp, vp + 16);
#pragma unroll
                for (int i = 0; i < 4; ++i) o[d][i] = mfma16(vf, pf[ksp][i], o[d][i]);
            }
    }
    bf16_t* as = (bf16_t*)(p.ws + WS_AS);
#pragma unroll
    for (int i = 0; i < 4; ++i) {
        const float l = __shfl(o[4][i][0], l16);
        const float inv = 1.f / l;
        const int row = q0row + wave * 64 + i * 16 + l16;
#pragma unroll
        for (int d = 0; d < 4; ++d)
            st4bf(as + frag_off(row, h * 64 + d * 16 + quad * 4, 1024), o[d][i][0] * inv, o[d][i][1] * inv, o[d][i][2] * inv, o[d][i][3] * inv);
    }
}

__device__ void sg_item(CParams& p, int j2, int chunk, int g, bf16_t* smem) {
    const int lane = tid_() & 63, wave = tid_() >> 6, l16 = lane & 15, quad = lane >> 4;
    const bf16_t* A = (const bf16_t*)(p.ws + WS_SGW) + (size_t)(j2 * 4 + g) * 128 * 128;
    const bf16_t* W = (const bf16_t*)(p.ws + WS_GVT) + ((size_t)chunk * 512 + g * 128) * 128;
    f32x4 acc[2][8];
    gemm_tile<2, 128, 128, 128>(A, W, acc, smem);
    const bf16_t* u = (const bf16_t*)(p.ws + WS_U);
    bf16_t* as = (bf16_t*)(p.ws + WS_AS);
    const float* bs = p.sgu_b + (size_t)(j2 * 4 + g) * 128;
#pragma unroll
    for (int i = 0; i < 2; ++i) {
        const int pt = wave * 32 + i * 16 + l16;
        const int row = chunk * 128 + pt;
        const float bias = bs[pt];
#pragma unroll
        for (int j = 0; j < 8; ++j) {
            const int c = g * 128 + j * 16 + quad * 4;
            const u32x2 uw = *(const u32x2*)(u + (size_t)row * 512 + c);
            const float u0 = __uint_as_float(uw.x << 16), u1 = __uint_as_float(uw.x & 0xffff0000u);
            const float u2 = __uint_as_float(uw.y << 16), u3 = __uint_as_float(uw.y & 0xffff0000u);
            const f32x4 v = acc[i][j];
            st4bf(as + frag_off(row, 512 + c, 1024), u0 * (v[0] + bias), u1 * (v[1] + bias), u2 * (v[2] + bias), u3 * (v[3] + bias));
        }
    }
}

__device__ void attn_sg_phase(CParams& p, int layer, bf16_t* smem) {
    const int j2 = layer >> 1;
    const int nA = NB * 8 * 32, nS = (MT / 128) * 4, nC = NB * 8;
    for (int t = blockIdx.x; t < nA + nS + nC; t += gridDim.x) {
        if (t < nA) {
            const int xcd = t & 7, li = t >> 3;
            const int bh = xcd * 2 + (li >> 5), qb = li & 31;
            attn_item(p, j2, bh >> 3, bh & 7, (bh >> 3) * SEQ + qb * 256, TALL, smem);
        } else if (t < nA + nS) {
            const int u = t - nA;
            sg_item(p, j2, u >> 2, u & 3, smem);
        } else {
            const int u = t - nA - nS;
            const int h = u & 7, b = u >> 3;
            attn_item(p, j2, b, h, ML + b * CTX, CTX, smem);
        }
    }
}

__device__ void conv_phase(CParams& p, int layer, float* smf) {
    const int j2 = layer >> 1, tid = tid_();
    const bf16_t* xbc = (const bf16_t*)(p.ws + WS_XBC);
    bf16_t* XT = (bf16_t*)(p.ws + WS_XT); bf16_t* Bn = (bf16_t*)(p.ws + WS_BN); bf16_t* Cn = (bf16_t*)(p.ws + WS_CN); bf16_t* BT = (bf16_t*)(p.ws + WS_BT);
    const float* cw = p.ssm_conv_w + (size_t)j2 * 3 * 3072;
    const float* cb = p.ssm_conv_b + (size_t)j2 * 3072;
    float* sin_ = smf;
    float* sout = smf + 66 * 65;
    const int nCt = 3072 / 64, nRt = MT / 64;
    for (int t = blockIdx.x; t < nCt * nRt; t += gridDim.x) {
        const int rt = t / nCt, ct = t - rt * nCt;
        const int r0 = rt * 64, c0 = ct * 64;
        const bool first = r0 < ML ? ((r0 & (SEQ - 1)) == 0) : (((r0 - ML) & (CTX - 1)) == 0);
        const bool last = r0 < ML ? (((r0 + 64) & (SEQ - 1)) == 0) : ((((r0 + 64) - ML) & (CTX - 1)) == 0);
        lds_sync();
        for (int e = tid; e < 66 * 8; e += 256) {
            const int rr = e >> 3, c8 = (e & 7) * 8;
            const int row = r0 - 1 + rr;
            u32x4 v = (u32x4){0u, 0u, 0u, 0u};
            if (!((rr == 0 && first) || (rr == 65 && last))) v = *(const u32x4*)(xbc + (size_t)row * 3072 + c0 + c8);
            float* d = sin_ + rr * 65 + c8;
            d[0] = __uint_as_float(v.x << 16); d[1] = __uint_as_float(v.x & 0xffff0000u);
            d[2] = __uint_as_float(v.y << 16); d[3] = __uint_as_float(v.y & 0xffff0000u);
            d[4] = __uint_as_float(v.z << 16); d[5] = __uint_as_float(v.z & 0xffff0000u);
            d[6] = __uint_as_float(v.w << 16); d[7] = __uint_as_float(v.w & 0xffff0000u);
        }
        lds_sync();
        {
            const int c = tid & 63;
            const float w0 = cw[c0 + c], w1 = cw[3072 + c0 + c], w2 = cw[2 * 3072 + c0 + c], bb = cb[c0 + c];
#pragma unroll
            for (int k = 0; k < 16; ++k) {
                const int tt = (tid >> 6) + k * 4;
                const float v = w0 * sin_[tt * 65 + c] + w1 * sin_[(tt + 1) * 65 + c] + w2 * sin_[(tt + 2) * 65 + c] + bb;
                sout[c * 65 + tt] = siluf(v);
            }
        }
        lds_sync();
        const int q = tid >> 2, e16 = (tid & 3) * 16;
        if (c0 >= 2048) {
            u32x4 o0, o1;
            o0.x = pack2(sout[(e16 + 0) * 65 + q], sout[(e16 + 1) * 65 + q]); o0.y = pack2(sout[(e16 + 2) * 65 + q], sout[(e16 + 3) * 65 + q]);
            o0.z = pack2(sout[(e16 + 4) * 65 + q], sout[(e16 + 5) * 65 + q]); o0.w = pack2(sout[(e16 + 6) * 65 + q], sout[(e16 + 7) * 65 + q]);
            o1.x = pack2(sout[(e16 + 8) * 65 + q], sout[(e16 + 9) * 65 + q]); o1.y = pack2(sout[(e16 + 10) * 65 + q], sout[(e16 + 11) * 65 + q]);
            o1.z = pack2(sout[(e16 + 12) * 65 + q], sout[(e16 + 13) * 65 + q]); o1.w = pack2(sout[(e16 + 14) * 65 + q], sout[(e16 + 15) * 65 + q]);
            if (c0 < 2560) {
                bf16_t* dst = Bn + (c0 - 2048) + (size_t)(r0 + q) * 512 + e16;
                *(u32x4*)dst = o0; *(u32x4*)(dst + 8) = o1;
            } else {
                *(u32x4*)(Cn + frag_off(r0 + q, c0 - 2560 + e16, 512)) = o0;
                *(u32x4*)(Cn + frag_off(r0 + q, c0 - 2560 + e16 + 8, 512)) = o1;
            }
        }
        if (c0 < 2560) {
            const float* sp = sout + q * 65 + e16;
            u32x4 o0, o1;
            o0.x = pack2(sp[0], sp[1]); o0.y = pack2(sp[2], sp[3]); o0.z = pack2(sp[4], sp[5]); o0.w = pack2(sp[6], sp[7]);
            o1.x = pack2(sp[8], sp[9]); o1.y = pack2(sp[10], sp[11]); o1.z = pack2(sp[12], sp[13]); o1.w = pack2(sp[14], sp[15]);
            if (c0 < 2048) {
                bf16_t* dst = XT + (size_t)(c0 + q) * MT + r0 + e16;
                *(u32x4*)dst = o0; *(u32x4*)(dst + 8) = o1;
            } else {
                *(u32x4*)(BT + frag_off(c0 - 2048 + q, r0 + e16, MT)) = o0;
                *(u32x4*)(BT + frag_off(c0 - 2048 + q, r0 + e16 + 8, MT)) = o1;
            }
        }
    }
}

__device__ void ssd_diag_item(CParams& p, int j2, int row0, int h, bf16_t* smem) {
    const int tid = tid_(), lane = tid & 63, wave = tid >> 6, l16 = lane & 15, quad = lane >> 4;
    const int g = h >> 3;
    bf16_t* sB = smem;
    bf16_t* sX = sB + 128 * SST;
    float* sda = (float*)(sX + 64 * SST);
    float* sPf = sda + 256;
    float* sRb = sPf + 128;
    float* sdtf = sRb + 128;
    float* sdtb = sdtf + 128;
    const bf16_t* XT = (const bf16_t*)(p.ws + WS_XT) + (size_t)(h * 64) * MT;
    const bf16_t* Bn = (const bf16_t*)(p.ws + WS_BN) + g * 128;
    const bf16_t* Cn = (const bf16_t*)(p.ws + WS_CN) + (size_t)(g * 4) * 512;
    const float* DT = (const float*)(p.ws + WS_DT);
    bf16_t* Y = (bf16_t*)(p.ws + WS_YF);
    const float af = -expf(p.ssm_a_log[(j2 * 2 + 0) * 32 + h]);
    const float ab = -expf(p.ssm_a_log[(j2 * 2 + 1) * 32 + h]);
    const float dsk = p.ssm_d[j2 * 32 + h];
    lds_sync();
#pragma unroll
    for (int i = 0; i < 8; ++i) {
        const int c = tid + i * 256, r = c >> 4, kc = (c & 15) * 8;
        *(u32x4*)(sB + r * SST + kc) = *(const u32x4*)(Bn + (size_t)(row0 + r) * 512 + kc);
    }
#pragma unroll
    for (int i = 0; i < 4; ++i) {
        const int c = tid + i * 256, r = c >> 4, kc = (c & 15) * 8;
        *(u32x4*)(sX + r * SST + kc) = *(const u32x4*)(XT + (size_t)r * MT + row0 + kc);
    }
    {
        const int d = wave >> 1;
        const float d0 = DT[(size_t)(row0 + lane) * 64 + d * 32 + h], d1 = DT[(size_t)(row0 + 64 + lane) * 64 + d * 32 + h];
        const float aa = d ? ab : af;
        const f32x2 sc2 = scan128(d0 * aa, d1 * aa, lane, d);
        float* sc = d ? sRb : sPf; float* sd = d ? sdtb : sdtf;
        if ((wave & 1) == 0) { sc[lane] = sc2.x; sd[lane] = d0; } else { sc[64 + lane] = sc2.y; sd[64 + lane] = d1; }
    }
    bf16x8 cf[2][4];
#pragma unroll
    for (int i = 0; i < 2; ++i)
#pragma unroll
        for (int ks = 0; ks < 4; ++ks)
            cf[i][ks] = *(const bf16x8*)(Cn + ((size_t)((row0 >> 4) + wave * 2 + i) * 16 + ks) * 512 + lane * 8);
    lds_sync();
    float pfl[2], rbl[2];
#pragma unroll
    for (int i = 0; i < 2; ++i) { pfl[i] = sPf[wave * 32 + i * 16 + l16]; rbl[i] = sRb[wave * 32 + i * 16 + l16]; }
    f32x4 y[4][2];
#pragma unroll
    for (int pt = 0; pt < 4; ++pt)
#pragma unroll
        for (int i = 0; i < 2; ++i) y[pt][i] = (f32x4){0.f, 0.f, 0.f, 0.f};
#pragma unroll 1
    for (int sp = 0; sp < 4; ++sp) {
        f32x4 gt[2][2];
#pragma unroll
        for (int s2 = 0; s2 < 2; ++s2)
#pragma unroll
            for (int i = 0; i < 2; ++i) gt[s2][i] = (f32x4){0.f, 0.f, 0.f, 0.f};
#pragma unroll
        for (int ks = 0; ks < 4; ++ks)
#pragma unroll
            for (int s2 = 0; s2 < 2; ++s2) {
                const bf16x8 bfr = lds16(sB + (sp * 32 + s2 * 16 + l16) * SST + ks * 32 + quad * 8);
#pragma unroll
                for (int i = 0; i < 2; ++i) gt[s2][i] = mfma16(bfr, cf[i][ks], gt[s2][i]);
            }
        bf16x8 mf[2];
#pragma unroll
        for (int i = 0; i < 2; ++i) {
            const int l = wave * 32 + i * 16 + l16;
#pragma unroll
            for (int s2 = 0; s2 < 2; ++s2)
#pragma unroll
                for (int r = 0; r < 4; ++r) {
                    const int s = sp * 32 + s2 * 16 + quad * 4 + r;
                    const float arg = s < l ? (pfl[i] - sPf[s]) : (rbl[i] - sRb[s]);
                    float coef = __expf(fminf(arg, 0.f)) * (s < l ? sdtf[s] : sdtb[s]);
                    if (s == l) coef = sdtf[s] + sdtb[s];
                    gt[s2][i][r] *= coef;
                }
            mf[i] = pack8(gt[0][i], gt[1][i]);
        }
#pragma unroll
        for (int pt = 0; pt < 4; ++pt) {
            const bf16_t* xp = sX + (pt * 16 + l16) * SST + sp * 32 + quad * 4;
            const bf16x8 xf = lds8x2(xp, xp + 16);
#pragma unroll
            for (int i = 0; i < 2; ++i) y[pt][i] = mfma16(xf, mf[i], y[pt][i]);
        }
    }
#pragma unroll
    for (int i = 0; i < 2; ++i) {
        const int l = wave * 32 + i * 16 + l16;
#pragma unroll
        for (int pt = 0; pt < 4; ++pt) {
            f32x4 v = y[pt][i];
#pragma unroll
            for (int r = 0; r < 4; ++r) v[r] += dsk * bf2f(sX[(pt * 16 + quad * 4 + r) * SST + l]);
            st4bf(Y + frag_off(row0 + l, h * 64 + pt * 16 + quad * 4, 2048), v[0], v[1], v[2], v[3]);
        }
    }
}

__device__ void ssd_diag_phase(CParams& p, int layer, bf16_t* smem) {
    const int j2 = layer >> 1;
    for (int t = blockIdx.x; t < (MT / 128) * 32; t += gridDim.x) {
        const int h = t & 31, chunk = t >> 5;
        ssd_diag_item(p, j2, chunk * 128, h, smem);
    }
}

struct SsdPre { u32x4 xq; u32x4 bt[2][4]; u32x4 cf[2][4]; u32x2 yold[2]; float dt0, dt1; };

__device__ __forceinline__ int ssd_row0(int b, int dir, int cc) {
    if (cc < 2) { const int ci = dir ? 1 - cc : cc; return ML + b * CTX + ci * 128; }
    const int k = cc - 2; const int ci = dir ? 63 - k : k; return b * SEQ + ci * 128;
}

__device__ __forceinline__ void ssd_scan_item(CParams& p, int j2, int b, int dir, int h, int pq, bf16_t* smem) {
    const int tid = tid_(), lane = tid & 63, wave = tid >> 6, l16 = lane & 15, quad = lane >> 4;
    const int g = h >> 3;
    bf16_t* sX = smem;
    bf16_t* sH = sX + 16 * SST;
    float* seacs = (float*)(sH + 16 * SST);
    float* sw = seacs + 128;
    float* sdec = sw + 128;
    const bf16_t* XT = (const bf16_t*)(p.ws + WS_XT) + (size_t)(h * 64 + pq * 16 + (tid >> 4)) * MT + (tid & 15) * 8;
    const bf16_t* Cn = (const bf16_t*)(p.ws + WS_CN) + ((size_t)(wave * 2) * 16 + g * 4) * 512 + lane * 8;
    const bf16_t* BT = (const bf16_t*)(p.ws + WS_BT) + (size_t)(g * 8 + wave * 2) * (MT / 32) * 512 + lane * 8;
    const float* DT = (const float*)(p.ws + WS_DT) + dir * 32 + h;
    bf16_t* Y = (bf16_t*)(p.ws + (dir ? WS_YB : WS_YF)) + frag_off(wave * 32 + l16, h * 64 + pq * 16 + quad * 4, 2048);
    const float a = -expf(p.ssm_a_log[(j2 * 2 + dir) * 32 + h]);
    f32x4 st[2];
    st[0] = (f32x4){0.f, 0.f, 0.f, 0.f}; st[1] = (f32x4){0.f, 0.f, 0.f, 0.f};
    SsdPre S0, S1;
    auto load_small = [&](SsdPre& S, int r) __attribute__((always_inline)) {
        S.xq = *(const u32x4*)(XT + r);
        S.dt0 = DT[(size_t)(r + lane) * 64]; S.dt1 = DT[(size_t)(r + 64 + lane) * 64];
    };
    auto load_cf = [&](SsdPre& S, int r) __attribute__((always_inline)) {
#pragma unroll
        for (int i = 0; i < 2; ++i)
#pragma unroll
            for (int ks = 0; ks < 4; ++ks) S.cf[i][ks] = *(const u32x4*)(Cn + ((size_t)((r >> 4) + i) * 16 + ks) * 512);
    };
    auto load_yold = [&](SsdPre& S, int r) __attribute__((always_inline)) {
#pragma unroll
        for (int i = 0; i < 2; ++i) S.yold[i] = dir == 0 ? *(const u32x2*)(Y + (size_t)((r >> 4) + i) * (64 * 512)) : (u32x2){0u, 0u};
    };
    auto load_bt = [&](SsdPre& S, int r) __attribute__((always_inline)) {
#pragma unroll
        for (int nt = 0; nt < 2; ++nt)
#pragma unroll
            for (int ks = 0; ks < 4; ++ks) S.bt[nt][ks] = *(const u32x4*)(BT + ((size_t)nt * (MT / 32) + (r >> 5) + ks) * 512);
    };
    {
        const int r0 = ssd_row0(b, dir, 0), r1 = ssd_row0(b, dir, 1);
        load_small(S0, r0); load_cf(S0, r0); load_yold(S0, r0); load_bt(S0, r0);
        load_small(S1, r1); load_cf(S1, r1); load_yold(S1, r1); load_bt(S1, r1);
    }
    auto body = [&](SsdPre& S, int cc) __attribute__((always_inline)) {
        const int row0 = ssd_row0(b, dir, cc);
        const int row2 = ssd_row0(b, dir, cc + 2 < 66 ? cc + 2 : 65);
        lds_sync();
        *(u32x4*)(sX + (tid >> 4) * SST + (tid & 15) * 8) = S.xq;
#pragma unroll
        for (int nt = 0; nt < 2; ++nt) st4bf(sH + l16 * SST + wave * 32 + nt * 16 + quad * 4, st[nt][0], st[nt][1], st[nt][2], st[nt][3]);
        if (wave < 2) {
            const f32x2 sc2 = scan128(S.dt0 * a, S.dt1 * a, lane, dir);
            const float total = dir == 0 ? __shfl(sc2.y, 63) : __shfl(sc2.x, 0);
            if (wave == 0) { seacs[lane] = __expf(sc2.x); sw[lane] = S.dt0 * __expf(total - sc2.x); if (lane == 0) sdec[0] = __expf(total); }
            else { seacs[64 + lane] = __expf(sc2.y); sw[64 + lane] = S.dt1 * __expf(total - sc2.y); }
        }
        lds_sync();
        load_small(S, row2);
        f32x4 yo[2];
        yo[0] = (f32x4){0.f, 0.f, 0.f, 0.f}; yo[1] = (f32x4){0.f, 0.f, 0.f, 0.f};
#pragma unroll
        for (int ks = 0; ks < 4; ++ks) {
            const bf16x8 hf = lds16(sH + l16 * SST + ks * 32 + quad * 8);
#pragma unroll
            for (int i = 0; i < 2; ++i) yo[i] = mfma16(hf, __builtin_bit_cast(bf16x8, S.cf[i][ks]), yo[i]);
        }
        __builtin_amdgcn_sched_barrier(0);
        load_cf(S, row2);
#pragma unroll
        for (int i = 0; i < 2; ++i) {
            const float e = seacs[wave * 32 + i * 16 + l16];
            const float o0 = __uint_as_float(S.yold[i].x << 16), o1 = __uint_as_float(S.yold[i].x & 0xffff0000u);
            const float o2 = __uint_as_float(S.yold[i].y << 16), o3 = __uint_as_float(S.yold[i].y & 0xffff0000u);
            st4bf(Y + (size_t)((row0 >> 4) + i) * (64 * 512), yo[i][0] * e + o0, yo[i][1] * e + o1, yo[i][2] * e + o2, yo[i][3] * e + o3);
        }
        __builtin_amdgcn_sched_barrier(0);
        load_yold(S, row2);
        {
            const float dec = sdec[0];
            st[0] *= dec; st[1] *= dec;
#pragma unroll
            for (int ks = 0; ks < 4; ++ks) {
                const f32x4 w0 = *(const f32x4*)(sw + ks * 32 + quad * 8), w1 = *(const f32x4*)(sw + ks * 32 + quad * 8 + 4);
                const u32x4 raw = *(const u32x4*)(sX + l16 * SST + ks * 32 + quad * 8);
                u32x4 xs;
                xs.x = pack2(__uint_as_float(raw.x << 16) * w0[0], __uint_as_float(raw.x & 0xffff0000u) * w0[1]);
                xs.y = pack2(__uint_as_float(raw.y << 16) * w0[2], __uint_as_float(raw.y & 0xffff0000u) * w0[3]);
                xs.z = pack2(__uint_as_float(raw.z << 16) * w1[0], __uint_as_float(raw.z & 0xffff0000u) * w1[1]);
                xs.w = pack2(__uint_as_float(raw.w << 16) * w1[2], __uint_as_float(raw.w & 0xffff0000u) * w1[3]);
                const bf16x8 xbf = __builtin_bit_cast(bf16x8, xs);
#pragma unroll
                for (int nt = 0; nt < 2; ++nt) st[nt] = mfma16(__builtin_bit_cast(bf16x8, S.bt[nt][ks]), xbf, st[nt]);
            }
        }
        __builtin_amdgcn_sched_barrier(0);
        load_bt(S, row2);
    };
#pragma unroll 1
    for (int cc = 0; cc < 66; cc += 2) {
        body(S0, cc);
        body(S1, cc + 1);
    }
}

__device__ void ssd_scan_phase(CParams& p, int layer, bf16_t* smem) {
    const int j2 = layer >> 1;
    for (int t = blockIdx.x; t < NB * 2 * 32 * 4; t += gridDim.x) {
        const int xcd = t & 7, li = t >> 3, gi = xcd * 2 + (li >> 5);
        const int pq = li & 3, h = (gi & 3) * 8 + ((li & 31) >> 2), dir = (gi >> 2) & 1, b = gi >> 3;
        ssd_scan_item(p, j2, b, dir, h, pq, smem);
    }
}

__device__ void finish_phase(CParams& p, int layer) {
    const int j2 = layer >> 1, lane = tid_() & 63, wave = tid_() >> 6, quad = lane >> 4;
    bf16_t* yf = (bf16_t*)(p.ws + WS_YF); const bf16_t* yb = (const bf16_t*)(p.ws + WS_YB); const bf16_t* z = (const bf16_t*)(p.ws + WS_Z);
    const float* gn = p.ssm_norm_g + (size_t)j2 * 2048;
    for (int tr = blockIdx.x * 4 + wave; tr < MT / 16; tr += gridDim.x * 4) {
        const size_t base = (size_t)tr * 64 * 512 + lane * 8;
#pragma unroll 1
        for (int g = 0; g < 4; ++g) {
            float ss = 0.f;
#pragma unroll 4
            for (int kk = 0; kk < 16; ++kk) {
                const size_t off = base + (size_t)(g * 16 + kk) * 512;
                const u32x4 a = *(const u32x4*)(yf + off), bq = *(const u32x4*)(yb + off), zq = *(const u32x4*)(z + off);
                const unsigned aw[4] = {a.x, a.y, a.z, a.w}, bw[4] = {bq.x, bq.y, bq.z, bq.w}, zw[4] = {zq.x, zq.y, zq.z, zq.w};
#pragma unroll
                for (int k = 0; k < 4; ++k) {
                    const float v0 = (__uint_as_float(aw[k] << 16) + __uint_as_float(bw[k] << 16)) * __uint_as_float(zw[k] << 16);
                    const float v1 = (__uint_as_float(aw[k] & 0xffff0000u) + __uint_as_float(bw[k] & 0xffff0000u)) * __uint_as_float(zw[k] & 0xffff0000u);
                    ss += v0 * v0 + v1 * v1;
                }
            }
            ss += __shfl_xor(ss, 16); ss += __shfl_xor(ss, 32);
            const float rstd = rsqrtf(ss * (1.f / 512.f) + EPS);
#pragma unroll 4
            for (int kk = 0; kk < 16; ++kk) {
                const size_t off = base + (size_t)(g * 16 + kk) * 512;
                const u32x4 a = *(const u32x4*)(yf + off), bq = *(const u32x4*)(yb + off), zq = *(const u32x4*)(z + off);
                const unsigned aw[4] = {a.x, a.y, a.z, a.w}, bw[4] = {bq.x, bq.y, bq.z, bq.w}, zw[4] = {zq.x, zq.y, zq.z, zq.w};
                const int col = (g * 16 + kk) * 32 + quad * 8;
                const f32x4 g0 = *(const f32x4*)(gn + col), g1 = *(const f32x4*)(gn + col + 4);
                const float gg[8] = {g0[0], g0[1], g0[2], g0[3], g1[0], g1[1], g1[2], g1[3]};
                unsigned ow[4];
#pragma unroll
                for (int k = 0; k < 4; ++k) {
                    const float v0 = (__uint_as_float(aw[k] << 16) + __uint_as_float(bw[k] << 16)) * __uint_as_float(zw[k] << 16);
                    const float v1 = (__uint_as_float(aw[k] & 0xffff0000u) + __uint_as_float(bw[k] & 0xffff0000u)) * __uint_as_float(zw[k] & 0xffff0000u);
                    ow[k] = pack2(v0 * rstd * gg[2 * k], v1 * rstd * gg[2 * k + 1]);
                }
                u32x4 o4; o4.x = ow[0]; o4.y = ow[1]; o4.z = ow[2]; o4.w = ow[3];
                *(u32x4*)(yf + off) = o4;
            }
        }
    }
}

__global__ void __launch_bounds__(256, 2) hybrid_fwd(Params p) {
    extern __shared__ __attribute__((aligned(16))) unsigned char lds[];
    cg::grid_group grid = cg::this_grid();
    bf16_t* smem = (bf16_t*)lds; float* smf = (float*)lds;
    volatile LAS unsigned* bst = (volatile LAS unsigned*)(lds + LDS_BYTES - 16);
    if (threadIdx.x == 0) { bst[0] = 0u; bst[1] = 0u; }
    __syncthreads();
    const XcdBarrier xb = xcd_barrier_post((unsigned*)(p.ws + WS_BAR), bst);
    enum { C_NORM1 = 0, C_MIXIN, C_ATTN, C_MIXOUT, C_NORM2, C_FFNIN, C_FFNOUT, C_SSMIN, C_CONV, C_SSD, C_FINISH, C_SSMOUT, C_PRO, C_SSDB };
    const unsigned long long evc = 0x6543210ull;
    const unsigned long long odc = 0x654BAD9870ull;
    for (int ph = 0; ph < 35; ++ph) {
        int code, layer;
        if (ph == 0) { code = C_PRO; layer = 0; }
        else {
            const int q = ph - 1, pair = q / 17, r = q - pair * 17;
            if (r < 7) { layer = 2 * pair; code = (int)((evc >> (4 * r)) & 15); }
            else { layer = 2 * pair + 1; code = (int)((odc >> (4 * (r - 7))) & 15); }
        }
        CParams* kp = (CParams*)__builtin_amdgcn_kernarg_segment_ptr();
        asm volatile("" : "+s"(kp));
        CParams& q = *kp;
#define PHASE(c) asm volatile("" : "+s"(code)); if (code == (c))
        PHASE(C_PRO) prologue(q, smf);
        PHASE(C_NORM1) { if (layer > 0) convert_layer_weights(q, layer, smf); norm_phase(q, layer, 0); }
        PHASE(C_NORM2) norm_phase(q, layer, 1);
        PHASE(C_MIXIN) gemm_phase<G_MIXIN>(q, layer, smem);
        PHASE(C_ATTN) attn_sg_phase(q, layer, smem);
        PHASE(C_MIXOUT) gemm_phase<G_MIXOUT>(q, layer, smem);
        PHASE(C_FFNIN) gemm_phase<G_FFNIN>(q, layer, smem);
        PHASE(C_FFNOUT) gemm_phase<G_FFNOUT>(q, layer, smem);
        PHASE(C_SSMIN) gemm_phase<G_SSMIN>(q, layer, smem);
        PHASE(C_CONV) conv_phase(q, layer, smf);
        PHASE(C_SSD) ssd_diag_phase(q, layer, smem);
        PHASE(C_SSDB) ssd_scan_phase(q, layer, smem);
        PHASE(C_FINISH) finish_phase(q, layer);
        PHASE(C_SSMOUT) gemm_phase<G_SSMOUT>(q, layer, smem);
#undef PHASE
        if (q.out == nullptr) grid.sync();
        xcd_barrier(xb);
    }
}

extern "C" void kernel_launch(void* const* d_in, const int* in_sizes, int n_in, void* d_out, int out_size, void* d_ws, size_t ws_size, hipStream_t stream) {
    static int grid_blocks = 0;
    if (grid_blocks == 0) {
        if (ws_size < WS_TOTAL) { fprintf(stderr, "kernel_launch: workspace too small: %zu < %zu\n", ws_size, (size_t)WS_TOTAL); grid_blocks = -1; return; }
        int dev = 0, cus = 0, per_cu = 0;
        hipGetDevice(&dev);
        hipDeviceGetAttribute(&cus, hipDeviceAttributeMultiprocessorCount, dev);
        if (hipFuncSetAttribute((const void*)hybrid_fwd, hipFuncAttributeMaxDynamicSharedMemorySize, LDS_BYTES) != hipSuccess) { fprintf(stderr, "kernel_launch: hipFuncSetAttribute failed\n"); }
        if (hipOccupancyMaxActiveBlocksPerMultiprocessor(&per_cu, (const void*)hybrid_fwd, 256, LDS_BYTES) != hipSuccess || per_cu < 1) { fprintf(stderr, "kernel_launch: occupancy query failed (%d)\n", per_cu); per_cu = 1; }
        if (per_cu > 2) per_cu = 2;
        (void)hipGetLastError();
        grid_blocks = cus * per_cu;
    }
    if (grid_blocks < 0) return;
    if (hipMemsetAsync((char*)d_ws + WS_BAR, 0, XCD_BAR_WORDS * sizeof(unsigned), stream) != hipSuccess) { fprintf(stderr, "kernel_launch: hipMemsetAsync failed\n"); return; }
    Params p{};
    const float** f = (const float**)&p;
    for (int i = 0; i < 25; ++i) f[i] = (const float*)d_in[i];
    p.out = (float*)d_out; p.ws = (unsigned char*)d_ws;
    void* args[] = {&p};
    hipError_t e = hipLaunchCooperativeKernel((const void*)hybrid_fwd, dim3(grid_blocks), dim3(256), args, LDS_BYTES, stream);
    if (e != hipSuccess) fprintf(stderr, "cooperative launch failed: %s (grid %d)\n", hipGetErrorString(e), grid_blocks);
}
```

```cpp
#include <hip/hip_runtime.h>
#include <hip/hip_cooperative_groups.h>
#include <cstdio>
#include <cstdint>
namespace cg = cooperative_groups;

typedef unsigned short bf16_t;
typedef short bf16x8 __attribute__((ext_vector_type(8)));
typedef short bf16x4 __attribute__((ext_vector_type(4)));
typedef float f32x4 __attribute__((ext_vector_type(4)));
typedef unsigned u32x4 __attribute__((ext_vector_type(4)));
typedef unsigned u32x2 __attribute__((ext_vector_type(2)));

constexpr int D = 1024, NB = 2, SEQ = 8192, CTX = 256;
constexpr int ML = NB * SEQ;
constexpr int MC = NB * CTX;
constexpr int MT = ML + MC;
constexpr int TALL = CTX + SEQ;
constexpr int FFH = 2816;
constexpr int MIXIN = 1792;
constexpr int SSMIN = 5184, SSMIN_PAD = 5248;
constexpr int SSI = 2048;
constexpr float EPS = 1e-6f;
constexpr float QSCALE = 0.125f * 1.4426950408889634f;

constexpr size_t MB = 1024 * 1024;
constexpr size_t WS_MOD = 0;
constexpr size_t WS_ROPE = 1 * MB;
constexpr size_t WS_XCTX = 3 * MB;
constexpr size_t WS_SGW = 5 * MB + 512 * 1024;
constexpr size_t WS_BAR = 7 * MB;
constexpr size_t WS_PART = 7 * MB + 64 * 1024;
constexpr size_t WS_WT = 8 * MB;
constexpr size_t WT_FFNIN = 0;
constexpr size_t WT_FFNOUT = WT_FFNIN + (size_t)5632 * 1024 * 2;
constexpr size_t WT_MIXIN = WT_FFNOUT + (size_t)1024 * 2816 * 2;
constexpr size_t WT_MIXOUT = WT_MIXIN + (size_t)SSMIN_PAD * 1024 * 2;
constexpr size_t WT_END = WT_MIXOUT + (size_t)1024 * 2048 * 2;
constexpr size_t WS_R0 = WS_WT + ((WT_END + MB - 1) / MB) * MB;
constexpr size_t SZ_XBC = (size_t)MT * 3072 * 2;
constexpr size_t SZ_HN = (size_t)MT * 1024 * 2;
constexpr size_t WS_XBC = WS_R0;
constexpr size_t WS_HN = WS_XBC + SZ_XBC;
constexpr size_t WS_YF = WS_XBC;
constexpr size_t WS_YB = WS_YF + (size_t)MT * 2048 * 2;
constexpr size_t WS_R1 = WS_HN + SZ_HN;
constexpr size_t WS_Z = WS_R1;
constexpr size_t WS_XT = WS_Z + (size_t)MT * 2048 * 2;
constexpr size_t WS_BN = WS_XT + (size_t)MT * 2048 * 2;
constexpr size_t WS_CN = WS_BN + (size_t)MT * 512 * 2;
constexpr size_t WS_BT = WS_CN + (size_t)MT * 512 * 2;
constexpr size_t WS_DT = WS_BT + (size_t)MT * 512 * 2;
constexpr size_t WS_END_ODD = WS_DT + (size_t)MT * 64 * 4;
constexpr size_t WS_Q = WS_R1;
constexpr size_t WS_K = WS_Q + (size_t)MT * 512 * 2;
constexpr size_t WS_VT = WS_K + (size_t)MT * 128 * 2;
constexpr size_t WS_U = WS_VT + (size_t)MT * 128 * 2;
constexpr size_t WS_GVT = WS_U + (size_t)MT * 512 * 2;
constexpr size_t WS_AS = WS_GVT + (size_t)MT * 512 * 2;
constexpr size_t WS_HID = WS_R1;
constexpr size_t WS_TOTAL = WS_END_ODD;
static_assert(WS_TOTAL < (size_t)400 * MB, "workspace too large");
static_assert(WS_AS + (size_t)MT * 1024 * 2 <= WS_END_ODD, "even buffers fit");
static_assert(WS_HID + (size_t)MT * FFH * 2 <= WS_END_ODD, "hid fits");

constexpr int LDS_BYTES = 73728;
constexpr int GST = 72;
constexpr int SST = 136;

struct Params {
    const float* x; const float* c; const float* ctx; const float* c_ctx;
    const float* ada_w; const float* ada_b; const float* norm1_g; const float* norm2_g;
    const float* ffn_w_in; const float* ffn_w_out; const float* mix_w_in; const float* mix_w_out;
    const float* q_norm_g; const float* k_norm_g; const float* sgu_norm_g; const float* sgu_w; const float* sgu_b;
    const float* ssm_w_in; const float* ssm_conv_w; const float* ssm_conv_b; const float* ssm_dt_bias;
    const float* ssm_a_log; const float* ssm_d; const float* ssm_norm_g; const float* ssm_w_out;
    float* out; unsigned char* ws;
};

typedef const __attribute__((address_space(4))) Params CParams;

__device__ __forceinline__ int tid_() { int t = threadIdx.x; asm volatile("" : "+v"(t)); return t; }
__device__ __forceinline__ bf16_t f2bf(float f) {
    unsigned u = __float_as_uint(f);
    u += 0x7fffu + ((u >> 16) & 1u);
    return (bf16_t)(u >> 16);
}
__device__ __forceinline__ float bf2f(bf16_t h) { return __uint_as_float(((unsigned)h) << 16); }
__device__ __forceinline__ unsigned pack2(float a, float b) { unsigned r; asm volatile("v_cvt_pk_bf16_f32 %0, %1, %2" : "=v"(r) : "v"(a), "v"(b)); return r; }
__device__ __forceinline__ float siluf(float v) { return v / (1.f + __expf(-v)); }
__device__ __forceinline__ float geluf(float v) {
    const float u = 0.7978845608028654f * (v + 0.044715f * v * v * v);
    return v / (1.f + __expf(-2.f * u));
}
__device__ __forceinline__ float softplusf(float v) { return v > 20.f ? v : log1pf(expf(v)); }
__device__ __forceinline__ int seg_of(int row) { return row < SEQ ? 0 : (row < ML ? 1 : 2); }
__device__ __forceinline__ float* xrow(CParams& p, int row) {
    return row < ML ? p.out + (size_t)row * D : (float*)(p.ws + WS_XCTX) + (size_t)(row - ML) * D;
}
__device__ __forceinline__ void lds_sync() {
    __builtin_amdgcn_fence(__ATOMIC_RELEASE, "workgroup", "local");
    __builtin_amdgcn_s_barrier();
    __builtin_amdgcn_fence(__ATOMIC_ACQUIRE, "workgroup", "local");
}
typedef float f32x2 __attribute__((ext_vector_type(2)));
__device__ __forceinline__ f32x2 scan128(float s0, float s1, int lane, int dir) {
    if (dir == 0) {
#pragma unroll
        for (int o = 1; o < 64; o <<= 1) { const float t0 = __shfl_up(s0, o), t1 = __shfl_up(s1, o); s0 += lane >= o ? t0 : 0.f; s1 += lane >= o ? t1 : 0.f; }
        s1 += __shfl(s0, 63);
    } else {
#pragma unroll
        for (int o = 1; o < 64; o <<= 1) { const float t0 = __shfl_down(s0, o), t1 = __shfl_down(s1, o); s0 += lane + o < 64 ? t0 : 0.f; s1 += lane + o < 64 ? t1 : 0.f; }
        s0 += __shfl(s1, 0);
    }
    return (f32x2){s0, s1};
}
__device__ __forceinline__ f32x4 mfma16(bf16x8 a, bf16x8 b, f32x4 c) { return __builtin_amdgcn_mfma_f32_16x16x32_bf16(a, b, c, 0, 0, 0); }
__device__ __forceinline__ bf16x8 lds16(const bf16_t* p) { return *(const bf16x8*)p; }
__device__ __forceinline__ bf16x8 lds8x2(const bf16_t* p0, const bf16_t* p1) {
    const bf16x4 a = *(const bf16x4*)p0, b = *(const bf16x4*)p1;
    bf16x8 r; r[0] = a[0]; r[1] = a[1]; r[2] = a[2]; r[3] = a[3]; r[4] = b[0]; r[5] = b[1]; r[6] = b[2]; r[7] = b[3];
    return r;
}
__device__ __forceinline__ bf16x8 pack8(f32x4 a, f32x4 b) {
    u32x4 w; w.x = pack2(a[0], a[1]); w.y = pack2(a[2], a[3]); w.z = pack2(b[0], b[1]); w.w = pack2(b[2], b[3]);
    return __builtin_bit_cast(bf16x8, w);
}
__device__ __forceinline__ void st4bf(bf16_t* dst, float a, float b, float c, float d) {
    u32x2 w; w.x = pack2(a, b); w.y = pack2(c, d); *(u32x2*)dst = w;
}


#define XB_TMO      128
#define XB_XCNT(j)  (256  + 64 * (j))
#define XB_XSUB(j)  (1280 + 64 * (j))
#define XB_XGEN(j)  (2304 + 64 * (j))
#define XB_TOP      3328
#define XB_TOPGEN   3392
#define XCD_BAR_WORDS 3456
#define XB_SPIN_CAP (1u << 18)
#define LAS __attribute__((address_space(3)))
__device__ __forceinline__ unsigned xb_ld(unsigned* p)              { return __hip_atomic_load(p, __ATOMIC_RELAXED, __HIP_MEMORY_SCOPE_AGENT); }
__device__ __forceinline__ unsigned xb_add(unsigned* p, unsigned v) { return __hip_atomic_fetch_add(p, v, __ATOMIC_RELAXED, __HIP_MEMORY_SCOPE_AGENT); }
__device__ __forceinline__ unsigned xb_xcc_id() { return (unsigned)__builtin_amdgcn_s_getreg((3 << 11) | 20) & 0xFu; }
#define XB_SPIN(cond, bar) do { unsigned _sp = 0; while (cond) { __builtin_amdgcn_s_sleep(1); \
    if ((++_sp & 255u) == 0u) { if (xb_ld(&(bar)[XB_TMO])) break; if (_sp > XB_SPIN_CAP) { atomicAdd(&(bar)[XB_TMO], 1u); break; } } } } while (0)
struct XcdBarrier { unsigned* bar; unsigned x; volatile LAS unsigned* st; };
__device__ __forceinline__ XcdBarrier xcd_barrier_post(unsigned* bar, volatile LAS unsigned* st) {
    XcdBarrier b; b.bar = bar; b.x = xb_xcc_id(); b.st = st;
    if (threadIdx.x == 0) (void)xb_add(&bar[XB_XCNT(b.x)], 1u);
    return b;
}
__device__ __forceinline__ void xcd_barrier_complete(unsigned* bar, unsigned x, unsigned& nloc, unsigned& nx) {
    const unsigned G = gridDim.x * gridDim.y * gridDim.z;
    unsigned sum, cnt, mine, sp = 0u;
    for (;;) {
        sum = 0u; cnt = 0u; mine = 0u;
#pragma unroll
        for (unsigned j = 0; j < 16; ++j) { const unsigned c = xb_ld(&bar[XB_XCNT(j)]); sum += c; cnt += (c > 0u) ? 1u : 0u; mine = (j == x) ? c : mine; }
        if (sum == G) break;
        __builtin_amdgcn_s_sleep(1);
        if ((++sp & 255u) == 0u) { if (xb_ld(&bar[XB_TMO])) break; if (sp > XB_SPIN_CAP) { atomicAdd(&bar[XB_TMO], 1u); break; } }
    }
    nloc = mine > 0u ? mine : 1u; nx = cnt > 0u ? cnt : 1u;
}
__device__ __forceinline__ void xcd_barrier(const XcdBarrier& b) {
    asm volatile("s_waitcnt vmcnt(0)" ::: "memory");
    __syncthreads();
    if (threadIdx.x == 0) {
        unsigned* bar = b.bar;
        __builtin_amdgcn_s_waitcnt(0);
        unsigned nloc = b.st[0], nx = b.st[1];
        if (nloc == 0u) { xcd_barrier_complete(bar, b.x, nloc, nx); b.st[0] = nloc; b.st[1] = nx; }
        const unsigned old = xb_add(&bar[XB_XSUB(b.x)], 1u);
        const unsigned gen = old / nloc;
        if (old + 1u == (gen + 1u) * nloc) {
            __builtin_amdgcn_fence(__ATOMIC_RELEASE, "agent");
            asm volatile("s_waitcnt vmcnt(0)" ::: "memory");
            const unsigned og = xb_add(&bar[XB_TOP], 1u);
            const unsigned tg = og / nx;
            if (og + 1u == (tg + 1u) * nx) xb_add(&bar[XB_TOPGEN], 1u);
            else XB_SPIN(xb_ld(&bar[XB_TOPGEN]) == tg, bar);
            __builtin_amdgcn_fence(__ATOMIC_ACQUIRE, "agent");
            xb_add(&bar[XB_XGEN(b.x)], 1u);
            asm volatile("s_waitcnt vmcnt(0)" ::: "memory");
        } else {
            XB_SPIN(xb_ld(&bar[XB_XGEN(b.x)]) == gen, bar);
            __builtin_amdgcn_fence(__ATOMIC_ACQUIRE, "agent");
            asm volatile("s_waitcnt vmcnt(0)" ::: "memory");
        }
    }
    __syncthreads();
}

__device__ __forceinline__ size_t frag_off(int row, int col, int K) {
    return ((size_t)(row >> 4) * (K >> 5) + (col >> 5)) * 512 + ((row & 15) + 16 * ((col & 31) >> 3)) * 8 + (col & 7);
}

template <int MI, int lda, int ldw, int K, int FRAG = 0>
__device__ __forceinline__ void gemm_tile(const bf16_t* __restrict__ A, const bf16_t* __restrict__ W,
                                          f32x4 (&acc)[MI][8], bf16_t* sW) {
    const int tid = tid_(), lane = tid & 63, wave = tid >> 6, l16 = lane & 15, quad = lane >> 4;
    const int srow = tid >> 3, skc = (tid & 7) * 8;
    constexpr int ASI = FRAG ? (K / 32) * 512 : 16 * lda;
    constexpr int ASK = FRAG ? 512 : 32;
    const bf16_t* ap = FRAG ? A + (size_t)(wave * MI) * ASI + lane * 8 : A + (size_t)(wave * 16 * MI + l16) * lda + quad * 8;
    const bf16_t* wp = W + (size_t)srow * ldw + skc;
    const bf16_t* wr = sW + l16 * GST + quad * 8;
    u32x4 ra[MI][2], rw[4];
#pragma unroll
    for (int i = 0; i < 4; ++i) rw[i] = *(const u32x4*)(wp + (size_t)(i * 32) * ldw);
#pragma unroll
    for (int i = 0; i < MI; ++i)
#pragma unroll
        for (int ks = 0; ks < 2; ++ks) ra[i][ks] = *(const u32x4*)(ap + (size_t)i * ASI + ks * ASK);
#pragma unroll
    for (int i = 0; i < MI; ++i)
#pragma unroll
        for (int j = 0; j < 8; ++j) acc[i][j] = (f32x4){0.f, 0.f, 0.f, 0.f};
    constexpr int nk = K >> 6;
#pragma unroll 1
    for (int kt = 0; kt < nk; ++kt) {
        lds_sync();
#pragma unroll
        for (int i = 0; i < 4; ++i) *(u32x4*)(sW + (srow + i * 32) * GST + skc) = rw[i];
        lds_sync();
        const int k0 = (kt + 1 < nk ? kt + 1 : kt) << 6;
        const int ka = FRAG ? (k0 >> 5) * 512 : k0;
#pragma unroll
        for (int i = 0; i < 4; ++i) rw[i] = *(const u32x4*)(wp + (size_t)(i * 32) * ldw + k0);
        bf16x8 wa[4], wb[4];
#pragma unroll
        for (int j = 0; j < 4; ++j) wa[j] = lds16(wr + (j * 16) * GST);
#pragma unroll
        for (int j = 0; j < 4; ++j) wb[j] = lds16(wr + ((j + 4) * 16) * GST);
        __builtin_amdgcn_sched_barrier(0);
        __builtin_amdgcn_s_setprio(1);
#pragma unroll
        for (int j = 0; j < 4; ++j)
#pragma unroll
            for (int i = 0; i < MI; ++i) acc[i][j] = mfma16(wa[j], __builtin_bit_cast(bf16x8, ra[i][0]), acc[i][j]);
        __builtin_amdgcn_sched_barrier(0);
#pragma unroll
        for (int j = 0; j < 4; ++j) wa[j] = lds16(wr + (j * 16) * GST + 32);
        __builtin_amdgcn_sched_barrier(0);
#pragma unroll
        for (int j = 0; j < 4; ++j)
#pragma unroll
            for (int i = 0; i < MI; ++i) acc[i][j + 4] = mfma16(wb[j], __builtin_bit_cast(bf16x8, ra[i][0]), acc[i][j + 4]);
        __builtin_amdgcn_sched_barrier(0);
#pragma unroll
        for (int i = 0; i < MI; ++i) ra[i][0] = *(const u32x4*)(ap + (size_t)i * ASI + ka);
#pragma unroll
        for (int j = 0; j < 4; ++j) wb[j] = lds16(wr + ((j + 4) * 16) * GST + 32);
        __builtin_amdgcn_sched_barrier(0);
#pragma unroll
        for (int j = 0; j < 4; ++j)
#pragma unroll
            for (int i = 0; i < MI; ++i) acc[i][j] = mfma16(wa[j], __builtin_bit_cast(bf16x8, ra[i][1]), acc[i][j]);
        __builtin_amdgcn_sched_barrier(0);
#pragma unroll
        for (int j = 0; j < 4; ++j)
#pragma unroll
            for (int i = 0; i < MI; ++i) acc[i][j + 4] = mfma16(wb[j], __builtin_bit_cast(bf16x8, ra[i][1]), acc[i][j + 4]);
        __builtin_amdgcn_s_setprio(0);
        __builtin_amdgcn_sched_barrier(0);
#pragma unroll
        for (int i = 0; i < MI; ++i) ra[i][1] = *(const u32x4*)(ap + (size_t)i * ASI + ka + ASK);
    }
}

template <int MI>
__device__ __forceinline__ void epi_resid(CParams& p, int m0, int n0, const f32x4 (&acc)[MI][8], const float* gate  ) {
    const int lane = tid_() & 63, wave = tid_() >> 6, l16 = lane & 15, quad = lane >> 4;
#pragma unroll
    for (int i = 0; i < MI; ++i) {
        const int row = m0 + wave * 16 * MI + i * 16 + l16;
        float* xr = xrow(p, row);
        const float* g = gate + (size_t)seg_of(row) * 6144;
        float ss = 0.f;
#pragma unroll
        for (int j = 0; j < 8; ++j) {
            const int col = n0 + j * 16 + quad * 4;
            const f32x4 gv = *(const f32x4*)(g + col);
            f32x4 xv = *(f32x4*)(xr + col);
            xv += gv * acc[i][j];
            *(f32x4*)(xr + col) = xv;
            ss += xv[0] * xv[0] + xv[1] * xv[1] + xv[2] * xv[2] + xv[3] * xv[3];
        }
        ss += __shfl_xor(ss, 16); ss += __shfl_xor(ss, 32);
        if (quad == 0) ((float*)(p.ws + WS_PART))[(size_t)row * 8 + (n0 >> 7)] = ss;
        __builtin_amdgcn_sched_barrier(0);
    }
}

template <int MI>
__device__ __forceinline__ void epi_swiglu(CParams& p, int m0, int n0, const f32x4 (&acc)[MI][8]) {
    const int lane = tid_() & 63, wave = tid_() >> 6, l16 = lane & 15, quad = lane >> 4;
    bf16_t* hid = (bf16_t*)(p.ws + WS_HID);
#pragma unroll
    for (int i = 0; i < MI; ++i) {
        const int row = m0 + wave * 16 * MI + i * 16 + l16;
#pragma unroll
        for (int jj = 0; jj < 4; ++jj) {
            const f32x4 g = acc[i][2 * jj], u = acc[i][2 * jj + 1];
            const int hc = (n0 >> 1) + jj * 16 + quad * 4;
            const size_t off = ((size_t)(row >> 4) * (FFH / 32) + (hc >> 5)) * 512 + ((row & 15) + 16 * ((hc & 31) >> 3)) * 8 + (hc & 7);
            st4bf(hid + off, siluf(g[0]) * u[0], siluf(g[1]) * u[1], siluf(g[2]) * u[2], siluf(g[3]) * u[3]);
        }
    }
}

template <int MI>
__device__ __forceinline__ void epi_mixin(CParams& p, int j2, int m0, int tn, f32x4 (&acc)[MI][8]) {
    const int lane = tid_() & 63, wave = tid_() >> 6, l16 = lane & 15, quad = lane >> 4;
    if (tn < 5) {
        const float* gsrc = (tn < 4 ? p.q_norm_g : p.k_norm_g) + j2 * 64;
        const float* cosT = (const float*)(p.ws + WS_ROPE);
        const float* sinT = cosT + 8192 * 32;
#pragma unroll
        for (int i = 0; i < MI; ++i) {
            const int row = m0 + wave * 16 * MI + i * 16 + l16;
#pragma unroll
            for (int hh = 0; hh < 2; ++hh) {
                float ss = 0.f;
#pragma unroll
                for (int j = 0; j < 4; ++j) { const f32x4 v = acc[i][hh * 4 + j]; ss += v[0] * v[0] + v[1] * v[1] + v[2] * v[2] + v[3] * v[3]; }
                ss += __shfl_xor(ss, 16); ss += __shfl_xor(ss, 32);
                const float rstd = rsqrtf(ss * (1.f / 64.f) + EPS);
                f32x4 y[4];
#pragma unroll
                for (int j = 0; j < 4; ++j) {
                    const f32x4 gv = *(const f32x4*)(gsrc + j * 16 + quad * 4);
                    y[j] = acc[i][hh * 4 + j] * rstd * gv;
                }
                if (row < ML) {
                    const int s = row & (SEQ - 1);
#pragma unroll
                    for (int j = 0; j < 2; ++j) {
                        const f32x4 cs = *(const f32x4*)(cosT + (size_t)s * 32 + j * 16 + quad * 4);
                        const f32x4 sn = *(const f32x4*)(sinT + (size_t)s * 32 + j * 16 + quad * 4);
                        const f32x4 x1 = y[j], x2 = y[j + 2];
                        y[j] = x1 * cs - x2 * sn;
                        y[j + 2] = x2 * cs + x1 * sn;
                    }
                }
                if (tn < 4) {
                    bf16_t* q = (bf16_t*)(p.ws + WS_Q) + (size_t)row * 512 + (tn * 2 + hh) * 64;
#pragma unroll
                    for (int j = 0; j < 4; ++j) st4bf(q + j * 16 + quad * 4, y[j][0] * QSCALE, y[j][1] * QSCALE, y[j][2] * QSCALE, y[j][3] * QSCALE);
                } else {
                    const int b = row < ML ? (row >> 13) : ((row - ML) >> 8);
                    const int t = row < ML ? CTX + (row & (SEQ - 1)) : ((row - ML) & (CTX - 1));
                    bf16_t* k = (bf16_t*)(p.ws + WS_K) + ((size_t)b * TALL + t) * 128 + hh * 64;
#pragma unroll
                    for (int j = 0; j < 4; ++j) st4bf(k + j * 16 + quad * 4, y[j][0], y[j][1], y[j][2], y[j][3]);
                }
            }
        }
    } else if (tn == 5) {
        bf16_t* vt = (bf16_t*)(p.ws + WS_VT);
#pragma unroll
        for (int i = 0; i < MI; ++i) {
            const int row = m0 + wave * 16 * MI + i * 16 + l16;
            const int b = row < ML ? (row >> 13) : ((row - ML) >> 8);
            const int t = row < ML ? CTX + (row & (SEQ - 1)) : ((row - ML) & (CTX - 1));
#pragma unroll
            for (int j = 0; j < 8; ++j) {
                const int kh = j >> 2;
#pragma unroll
                for (int r = 0; r < 4; ++r) {
                    const int d = (j & 3) * 16 + quad * 4 + r;
                    vt[((size_t)(b * 2 + kh) * 64 + d) * TALL + t] = f2bf(acc[i][j][r]);
                }
            }
        }
    } else if (tn < 10) {
        bf16_t* u = (bf16_t*)(p.ws + WS_U);
#pragma unroll
        for (int i = 0; i < MI; ++i) {
            const int row = m0 + wave * 16 * MI + i * 16 + l16;
#pragma unroll
            for (int j = 0; j < 8; ++j) {
                const f32x4 v = acc[i][j];
                st4bf(u + (size_t)row * 512 + (tn - 6) * 128 + j * 16 + quad * 4, geluf(v[0]), geluf(v[1]), geluf(v[2]), geluf(v[3]));
            }
        }
    } else {
        const int g = tn - 10;
        const float* gn = p.sgu_norm_g + j2 * 512 + g * 128;
        bf16_t* gvt = (bf16_t*)(p.ws + WS_GVT);
#pragma unroll
        for (int i = 0; i < MI; ++i) {
            const int row = m0 + wave * 16 * MI + i * 16 + l16;
            float ss = 0.f;
#pragma unroll
            for (int j = 0; j < 8; ++j) {
                f32x4 v = acc[i][j];
                v[0] = geluf(v[0]); v[1] = geluf(v[1]); v[2] = geluf(v[2]); v[3] = geluf(v[3]);
                acc[i][j] = v;
                ss += v[0] * v[0] + v[1] * v[1] + v[2] * v[2] + v[3] * v[3];
            }
            ss += __shfl_xor(ss, 16); ss += __shfl_xor(ss, 32);
            const float rstd = rsqrtf(ss * (1.f / 128.f) + EPS);
            const int chunk = row >> 7, pt = row & 127;
#pragma unroll
            for (int j = 0; j < 8; ++j) {
                const f32x4 gv = *(const f32x4*)(gn + j * 16 + quad * 4);
#pragma unroll
                for (int r = 0; r < 4; ++r) {
                    const int cc = g * 128 + j * 16 + quad * 4 + r;
                    gvt[((size_t)chunk * 512 + cc) * 128 + pt] = f2bf(acc[i][j][r] * rstd * gv[r]);
                }
            }
        }
    }
}

template <int MI>
__device__ __forceinline__ void epi_ssmin(CParams& p, int j2, int m0, int tn, const f32x4 (&acc)[MI][8]) {
    const int lane = tid_() & 63, wave = tid_() >> 6, l16 = lane & 15, quad = lane >> 4;
#pragma unroll
    for (int i = 0; i < MI; ++i) {
        const int row = m0 + wave * 16 * MI + i * 16 + l16;
        if (tn < 16) {
            bf16_t* z = (bf16_t*)(p.ws + WS_Z);
#pragma unroll
            for (int j = 0; j < 8; ++j) { const f32x4 v = acc[i][j]; st4bf(z + frag_off(row, tn * 128 + j * 16 + quad * 4, 2048), siluf(v[0]), siluf(v[1]), siluf(v[2]), siluf(v[3])); }
        } else if (tn < 40) {
            bf16_t* xb = (bf16_t*)(p.ws + WS_XBC) + (size_t)row * 3072 + (tn - 16) * 128;
#pragma unroll
            for (int j = 0; j < 8; ++j) { const f32x4 v = acc[i][j]; st4bf(xb + j * 16 + quad * 4, v[0], v[1], v[2], v[3]); }
        } else {
            float* dt = (float*)(p.ws + WS_DT) + (size_t)row * 64;
            const float* bias = p.ssm_dt_bias + j2 * 64;
#pragma unroll
            for (int j = 0; j < 4; ++j) {
                const int c = j * 16 + quad * 4;
                const f32x4 v = acc[i][j];
                f32x4 o;
                o[0] = softplusf(v[0] + bias[c + 0]); o[1] = softplusf(v[1] + bias[c + 1]);
                o[2] = softplusf(v[2] + bias[c + 2]); o[3] = softplusf(v[3] + bias[c + 3]);
                *(f32x4*)(dt + c) = o;
            }
        }
    }
}

enum { G_MIXIN = 0, G_MIXOUT, G_SSMIN, G_SSMOUT, G_FFNIN, G_FFNOUT };

template <int KIND>
__device__ __forceinline__ void gemm_phase(CParams& p, int layer, bf16_t* smem) {
    const int j2 = layer >> 1;
    constexpr int lda = (KIND == G_SSMOUT) ? 2048 : (KIND == G_FFNOUT) ? FFH : 1024;
    constexpr int K = lda, ldw = K;
    constexpr int N = (KIND == G_MIXIN) ? MIXIN : (KIND == G_SSMIN) ? SSMIN_PAD : (KIND == G_FFNIN) ? 2 * FFH : 1024;
    constexpr size_t aoff = (KIND == G_MIXOUT) ? WS_AS : (KIND == G_SSMOUT) ? WS_YF : (KIND == G_FFNOUT) ? WS_HID : WS_HN;
    constexpr size_t woff = (KIND == G_MIXIN || KIND == G_SSMIN) ? WT_MIXIN : (KIND == G_MIXOUT || KIND == G_SSMOUT) ? WT_MIXOUT : (KIND == G_FFNIN) ? WT_FFNIN : WT_FFNOUT;
    const bf16_t* A = (const bf16_t*)(p.ws + aoff);
    const bf16_t* W = (const bf16_t*)(p.ws + WS_WT + woff);
    constexpr int MI = (KIND == G_MIXIN) ? 2 : 4;
    constexpr int FRAG = 1;
    constexpr int nN = N >> 7, nM = MT / (64 * MI);
    const float* mod = (const float*)(p.ws + WS_MOD) + (size_t)layer * 3 * 6144;
    bf16_t* sW = smem;
    if (N == 1024) {
        const int nlat = (ML / 256) * 8, nctx = layer == 3 ? 0 : (MC / 64) * 8;
        const float* gate = mod + (KIND == G_FFNOUT ? 5 : 2) * 1024;
        for (int t = blockIdx.x; t < nlat + nctx; t += gridDim.x) {
            if (t < nlat) {
                const int u = (gridDim.x == 512) ? ((t & 7) * 64 + (t >> 3)) : t;
                const int tm = u >> 3, tn = u & 7;
                f32x4 acc[4][8];
                gemm_tile<4, lda, ldw, K, FRAG>(A + (size_t)tm * 256 * lda, W + (size_t)tn * 128 * ldw, acc, sW);
                epi_resid<4>(p, tm * 256, tn * 128, acc, gate);
            } else {
                const int u = t - nlat, tm = u >> 3, tn = u & 7;
                f32x4 acc[1][8];
                gemm_tile<1, lda, ldw, K, FRAG>(A + (size_t)(ML + tm * 64) * lda, W + (size_t)tn * 128 * ldw, acc, sW);
                epi_resid<1>(p, ML + tm * 64, tn * 128, acc, gate);
            }
        }
        return;
    }
    constexpr int T = nM * nN, share = (T + 7) / 8, nsc = (nN + 7) / 8;
    const int xcd = blockIdx.x & 7, slot = blockIdx.x >> 3, nslot = gridDim.x >> 3;
    for (int li = slot; li < share; li += nslot) {
        const int u = xcd * share + li;
        if (u >= T) break;
        int sc = u / (nM * 8); if (sc > nsc - 1) sc = nsc - 1;
        const int rem = u - sc * nM * 8, wd = (sc == nsc - 1) ? (nN - 8 * sc) : 8;
        const int tm = rem / wd, tn = sc * 8 + rem - tm * wd;
        f32x4 acc[MI][8];
        gemm_tile<MI, lda, ldw, K, FRAG>(A + (size_t)tm * (64 * MI) * lda, W + (size_t)tn * 128 * ldw, acc, sW);
        if (KIND == G_MIXIN) epi_mixin<MI>(p, j2, tm * (64 * MI), tn, acc);
        else if (KIND == G_SSMIN) epi_ssmin<MI>(p, j2, tm * (64 * MI), tn, acc);
        else if (KIND == G_FFNIN) epi_swiglu<MI>(p, tm * (64 * MI), tn * 128, acc);
    }
}

__device__ __forceinline__ void norm_phase(CParams& p, int layer, int which) {
    const int lane = tid_() & 63, wave = tid_() >> 6, l16 = lane & 15, quad = lane >> 4;
    const float* g = (which ? p.norm2_g : p.norm1_g) + layer * 1024;
    const float* mod = (const float*)(p.ws + WS_MOD) + (size_t)layer * 3 * 6144;
    const float* part = (const float*)(p.ws + WS_PART);
    bf16_t* hn = (bf16_t*)(p.ws + WS_HN);
#pragma unroll 4
    for (int it = blockIdx.x * 4 + wave; it < (MT / 16) * 32; it += gridDim.x * 4) {
        const int tr = it >> 5, kb = it & 31, row = tr * 16 + l16, col = kb * 32 + quad * 8;
        const f32x4 p0 = *(const f32x4*)(part + (size_t)row * 8), p1 = *(const f32x4*)(part + (size_t)row * 8 + 4);
        const float rs = rsqrtf((((p0[0] + p0[1]) + (p0[2] + p0[3])) + ((p1[0] + p1[1]) + (p1[2] + p1[3]))) * (1.f / 1024.f) + EPS);
        const float* m = mod + (size_t)seg_of(row) * 6144 + (which ? 3 * 1024 : 0);
        const float* xr = xrow(p, row) + col;
        const f32x4 v0 = *(const f32x4*)(xr), v1 = *(const f32x4*)(xr + 4);
        const f32x4 g0 = *(const f32x4*)(g + col), g1 = *(const f32x4*)(g + col + 4);
        const f32x4 sh0 = *(const f32x4*)(m + col), sh1 = *(const f32x4*)(m + col + 4);
        const f32x4 sc0 = *(const f32x4*)(m + 1024 + col), sc1 = *(const f32x4*)(m + 1024 + col + 4);
        const f32x4 y0 = (v0 * rs * g0) * (sc0 + 1.f) + sh0, y1 = (v1 * rs * g1) * (sc1 + 1.f) + sh1;
        u32x4 o; o.x = pack2(y0[0], y0[1]); o.y = pack2(y0[2], y0[3]); o.z = pack2(y1[0], y1[1]); o.w = pack2(y1[2], y1[3]);
        *(u32x4*)(hn + (size_t)it * 512 + lane * 8) = o;
    }
}

__device__ __forceinline__ void convert_wt(const float* __restrict__ W, int K, int N, bf16_t* __restrict__ Wt, int mode, float* tile) {
    const int tid = tid_();
    const int nKt = K >> 6, nNt = N >> 6;
    for (int t = blockIdx.x; t < nKt * nNt; t += gridDim.x) {
        const int kt = t / nNt, nt = t - kt * nNt;
        lds_sync();
#pragma unroll
        for (int i = 0; i < 16; ++i) {
            const int kk = (tid >> 6) + i * 4, nn = tid & 63;
            tile[kk * 65 + nn] = W[(size_t)(kt * 64 + kk) * N + nt * 64 + nn];
        }
        lds_sync();
        {
            const int nn = tid >> 2, kq = (tid & 3) * 16;
            const int n = nt * 64 + nn;
            int dr = n;
            if (mode == 1) { const int hm = n < FFH ? n : n - FFH; dr = (hm >> 4) * 32 + (hm & 15) + (n < FFH ? 0 : 16); }
            u32x4 o0, o1;
            o0.x = pack2(tile[(kq + 0) * 65 + nn], tile[(kq + 1) * 65 + nn]); o0.y = pack2(tile[(kq + 2) * 65 + nn], tile[(kq + 3) * 65 + nn]);
            o0.z = pack2(tile[(kq + 4) * 65 + nn], tile[(kq + 5) * 65 + nn]); o0.w = pack2(tile[(kq + 6) * 65 + nn], tile[(kq + 7) * 65 + nn]);
            o1.x = pack2(tile[(kq + 8) * 65 + nn], tile[(kq + 9) * 65 + nn]); o1.y = pack2(tile[(kq + 10) * 65 + nn], tile[(kq + 11) * 65 + nn]);
            o1.z = pack2(tile[(kq + 12) * 65 + nn], tile[(kq + 13) * 65 + nn]); o1.w = pack2(tile[(kq + 14) * 65 + nn], tile[(kq + 15) * 65 + nn]);
            bf16_t* dst = Wt + (size_t)dr * K + kt * 64 + kq;
            *(u32x4*)dst = o0; *(u32x4*)(dst + 8) = o1;
        }
    }
}

__device__ __forceinline__ void convert_layer_weights(CParams& p, int layer, float* tile) {
    unsigned char* wt = p.ws + WS_WT;
    const int j2 = layer >> 1;
    convert_wt(p.ffn_w_in + (size_t)layer * 1024 * 2 * FFH, 1024, 2 * FFH, (bf16_t*)(wt + WT_FFNIN), 1, tile);
    convert_wt(p.ffn_w_out + (size_t)layer * FFH * 1024, FFH, 1024, (bf16_t*)(wt + WT_FFNOUT), 0, tile);
    if ((layer & 1) == 0) {
        convert_wt(p.mix_w_in + (size_t)j2 * 1024 * MIXIN, 1024, MIXIN, (bf16_t*)(wt + WT_MIXIN), 0, tile);
        convert_wt(p.mix_w_out + (size_t)j2 * 1024 * 1024, 1024, 1024, (bf16_t*)(wt + WT_MIXOUT), 0, tile);
    } else {
        convert_wt(p.ssm_w_in + (size_t)j2 * 1024 * SSMIN, 1024, SSMIN, (bf16_t*)(wt + WT_MIXIN), 0, tile);
        convert_wt(p.ssm_w_out + (size_t)j2 * SSI * 1024, SSI, 1024, (bf16_t*)(wt + WT_MIXOUT), 0, tile);
        bf16_t* padp = (bf16_t*)(wt + WT_MIXIN) + (size_t)SSMIN * 1024;
        for (int i = blockIdx.x * 256 + tid_(); i < (SSMIN_PAD - SSMIN) * 1024; i += gridDim.x * 256) padp[i] = 0;
    }
}

__device__ __forceinline__ void prologue(CParams& p, float* smf) {
    const int tid = tid_();
    const size_t gtid = (size_t)blockIdx.x * 256 + tid, gsz = (size_t)gridDim.x * 256;
    {
        const f32x4* s = (const f32x4*)p.x; f32x4* d = (f32x4*)p.out;
        for (size_t i = gtid; i < (size_t)ML * D / 4; i += gsz) d[i] = s[i];
        const f32x4* s2 = (const f32x4*)p.ctx; f32x4* d2 = (f32x4*)(p.ws + WS_XCTX);
        for (size_t i = gtid; i < (size_t)MC * D / 4; i += gsz) d2[i] = s2[i];
    }
    {
        float* part = (float*)(p.ws + WS_PART);
        const int lane = tid & 63, wv = tid >> 6;
        for (int row = blockIdx.x * 4 + wv; row < MT; row += gridDim.x * 4) {
            const float* xr = row < ML ? p.x + (size_t)row * D : p.ctx + (size_t)(row - ML) * D;
            float ss = 0.f;
#pragma unroll
            for (int i = 0; i < 4; ++i) { const f32x4 v = *(const f32x4*)(xr + i * 256 + lane * 4); ss += v[0] * v[0] + v[1] * v[1] + v[2] * v[2] + v[3] * v[3]; }
#pragma unroll
            for (int o = 1; o < 64; o <<= 1) ss += __shfl_xor(ss, o);
            if (lane < 8) part[(size_t)row * 8 + lane] = lane == 0 ? ss : 0.f;
        }
    }
    {
        float* cosT = (float*)(p.ws + WS_ROPE); float* sinT = cosT + 8192 * 32;
        for (size_t i = gtid; i < (size_t)8192 * 32; i += gsz) {
            const int s = (int)(i >> 5), j = (int)(i & 31), f = j & 15;
            const float inv = powf(10000.f, -(float)f / 16.f);
            const float pos = (float)(j < 16 ? (s >> 6) : (s & 63));
            const float ang = pos * inv;
            cosT[i] = cosf(ang); sinT[i] = sinf(ang);
        }
    }
    {
        bf16_t* sgw = (bf16_t*)(p.ws + WS_SGW);
        for (size_t i = gtid; i < (size_t)2 * 4 * 128 * 128; i += gsz) sgw[i] = f2bf(p.sgu_w[i]);
    }
    {
        float* sc = smf;
        float* red = smf + 3 * 1024;
        lds_sync();
        for (int i = tid; i < 3 * 1024; i += 256) {
            const int sgi = i >> 10, k = i & 1023;
            const float v = sgi < 2 ? p.c[sgi * 1024 + k] : p.c_ctx[k];
            sc[i] = siluf(v);
        }
        lds_sync();
        float* mod = (float*)(p.ws + WS_MOD);
        const int cl = tid & 63, kg = tid >> 6;
        for (int wi = blockIdx.x; wi < 4 * 96; wi += gridDim.x) {
            const int layer = wi / 96, cb = wi - layer * 96;
            const float* w = p.ada_w + (size_t)layer * 1024 * 6144 + cb * 64 + cl;
            float s0 = 0.f, s1 = 0.f, s2 = 0.f;
            for (int k = kg * 256; k < kg * 256 + 256; ++k) {
                const float wv = w[(size_t)k * 6144];
                s0 += sc[k] * wv; s1 += sc[1024 + k] * wv; s2 += sc[2048 + k] * wv;
            }
            lds_sync();
            red[(kg * 3 + 0) * 64 + cl] = s0; red[(kg * 3 + 1) * 64 + cl] = s1; red[(kg * 3 + 2) * 64 + cl] = s2;
            lds_sync();
            if (tid < 192) {
                const int sgi = tid >> 6;
                const float v = red[(0 * 3 + sgi) * 64 + cl] + red[(1 * 3 + sgi) * 64 + cl] + red[(2 * 3 + sgi) * 64 + cl] + red[(3 * 3 + sgi) * 64 + cl];
                const int n = cb * 64 + cl;
                mod[((size_t)layer * 3 + sgi) * 6144 + n] = v + p.ada_b[layer * 6144 + n];
            }
        }
        lds_sync();
    }
    convert_layer_weights(p, 0, smf);
}

__device__ __forceinline__ void attn_item(CParams& p, int j2, int b, int h, int q0row, int nkeys, bf16_t* smem) {
    const int tid = tid_(), lane = tid & 63, wave = tid >> 6, l16 = lane & 15, quad = lane >> 4;
    const int kh = h >> 2;
    const bf16_t* Q = (const bf16_t*)(p.ws + WS_Q);
    const bf16_t* Kb = (const bf16_t*)(p.ws + WS_K) + (size_t)b * TALL * 128 + kh * 64;
    const bf16_t* Vb = (const bf16_t*)(p.ws + WS_VT) + (size_t)(b * 2 + kh) * 64 * TALL;
    bf16_t* sK = smem; bf16_t* sV = smem + 64 * GST;
    constexpr float LOG2E = 1.4426950408889634f;
    float mb;
    {
        float gq = fabsf(p.q_norm_g[j2 * 64 + lane]), gk = fabsf(p.k_norm_g[j2 * 64 + lane]);
#pragma unroll
        for (int o = 1; o < 64; o <<= 1) { gq = fmaxf(gq, __shfl_xor(gq, o)); gk = fmaxf(gk, __shfl_xor(gk, o)); }
        mb = 8.f * 1.02f * gq * gk * LOG2E;
    }
    bf16x8 qf[4][2];
#pragma unroll
    for (int i = 0; i < 4; ++i)
#pragma unroll
        for (int ks = 0; ks < 2; ++ks)
            qf[i][ks] = *(const bf16x8*)(Q + (size_t)(q0row + wave * 64 + i * 16 + l16) * 512 + h * 64 + ks * 32 + quad * 8);
    f32x4 o[5][4];
#pragma unroll
    for (int d = 0; d < 5; ++d)
#pragma unroll
        for (int i = 0; i < 4; ++i) o[d][i] = (f32x4){0.f, 0.f, 0.f, 0.f};
    lds_sync();
    {
        const int r = 64 + (tid >> 4);
        u32x2 one; one.x = r == 64 ? 0x3F803F80u : 0u; one.y = one.x;
        *(u32x2*)(sV + r * GST + (tid & 15) * 4) = one;
    }
    const int srow = tid >> 3, skc = (tid & 7) * 8;
    u32x4 rk[2], rv[2];
#pragma unroll
    for (int i = 0; i < 2; ++i) {
        rk[i] = *(const u32x4*)(Kb + (size_t)(srow + i * 32) * 128 + skc);
        rv[i] = *(const u32x4*)(Vb + (size_t)(srow + i * 32) * TALL + skc);
    }
    const int nt = nkeys >> 6;
#pragma unroll 1
    for (int kt = 0; kt < nt; ++kt) {
        lds_sync();
#pragma unroll
        for (int i = 0; i < 2; ++i) {
            *(u32x4*)(sK + (srow + i * 32) * GST + skc) = rk[i];
            *(u32x4*)(sV + (srow + i * 32) * GST + skc) = rv[i];
        }
        lds_sync();
        {
            const int t0 = (kt + 1 < nt ? kt + 1 : kt) << 6;
#pragma unroll
            for (int i = 0; i < 2; ++i) {
                rk[i] = *(const u32x4*)(Kb + (size_t)(t0 + srow + i * 32) * 128 + skc);
                rv[i] = *(const u32x4*)(Vb + (size_t)(srow + i * 32) * TALL + t0 + skc);
            }
        }
        bf16x8 pf[2][4];
#pragma unroll
        for (int ih = 0; ih < 2; ++ih) {
            f32x4 s[4][2];
#pragma unroll
            for (int tt = 0; tt < 4; ++tt)
#pragma unroll
                for (int i = 0; i < 2; ++i) s[tt][i] = (f32x4){-mb, -mb, -mb, -mb};
#pragma unroll
            for (int ks = 0; ks < 2; ++ks)
#pragma unroll
                for (int tt = 0; tt < 4; ++tt) {
                    const bf16x8 kf = lds16(sK + (tt * 16 + l16) * GST + ks * 32 + quad * 8);
#pragma unroll
                    for (int i = 0; i < 2; ++i) s[tt][i] = mfma16(kf, qf[ih * 2 + i][ks], s[tt][i]);
                }
#pragma unroll
            for (int i = 0; i < 2; ++i) {
#pragma unroll
                for (int tt = 0; tt < 4; ++tt) {
#pragma unroll
                    for (int r = 0; r < 4; ++r) s[tt][i][r] = __builtin_amdgcn_exp2f(s[tt][i][r]);
                }
#pragma unroll
                for (int ksp = 0; ksp < 2; ++ksp) pf[ksp][ih * 2 + i] = pack8(s[2 * ksp][i], s[2 * ksp + 1][i]);
            }
        }
#pragma unroll
        for (int ksp = 0; ksp < 2; ++ksp)
#pragma unroll
            for (int d = 0; d < 5; ++d) {
                const bf16_t* vp = sV + (d * 16 + l16) * GST + ksp * 32 + quad * 4;
                const bf16x8 vf = lds8x2(vp, vp + 16);
#pragma unroll
                for (int i = 0; i < 4; ++i) o[d][i] = mfma16(vf, pf[ksp][i], o[d][i]);
            }
    }
    bf16_t* as = (bf16_t*)(p.ws + WS_AS);
#pragma unroll
    for (int i = 0; i < 4; ++i) {
        const float l = __shfl(o[4][i][0], l16);
        const float inv = 1.f / l;
        const int row = q0row + wave * 64 + i * 16 + l16;
#pragma unroll
        for (int d = 0; d < 4; ++d)
            st4bf(as + frag_off(row, h * 64 + d * 16 + quad * 4, 1024), o[d][i][0] * inv, o[d][i][1] * inv, o[d][i][2] * inv, o[d][i][3] * inv);
    }
}

__device__ __forceinline__ void sg_item(CParams& p, int j2, int chunk, int g, bf16_t* smem) {
    const int lane = tid_() & 63, wave = tid_() >> 6, l16 = lane & 15, quad = lane >> 4;
    const bf16_t* A = (const bf16_t*)(p.ws + WS_SGW) + (size_t)(j2 * 4 + g) * 128 * 128;
    const bf16_t* W = (const bf16_t*)(p.ws + WS_GVT) + ((size_t)chunk * 512 + g * 128) * 128;
    f32x4 acc[2][8];
    gemm_tile<2, 128, 128, 128>(A, W, acc, smem);
    const bf16_t* u = (const bf16_t*)(p.ws + WS_U);
    bf16_t* as = (bf16_t*)(p.ws + WS_AS);
    const float* bs = p.sgu_b + (size_t)(j2 * 4 + g) * 128;
#pragma unroll
    for (int i = 0; i < 2; ++i) {
        const int pt = wave * 32 + i * 16 + l16;
        const int row = chunk * 128 + pt;
        const float bias = bs[pt];
#pragma unroll
        for (int j = 0; j < 8; ++j) {
            const int c = g * 128 + j * 16 + quad * 4;
            const u32x2 uw = *(const u32x2*)(u + (size_t)row * 512 + c);
            const float u0 = __uint_as_float(uw.x << 16), u1 = __uint_as_float(uw.x & 0xffff0000u);
            const float u2 = __uint_as_float(uw.y << 16), u3 = __uint_as_float(uw.y & 0xffff0000u);
            const f32x4 v = acc[i][j];
            st4bf(as + frag_off(row, 512 + c, 1024), u0 * (v[0] + bias), u1 * (v[1] + bias), u2 * (v[2] + bias), u3 * (v[3] + bias));
        }
    }
}

__device__ __forceinline__ void attn_sg_phase(CParams& p, int layer, bf16_t* smem) {
    const int j2 = layer >> 1;
    const int nA = NB * 8 * 32, nS = (MT / 128) * 4, nC = NB * 8;
    for (int t = blockIdx.x; t < nA + nS + nC; t += gridDim.x) {
        if (t < nA) {
            const int xcd = t & 7, li = t >> 3;
            const int bh = xcd * 2 + (li >> 5), qb = li & 31;
            attn_item(p, j2, bh >> 3, bh & 7, (bh >> 3) * SEQ + qb * 256, TALL, smem);
        } else if (t < nA + nS) {
            const int u = t - nA;
            sg_item(p, j2, u >> 2, u & 3, smem);
        } else {
            const int u = t - nA - nS;
            const int h = u & 7, b = u >> 3;
            attn_item(p, j2, b, h, ML + b * CTX, CTX, smem);
        }
    }
}

__device__ __forceinline__ void conv_phase(CParams& p, int layer, float* smf) {
    const int j2 = layer >> 1, tid = tid_();
    const bf16_t* xbc = (const bf16_t*)(p.ws + WS_XBC);
    bf16_t* XT = (bf16_t*)(p.ws + WS_XT); bf16_t* Bn = (bf16_t*)(p.ws + WS_BN); bf16_t* Cn = (bf16_t*)(p.ws + WS_CN); bf16_t* BT = (bf16_t*)(p.ws + WS_BT);
    const float* cw = p.ssm_conv_w + (size_t)j2 * 3 * 3072;
    const float* cb = p.ssm_conv_b + (size_t)j2 * 3072;
    float* sin_ = smf;
    float* sout = smf + 66 * 65;
    const int nCt = 3072 / 64, nRt = MT / 64;
    for (int t = blockIdx.x; t < nCt * nRt; t += gridDim.x) {
        const int rt = t / nCt, ct = t - rt * nCt;
        const int r0 = rt * 64, c0 = ct * 64;
        const bool first = r0 < ML ? ((r0 & (SEQ - 1)) == 0) : (((r0 - ML) & (CTX - 1)) == 0);
        const bool last = r0 < ML ? (((r0 + 64) & (SEQ - 1)) == 0) : ((((r0 + 64) - ML) & (CTX - 1)) == 0);
        lds_sync();
        for (int e = tid; e < 66 * 8; e += 256) {
            const int rr = e >> 3, c8 = (e & 7) * 8;
            const int row = r0 - 1 + rr;
            u32x4 v = (u32x4){0u, 0u, 0u, 0u};
            if (!((rr == 0 && first) || (rr == 65 && last))) v = *(const u32x4*)(xbc + (size_t)row * 3072 + c0 + c8);
            float* d = sin_ + rr * 65 + c8;
            d[0] = __uint_as_float(v.x << 16); d[1] = __uint_as_float(v.x & 0xffff0000u);
            d[2] = __uint_as_float(v.y << 16); d[3] = __uint_as_float(v.y & 0xffff0000u);
            d[4] = __uint_as_float(v.z << 16); d[5] = __uint_as_float(v.z & 0xffff0000u);
            d[6] = __uint_as_float(v.w << 16); d[7] = __uint_as_float(v.w & 0xffff0000u);
        }
        lds_sync();
        {
            const int c = tid & 63;
            const float w0 = cw[c0 + c], w1 = cw[3072 + c0 + c], w2 = cw[2 * 3072 + c0 + c], bb = cb[c0 + c];
#pragma unroll
            for (int k = 0; k < 16; ++k) {
                const int tt = (tid >> 6) + k * 4;
                const float v = w0 * sin_[tt * 65 + c] + w1 * sin_[(tt + 1) * 65 + c] + w2 * sin_[(tt + 2) * 65 + c] + bb;
                sout[c * 65 + tt] = siluf(v);
            }
        }
        lds_sync();
        const int q = tid >> 2, e16 = (tid & 3) * 16;
        if (c0 >= 2048) {
            u32x4 o0, o1;
            o0.x = pack2(sout[(e16 + 0) * 65 + q], sout[(e16 + 1) * 65 + q]); o0.y = pack2(sout[(e16 + 2) * 65 + q], sout[(e16 + 3) * 65 + q]);
            o0.z = pack2(sout[(e16 + 4) * 65 + q], sout[(e16 + 5) * 65 + q]); o0.w = pack2(sout[(e16 + 6) * 65 + q], sout[(e16 + 7) * 65 + q]);
            o1.x = pack2(sout[(e16 + 8) * 65 + q], sout[(e16 + 9) * 65 + q]); o1.y = pack2(sout[(e16 + 10) * 65 + q], sout[(e16 + 11) * 65 + q]);
            o1.z = pack2(sout[(e16 + 12) * 65 + q], sout[(e16 + 13) * 65 + q]); o1.w = pack2(sout[(e16 + 14) * 65 + q], sout[(e16 + 15) * 65 + q]);
            if (c0 < 2560) {
                bf16_t* dst = Bn + (c0 - 2048) + (size_t)(r0 + q) * 512 + e16;
                *(u32x4*)dst = o0; *(u32x4*)(dst + 8) = o1;
            } else {
                *(u32x4*)(Cn + frag_off(r0 + q, c0 - 2560 + e16, 512)) = o0;
                *(u32x4*)(Cn + frag_off(r0 + q, c0 - 2560 + e16 + 8, 512)) = o1;
            }
        }
        if (c0 < 2560) {
            const float* sp = sout + q * 65 + e16;
            u32x4 o0, o1;
            o0.x = pack2(sp[0], sp[1]); o0.y = pack2(sp[2], sp[3]); o0.z = pack2(sp[4], sp[5]); o0.w = pack2(sp[6], sp[7]);
            o1.x = pack2(sp[8], sp[9]); o1.y = pack2(sp[10], sp[11]); o1.z = pack2(sp[12], sp[13]); o1.w = pack2(sp[14], sp[15]);
            if (c0 < 2048) {
                bf16_t* dst = XT + (size_t)(c0 + q) * MT + r0 + e16;
                *(u32x4*)dst = o0; *(u32x4*)(dst + 8) = o1;
            } else {
                *(u32x4*)(BT + frag_off(c0 - 2048 + q, r0 + e16, MT)) = o0;
                *(u32x4*)(BT + frag_off(c0 - 2048 + q, r0 + e16 + 8, MT)) = o1;
            }
        }
    }
}

__device__ __forceinline__ void ssd_diag_item(CParams& p, int j2, int row0, int h, bf16_t* smem) {
    const int tid = tid_(), lane = tid & 63, wave = tid >> 6, l16 = lane & 15, quad = lane >> 4;
    const int g = h >> 3;
    bf16_t* sB = smem;
    bf16_t* sX = sB + 128 * SST;
    float* sda = (float*)(sX + 64 * SST);
    float* sPf = sda + 256;
    float* sRb = sPf + 128;
    float* sdtf = sRb + 128;
    float* sdtb = sdtf + 128;
    const bf16_t* XT = (const bf16_t*)(p.ws + WS_XT) + (size_t)(h * 64) * MT;
    const bf16_t* Bn = (const bf16_t*)(p.ws + WS_BN) + g * 128;
    const bf16_t* Cn = (const bf16_t*)(p.ws + WS_CN) + (size_t)(g * 4) * 512;
    const float* DT = (const float*)(p.ws + WS_DT);
    bf16_t* Y = (bf16_t*)(p.ws + WS_YF);
    const float af = -expf(p.ssm_a_log[(j2 * 2 + 0) * 32 + h]);
    const float ab = -expf(p.ssm_a_log[(j2 * 2 + 1) * 32 + h]);
    const float dsk = p.ssm_d[j2 * 32 + h];
    lds_sync();
#pragma unroll
    for (int i = 0; i < 8; ++i) {
        const int c = tid + i * 256, r = c >> 4, kc = (c & 15) * 8;
        *(u32x4*)(sB + r * SST + kc) = *(const u32x4*)(Bn + (size_t)(row0 + r) * 512 + kc);
    }
#pragma unroll
    for (int i = 0; i < 4; ++i) {
        const int c = tid + i * 256, r = c >> 4, kc = (c & 15) * 8;
        *(u32x4*)(sX + r * SST + kc) = *(const u32x4*)(XT + (size_t)r * MT + row0 + kc);
    }
    {
        const int d = wave >> 1;
        const float d0 = DT[(size_t)(row0 + lane) * 64 + d * 32 + h], d1 = DT[(size_t)(row0 + 64 + lane) * 64 + d * 32 + h];
        const float aa = d ? ab : af;
        const f32x2 sc2 = scan128(d0 * aa, d1 * aa, lane, d);
        float* sc = d ? sRb : sPf; float* sd = d ? sdtb : sdtf;
        if ((wave & 1) == 0) { sc[lane] = sc2.x; sd[lane] = d0; } else { sc[64 + lane] = sc2.y; sd[64 + lane] = d1; }
    }
    bf16x8 cf[2][4];
#pragma unroll
    for (int i = 0; i < 2; ++i)
#pragma unroll
        for (int ks = 0; ks < 4; ++ks)
            cf[i][ks] = *(const bf16x8*)(Cn + ((size_t)((row0 >> 4) + wave * 2 + i) * 16 + ks) * 512 + lane * 8);
    lds_sync();
    float pfl[2], rbl[2];
#pragma unroll
    for (int i = 0; i < 2; ++i) { pfl[i] = sPf[wave * 32 + i * 16 + l16]; rbl[i] = sRb[wave * 32 + i * 16 + l16]; }
    f32x4 y[4][2];
#pragma unroll
    for (int pt = 0; pt < 4; ++pt)
#pragma unroll
        for (int i = 0; i < 2; ++i) y[pt][i] = (f32x4){0.f, 0.f, 0.f, 0.f};
#pragma unroll 1
    for (int sp = 0; sp < 4; ++sp) {
        f32x4 gt[2][2];
#pragma unroll
        for (int s2 = 0; s2 < 2; ++s2)
#pragma unroll
            for (int i = 0; i < 2; ++i) gt[s2][i] = (f32x4){0.f, 0.f, 0.f, 0.f};
#pragma unroll
        for (int ks = 0; ks < 4; ++ks)
#pragma unroll
            for (int s2 = 0; s2 < 2; ++s2) {
                const bf16x8 bfr = lds16(sB + (sp * 32 + s2 * 16 + l16) * SST + ks * 32 + quad * 8);
#pragma unroll
                for (int i = 0; i < 2; ++i) gt[s2][i] = mfma16(bfr, cf[i][ks], gt[s2][i]);
            }
        bf16x8 mf[2];
#pragma unroll
        for (int i = 0; i < 2; ++i) {
            const int l = wave * 32 + i * 16 + l16;
#pragma unroll
            for (int s2 = 0; s2 < 2; ++s2)
#pragma unroll
                for (int r = 0; r < 4; ++r) {
                    const int s = sp * 32 + s2 * 16 + quad * 4 + r;
                    const float arg = s < l ? (pfl[i] - sPf[s]) : (rbl[i] - sRb[s]);
                    float coef = __expf(fminf(arg, 0.f)) * (s < l ? sdtf[s] : sdtb[s]);
                    if (s == l) coef = sdtf[s] + sdtb[s];
                    gt[s2][i][r] *= coef;
                }
            mf[i] = pack8(gt[0][i], gt[1][i]);
        }
#pragma unroll
        for (int pt = 0; pt < 4; ++pt) {
            const bf16_t* xp = sX + (pt * 16 + l16) * SST + sp * 32 + quad * 4;
            const bf16x8 xf = lds8x2(xp, xp + 16);
#pragma unroll
            for (int i = 0; i < 2; ++i) y[pt][i] = mfma16(xf, mf[i], y[pt][i]);
        }
    }
#pragma unroll
    for (int i = 0; i < 2; ++i) {
        const int l = wave * 32 + i * 16 + l16;
#pragma unroll
        for (int pt = 0; pt < 4; ++pt) {
            f32x4 v = y[pt][i];
#pragma unroll
            for (int r = 0; r < 4; ++r) v[r] += dsk * bf2f(sX[(pt * 16 + quad * 4 + r) * SST + l]);
            st4bf(Y + frag_off(row0 + l, h * 64 + pt * 16 + quad * 4, 2048), v[0], v[1], v[2], v[3]);
        }
    }
}

__device__ __forceinline__ void ssd_diag_phase(CParams& p, int layer, bf16_t* smem) {
    const int j2 = layer >> 1;
    for (int t = blockIdx.x; t < (MT / 128) * 32; t += gridDim.x) {
        const int h = t & 31, chunk = t >> 5;
        ssd_diag_item(p, j2, chunk * 128, h, smem);
    }
}

struct SsdPre { u32x4 xq; u32x4 bt[2][4]; u32x4 cf[2][4]; u32x2 yold[2]; float dt0, dt1; };

__device__ __forceinline__ int ssd_row0(int b, int dir, int cc) {
    if (cc < 2) { const int ci = dir ? 1 - cc : cc; return ML + b * CTX + ci * 128; }
    const int k = cc - 2; const int ci = dir ? 63 - k : k; return b * SEQ + ci * 128;
}

__device__ __forceinline__ void ssd_scan_item(CParams& p, int j2, int b, int dir, int h, int pq, bf16_t* smem) {
    const int tid = tid_(), lane = tid & 63, wave = tid >> 6, l16 = lane & 15, quad = lane >> 4;
    const int g = h >> 3;
    bf16_t* sX = smem;
    bf16_t* sH = sX + 16 * SST;
    float* seacs = (float*)(sH + 16 * SST);
    float* sw = seacs + 128;
    float* sdec = sw + 128;
    const bf16_t* XT = (const bf16_t*)(p.ws + WS_XT) + (size_t)(h * 64 + pq * 16 + (tid >> 4)) * MT + (tid & 15) * 8;
    const bf16_t* Cn = (const bf16_t*)(p.ws + WS_CN) + ((size_t)(wave * 2) * 16 + g * 4) * 512 + lane * 8;
    const bf16_t* BT = (const bf16_t*)(p.ws + WS_BT) + (size_t)(g * 8 + wave * 2) * (MT / 32) * 512 + lane * 8;
    const float* DT = (const float*)(p.ws + WS_DT) + dir * 32 + h;
    bf16_t* Y = (bf16_t*)(p.ws + (dir ? WS_YB : WS_YF)) + frag_off(wave * 32 + l16, h * 64 + pq * 16 + quad * 4, 2048);
    const float a = -expf(p.ssm_a_log[(j2 * 2 + dir) * 32 + h]);
    f32x4 st[2];
    st[0] = (f32x4){0.f, 0.f, 0.f, 0.f}; st[1] = (f32x4){0.f, 0.f, 0.f, 0.f};
    SsdPre S0, S1;
    auto load_small = [&](SsdPre& S, int r) __attribute__((always_inline)) {
        S.xq = *(const u32x4*)(XT + r);
        S.dt0 = DT[(size_t)(r + lane) * 64]; S.dt1 = DT[(size_t)(r + 64 + lane) * 64];
    };
    auto load_cf = [&](SsdPre& S, int r) __attribute__((always_inline)) {
#pragma unroll
        for (int i = 0; i < 2; ++i)
#pragma unroll
            for (int ks = 0; ks < 4; ++ks) S.cf[i][ks] = *(const u32x4*)(Cn + ((size_t)((r >> 4) + i) * 16 + ks) * 512);
    };
    auto load_yold = [&](SsdPre& S, int r) __attribute__((always_inline)) {
#pragma unroll
        for (int i = 0; i < 2; ++i) S.yold[i] = dir == 0 ? *(const u32x2*)(Y + (size_t)((r >> 4) + i) * (64 * 512)) : (u32x2){0u, 0u};
    };
    auto load_bt = [&](SsdPre& S, int r) __attribute__((always_inline)) {
#pragma unroll
        for (int nt = 0; nt < 2; ++nt)
#pragma unroll
            for (int ks = 0; ks < 4; ++ks) S.bt[nt][ks] = *(const u32x4*)(BT + ((size_t)nt * (MT / 32) + (r >> 5) + ks) * 512);
    };
    {
        const int r0 = ssd_row0(b, dir, 0), r1 = ssd_row0(b, dir, 1);
        load_small(S0, r0); load_cf(S0, r0); load_yold(S0, r0); load_bt(S0, r0);
        load_small(S1, r1); load_cf(S1, r1); load_yold(S1, r1); load_bt(S1, r1);
    }
    auto body = [&](SsdPre& S, int cc) __attribute__((always_inline)) {
        const int row0 = ssd_row0(b, dir, cc);
        const int row2 = ssd_row0(b, dir, cc + 2 < 66 ? cc + 2 : 65);
        lds_sync();
        *(u32x4*)(sX + (tid >> 4) * SST + (tid & 15) * 8) = S.xq;
#pragma unroll
        for (int nt = 0; nt < 2; ++nt) st4bf(sH + l16 * SST + wave * 32 + nt * 16 + quad * 4, st[nt][0], st[nt][1], st[nt][2], st[nt][3]);
        if (wave < 2) {
            const f32x2 sc2 = scan128(S.dt0 * a, S.dt1 * a, lane, dir);
            const float total = dir == 0 ? __shfl(sc2.y, 63) : __shfl(sc2.x, 0);
            if (wave == 0) { seacs[lane] = __expf(sc2.x); sw[lane] = S.dt0 * __expf(total - sc2.x); if (lane == 0) sdec[0] = __expf(total); }
            else { seacs[64 + lane] = __expf(sc2.y); sw[64 + lane] = S.dt1 * __expf(total - sc2.y); }
        }
        lds_sync();
        load_small(S, row2);
        f32x4 yo[2];
        yo[0] = (f32x4){0.f, 0.f, 0.f, 0.f}; yo[1] = (f32x4){0.f, 0.f, 0.f, 0.f};
#pragma unroll
        for (int ks = 0; ks < 4; ++ks) {
            const bf16x8 hf = lds16(sH + l16 * SST + ks * 32 + quad * 8);
#pragma unroll
            for (int i = 0; i < 2; ++i) yo[i] = mfma16(hf, __builtin_bit_cast(bf16x8, S.cf[i][ks]), yo[i]);
        }
        __builtin_amdgcn_sched_barrier(0);
        load_cf(S, row2);
#pragma unroll
        for (int i = 0; i < 2; ++i) {
            const float e = seacs[wave * 32 + i * 16 + l16];
            const float o0 = __uint_as_float(S.yold[i].x << 16), o1 = __uint_as_float(S.yold[i].x & 0xffff0000u);
            const float o2 = __uint_as_float(S.yold[i].y << 16), o3 = __uint_as_float(S.yold[i].y & 0xffff0000u);
            st4bf(Y + (size_t)((row0 >> 4) + i) * (64 * 512), yo[i][0] * e + o0, yo[i][1] * e + o1, yo[i][2] * e + o2, yo[i][3] * e + o3);
        }
        __builtin_amdgcn_sched_barrier(0);
        load_yold(S, row2);
        {
            const float dec = sdec[0];
            st[0] *= dec; st[1] *= dec;
#pragma unroll
            for (int ks = 0; ks < 4; ++ks) {
                const f32x4 w0 = *(const f32x4*)(sw + ks * 32 + quad * 8), w1 = *(const f32x4*)(sw + ks * 32 + quad * 8 + 4);
                const u32x4 raw = *(const u32x4*)(sX + l16 * SST + ks * 32 + quad * 8);
                u32x4 xs;
                xs.x = pack2(__uint_as_float(raw.x << 16) * w0[0], __uint_as_float(raw.x & 0xffff0000u) * w0[1]);
                xs.y = pack2(__uint_as_float(raw.y << 16) * w0[2], __uint_as_float(raw.y & 0xffff0000u) * w0[3]);
                xs.z = pack2(__uint_as_float(raw.z << 16) * w1[0], __uint_as_float(raw.z & 0xffff0000u) * w1[1]);
                xs.w = pack2(__uint_as_float(raw.w << 16) * w1[2], __uint_as_float(raw.w & 0xffff0000u) * w1[3]);
                const bf16x8 xbf = __builtin_bit_cast(bf16x8, xs);
#pragma unroll
                for (int nt = 0; nt < 2; ++nt) st[nt] = mfma16(__builtin_bit_cast(bf16x8, S.bt[nt][ks]), xbf, st[nt]);
            }
        }
        __builtin_amdgcn_sched_barrier(0);
        load_bt(S, row2);
    };
#pragma unroll 1
    for (int cc = 0; cc < 66; cc += 2) {
        body(S0, cc);
        body(S1, cc + 1);
    }
}

__device__ __forceinline__ void ssd_scan_phase(CParams& p, int layer, bf16_t* smem) {
    const int j2 = layer >> 1;
    for (int t = blockIdx.x; t < NB * 2 * 32 * 4; t += gridDim.x) {
        const int xcd = t & 7, li = t >> 3, gi = xcd * 2 + (li >> 5);
        const int pq = li & 3, h = (gi & 3) * 8 + ((li & 31) >> 2), dir = (gi >> 2) & 1, b = gi >> 3;
        ssd_scan_item(p, j2, b, dir, h, pq, smem);
    }
}

__device__ __forceinline__ void finish_phase(CParams& p, int layer) {
    const int j2 = layer >> 1, lane = tid_() & 63, wave = tid_() >> 6, quad = lane >> 4;
    bf16_t* yf = (bf16_t*)(p.ws + WS_YF); const bf16_t* yb = (const bf16_t*)(p.ws + WS_YB); const bf16_t* z = (const bf16_t*)(p.ws + WS_Z);
    const float* gn = p.ssm_norm_g + (size_t)j2 * 2048;
    for (int tr = blockIdx.x * 4 + wave; tr < MT / 16; tr += gridDim.x * 4) {
        const size_t base = (size_t)tr * 64 * 512 + lane * 8;
#pragma unroll 1
        for (int g = 0; g < 4; ++g) {
            float ss = 0.f;
#pragma unroll 4
            for (int kk = 0; kk < 16; ++kk) {
                const size_t off = base + (size_t)(g * 16 + kk) * 512;
                const u32x4 a = *(const u32x4*)(yf + off), bq = *(const u32x4*)(yb + off), zq = *(const u32x4*)(z + off);
                const unsigned aw[4] = {a.x, a.y, a.z, a.w}, bw[4] = {bq.x, bq.y, bq.z, bq.w}, zw[4] = {zq.x, zq.y, zq.z, zq.w};
#pragma unroll
                for (int k = 0; k < 4; ++k) {
                    const float v0 = (__uint_as_float(aw[k] << 16) + __uint_as_float(bw[k] << 16)) * __uint_as_float(zw[k] << 16);
                    const float v1 = (__uint_as_float(aw[k] & 0xffff0000u) + __uint_as_float(bw[k] & 0xffff0000u)) * __uint_as_float(zw[k] & 0xffff0000u);
                    ss += v0 * v0 + v1 * v1;
                }
            }
            ss += __shfl_xor(ss, 16); ss += __shfl_xor(ss, 32);
            const float rstd = rsqrtf(ss * (1.f / 512.f) + EPS);
#pragma unroll 4
            for (int kk = 0; kk < 16; ++kk) {
                const size_t off = base + (size_t)(g * 16 + kk) * 512;
                const u32x4 a = *(const u32x4*)(yf + off), bq = *(const u32x4*)(yb + off), zq = *(const u32x4*)(z + off);
                const unsigned aw[4] = {a.x, a.y, a.z, a.w}, bw[4] = {bq.x, bq.y, bq.z, bq.w}, zw[4] = {zq.x, zq.y, zq.z, zq.w};
                const int col = (g * 16 + kk) * 32 + quad * 8;
                const f32x4 g0 = *(const f32x4*)(gn + col), g1 = *(const f32x4*)(gn + col + 4);
                const float gg[8] = {g0[0], g0[1], g0[2], g0[3], g1[0], g1[1], g1[2], g1[3]};
                unsigned ow[4];
#pragma unroll
                for (int k = 0; k < 4; ++k) {
                    const float v0 = (__uint_as_float(aw[k] << 16) + __uint_as_float(bw[k] << 16)) * __uint_as_float(zw[k] << 16);
                    const float v1 = (__uint_as_float(aw[k] & 0xffff0000u) + __uint_as_float(bw[k] & 0xffff0000u)) * __uint_as_float(zw[k] & 0xffff0000u);
                    ow[k] = pack2(v0 * rstd * gg[2 * k], v1 * rstd * gg[2 * k + 1]);
                }
                u32x4 o4; o4.x = ow[0]; o4.y = ow[1]; o4.z = ow[2]; o4.w = ow[3];
                *(u32x4*)(yf + off) = o4;
            }
        }
    }
}

__global__ void __launch_bounds__(256, 2) hybrid_fwd(Params p) {
    extern __shared__ __attribute__((aligned(16))) unsigned char lds[];
    cg::grid_group grid = cg::this_grid();
    bf16_t* smem = (bf16_t*)lds; float* smf = (float*)lds;
    volatile LAS unsigned* bst = (volatile LAS unsigned*)(lds + LDS_BYTES - 16);
    if (threadIdx.x == 0) { bst[0] = 0u; bst[1] = 0u; }
    __syncthreads();
    const XcdBarrier xb = xcd_barrier_post((unsigned*)(p.ws + WS_BAR), bst);
    enum { C_NORM1 = 0, C_MIXIN, C_ATTN, C_MIXOUT, C_NORM2, C_FFNIN, C_FFNOUT, C_SSMIN, C_CONV, C_SSD, C_FINISH, C_SSMOUT, C_PRO, C_SSDB };
    const unsigned long long evc = 0x6543210ull;
    const unsigned long long odc = 0x654BAD9870ull;
    for (int ph = 0; ph < 35; ++ph) {
        int code, layer;
        if (ph == 0) { code = C_PRO; layer = 0; }
        else {
            const int q = ph - 1, pair = q / 17, r = q - pair * 17;
            if (r < 7) { layer = 2 * pair; code = (int)((evc >> (4 * r)) & 15); }
            else { layer = 2 * pair + 1; code = (int)((odc >> (4 * (r - 7))) & 15); }
        }
        CParams* kp = (CParams*)__builtin_amdgcn_kernarg_segment_ptr();
        asm volatile("" : "+s"(kp));
        CParams& q = *kp;
#define PHASE(c) asm volatile("" : "+s"(code)); if (code == (c))
        PHASE(C_PRO) prologue(q, smf);
        PHASE(C_NORM1) { if (layer > 0) convert_layer_weights(q, layer, smf); norm_phase(q, layer, 0); }
        PHASE(C_NORM2) norm_phase(q, layer, 1);
        PHASE(C_MIXIN) gemm_phase<G_MIXIN>(q, layer, smem);
        PHASE(C_ATTN) attn_sg_phase(q, layer, smem);
        PHASE(C_MIXOUT) gemm_phase<G_MIXOUT>(q, layer, smem);
        PHASE(C_FFNIN) gemm_phase<G_FFNIN>(q, layer, smem);
        PHASE(C_FFNOUT) gemm_phase<G_FFNOUT>(q, layer, smem);
        PHASE(C_SSMIN) gemm_phase<G_SSMIN>(q, layer, smem);
        PHASE(C_CONV) conv_phase(q, layer, smf);
        PHASE(C_SSD) ssd_diag_phase(q, layer, smem);
        PHASE(C_SSDB) ssd_scan_phase(q, layer, smem);
        PHASE(C_FINISH) finish_phase(q, layer);
        PHASE(C_SSMOUT) gemm_phase<G_SSMOUT>(q, layer, smem);
#undef PHASE
        if (q.out == nullptr) grid.sync();
        xcd_barrier(xb);
    }
}

extern "C" void kernel_launch(void* const* d_in, const int* in_sizes, int n_in, void* d_out, int out_size, void* d_ws, size_t ws_size, hipStream_t stream) {
    static int grid_blocks = 0;
    if (grid_blocks == 0) {
        if (ws_size < WS_TOTAL) { fprintf(stderr, "kernel_launch: workspace too small: %zu < %zu\n", ws_size, (size_t)WS_TOTAL); grid_blocks = -1; return; }
        int dev = 0, cus = 0, per_cu = 0;
        hipGetDevice(&dev);
        hipDeviceGetAttribute(&cus, hipDeviceAttributeMultiprocessorCount, dev);
        if (hipFuncSetAttribute((const void*)hybrid_fwd, hipFuncAttributeMaxDynamicSharedMemorySize, LDS_BYTES) != hipSuccess) { fprintf(stderr, "kernel_launch: hipFuncSetAttribute failed\n"); }
        if (hipOccupancyMaxActiveBlocksPerMultiprocessor(&per_cu, (const void*)hybrid_fwd, 256, LDS_BYTES) != hipSuccess || per_cu < 1) { fprintf(stderr, "kernel_launch: occupancy query failed (%d)\n", per_cu); per_cu = 1; }
        if (per_cu > 2) per_cu = 2;
        (void)hipGetLastError();
        grid_blocks = cus * per_cu;
    }
    if (grid_blocks < 0) return;
    if (hipMemsetAsync((char*)d_ws + WS_BAR, 0, XCD_BAR_WORDS * sizeof(unsigned), stream) != hipSuccess) { fprintf(stderr, "kernel_launch: hipMemsetAsync failed\n"); return; }
    Params p{};
    const float** f = (const float**)&p;
    for (int i = 0; i < 25; ++i) f[i] = (const float*)d_in[i];
    p.out = (float*)d_out; p.ws = (unsigned char*)d_ws;
    void* args[] = {&p};
    hipError_t e = hipLaunchCooperativeKernel((const void*)hybrid_fwd, dim3(grid_blocks), dim3(256), args, LDS_BYTES, stream);
    if (e != hipSuccess) fprintf(stderr, "cooperative launch failed: %s (grid %d)\n", hipGetErrorString(e), grid_blocks);
}
```

```cpp
#include <hip/hip_runtime.h>
#include <hip/hip_cooperative_groups.h>
#include <cstdio>
#include <cstdint>
namespace cg = cooperative_groups;

typedef unsigned short bf16_t;
typedef short bf16x8 __attribute__((ext_vector_type(8)));
typedef short bf16x4 __attribute__((ext_vector_type(4)));
typedef float f32x4 __attribute__((ext_vector_type(4)));
typedef unsigned u32x4 __attribute__((ext_vector_type(4)));
typedef unsigned u32x2 __attribute__((ext_vector_type(2)));

constexpr int D = 1024, NB = 2, SEQ = 8192, CTX = 256;
constexpr int ML = NB * SEQ;
constexpr int MC = NB * CTX;
constexpr int MT = ML + MC;
constexpr int TALL = CTX + SEQ;
constexpr int FFH = 2816;
constexpr int MIXIN = 1792;
constexpr int SSMIN = 5184, SSMIN_PAD = 5248;
constexpr int SSI = 2048;
constexpr float EPS = 1e-6f;
constexpr float QSCALE = 0.125f * 1.4426950408889634f;

constexpr size_t MB = 1024 * 1024;
constexpr size_t WS_MOD = 0;
constexpr size_t WS_ROPE = 1 * MB;
constexpr size_t WS_XCTX = 3 * MB;
constexpr size_t WS_SGW = 5 * MB + 512 * 1024;
constexpr size_t WS_BAR = 7 * MB;
constexpr size_t WS_PART = 7 * MB + 64 * 1024;
constexpr size_t WS_WT = 8 * MB;
constexpr size_t WT_FFNIN = 0;
constexpr size_t WT_FFNOUT = WT_FFNIN + (size_t)5632 * 1024 * 2;
constexpr size_t WT_MIXIN = WT_FFNOUT + (size_t)1024 * 2816 * 2;
constexpr size_t WT_MIXOUT = WT_MIXIN + (size_t)SSMIN_PAD * 1024 * 2;
constexpr size_t WT_END = WT_MIXOUT + (size_t)1024 * 2048 * 2;
constexpr size_t WS_R0 = WS_WT + ((WT_END + MB - 1) / MB) * MB;
constexpr size_t SZ_XBC = (size_t)MT * 3072 * 2;
constexpr size_t SZ_HN = (size_t)MT * 1024 * 2;
constexpr size_t WS_XBC = WS_R0;
constexpr size_t WS_HN = WS_XBC + SZ_XBC;
constexpr size_t WS_YF = WS_XBC;
constexpr size_t WS_YB = WS_YF + (size_t)MT * 2048 * 2;
constexpr size_t WS_R1 = WS_HN + SZ_HN;
constexpr size_t WS_Z = WS_R1;
constexpr size_t WS_XT = WS_Z + (size_t)MT * 2048 * 2;
constexpr size_t WS_BN = WS_XT + (size_t)MT * 2048 * 2;
constexpr size_t WS_CN = WS_BN + (size_t)MT * 512 * 2;
constexpr size_t WS_BT = WS_CN + (size_t)MT * 512 * 2;
constexpr size_t WS_DT = WS_BT + (size_t)MT * 512 * 2;
constexpr size_t WS_END_ODD = WS_DT + (size_t)MT * 64 * 4;
constexpr size_t WS_Q = WS_R1;
constexpr size_t WS_K = WS_Q + (size_t)MT * 512 * 2;
constexpr size_t WS_VT = WS_K + (size_t)MT * 128 * 2;
constexpr size_t WS_U = WS_VT + (size_t)MT * 128 * 2;
constexpr size_t WS_GVT = WS_U + (size_t)MT * 512 * 2;
constexpr size_t WS_AS = WS_GVT + (size_t)MT * 512 * 2;
constexpr size_t WS_HID = WS_R1;
constexpr size_t WS_TOTAL = WS_END_ODD;
static_assert(WS_TOTAL < (size_t)400 * MB, "workspace too large");
static_assert(WS_AS + (size_t)MT * 1024 * 2 <= WS_END_ODD, "even buffers fit");
static_assert(WS_HID + (size_t)MT * FFH * 2 <= WS_END_ODD, "hid fits");

constexpr int LDS_BYTES = 73728;
constexpr int GST = 72;
constexpr int SST = 136;

struct Params {
    const float* x; const float* c; const float* ctx; const float* c_ctx;
    const float* ada_w; const float* ada_b; const float* norm1_g; const float* norm2_g;
    const float* ffn_w_in; const float* ffn_w_out; const float* mix_w_in; const float* mix_w_out;
    const float* q_norm_g; const float* k_norm_g; const float* sgu_norm_g; const float* sgu_w; const float* sgu_b;
    const float* ssm_w_in; const float* ssm_conv_w; const float* ssm_conv_b; const float* ssm_dt_bias;
    const float* ssm_a_log; const float* ssm_d; const float* ssm_norm_g; const float* ssm_w_out;
    float* out; unsigned char* ws;
};

typedef const __attribute__((address_space(4))) Params CParams;

__device__ __forceinline__ int tid_() { int t = threadIdx.x; asm volatile("" : "+v"(t)); return t; }
__device__ __forceinline__ bf16_t f2bf(float f) {
    unsigned u = __float_as_uint(f);
    u += 0x7fffu + ((u >> 16) & 1u);
    return (bf16_t)(u >> 16);
}
__device__ __forceinline__ float bf2f(bf16_t h) { return __uint_as_float(((unsigned)h) << 16); }
typedef __bf16 bf16v2_t __attribute__((ext_vector_type(2)));
typedef float f32v2_t __attribute__((ext_vector_type(2)));
__device__ __forceinline__ unsigned pack2(float a, float b) { const f32v2_t v = {a, b}; return __builtin_bit_cast(unsigned, __builtin_convertvector(v, bf16v2_t)); }
__device__ __forceinline__ float siluf(float v) { return v / (1.f + __expf(-v)); }
__device__ __forceinline__ float geluf(float v) {
    const float u = 0.7978845608028654f * (v + 0.044715f * v * v * v);
    return v / (1.f + __expf(-2.f * u));
}
__device__ __forceinline__ float softplusf(float v) { return v > 20.f ? v : log1pf(expf(v)); }
__device__ __forceinline__ int seg_of(int row) { return row < SEQ ? 0 : (row < ML ? 1 : 2); }
__device__ __forceinline__ float* xrow(CParams& p, int row) {
    return row < ML ? p.out + (size_t)row * D : (float*)(p.ws + WS_XCTX) + (size_t)(row - ML) * D;
}
__device__ __forceinline__ void lds_sync() {
    __builtin_amdgcn_fence(__ATOMIC_RELEASE, "workgroup", "local");
    __builtin_amdgcn_s_barrier();
    __builtin_amdgcn_fence(__ATOMIC_ACQUIRE, "workgroup", "local");
}
typedef float f32x2 __attribute__((ext_vector_type(2)));
__device__ __forceinline__ f32x2 scan128(float s0, float s1, int lane, int dir) {
    if (dir == 0) {
#pragma unroll
        for (int o = 1; o < 64; o <<= 1) { const float t0 = __shfl_up(s0, o), t1 = __shfl_up(s1, o); s0 += lane >= o ? t0 : 0.f; s1 += lane >= o ? t1 : 0.f; }
        s1 += __shfl(s0, 63);
    } else {
#pragma unroll
        for (int o = 1; o < 64; o <<= 1) { const float t0 = __shfl_down(s0, o), t1 = __shfl_down(s1, o); s0 += lane + o < 64 ? t0 : 0.f; s1 += lane + o < 64 ? t1 : 0.f; }
        s0 += __shfl(s1, 0);
    }
    return (f32x2){s0, s1};
}
__device__ __forceinline__ f32x4 mfma16(bf16x8 a, bf16x8 b, f32x4 c) { return __builtin_amdgcn_mfma_f32_16x16x32_bf16(a, b, c, 0, 0, 0); }
__device__ __forceinline__ bf16x8 lds16(const bf16_t* p) { return *(const bf16x8*)p; }
__device__ __forceinline__ bf16x8 lds8x2(const bf16_t* p0, const bf16_t* p1) {
    const bf16x4 a = *(const bf16x4*)p0, b = *(const bf16x4*)p1;
    bf16x8 r; r[0] = a[0]; r[1] = a[1]; r[2] = a[2]; r[3] = a[3]; r[4] = b[0]; r[5] = b[1]; r[6] = b[2]; r[7] = b[3];
    return r;
}
__device__ __forceinline__ bf16x8 pack8(f32x4 a, f32x4 b) {
    u32x4 w; w.x = pack2(a[0], a[1]); w.y = pack2(a[2], a[3]); w.z = pack2(b[0], b[1]); w.w = pack2(b[2], b[3]);
    return __builtin_bit_cast(bf16x8, w);
}
__device__ __forceinline__ void st4bf(bf16_t* dst, float a, float b, float c, float d) {
    u32x2 w; w.x = pack2(a, b); w.y = pack2(c, d); *(u32x2*)dst = w;
}


#define XB_TMO      128
#define XB_XCNT(j)  (256  + 64 * (j))
#define XB_XSUB(j)  (1280 + 64 * (j))
#define XB_XGEN(j)  (2304 + 64 * (j))
#define XB_TOP      3328
#define XB_TOPGEN   3392
#define XCD_BAR_WORDS 3456
#define XB_SPIN_CAP (1u << 18)
#define LAS __attribute__((address_space(3)))
__device__ __forceinline__ unsigned xb_ld(unsigned* p)              { return __hip_atomic_load(p, __ATOMIC_RELAXED, __HIP_MEMORY_SCOPE_AGENT); }
__device__ __forceinline__ unsigned xb_add(unsigned* p, unsigned v) { return __hip_atomic_fetch_add(p, v, __ATOMIC_RELAXED, __HIP_MEMORY_SCOPE_AGENT); }
__device__ __forceinline__ unsigned xb_xcc_id() { return (unsigned)__builtin_amdgcn_s_getreg((3 << 11) | 20) & 0xFu; }
#define XB_SPIN(cond, bar) do { unsigned _sp = 0; while (cond) { __builtin_amdgcn_s_sleep(1); \
    if ((++_sp & 255u) == 0u) { if (xb_ld(&(bar)[XB_TMO])) break; if (_sp > XB_SPIN_CAP) { atomicAdd(&(bar)[XB_TMO], 1u); break; } } } } while (0)
struct XcdBarrier { unsigned* bar; unsigned x; volatile LAS unsigned* st; };
__device__ __forceinline__ XcdBarrier xcd_barrier_post(unsigned* bar, volatile LAS unsigned* st) {
    XcdBarrier b; b.bar = bar; b.x = xb_xcc_id(); b.st = st;
    if (threadIdx.x == 0) (void)xb_add(&bar[XB_XCNT(b.x)], 1u);
    return b;
}
__device__ __forceinline__ void xcd_barrier_complete(unsigned* bar, unsigned x, unsigned& nloc, unsigned& nx) {
    const unsigned G = gridDim.x * gridDim.y * gridDim.z;
    unsigned sum, cnt, mine, sp = 0u;
    for (;;) {
        sum = 0u; cnt = 0u; mine = 0u;
#pragma unroll
        for (unsigned j = 0; j < 16; ++j) { const unsigned c = xb_ld(&bar[XB_XCNT(j)]); sum += c; cnt += (c > 0u) ? 1u : 0u; mine = (j == x) ? c : mine; }
        if (sum == G) break;
        __builtin_amdgcn_s_sleep(1);
        if ((++sp & 255u) == 0u) { if (xb_ld(&bar[XB_TMO])) break; if (sp > XB_SPIN_CAP) { atomicAdd(&bar[XB_TMO], 1u); break; } }
    }
    nloc = mine > 0u ? mine : 1u; nx = cnt > 0u ? cnt : 1u;
}
__device__ __forceinline__ void xcd_barrier(const XcdBarrier& b) {
    asm volatile("s_waitcnt vmcnt(0)" ::: "memory");
    __syncthreads();
    if (threadIdx.x == 0) {
        unsigned* bar = b.bar;
        __builtin_amdgcn_s_waitcnt(0);
        unsigned nloc = b.st[0], nx = b.st[1];
        if (nloc == 0u) { xcd_barrier_complete(bar, b.x, nloc, nx); b.st[0] = nloc; b.st[1] = nx; }
        const unsigned old = xb_add(&bar[XB_XSUB(b.x)], 1u);
        const unsigned gen = old / nloc;
        if (old + 1u == (gen + 1u) * nloc) {
            __builtin_amdgcn_fence(__ATOMIC_RELEASE, "agent");
            asm volatile("s_waitcnt vmcnt(0)" ::: "memory");
            const unsigned og = xb_add(&bar[XB_TOP], 1u);
            const unsigned tg = og / nx;
            if (og + 1u == (tg + 1u) * nx) xb_add(&bar[XB_TOPGEN], 1u);
            else XB_SPIN(xb_ld(&bar[XB_TOPGEN]) == tg, bar);
            __builtin_amdgcn_fence(__ATOMIC_ACQUIRE, "agent");
            xb_add(&bar[XB_XGEN(b.x)], 1u);
            asm volatile("s_waitcnt vmcnt(0)" ::: "memory");
        } else {
            XB_SPIN(xb_ld(&bar[XB_XGEN(b.x)]) == gen, bar);
            __builtin_amdgcn_fence(__ATOMIC_ACQUIRE, "agent");
            asm volatile("s_waitcnt vmcnt(0)" ::: "memory");
        }
    }
    __syncthreads();
}

__device__ __forceinline__ size_t frag_off(int row, int col, int K) {
    return ((size_t)(row >> 4) * (K >> 5) + (col >> 5)) * 512 + ((row & 15) + 16 * ((col & 31) >> 3)) * 8 + (col & 7);
}

template <int MI, int lda, int ldw, int K, int FRAG = 0>
__device__ __forceinline__ void gemm_tile(const bf16_t* __restrict__ A, const bf16_t* __restrict__ W,
                                          f32x4 (&acc)[MI][8], bf16_t* sW) {
    const int tid = tid_(), lane = tid & 63, wave = tid >> 6, l16 = lane & 15, quad = lane >> 4;
    const int srow = tid >> 3, skc = (tid & 7) * 8;
    constexpr int ASI = FRAG ? (K / 32) * 512 : 16 * lda;
    constexpr int ASK = FRAG ? 512 : 32;
    const bf16_t* ap = FRAG ? A + (size_t)(wave * MI) * ASI + lane * 8 : A + (size_t)(wave * 16 * MI + l16) * lda + quad * 8;
    const bf16_t* wp = W + (size_t)srow * ldw + skc;
    const bf16_t* wr = sW + l16 * GST + quad * 8;
    u32x4 ra[MI][2], rw[4];
#pragma unroll
    for (int i = 0; i < 4; ++i) rw[i] = *(const u32x4*)(wp + (size_t)(i * 32) * ldw);
#pragma unroll
    for (int i = 0; i < MI; ++i)
#pragma unroll
        for (int ks = 0; ks < 2; ++ks) ra[i][ks] = *(const u32x4*)(ap + (size_t)i * ASI + ks * ASK);
#pragma unroll
    for (int i = 0; i < MI; ++i)
#pragma unroll
        for (int j = 0; j < 8; ++j) acc[i][j] = (f32x4){0.f, 0.f, 0.f, 0.f};
    constexpr int nk = K >> 6;
#pragma unroll 1
    for (int kt = 0; kt < nk; ++kt) {
        lds_sync();
#pragma unroll
        for (int i = 0; i < 4; ++i) *(u32x4*)(sW + (srow + i * 32) * GST + skc) = rw[i];
        lds_sync();
        const int k0 = (kt + 1 < nk ? kt + 1 : kt) << 6;
        const int ka = FRAG ? (k0 >> 5) * 512 : k0;
#pragma unroll
        for (int i = 0; i < 4; ++i) rw[i] = *(const u32x4*)(wp + (size_t)(i * 32) * ldw + k0);
        bf16x8 wa[4], wb[4];
#pragma unroll
        for (int j = 0; j < 4; ++j) wa[j] = lds16(wr + (j * 16) * GST);
#pragma unroll
        for (int j = 0; j < 4; ++j) wb[j] = lds16(wr + ((j + 4) * 16) * GST);
        __builtin_amdgcn_sched_barrier(0);
        __builtin_amdgcn_s_setprio(1);
#pragma unroll
        for (int j = 0; j < 4; ++j)
#pragma unroll
            for (int i = 0; i < MI; ++i) acc[i][j] = mfma16(wa[j], __builtin_bit_cast(bf16x8, ra[i][0]), acc[i][j]);
        __builtin_amdgcn_sched_barrier(0);
#pragma unroll
        for (int j = 0; j < 4; ++j) wa[j] = lds16(wr + (j * 16) * GST + 32);
        __builtin_amdgcn_sched_barrier(0);
#pragma unroll
        for (int j = 0; j < 4; ++j)
#pragma unroll
            for (int i = 0; i < MI; ++i) acc[i][j + 4] = mfma16(wb[j], __builtin_bit_cast(bf16x8, ra[i][0]), acc[i][j + 4]);
        __builtin_amdgcn_sched_barrier(0);
#pragma unroll
        for (int i = 0; i < MI; ++i) ra[i][0] = *(const u32x4*)(ap + (size_t)i * ASI + ka);
#pragma unroll
        for (int j = 0; j < 4; ++j) wb[j] = lds16(wr + ((j + 4) * 16) * GST + 32);
        __builtin_amdgcn_sched_barrier(0);
#pragma unroll
        for (int j = 0; j < 4; ++j)
#pragma unroll
            for (int i = 0; i < MI; ++i) acc[i][j] = mfma16(wa[j], __builtin_bit_cast(bf16x8, ra[i][1]), acc[i][j]);
        __builtin_amdgcn_sched_barrier(0);
#pragma unroll
        for (int j = 0; j < 4; ++j)
#pragma unroll
            for (int i = 0; i < MI; ++i) acc[i][j + 4] = mfma16(wb[j], __builtin_bit_cast(bf16x8, ra[i][1]), acc[i][j + 4]);
        __builtin_amdgcn_s_setprio(0);
        __builtin_amdgcn_sched_barrier(0);
#pragma unroll
        for (int i = 0; i < MI; ++i) ra[i][1] = *(const u32x4*)(ap + (size_t)i * ASI + ka + ASK);
    }
}

template <int MI>
__device__ __forceinline__ void epi_resid(CParams& p, int m0, int n0, const f32x4 (&acc)[MI][8], const float* gate  ) {
    const int lane = tid_() & 63, wave = tid_() >> 6, l16 = lane & 15, quad = lane >> 4;
#pragma unroll
    for (int i = 0; i < MI; ++i) {
        const int row = m0 + wave * 16 * MI + i * 16 + l16;
        float* xr = xrow(p, row);
        const float* g = gate + (size_t)seg_of(row) * 6144;
        float ss = 0.f;
#pragma unroll
        for (int j = 0; j < 8; ++j) {
            const int col = n0 + j * 16 + quad * 4;
            const f32x4 gv = *(const f32x4*)(g + col);
            f32x4 xv = *(f32x4*)(xr + col);
            xv += gv * acc[i][j];
            *(f32x4*)(xr + col) = xv;
            ss += xv[0] * xv[0] + xv[1] * xv[1] + xv[2] * xv[2] + xv[3] * xv[3];
        }
        ss += __shfl_xor(ss, 16); ss += __shfl_xor(ss, 32);
        if (quad == 0) ((float*)(p.ws + WS_PART))[(size_t)row * 8 + (n0 >> 7)] = ss;
        __builtin_amdgcn_sched_barrier(0);
    }
}

template <int MI>
__device__ __forceinline__ void epi_swiglu(CParams& p, int m0, int n0, const f32x4 (&acc)[MI][8]) {
    const int lane = tid_() & 63, wave = tid_() >> 6, l16 = lane & 15, quad = lane >> 4;
    bf16_t* hid = (bf16_t*)(p.ws + WS_HID);
#pragma unroll
    for (int i = 0; i < MI; ++i) {
        const int row = m0 + wave * 16 * MI + i * 16 + l16;
#pragma unroll
        for (int jj = 0; jj < 4; ++jj) {
            const f32x4 g = acc[i][2 * jj], u = acc[i][2 * jj + 1];
            const int hc = (n0 >> 1) + jj * 16 + quad * 4;
            const size_t off = ((size_t)(row >> 4) * (FFH / 32) + (hc >> 5)) * 512 + ((row & 15) + 16 * ((hc & 31) >> 3)) * 8 + (hc & 7);
            st4bf(hid + off, siluf(g[0]) * u[0], siluf(g[1]) * u[1], siluf(g[2]) * u[2], siluf(g[3]) * u[3]);
        }
    }
}

template <int MI>
__device__ __forceinline__ void epi_mixin(CParams& p, int j2, int m0, int tn, f32x4 (&acc)[MI][8]) {
    const int lane = tid_() & 63, wave = tid_() >> 6, l16 = lane & 15, quad = lane >> 4;
    if (tn < 5) {
        const float* gsrc = (tn < 4 ? p.q_norm_g : p.k_norm_g) + j2 * 64;
        const float* cosT = (const float*)(p.ws + WS_ROPE);
        const float* sinT = cosT + 8192 * 32;
#pragma unroll
        for (int i = 0; i < MI; ++i) {
            const int row = m0 + wave * 16 * MI + i * 16 + l16;
#pragma unroll
            for (int hh = 0; hh < 2; ++hh) {
                float ss = 0.f;
#pragma unroll
                for (int j = 0; j < 4; ++j) { const f32x4 v = acc[i][hh * 4 + j]; ss += v[0] * v[0] + v[1] * v[1] + v[2] * v[2] + v[3] * v[3]; }
                ss += __shfl_xor(ss, 16); ss += __shfl_xor(ss, 32);
                const float rstd = rsqrtf(ss * (1.f / 64.f) + EPS);
                f32x4 y[4];
#pragma unroll
                for (int j = 0; j < 4; ++j) {
                    const f32x4 gv = *(const f32x4*)(gsrc + j * 16 + quad * 4);
                    y[j] = acc[i][hh * 4 + j] * rstd * gv;
                }
                if (row < ML) {
                    const int s = row & (SEQ - 1);
#pragma unroll
                    for (int j = 0; j < 2; ++j) {
                        const f32x4 cs = *(const f32x4*)(cosT + (size_t)s * 32 + j * 16 + quad * 4);
                        const f32x4 sn = *(const f32x4*)(sinT + (size_t)s * 32 + j * 16 + quad * 4);
                        const f32x4 x1 = y[j], x2 = y[j + 2];
                        y[j] = x1 * cs - x2 * sn;
                        y[j + 2] = x2 * cs + x1 * sn;
                    }
                }
                if (tn < 4) {
                    bf16_t* q = (bf16_t*)(p.ws + WS_Q) + (size_t)row * 512 + (tn * 2 + hh) * 64;
#pragma unroll
                    for (int j = 0; j < 4; ++j) st4bf(q + j * 16 + quad * 4, y[j][0] * QSCALE, y[j][1] * QSCALE, y[j][2] * QSCALE, y[j][3] * QSCALE);
                } else {
                    const int b = row < ML ? (row >> 13) : ((row - ML) >> 8);
                    const int t = row < ML ? CTX + (row & (SEQ - 1)) : ((row - ML) & (CTX - 1));
                    bf16_t* k = (bf16_t*)(p.ws + WS_K) + ((size_t)b * TALL + t) * 128 + hh * 64;
#pragma unroll
                    for (int j = 0; j < 4; ++j) st4bf(k + j * 16 + quad * 4, y[j][0], y[j][1], y[j][2], y[j][3]);
                }
            }
        }
    } else if (tn == 5) {
        bf16_t* vt = (bf16_t*)(p.ws + WS_VT);
#pragma unroll
        for (int i = 0; i < MI; ++i) {
            const int row = m0 + wave * 16 * MI + i * 16 + l16;
            const int b = row < ML ? (row >> 13) : ((row - ML) >> 8);
            const int t = row < ML ? CTX + (row & (SEQ - 1)) : ((row - ML) & (CTX - 1));
#pragma unroll
            for (int j = 0; j < 8; ++j) {
                const int kh = j >> 2;
#pragma unroll
                for (int r = 0; r < 4; ++r) {
                    const int d = (j & 3) * 16 + quad * 4 + r;
                    vt[((size_t)(b * 2 + kh) * 64 + d) * TALL + t] = f2bf(acc[i][j][r]);
                }
            }
        }
    } else if (tn < 10) {
        bf16_t* u = (bf16_t*)(p.ws + WS_U);
#pragma unroll
        for (int i = 0; i < MI; ++i) {
            const int row = m0 + wave * 16 * MI + i * 16 + l16;
#pragma unroll
            for (int j = 0; j < 8; ++j) {
                const f32x4 v = acc[i][j];
                st4bf(u + (size_t)row * 512 + (tn - 6) * 128 + j * 16 + quad * 4, geluf(v[0]), geluf(v[1]), geluf(v[2]), geluf(v[3]));
            }
        }
    } else {
        const int g = tn - 10;
        const float* gn = p.sgu_norm_g + j2 * 512 + g * 128;
        bf16_t* gvt = (bf16_t*)(p.ws + WS_GVT);
#pragma unroll
        for (int i = 0; i < MI; ++i) {
            const int row = m0 + wave * 16 * MI + i * 16 + l16;
            float ss = 0.f;
#pragma unroll
            for (int j = 0; j < 8; ++j) {
                f32x4 v = acc[i][j];
                v[0] = geluf(v[0]); v[1] = geluf(v[1]); v[2] = geluf(v[2]); v[3] = geluf(v[3]);
                acc[i][j] = v;
                ss += v[0] * v[0] + v[1] * v[1] + v[2] * v[2] + v[3] * v[3];
            }
            ss += __shfl_xor(ss, 16); ss += __shfl_xor(ss, 32);
            const float rstd = rsqrtf(ss * (1.f / 128.f) + EPS);
            const int chunk = row >> 7, pt = row & 127;
#pragma unroll
            for (int j = 0; j < 8; ++j) {
                const f32x4 gv = *(const f32x4*)(gn + j * 16 + quad * 4);
#pragma unroll
                for (int r = 0; r < 4; ++r) {
                    const int cc = g * 128 + j * 16 + quad * 4 + r;
                    gvt[((size_t)chunk * 512 + cc) * 128 + pt] = f2bf(acc[i][j][r] * rstd * gv[r]);
                }
            }
        }
    }
}

template <int MI>
__device__ __forceinline__ void epi_ssmin(CParams& p, int j2, int m0, int tn, const f32x4 (&acc)[MI][8]) {
    const int lane = tid_() & 63, wave = tid_() >> 6, l16 = lane & 15, quad = lane >> 4;
#pragma unroll
    for (int i = 0; i < MI; ++i) {
        const int row = m0 + wave * 16 * MI + i * 16 + l16;
        if (tn < 16) {
            bf16_t* z = (bf16_t*)(p.ws + WS_Z);
#pragma unroll
            for (int j = 0; j < 8; ++j) { const f32x4 v = acc[i][j]; st4bf(z + frag_off(row, tn * 128 + j * 16 + quad * 4, 2048), siluf(v[0]), siluf(v[1]), siluf(v[2]), siluf(v[3])); }
        } else if (tn < 40) {
            bf16_t* xb = (bf16_t*)(p.ws + WS_XBC) + (size_t)row * 3072 + (tn - 16) * 128;
#pragma unroll
            for (int j = 0; j < 8; ++j) { const f32x4 v = acc[i][j]; st4bf(xb + j * 16 + quad * 4, v[0], v[1], v[2], v[3]); }
        } else {
            float* dt = (float*)(p.ws + WS_DT) + (size_t)row * 64;
            const float* bias = p.ssm_dt_bias + j2 * 64;
#pragma unroll
            for (int j = 0; j < 4; ++j) {
                const int c = j * 16 + quad * 4;
                const f32x4 v = acc[i][j];
                f32x4 o;
                o[0] = softplusf(v[0] + bias[c + 0]); o[1] = softplusf(v[1] + bias[c + 1]);
                o[2] = softplusf(v[2] + bias[c + 2]); o[3] = softplusf(v[3] + bias[c + 3]);
                *(f32x4*)(dt + c) = o;
            }
        }
    }
}

enum { G_MIXIN = 0, G_MIXOUT, G_SSMIN, G_SSMOUT, G_FFNIN, G_FFNOUT };

template <int KIND>
__device__ __forceinline__ void gemm_phase(CParams& p, int layer, bf16_t* smem) {
    const int j2 = layer >> 1;
    constexpr int lda = (KIND == G_SSMOUT) ? 2048 : (KIND == G_FFNOUT) ? FFH : 1024;
    constexpr int K = lda, ldw = K;
    constexpr int N = (KIND == G_MIXIN) ? MIXIN : (KIND == G_SSMIN) ? SSMIN_PAD : (KIND == G_FFNIN) ? 2 * FFH : 1024;
    constexpr size_t aoff = (KIND == G_MIXOUT) ? WS_AS : (KIND == G_SSMOUT) ? WS_YF : (KIND == G_FFNOUT) ? WS_HID : WS_HN;
    constexpr size_t woff = (KIND == G_MIXIN || KIND == G_SSMIN) ? WT_MIXIN : (KIND == G_MIXOUT || KIND == G_SSMOUT) ? WT_MIXOUT : (KIND == G_FFNIN) ? WT_FFNIN : WT_FFNOUT;
    const bf16_t* A = (const bf16_t*)(p.ws + aoff);
    const bf16_t* W = (const bf16_t*)(p.ws + WS_WT + woff);
    constexpr int MI = (KIND == G_MIXIN) ? 2 : 4;
    constexpr int FRAG = 1;
    constexpr int nN = N >> 7, nM = MT / (64 * MI);
    const float* mod = (const float*)(p.ws + WS_MOD) + (size_t)layer * 3 * 6144;
    bf16_t* sW = smem;
    if (N == 1024) {
        const int nlat = (ML / 256) * 8, nctx = layer == 3 ? 0 : (MC / 64) * 8;
        const float* gate = mod + (KIND == G_FFNOUT ? 5 : 2) * 1024;
        for (int t = blockIdx.x; t < nlat + nctx; t += gridDim.x) {
            if (t < nlat) {
                const int u = (gridDim.x == 512) ? ((t & 7) * 64 + (t >> 3)) : t;
                const int tm = u >> 3, tn = u & 7;
                f32x4 acc[4][8];
                gemm_tile<4, lda, ldw, K, FRAG>(A + (size_t)tm * 256 * lda, W + (size_t)tn * 128 * ldw, acc, sW);
                epi_resid<4>(p, tm * 256, tn * 128, acc, gate);
            } else {
                const int u = t - nlat, tm = u >> 3, tn = u & 7;
                f32x4 acc[1][8];
                gemm_tile<1, lda, ldw, K, FRAG>(A + (size_t)(ML + tm * 64) * lda, W + (size_t)tn * 128 * ldw, acc, sW);
                epi_resid<1>(p, ML + tm * 64, tn * 128, acc, gate);
            }
        }
        return;
    }
    constexpr int T = nM * nN, share = (T + 7) / 8, nsc = (nN + 7) / 8;
    const int xcd = blockIdx.x & 7, slot = blockIdx.x >> 3, nslot = gridDim.x >> 3;
    for (int li = slot; li < share; li += nslot) {
        const int u = xcd * share + li;
        if (u >= T) break;
        int sc = u / (nM * 8); if (sc > nsc - 1) sc = nsc - 1;
        const int rem = u - sc * nM * 8, wd = (sc == nsc - 1) ? (nN - 8 * sc) : 8;
        const int tm = rem / wd, tn = sc * 8 + rem - tm * wd;
        f32x4 acc[MI][8];
        gemm_tile<MI, lda, ldw, K, FRAG>(A + (size_t)tm * (64 * MI) * lda, W + (size_t)tn * 128 * ldw, acc, sW);
        if (KIND == G_MIXIN) epi_mixin<MI>(p, j2, tm * (64 * MI), tn, acc);
        else if (KIND == G_SSMIN) epi_ssmin<MI>(p, j2, tm * (64 * MI), tn, acc);
        else if (KIND == G_FFNIN) epi_swiglu<MI>(p, tm * (64 * MI), tn * 128, acc);
    }
}

__device__ __forceinline__ void norm_phase(CParams& p, int layer, int which) {
    const int lane = tid_() & 63, wave = tid_() >> 6, l16 = lane & 15, quad = lane >> 4;
    const float* g = (which ? p.norm2_g : p.norm1_g) + layer * 1024;
    const float* mod = (const float*)(p.ws + WS_MOD) + (size_t)layer * 3 * 6144;
    const float* part = (const float*)(p.ws + WS_PART);
    bf16_t* hn = (bf16_t*)(p.ws + WS_HN);
#pragma unroll 4
    for (int it = blockIdx.x * 4 + wave; it < (MT / 16) * 32; it += gridDim.x * 4) {
        const int tr = it >> 5, kb = it & 31, row = tr * 16 + l16, col = kb * 32 + quad * 8;
        const f32x4 p0 = *(const f32x4*)(part + (size_t)row * 8), p1 = *(const f32x4*)(part + (size_t)row * 8 + 4);
        const float rs = rsqrtf((((p0[0] + p0[1]) + (p0[2] + p0[3])) + ((p1[0] + p1[1]) + (p1[2] + p1[3]))) * (1.f / 1024.f) + EPS);
        const float* m = mod + (size_t)seg_of(row) * 6144 + (which ? 3 * 1024 : 0);
        const float* xr = xrow(p, row) + col;
        const f32x4 v0 = *(const f32x4*)(xr), v1 = *(const f32x4*)(xr + 4);
        const f32x4 g0 = *(const f32x4*)(g + col), g1 = *(const f32x4*)(g + col + 4);
        const f32x4 sh0 = *(const f32x4*)(m + col), sh1 = *(const f32x4*)(m + col + 4);
        const f32x4 sc0 = *(const f32x4*)(m + 1024 + col), sc1 = *(const f32x4*)(m + 1024 + col + 4);
        const f32x4 y0 = (v0 * rs * g0) * (sc0 + 1.f) + sh0, y1 = (v1 * rs * g1) * (sc1 + 1.f) + sh1;
        u32x4 o; o.x = pack2(y0[0], y0[1]); o.y = pack2(y0[2], y0[3]); o.z = pack2(y1[0], y1[1]); o.w = pack2(y1[2], y1[3]);
        *(u32x4*)(hn + (size_t)it * 512 + lane * 8) = o;
    }
}

__device__ __forceinline__ void convert_wt(const float* __restrict__ W, int K, int N, bf16_t* __restrict__ Wt, int mode, float* tile) {
    const int tid = tid_();
    const int nKt = K >> 6, nNt = N >> 6;
    for (int t = blockIdx.x; t < nKt * nNt; t += gridDim.x) {
        const int kt = t / nNt, nt = t - kt * nNt;
        lds_sync();
#pragma unroll
        for (int i = 0; i < 16; ++i) {
            const int kk = (tid >> 6) + i * 4, nn = tid & 63;
            tile[kk * 65 + nn] = W[(size_t)(kt * 64 + kk) * N + nt * 64 + nn];
        }
        lds_sync();
        {
            const int nn = tid >> 2, kq = (tid & 3) * 16;
            const int n = nt * 64 + nn;
            int dr = n;
            if (mode == 1) { const int hm = n < FFH ? n : n - FFH; dr = (hm >> 4) * 32 + (hm & 15) + (n < FFH ? 0 : 16); }
            u32x4 o0, o1;
            o0.x = pack2(tile[(kq + 0) * 65 + nn], tile[(kq + 1) * 65 + nn]); o0.y = pack2(tile[(kq + 2) * 65 + nn], tile[(kq + 3) * 65 + nn]);
            o0.z = pack2(tile[(kq + 4) * 65 + nn], tile[(kq + 5) * 65 + nn]); o0.w = pack2(tile[(kq + 6) * 65 + nn], tile[(kq + 7) * 65 + nn]);
            o1.x = pack2(tile[(kq + 8) * 65 + nn], tile[(kq + 9) * 65 + nn]); o1.y = pack2(tile[(kq + 10) * 65 + nn], tile[(kq + 11) * 65 + nn]);
            o1.z = pack2(tile[(kq + 12) * 65 + nn], tile[(kq + 13) * 65 + nn]); o1.w = pack2(tile[(kq + 14) * 65 + nn], tile[(kq + 15) * 65 + nn]);
            bf16_t* dst = Wt + (size_t)dr * K + kt * 64 + kq;
            *(u32x4*)dst = o0; *(u32x4*)(dst + 8) = o1;
        }
    }
}

__device__ __forceinline__ void convert_layer_weights(CParams& p, int layer, float* tile) {
    unsigned char* wt = p.ws + WS_WT;
    const int j2 = layer >> 1;
    convert_wt(p.ffn_w_in + (size_t)layer * 1024 * 2 * FFH, 1024, 2 * FFH, (bf16_t*)(wt + WT_FFNIN), 1, tile);
    convert_wt(p.ffn_w_out + (size_t)layer * FFH * 1024, FFH, 1024, (bf16_t*)(wt + WT_FFNOUT), 0, tile);
    if ((layer & 1) == 0) {
        convert_wt(p.mix_w_in + (size_t)j2 * 1024 * MIXIN, 1024, MIXIN, (bf16_t*)(wt + WT_MIXIN), 0, tile);
        convert_wt(p.mix_w_out + (size_t)j2 * 1024 * 1024, 1024, 1024, (bf16_t*)(wt + WT_MIXOUT), 0, tile);
    } else {
        convert_wt(p.ssm_w_in + (size_t)j2 * 1024 * SSMIN, 1024, SSMIN, (bf16_t*)(wt + WT_MIXIN), 0, tile);
        convert_wt(p.ssm_w_out + (size_t)j2 * SSI * 1024, SSI, 1024, (bf16_t*)(wt + WT_MIXOUT), 0, tile);
        bf16_t* padp = (bf16_t*)(wt + WT_MIXIN) + (size_t)SSMIN * 1024;
        for (int i = blockIdx.x * 256 + tid_(); i < (SSMIN_PAD - SSMIN) * 1024; i += gridDim.x * 256) padp[i] = 0;
    }
}

__device__ __forceinline__ void prologue(CParams& p, float* smf) {
    const int tid = tid_();
    const size_t gtid = (size_t)blockIdx.x * 256 + tid, gsz = (size_t)gridDim.x * 256;
    {
        const f32x4* s = (const f32x4*)p.x; f32x4* d = (f32x4*)p.out;
        for (size_t i = gtid; i < (size_t)ML * D / 4; i += gsz) d[i] = s[i];
        const f32x4* s2 = (const f32x4*)p.ctx; f32x4* d2 = (f32x4*)(p.ws + WS_XCTX);
        for (size_t i = gtid; i < (size_t)MC * D / 4; i += gsz) d2[i] = s2[i];
    }
    {
        float* part = (float*)(p.ws + WS_PART);
        const int lane = tid & 63, wv = tid >> 6;
        for (int row = blockIdx.x * 4 + wv; row < MT; row += gridDim.x * 4) {
            const float* xr = row < ML ? p.x + (size_t)row * D : p.ctx + (size_t)(row - ML) * D;
            float ss = 0.f;
#pragma unroll
            for (int i = 0; i < 4; ++i) { const f32x4 v = *(const f32x4*)(xr + i * 256 + lane * 4); ss += v[0] * v[0] + v[1] * v[1] + v[2] * v[2] + v[3] * v[3]; }
#pragma unroll
            for (int o = 1; o < 64; o <<= 1) ss += __shfl_xor(ss, o);
            if (lane < 8) part[(size_t)row * 8 + lane] = lane == 0 ? ss : 0.f;
        }
    }
    {
        float* cosT = (float*)(p.ws + WS_ROPE); float* sinT = cosT + 8192 * 32;
        for (size_t i = gtid; i < (size_t)8192 * 32; i += gsz) {
            const int s = (int)(i >> 5), j = (int)(i & 31), f = j & 15;
            const float inv = powf(10000.f, -(float)f / 16.f);
            const float pos = (float)(j < 16 ? (s >> 6) : (s & 63));
            const float ang = pos * inv;
            cosT[i] = cosf(ang); sinT[i] = sinf(ang);
        }
    }
    {
        bf16_t* sgw = (bf16_t*)(p.ws + WS_SGW);
        for (size_t i = gtid; i < (size_t)2 * 4 * 128 * 128; i += gsz) sgw[i] = f2bf(p.sgu_w[i]);
    }
    {
        float* sc = smf;
        float* red = smf + 3 * 1024;
        lds_sync();
        for (int i = tid; i < 3 * 1024; i += 256) {
            const int sgi = i >> 10, k = i & 1023;
            const float v = sgi < 2 ? p.c[sgi * 1024 + k] : p.c_ctx[k];
            sc[i] = siluf(v);
        }
        lds_sync();
        float* mod = (float*)(p.ws + WS_MOD);
        const int cl = tid & 63, kg = tid >> 6;
        for (int wi = blockIdx.x; wi < 4 * 96; wi += gridDim.x) {
            const int layer = wi / 96, cb = wi - layer * 96;
            const float* w = p.ada_w + (size_t)layer * 1024 * 6144 + cb * 64 + cl;
            float s0 = 0.f, s1 = 0.f, s2 = 0.f;
            for (int k = kg * 256; k < kg * 256 + 256; ++k) {
                const float wv = w[(size_t)k * 6144];
                s0 += sc[k] * wv; s1 += sc[1024 + k] * wv; s2 += sc[2048 + k] * wv;
            }
            lds_sync();
            red[(kg * 3 + 0) * 64 + cl] = s0; red[(kg * 3 + 1) * 64 + cl] = s1; red[(kg * 3 + 2) * 64 + cl] = s2;
            lds_sync();
            if (tid < 192) {
                const int sgi = tid >> 6;
                const float v = red[(0 * 3 + sgi) * 64 + cl] + red[(1 * 3 + sgi) * 64 + cl] + red[(2 * 3 + sgi) * 64 + cl] + red[(3 * 3 + sgi) * 64 + cl];
                const int n = cb * 64 + cl;
                mod[((size_t)layer * 3 + sgi) * 6144 + n] = v + p.ada_b[layer * 6144 + n];
            }
        }
        lds_sync();
    }
    convert_layer_weights(p, 0, smf);
}

__device__ __forceinline__ void attn_item(CParams& p, int j2, int b, int h, int q0row, int nkeys, bf16_t* smem) {
    const int tid = tid_(), lane = tid & 63, wave = tid >> 6, l16 = lane & 15, quad = lane >> 4;
    const int kh = h >> 2;
    const bf16_t* Q = (const bf16_t*)(p.ws + WS_Q);
    const bf16_t* Kb = (const bf16_t*)(p.ws + WS_K) + (size_t)b * TALL * 128 + kh * 64;
    const bf16_t* Vb = (const bf16_t*)(p.ws + WS_VT) + (size_t)(b * 2 + kh) * 64 * TALL;
    bf16_t* sK = smem; bf16_t* sV = smem + 64 * GST;
    constexpr float LOG2E = 1.4426950408889634f;
    float mb;
    {
        float gq = fabsf(p.q_norm_g[j2 * 64 + lane]), gk = fabsf(p.k_norm_g[j2 * 64 + lane]);
#pragma unroll
        for (int o = 1; o < 64; o <<= 1) { gq = fmaxf(gq, __shfl_xor(gq, o)); gk = fmaxf(gk, __shfl_xor(gk, o)); }
        mb = 8.f * 1.02f * gq * gk * LOG2E;
    }
    bf16x8 qf[4][2];
#pragma unroll
    for (int i = 0; i < 4; ++i)
#pragma unroll
        for (int ks = 0; ks < 2; ++ks)
            qf[i][ks] = *(const bf16x8*)(Q + (size_t)(q0row + wave * 64 + i * 16 + l16) * 512 + h * 64 + ks * 32 + quad * 8);
    f32x4 o[5][4];
#pragma unroll
    for (int d = 0; d < 5; ++d)
#pragma unroll
        for (int i = 0; i < 4; ++i) o[d][i] = (f32x4){0.f, 0.f, 0.f, 0.f};
    lds_sync();
    {
        const int r = 64 + (tid >> 4);
        u32x2 one; one.x = r == 64 ? 0x3F803F80u : 0u; one.y = one.x;
        *(u32x2*)(sV + r * GST + (tid & 15) * 4) = one;
    }
    const int srow = tid >> 3, skc = (tid & 7) * 8;
    u32x4 rk[2], rv[2];
#pragma unroll
    for (int i = 0; i < 2; ++i) {
        rk[i] = *(const u32x4*)(Kb + (size_t)(srow + i * 32) * 128 + skc);
        rv[i] = *(const u32x4*)(Vb + (size_t)(srow + i * 32) * TALL + skc);
    }
    const int nt = nkeys >> 6;
#pragma unroll 1
    for (int kt = 0; kt < nt; ++kt) {
        lds_sync();
#pragma unroll
        for (int i = 0; i < 2; ++i) {
            *(u32x4*)(sK + (srow + i * 32) * GST + skc) = rk[i];
            *(u32x4*)(sV + (srow + i * 32) * GST + skc) = rv[i];
        }
        lds_sync();
        {
            const int t0 = (kt + 1 < nt ? kt + 1 : kt) << 6;
#pragma unroll
            for (int i = 0; i < 2; ++i) {
                rk[i] = *(const u32x4*)(Kb + (size_t)(t0 + srow + i * 32) * 128 + skc);
                rv[i] = *(const u32x4*)(Vb + (size_t)(srow + i * 32) * TALL + t0 + skc);
            }
        }
        bf16x8 pf[2][4];
#pragma unroll
        for (int ih = 0; ih < 2; ++ih) {
            f32x4 s[4][2];
#pragma unroll
            for (int tt = 0; tt < 4; ++tt)
#pragma unroll
                for (int i = 0; i < 2; ++i) s[tt][i] = (f32x4){-mb, -mb, -mb, -mb};
#pragma unroll
            for (int ks = 0; ks < 2; ++ks)
#pragma unroll
                for (int tt = 0; tt < 4; ++tt) {
                    const bf16x8 kf = lds16(sK + (tt * 16 + l16) * GST + ks * 32 + quad * 8);
#pragma unroll
                    for (int i = 0; i < 2; ++i) s[tt][i] = mfma16(kf, qf[ih * 2 + i][ks], s[tt][i]);
                }
#pragma unroll
            for (int i = 0; i < 2; ++i) {
#pragma unroll
                for (int tt = 0; tt < 4; ++tt) {
#pragma unroll
                    for (int r = 0; r < 4; ++r) s[tt][i][r] = __builtin_amdgcn_exp2f(s[tt][i][r]);
                }
#pragma unroll
                for (int ksp = 0; ksp < 2; ++ksp) pf[ksp][ih * 2 + i] = pack8(s[2 * ksp][i], s[2 * ksp + 1][i]);
            }
        }
#pragma unroll
        for (int ksp = 0; ksp < 2; ++ksp)
#pragma unroll
            for (int d = 0; d < 5; ++d) {
                const bf16_t* vp = sV + (d * 16 + l16) * GST + ksp * 32 + quad * 4;
                const bf16x8 vf = lds8x2(vp, vp + 16);
#pragma unroll
                for (int i = 0; i < 4; ++i) o[d][i] = mfma16(vf, pf[ksp][i], o[d][i]);
            }
    }
    bf16_t* as = (bf16_t*)(p.ws + WS_AS);
#pragma unroll
    for (int i = 0; i < 4; ++i) {
        const float l = __shfl(o[4][i][0], l16);
        const float inv = 1.f / l;
        const int row = q0row + wave * 64 + i * 16 + l16;
#pragma unroll
        for (int d = 0; d < 4; ++d)
            st4bf(as + frag_off(row, h * 64 + d * 16 + quad * 4, 1024), o[d][i][0] * inv, o[d][i][1] * inv, o[d][i][2] * inv, o[d][i][3] * inv);
    }
}

__device__ __forceinline__ void sg_item(CParams& p, int j2, int chunk, int g, bf16_t* smem) {
    const int lane = tid_() & 63, wave = tid_() >> 6, l16 = lane & 15, quad = lane >> 4;
    const bf16_t* A = (const bf16_t*)(p.ws + WS_SGW) + (size_t)(j2 * 4 + g) * 128 * 128;
    const bf16_t* W = (const bf16_t*)(p.ws + WS_GVT) + ((size_t)chunk * 512 + g * 128) * 128;
    f32x4 acc[2][8];
    gemm_tile<2, 128, 128, 128>(A, W, acc, smem);
    const bf16_t* u = (const bf16_t*)(p.ws + WS_U);
    bf16_t* as = (bf16_t*)(p.ws + WS_AS);
    const float* bs = p.sgu_b + (size_t)(j2 * 4 + g) * 128;
#pragma unroll
    for (int i = 0; i < 2; ++i) {
        const int pt = wave * 32 + i * 16 + l16;
        const int row = chunk * 128 + pt;
        const float bias = bs[pt];
#pragma unroll
        for (int j = 0; j < 8; ++j) {
            const int c = g * 128 + j * 16 + quad * 4;
            const u32x2 uw = *(const u32x2*)(u + (size_t)row * 512 + c);
            const float u0 = __uint_as_float(uw.x << 16), u1 = __uint_as_float(uw.x & 0xffff0000u);
            const float u2 = __uint_as_float(uw.y << 16), u3 = __uint_as_float(uw.y & 0xffff0000u);
            const f32x4 v = acc[i][j];
            st4bf(as + frag_off(row, 512 + c, 1024), u0 * (v[0] + bias), u1 * (v[1] + bias), u2 * (v[2] + bias), u3 * (v[3] + bias));
        }
    }
}

__device__ __forceinline__ void attn_sg_phase(CParams& p, int layer, bf16_t* smem) {
    const int j2 = layer >> 1;
    const int nA = NB * 8 * 32, nS = (MT / 128) * 4, nC = NB * 8;
    for (int t = blockIdx.x; t < nA + nS + nC; t += gridDim.x) {
        if (t < nA) {
            const int xcd = t & 7, li = t >> 3;
            const int bh = xcd * 2 + (li >> 5), qb = li & 31;
            attn_item(p, j2, bh >> 3, bh & 7, (bh >> 3) * SEQ + qb * 256, TALL, smem);
        } else if (t < nA + nS) {
            const int u = t - nA;
            sg_item(p, j2, u >> 2, u & 3, smem);
        } else {
            const int u = t - nA - nS;
            const int h = u & 7, b = u >> 3;
            attn_item(p, j2, b, h, ML + b * CTX, CTX, smem);
        }
    }
}

__device__ __forceinline__ void conv_phase(CParams& p, int layer, float* smf) {
    const int j2 = layer >> 1, tid = tid_();
    const bf16_t* xbc = (const bf16_t*)(p.ws + WS_XBC);
    bf16_t* XT = (bf16_t*)(p.ws + WS_XT); bf16_t* Bn = (bf16_t*)(p.ws + WS_BN); bf16_t* Cn = (bf16_t*)(p.ws + WS_CN); bf16_t* BT = (bf16_t*)(p.ws + WS_BT);
    const float* cw = p.ssm_conv_w + (size_t)j2 * 3 * 3072;
    const float* cb = p.ssm_conv_b + (size_t)j2 * 3072;
    float* sin_ = smf;
    float* sout = smf + 66 * 65;
    const int nCt = 3072 / 64, nRt = MT / 64;
    for (int t = blockIdx.x; t < nCt * nRt; t += gridDim.x) {
        const int rt = t / nCt, ct = t - rt * nCt;
        const int r0 = rt * 64, c0 = ct * 64;
        const bool first = r0 < ML ? ((r0 & (SEQ - 1)) == 0) : (((r0 - ML) & (CTX - 1)) == 0);
        const bool last = r0 < ML ? (((r0 + 64) & (SEQ - 1)) == 0) : ((((r0 + 64) - ML) & (CTX - 1)) == 0);
        lds_sync();
        for (int e = tid; e < 66 * 8; e += 256) {
            const int rr = e >> 3, c8 = (e & 7) * 8;
            const int row = r0 - 1 + rr;
            u32x4 v = (u32x4){0u, 0u, 0u, 0u};
            if (!((rr == 0 && first) || (rr == 65 && last))) v = *(const u32x4*)(xbc + (size_t)row * 3072 + c0 + c8);
            float* d = sin_ + rr * 65 + c8;
            d[0] = __uint_as_float(v.x << 16); d[1] = __uint_as_float(v.x & 0xffff0000u);
            d[2] = __uint_as_float(v.y << 16); d[3] = __uint_as_float(v.y & 0xffff0000u);
            d[4] = __uint_as_float(v.z << 16); d[5] = __uint_as_float(v.z & 0xffff0000u);
            d[6] = __uint_as_float(v.w << 16); d[7] = __uint_as_float(v.w & 0xffff0000u);
        }
        lds_sync();
        {
            const int c = tid & 63;
            const float w0 = cw[c0 + c], w1 = cw[3072 + c0 + c], w2 = cw[2 * 3072 + c0 + c], bb = cb[c0 + c];
#pragma unroll
            for (int k = 0; k < 16; ++k) {
                const int tt = (tid >> 6) + k * 4;
                const float v = w0 * sin_[tt * 65 + c] + w1 * sin_[(tt + 1) * 65 + c] + w2 * sin_[(tt + 2) * 65 + c] + bb;
                sout[c * 65 + tt] = siluf(v);
            }
        }
        lds_sync();
        const int q = tid >> 2, e16 = (tid & 3) * 16;
        if (c0 >= 2048) {
            u32x4 o0, o1;
            o0.x = pack2(sout[(e16 + 0) * 65 + q], sout[(e16 + 1) * 65 + q]); o0.y = pack2(sout[(e16 + 2) * 65 + q], sout[(e16 + 3) * 65 + q]);
            o0.z = pack2(sout[(e16 + 4) * 65 + q], sout[(e16 + 5) * 65 + q]); o0.w = pack2(sout[(e16 + 6) * 65 + q], sout[(e16 + 7) * 65 + q]);
            o1.x = pack2(sout[(e16 + 8) * 65 + q], sout[(e16 + 9) * 65 + q]); o1.y = pack2(sout[(e16 + 10) * 65 + q], sout[(e16 + 11) * 65 + q]);
            o1.z = pack2(sout[(e16 + 12) * 65 + q], sout[(e16 + 13) * 65 + q]); o1.w = pack2(sout[(e16 + 14) * 65 + q], sout[(e16 + 15) * 65 + q]);
            if (c0 < 2560) {
                bf16_t* dst = Bn + (c0 - 2048) + (size_t)(r0 + q) * 512 + e16;
                *(u32x4*)dst = o0; *(u32x4*)(dst + 8) = o1;
            } else {
                *(u32x4*)(Cn + frag_off(r0 + q, c0 - 2560 + e16, 512)) = o0;
                *(u32x4*)(Cn + frag_off(r0 + q, c0 - 2560 + e16 + 8, 512)) = o1;
            }
        }
        if (c0 < 2560) {
            const float* sp = sout + q * 65 + e16;
            u32x4 o0, o1;
            o0.x = pack2(sp[0], sp[1]); o0.y = pack2(sp[2], sp[3]); o0.z = pack2(sp[4], sp[5]); o0.w = pack2(sp[6], sp[7]);
            o1.x = pack2(sp[8], sp[9]); o1.y = pack2(sp[10], sp[11]); o1.z = pack2(sp[12], sp[13]); o1.w = pack2(sp[14], sp[15]);
            if (c0 < 2048) {
                bf16_t* dst = XT + (size_t)(c0 + q) * MT + r0 + e16;
                *(u32x4*)dst = o0; *(u32x4*)(dst + 8) = o1;
            } else {
                *(u32x4*)(BT + frag_off(c0 - 2048 + q, r0 + e16, MT)) = o0;
                *(u32x4*)(BT + frag_off(c0 - 2048 + q, r0 + e16 + 8, MT)) = o1;
            }
        }
    }
}

__device__ __forceinline__ void ssd_diag_item(CParams& p, int j2, int row0, int h, bf16_t* smem) {
    const int tid = tid_(), lane = tid & 63, wave = tid >> 6, l16 = lane & 15, quad = lane >> 4;
    const int g = h >> 3;
    bf16_t* sB = smem;
    bf16_t* sX = sB + 128 * SST;
    float* sda = (float*)(sX + 64 * SST);
    float* sPf = sda + 256;
    float* sRb = sPf + 128;
    float* sdtf = sRb + 128;
    float* sdtb = sdtf + 128;
    const bf16_t* XT = (const bf16_t*)(p.ws + WS_XT) + (size_t)(h * 64) * MT;
    const bf16_t* Bn = (const bf16_t*)(p.ws + WS_BN) + g * 128;
    const bf16_t* Cn = (const bf16_t*)(p.ws + WS_CN) + (size_t)(g * 4) * 512;
    const float* DT = (const float*)(p.ws + WS_DT);
    bf16_t* Y = (bf16_t*)(p.ws + WS_YF);
    const float af = -expf(p.ssm_a_log[(j2 * 2 + 0) * 32 + h]);
    const float ab = -expf(p.ssm_a_log[(j2 * 2 + 1) * 32 + h]);
    const float dsk = p.ssm_d[j2 * 32 + h];
    lds_sync();
#pragma unroll
    for (int i = 0; i < 8; ++i) {
        const int c = tid + i * 256, r = c >> 4, kc = (c & 15) * 8;
        *(u32x4*)(sB + r * SST + kc) = *(const u32x4*)(Bn + (size_t)(row0 + r) * 512 + kc);
    }
#pragma unroll
    for (int i = 0; i < 4; ++i) {
        const int c = tid + i * 256, r = c >> 4, kc = (c & 15) * 8;
        *(u32x4*)(sX + r * SST + kc) = *(const u32x4*)(XT + (size_t)r * MT + row0 + kc);
    }
    {
        const int d = wave >> 1;
        const float d0 = DT[(size_t)(row0 + lane) * 64 + d * 32 + h], d1 = DT[(size_t)(row0 + 64 + lane) * 64 + d * 32 + h];
        const float aa = d ? ab : af;
        const f32x2 sc2 = scan128(d0 * aa, d1 * aa, lane, d);
        float* sc = d ? sRb : sPf; float* sd = d ? sdtb : sdtf;
        if ((wave & 1) == 0) { sc[lane] = sc2.x; sd[lane] = d0; } else { sc[64 + lane] = sc2.y; sd[64 + lane] = d1; }
    }
    bf16x8 cf[2][4];
#pragma unroll
    for (int i = 0; i < 2; ++i)
#pragma unroll
        for (int ks = 0; ks < 4; ++ks)
            cf[i][ks] = *(const bf16x8*)(Cn + ((size_t)((row0 >> 4) + wave * 2 + i) * 16 + ks) * 512 + lane * 8);
    lds_sync();
    float pfl[2], rbl[2];
#pragma unroll
    for (int i = 0; i < 2; ++i) { pfl[i] = sPf[wave * 32 + i * 16 + l16]; rbl[i] = sRb[wave * 32 + i * 16 + l16]; }
    f32x4 y[4][2];
#pragma unroll
    for (int pt = 0; pt < 4; ++pt)
#pragma unroll
        for (int i = 0; i < 2; ++i) y[pt][i] = (f32x4){0.f, 0.f, 0.f, 0.f};
#pragma unroll 1
    for (int sp = 0; sp < 4; ++sp) {
        f32x4 gt[2][2];
#pragma unroll
        for (int s2 = 0; s2 < 2; ++s2)
#pragma unroll
            for (int i = 0; i < 2; ++i) gt[s2][i] = (f32x4){0.f, 0.f, 0.f, 0.f};
#pragma unroll
        for (int ks = 0; ks < 4; ++ks)
#pragma unroll
            for (int s2 = 0; s2 < 2; ++s2) {
                const bf16x8 bfr = lds16(sB + (sp * 32 + s2 * 16 + l16) * SST + ks * 32 + quad * 8);
#pragma unroll
                for (int i = 0; i < 2; ++i) gt[s2][i] = mfma16(bfr, cf[i][ks], gt[s2][i]);
            }
        bf16x8 mf[2];
#pragma unroll
        for (int i = 0; i < 2; ++i) {
            const int l = wave * 32 + i * 16 + l16;
#pragma unroll
            for (int s2 = 0; s2 < 2; ++s2)
#pragma unroll
                for (int r = 0; r < 4; ++r) {
                    const int s = sp * 32 + s2 * 16 + quad * 4 + r;
                    const float arg = s < l ? (pfl[i] - sPf[s]) : (rbl[i] - sRb[s]);
                    float coef = __expf(fminf(arg, 0.f)) * (s < l ? sdtf[s] : sdtb[s]);
                    if (s == l) coef = sdtf[s] + sdtb[s];
                    gt[s2][i][r] *= coef;
                }
            mf[i] = pack8(gt[0][i], gt[1][i]);
        }
#pragma unroll
        for (int pt = 0; pt < 4; ++pt) {
            const bf16_t* xp = sX + (pt * 16 + l16) * SST + sp * 32 + quad * 4;
            const bf16x8 xf = lds8x2(xp, xp + 16);
#pragma unroll
            for (int i = 0; i < 2; ++i) y[pt][i] = mfma16(xf, mf[i], y[pt][i]);
        }
    }
#pragma unroll
    for (int i = 0; i < 2; ++i) {
        const int l = wave * 32 + i * 16 + l16;
#pragma unroll
        for (int pt = 0; pt < 4; ++pt) {
            f32x4 v = y[pt][i];
#pragma unroll
            for (int r = 0; r < 4; ++r) v[r] += dsk * bf2f(sX[(pt * 16 + quad * 4 + r) * SST + l]);
            st4bf(Y + frag_off(row0 + l, h * 64 + pt * 16 + quad * 4, 2048), v[0], v[1], v[2], v[3]);
        }
    }
}

__device__ __forceinline__ void ssd_diag_phase(CParams& p, int layer, bf16_t* smem) {
    const int j2 = layer >> 1;
    for (int t = blockIdx.x; t < (MT / 128) * 32; t += gridDim.x) {
        const int h = t & 31, chunk = t >> 5;
        ssd_diag_item(p, j2, chunk * 128, h, smem);
    }
}

struct SsdPre { u32x4 xq; u32x4 bt[2][4]; u32x4 cf[2][4]; u32x2 yold[2]; float dt0, dt1; };

__device__ __forceinline__ int ssd_row0(int b, int dir, int cc) {
    if (cc < 2) { const int ci = dir ? 1 - cc : cc; return ML + b * CTX + ci * 128; }
    const int k = cc - 2; const int ci = dir ? 63 - k : k; return b * SEQ + ci * 128;
}

__device__ __forceinline__ void ssd_scan_item(CParams& p, int j2, int b, int dir, int h, int pq, bf16_t* smem) {
    const int tid = tid_(), lane = tid & 63, wave = tid >> 6, l16 = lane & 15, quad = lane >> 4;
    const int g = h >> 3;
    bf16_t* sX = smem;
    bf16_t* sH = sX + 16 * SST;
    float* seacs = (float*)(sH + 16 * SST);
    float* sw = seacs + 128;
    float* sdec = sw + 128;
    const bf16_t* XT = (const bf16_t*)(p.ws + WS_XT) + (size_t)(h * 64 + pq * 16 + (tid >> 4)) * MT + (tid & 15) * 8;
    const bf16_t* Cn = (const bf16_t*)(p.ws + WS_CN) + ((size_t)(wave * 2) * 16 + g * 4) * 512 + lane * 8;
    const bf16_t* BT = (const bf16_t*)(p.ws + WS_BT) + (size_t)(g * 8 + wave * 2) * (MT / 32) * 512 + lane * 8;
    const float* DT = (const float*)(p.ws + WS_DT) + dir * 32 + h;
    bf16_t* Y = (bf16_t*)(p.ws + (dir ? WS_YB : WS_YF)) + frag_off(wave * 32 + l16, h * 64 + pq * 16 + quad * 4, 2048);
    const float a = -expf(p.ssm_a_log[(j2 * 2 + dir) * 32 + h]);
    f32x4 st[2];
    st[0] = (f32x4){0.f, 0.f, 0.f, 0.f}; st[1] = (f32x4){0.f, 0.f, 0.f, 0.f};
    SsdPre S0, S1;
    auto load_small = [&](SsdPre& S, int r) __attribute__((always_inline)) {
        S.xq = *(const u32x4*)(XT + r);
        S.dt0 = DT[(size_t)(r + lane) * 64]; S.dt1 = DT[(size_t)(r + 64 + lane) * 64];
    };
    auto load_cf = [&](SsdPre& S, int r) __attribute__((always_inline)) {
#pragma unroll
        for (int i = 0; i < 2; ++i)
#pragma unroll
            for (int ks = 0; ks < 4; ++ks) S.cf[i][ks] = *(const u32x4*)(Cn + ((size_t)((r >> 4) + i) * 16 + ks) * 512);
    };
    auto load_yold = [&](SsdPre& S, int r) __attribute__((always_inline)) {
#pragma unroll
        for (int i = 0; i < 2; ++i) S.yold[i] = dir == 0 ? *(const u32x2*)(Y + (size_t)((r >> 4) + i) * (64 * 512)) : (u32x2){0u, 0u};
    };
    auto load_bt = [&](SsdPre& S, int r) __attribute__((always_inline)) {
#pragma unroll
        for (int nt = 0; nt < 2; ++nt)
#pragma unroll
            for (int ks = 0; ks < 4; ++ks) S.bt[nt][ks] = *(const u32x4*)(BT + ((size_t)nt * (MT / 32) + (r >> 5) + ks) * 512);
    };
    {
        const int r0 = ssd_row0(b, dir, 0), r1 = ssd_row0(b, dir, 1);
        load_small(S0, r0); load_cf(S0, r0); load_yold(S0, r0); load_bt(S0, r0);
        load_small(S1, r1); load_cf(S1, r1); load_yold(S1, r1); load_bt(S1, r1);
    }
    auto body = [&](SsdPre& S, int cc) __attribute__((always_inline)) {
        const int row0 = ssd_row0(b, dir, cc);
        const int row2 = ssd_row0(b, dir, cc + 2 < 66 ? cc + 2 : 65);
        lds_sync();
        *(u32x4*)(sX + (tid >> 4) * SST + (tid & 15) * 8) = S.xq;
#pragma unroll
        for (int nt = 0; nt < 2; ++nt) st4bf(sH + l16 * SST + wave * 32 + nt * 16 + quad * 4, st[nt][0], st[nt][1], st[nt][2], st[nt][3]);
        if (wave < 2) {
            const f32x2 sc2 = scan128(S.dt0 * a, S.dt1 * a, lane, dir);
            const float total = dir == 0 ? __shfl(sc2.y, 63) : __shfl(sc2.x, 0);
            if (wave == 0) { seacs[lane] = __expf(sc2.x); sw[lane] = S.dt0 * __expf(total - sc2.x); if (lane == 0) sdec[0] = __expf(total); }
            else { seacs[64 + lane] = __expf(sc2.y); sw[64 + lane] = S.dt1 * __expf(total - sc2.y); }
        }
        lds_sync();
        load_small(S, row2);
        f32x4 yo[2];
        yo[0] = (f32x4){0.f, 0.f, 0.f, 0.f}; yo[1] = (f32x4){0.f, 0.f, 0.f, 0.f};
#pragma unroll
        for (int ks = 0; ks < 4; ++ks) {
            const bf16x8 hf = lds16(sH + l16 * SST + ks * 32 + quad * 8);
#pragma unroll
            for (int i = 0; i < 2; ++i) yo[i] = mfma16(hf, __builtin_bit_cast(bf16x8, S.cf[i][ks]), yo[i]);
        }
        __builtin_amdgcn_sched_barrier(0);
        load_cf(S, row2);
#pragma unroll
        for (int i = 0; i < 2; ++i) {
            const float e = seacs[wave * 32 + i * 16 + l16];
            const float o0 = __uint_as_float(S.yold[i].x << 16), o1 = __uint_as_float(S.yold[i].x & 0xffff0000u);
            const float o2 = __uint_as_float(S.yold[i].y << 16), o3 = __uint_as_float(S.yold[i].y & 0xffff0000u);
            st4bf(Y + (size_t)((row0 >> 4) + i) * (64 * 512), yo[i][0] * e + o0, yo[i][1] * e + o1, yo[i][2] * e + o2, yo[i][3] * e + o3);
        }
        __builtin_amdgcn_sched_barrier(0);
        load_yold(S, row2);
        {
            const float dec = sdec[0];
            st[0] *= dec; st[1] *= dec;
#pragma unroll
            for (int ks = 0; ks < 4; ++ks) {
                const f32x4 w0 = *(const f32x4*)(sw + ks * 32 + quad * 8), w1 = *(const f32x4*)(sw + ks * 32 + quad * 8 + 4);
                const u32x4 raw = *(const u32x4*)(sX + l16 * SST + ks * 32 + quad * 8);
                u32x4 xs;
                xs.x = pack2(__uint_as_float(raw.x << 16) * w0[0], __uint_as_float(raw.x & 0xffff0000u) * w0[1]);
                xs.y = pack2(__uint_as_float(raw.y << 16) * w0[2], __uint_as_float(raw.y & 0xffff0000u) * w0[3]);
                xs.z = pack2(__uint_as_float(raw.z << 16) * w1[0], __uint_as_float(raw.z & 0xffff0000u) * w1[1]);
                xs.w = pack2(__uint_as_float(raw.w << 16) * w1[2], __uint_as_float(raw.w & 0xffff0000u) * w1[3]);
                const bf16x8 xbf = __builtin_bit_cast(bf16x8, xs);
#pragma unroll
                for (int nt = 0; nt < 2; ++nt) st[nt] = mfma16(__builtin_bit_cast(bf16x8, S.bt[nt][ks]), xbf, st[nt]);
            }
        }
        __builtin_amdgcn_sched_barrier(0);
        load_bt(S, row2);
    };
#pragma unroll 1
    for (int cc = 0; cc < 66; cc += 2) {
        body(S0, cc);
        body(S1, cc + 1);
    }
}

__device__ __forceinline__ void ssd_scan_phase(CParams& p, int layer, bf16_t* smem) {
    const int j2 = layer >> 1;
    for (int t = blockIdx.x; t < NB * 2 * 32 * 4; t += gridDim.x) {
        const int xcd = t & 7, li = t >> 3, gi = xcd * 2 + (li >> 5);
        const int pq = li & 3, h = (gi & 3) * 8 + ((li & 31) >> 2), dir = (gi >> 2) & 1, b = gi >> 3;
        ssd_scan_item(p, j2, b, dir, h, pq, smem);
    }
}

__device__ __forceinline__ void finish_phase(CParams& p, int layer) {
    const int j2 = layer >> 1, lane = tid_() & 63, wave = tid_() >> 6, quad = lane >> 4;
    bf16_t* yf = (bf16_t*)(p.ws + WS_YF); const bf16_t* yb = (const bf16_t*)(p.ws + WS_YB); const bf16_t* z = (const bf16_t*)(p.ws + WS_Z);
    const float* gn = p.ssm_norm_g + (size_t)j2 * 2048;
    for (int tr = blockIdx.x * 4 + wave; tr < MT / 16; tr += gridDim.x * 4) {
        const size_t base = (size_t)tr * 64 * 512 + lane * 8;
#pragma unroll 1
        for (int g = 0; g < 4; ++g) {
            float ss = 0.f;
#pragma unroll 4
            for (int kk = 0; kk < 16; ++kk) {
                const size_t off = base + (size_t)(g * 16 + kk) * 512;
                const u32x4 a = *(const u32x4*)(yf + off), bq = *(const u32x4*)(yb + off), zq = *(const u32x4*)(z + off);
                const unsigned aw[4] = {a.x, a.y, a.z, a.w}, bw[4] = {bq.x, bq.y, bq.z, bq.w}, zw[4] = {zq.x, zq.y, zq.z, zq.w};
#pragma unroll
                for (int k = 0; k < 4; ++k) {
                    const float v0 = (__uint_as_float(aw[k] << 16) + __uint_as_float(bw[k] << 16)) * __uint_as_float(zw[k] << 16);
                    const float v1 = (__uint_as_float(aw[k] & 0xffff0000u) + __uint_as_float(bw[k] & 0xffff0000u)) * __uint_as_float(zw[k] & 0xffff0000u);
                    ss += v0 * v0 + v1 * v1;
                }
            }
            ss += __shfl_xor(ss, 16); ss += __shfl_xor(ss, 32);
            const float rstd = rsqrtf(ss * (1.f / 512.f) + EPS);
#pragma unroll 4
            for (int kk = 0; kk < 16; ++kk) {
                const size_t off = base + (size_t)(g * 16 + kk) * 512;
                const u32x4 a = *(const u32x4*)(yf + off), bq = *(const u32x4*)(yb + off), zq = *(const u32x4*)(z + off);
                const unsigned aw[4] = {a.x, a.y, a.z, a.w}, bw[4] = {bq.x, bq.y, bq.z, bq.w}, zw[4] = {zq.x, zq.y, zq.z, zq.w};
                const int col = (g * 16 + kk) * 32 + quad * 8;
                const f32x4 g0 = *(const f32x4*)(gn + col), g1 = *(const f32x4*)(gn + col + 4);
                const float gg[8] = {g0[0], g0[1], g0[2], g0[3], g1[0], g1[1], g1[2], g1[3]};
                unsigned ow[4];
#pragma unroll
                for (int k = 0; k < 4; ++k) {
                    const float v0 = (__uint_as_float(aw[k] << 16) + __uint_as_float(bw[k] << 16)) * __uint_as_float(zw[k] << 16);
                    const float v1 = (__uint_as_float(aw[k] & 0xffff0000u) + __uint_as_float(bw[k] & 0xffff0000u)) * __uint_as_float(zw[k] & 0xffff0000u);
                    ow[k] = pack2(v0 * rstd * gg[2 * k], v1 * rstd * gg[2 * k + 1]);
                }
                u32x4 o4; o4.x = ow[0]; o4.y = ow[1]; o4.z = ow[2]; o4.w = ow[3];
                *(u32x4*)(yf + off) = o4;
            }
        }
    }
}

__global__ void __launch_bounds__(256, 2) hybrid_fwd(Params p) {
    extern __shared__ __attribute__((aligned(16))) unsigned char lds[];
    cg::grid_group grid = cg::this_grid();
    bf16_t* smem = (bf16_t*)lds; float* smf = (float*)lds;
    volatile LAS unsigned* bst = (volatile LAS unsigned*)(lds + LDS_BYTES - 16);
    if (threadIdx.x == 0) { bst[0] = 0u; bst[1] = 0u; }
    __syncthreads();
    const XcdBarrier xb = xcd_barrier_post((unsigned*)(p.ws + WS_BAR), bst);
    enum { C_NORM1 = 0, C_MIXIN, C_ATTN, C_MIXOUT, C_NORM2, C_FFNIN, C_FFNOUT, C_SSMIN, C_CONV, C_SSD, C_FINISH, C_SSMOUT, C_PRO, C_SSDB };
    const unsigned long long evc = 0x6543210ull;
    const unsigned long long odc = 0x654BAD9870ull;
    for (int ph = 0; ph < 35; ++ph) {
        int code, layer;
        if (ph == 0) { code = C_PRO; layer = 0; }
        else {
            const int q = ph - 1, pair = q / 17, r = q - pair * 17;
            if (r < 7) { layer = 2 * pair; code = (int)((evc >> (4 * r)) & 15); }
            else { layer = 2 * pair + 1; code = (int)((odc >> (4 * (r - 7))) & 15); }
        }
        CParams* kp = (CParams*)__builtin_amdgcn_kernarg_segment_ptr();
        asm volatile("" : "+s"(kp));
        CParams& q = *kp;
#define PHASE(c) asm volatile("" : "+s"(code)); if (code == (c))
        PHASE(C_PRO) prologue(q, smf);
        PHASE(C_NORM1) { if (layer > 0) convert_layer_weights(q, layer, smf); norm_phase(q, layer, 0); }
        PHASE(C_NORM2) norm_phase(q, layer, 1);
        PHASE(C_MIXIN) gemm_phase<G_MIXIN>(q, layer, smem);
        PHASE(C_ATTN) attn_sg_phase(q, layer, smem);
        PHASE(C_MIXOUT) gemm_phase<G_MIXOUT>(q, layer, smem);
        PHASE(C_FFNIN) gemm_phase<G_FFNIN>(q, layer, smem);
        PHASE(C_FFNOUT) gemm_phase<G_FFNOUT>(q, layer, smem);
        PHASE(C_SSMIN) gemm_phase<G_SSMIN>(q, layer, smem);
        PHASE(C_CONV) conv_phase(q, layer, smf);
        PHASE(C_SSD) ssd_diag_phase(q, layer, smem);
        PHASE(C_SSDB) ssd_scan_phase(q, layer, smem);
        PHASE(C_FINISH) finish_phase(q, layer);
        PHASE(C_SSMOUT) gemm_phase<G_SSMOUT>(q, layer, smem);
#undef PHASE
        if (q.out == nullptr) grid.sync();
        xcd_barrier(xb);
    }
}

extern "C" void kernel_launch(void* const* d_in, const int* in_sizes, int n_in, void* d_out, int out_size, void* d_ws, size_t ws_size, hipStream_t stream) {
    static int grid_blocks = 0;
    if (grid_blocks == 0) {
        if (ws_size < WS_TOTAL) { fprintf(stderr, "kernel_launch: workspace too small: %zu < %zu\n", ws_size, (size_t)WS_TOTAL); grid_blocks = -1; return; }
        int dev = 0, cus = 0, per_cu = 0;
        hipGetDevice(&dev);
        hipDeviceGetAttribute(&cus, hipDeviceAttributeMultiprocessorCount, dev);
        if (hipFuncSetAttribute((const void*)hybrid_fwd, hipFuncAttributeMaxDynamicSharedMemorySize, LDS_BYTES) != hipSuccess) { fprintf(stderr, "kernel_launch: hipFuncSetAttribute failed\n"); }
        if (hipOccupancyMaxActiveBlocksPerMultiprocessor(&per_cu, (const void*)hybrid_fwd, 256, LDS_BYTES) != hipSuccess || per_cu < 1) { fprintf(stderr, "kernel_launch: occupancy query failed (%d)\n", per_cu); per_cu = 1; }
        if (per_cu > 2) per_cu = 2;
        (void)hipGetLastError();
        grid_blocks = cus * per_cu;
    }
    if (grid_blocks < 0) return;
    if (hipMemsetAsync((char*)d_ws + WS_BAR, 0, XCD_BAR_WORDS * sizeof(unsigned), stream) != hipSuccess) { fprintf(stderr, "kernel_launch: hipMemsetAsync failed\n"); return; }
    Params p{};
    const float** f = (const float**)&p;
    for (int i = 0; i < 25; ++i) f[i] = (const float*)d_in[i];
    p.out = (float*)d_out; p.ws = (unsigned char*)d_ws;
    void* args[] = {&p};
    hipError_t e = hipLaunchCooperativeKernel((const void*)hybrid_fwd, dim3(grid_blocks), dim3(256), args, LDS_BYTES, stream);
    if (e != hipSuccess) fprintf(stderr, "cooperative launch failed: %s (grid %d)\n", hipGetErrorString(e), grid_blocks);
}
```

```cpp
#include <hip/hip_runtime.h>
#include <hip/hip_cooperative_groups.h>
#include <cstdio>
#include <cstdint>
namespace cg = cooperative_groups;

typedef unsigned short bf16_t;
typedef short bf16x8 __attribute__((ext_vector_type(8)));
typedef short bf16x4 __attribute__((ext_vector_type(4)));
typedef float f32x4 __attribute__((ext_vector_type(4)));
typedef unsigned u32x4 __attribute__((ext_vector_type(4)));
typedef unsigned u32x2 __attribute__((ext_vector_type(2)));

constexpr int D = 1024, NB = 2, SEQ = 8192, CTX = 256;
constexpr int ML = NB * SEQ;
constexpr int MC = NB * CTX;
constexpr int MT = ML + MC;
constexpr int TALL = CTX + SEQ;
constexpr int FFH = 2816;
constexpr int MIXIN = 1792;
constexpr int SSMIN = 5184, SSMIN_PAD = 5248;
constexpr int SSI = 2048;
constexpr float EPS = 1e-6f;
constexpr float QSCALE = 0.125f * 1.4426950408889634f;

constexpr size_t MB = 1024 * 1024;
constexpr size_t WS_MOD = 0;
constexpr size_t WS_ROPE = 1 * MB;
constexpr size_t WS_XCTX = 3 * MB;
constexpr size_t WS_SGW = 5 * MB + 512 * 1024;
constexpr size_t WS_BAR = 7 * MB;
constexpr size_t WS_PART = 7 * MB + 64 * 1024;
constexpr size_t WS_WT = 8 * MB;
constexpr size_t WT_FFNIN = 0;
constexpr size_t WT_FFNOUT = WT_FFNIN + (size_t)5632 * 1024 * 2;
constexpr size_t WT_MIXIN = WT_FFNOUT + (size_t)1024 * 2816 * 2;
constexpr size_t WT_MIXOUT = WT_MIXIN + (size_t)SSMIN_PAD * 1024 * 2;
constexpr size_t WT_END = WT_MIXOUT + (size_t)1024 * 2048 * 2;
constexpr size_t WS_R0 = WS_WT + ((WT_END + MB - 1) / MB) * MB;
constexpr size_t SZ_XBC = (size_t)MT * 3072 * 2;
constexpr size_t SZ_HN = (size_t)MT * 1024 * 2;
constexpr size_t WS_XBC = WS_R0;
constexpr size_t WS_HN = WS_XBC + SZ_XBC;
constexpr size_t WS_YF = WS_XBC;
constexpr size_t WS_YB = WS_YF + (size_t)MT * 2048 * 2;
constexpr size_t WS_R1 = WS_HN + SZ_HN;
constexpr size_t WS_Z = WS_R1;
constexpr size_t WS_XT = WS_Z + (size_t)MT * 2048 * 2;
constexpr size_t WS_BN = WS_XT + (size_t)MT * 2048 * 2;
constexpr size_t WS_CN = WS_BN + (size_t)MT * 512 * 2;
constexpr size_t WS_BT = WS_CN + (size_t)MT * 512 * 2;
constexpr size_t WS_DT = WS_BT + (size_t)MT * 512 * 2;
constexpr size_t WS_END_ODD = WS_DT + (size_t)MT * 64 * 4;
constexpr size_t WS_Q = WS_R1;
constexpr size_t WS_K = WS_Q + (size_t)MT * 512 * 2;
constexpr size_t WS_VT = WS_K + (size_t)MT * 128 * 2;
constexpr size_t WS_U = WS_VT + (size_t)MT * 128 * 2;
constexpr size_t WS_GVT = WS_U + (size_t)MT * 512 * 2;
constexpr size_t WS_AS = WS_GVT + (size_t)MT * 512 * 2;
constexpr size_t WS_HID = WS_R1;
constexpr size_t WS_TOTAL = WS_END_ODD;
static_assert(WS_TOTAL < (size_t)400 * MB, "workspace too large");
static_assert(WS_AS + (size_t)MT * 1024 * 2 <= WS_END_ODD, "even buffers fit");
static_assert(WS_HID + (size_t)MT * FFH * 2 <= WS_END_ODD, "hid fits");

constexpr int LDS_BYTES = 73728;
constexpr int GST = 72;
constexpr int SST = 136;

struct Params {
    const float* x; const float* c; const float* ctx; const float* c_ctx;
    const float* ada_w; const float* ada_b; const float* norm1_g; const float* norm2_g;
    const float* ffn_w_in; const float* ffn_w_out; const float* mix_w_in; const float* mix_w_out;
    const float* q_norm_g; const float* k_norm_g; const float* sgu_norm_g; const float* sgu_w; const float* sgu_b;
    const float* ssm_w_in; const float* ssm_conv_w; const float* ssm_conv_b; const float* ssm_dt_bias;
    const float* ssm_a_log; const float* ssm_d; const float* ssm_norm_g; const float* ssm_w_out;
    float* out; unsigned char* ws;
};

typedef const __attribute__((address_space(4))) Params CParams;

__device__ __forceinline__ int tid_() { int t = threadIdx.x; asm volatile("" : "+v"(t)); return t; }
__device__ __forceinline__ bf16_t f2bf(float f) {
    unsigned u = __float_as_uint(f);
    u += 0x7fffu + ((u >> 16) & 1u);
    return (bf16_t)(u >> 16);
}
__device__ __forceinline__ float bf2f(bf16_t h) { return __uint_as_float(((unsigned)h) << 16); }
typedef __bf16 bf16v2_t __attribute__((ext_vector_type(2)));
typedef float f32v2_t __attribute__((ext_vector_type(2)));
__device__ __forceinline__ unsigned pack2(float a, float b) { const f32v2_t v = {a, b}; return __builtin_bit_cast(unsigned, __builtin_convertvector(v, bf16v2_t)); }
__device__ __forceinline__ float siluf(float v) { return v / (1.f + __expf(-v)); }
__device__ __forceinline__ float geluf(float v) {
    const float u = 0.7978845608028654f * (v + 0.044715f * v * v * v);
    return v / (1.f + __expf(-2.f * u));
}
__device__ __forceinline__ float softplusf(float v) { return v > 20.f ? v : log1pf(expf(v)); }
__device__ __forceinline__ int seg_of(int row) { return row < SEQ ? 0 : (row < ML ? 1 : 2); }
__device__ __forceinline__ float* xrow(CParams& p, int row) {
    return row < ML ? p.out + (size_t)row * D : (float*)(p.ws + WS_XCTX) + (size_t)(row - ML) * D;
}
__device__ __forceinline__ void lds_sync() {
    __builtin_amdgcn_fence(__ATOMIC_RELEASE, "workgroup", "local");
    __builtin_amdgcn_s_barrier();
    __builtin_amdgcn_fence(__ATOMIC_ACQUIRE, "workgroup", "local");
}
typedef float f32x2 __attribute__((ext_vector_type(2)));
__device__ __forceinline__ f32x2 scan128(float s0, float s1, int lane, int dir) {
    if (dir == 0) {
#pragma unroll
        for (int o = 1; o < 64; o <<= 1) { const float t0 = __shfl_up(s0, o), t1 = __shfl_up(s1, o); s0 += lane >= o ? t0 : 0.f; s1 += lane >= o ? t1 : 0.f; }
        s1 += __shfl(s0, 63);
    } else {
#pragma unroll
        for (int o = 1; o < 64; o <<= 1) { const float t0 = __shfl_down(s0, o), t1 = __shfl_down(s1, o); s0 += lane + o < 64 ? t0 : 0.f; s1 += lane + o < 64 ? t1 : 0.f; }
        s0 += __shfl(s1, 0);
    }
    return (f32x2){s0, s1};
}
__device__ __forceinline__ f32x4 mfma16(bf16x8 a, bf16x8 b, f32x4 c) { return __builtin_amdgcn_mfma_f32_16x16x32_bf16(a, b, c, 0, 0, 0); }
__device__ __forceinline__ bf16x8 lds16(const bf16_t* p) { return *(const bf16x8*)p; }
__device__ __forceinline__ bf16x8 lds8x2(const bf16_t* p0, const bf16_t* p1) {
    const bf16x4 a = *(const bf16x4*)p0, b = *(const bf16x4*)p1;
    bf16x8 r; r[0] = a[0]; r[1] = a[1]; r[2] = a[2]; r[3] = a[3]; r[4] = b[0]; r[5] = b[1]; r[6] = b[2]; r[7] = b[3];
    return r;
}
__device__ __forceinline__ bf16x8 pack8(f32x4 a, f32x4 b) {
    u32x4 w; w.x = pack2(a[0], a[1]); w.y = pack2(a[2], a[3]); w.z = pack2(b[0], b[1]); w.w = pack2(b[2], b[3]);
    return __builtin_bit_cast(bf16x8, w);
}
__device__ __forceinline__ void st4bf(bf16_t* dst, float a, float b, float c, float d) {
    u32x2 w; w.x = pack2(a, b); w.y = pack2(c, d); *(u32x2*)dst = w;
}


#define XB_TMO      128
#define XB_XCNT(j)  (256  + 64 * (j))
#define XB_XSUB(j)  (1280 + 64 * (j))
#define XB_XGEN(j)  (2304 + 64 * (j))
#define XB_TOP      3328
#define XB_TOPGEN   3392
#define XCD_BAR_WORDS 3456
#define XB_SPIN_CAP (1u << 18)
#define LAS __attribute__((address_space(3)))
__device__ __forceinline__ unsigned xb_ld(unsigned* p)              { return __hip_atomic_load(p, __ATOMIC_RELAXED, __HIP_MEMORY_SCOPE_AGENT); }
__device__ __forceinline__ unsigned xb_add(unsigned* p, unsigned v) { return __hip_atomic_fetch_add(p, v, __ATOMIC_RELAXED, __HIP_MEMORY_SCOPE_AGENT); }
__device__ __forceinline__ unsigned xb_xcc_id() { return (unsigned)__builtin_amdgcn_s_getreg((3 << 11) | 20) & 0xFu; }
#define XB_SPIN(cond, bar) do { unsigned _sp = 0; while (cond) { __builtin_amdgcn_s_sleep(1); \
    if ((++_sp & 255u) == 0u) { if (xb_ld(&(bar)[XB_TMO])) break; if (_sp > XB_SPIN_CAP) { atomicAdd(&(bar)[XB_TMO], 1u); break; } } } } while (0)
struct XcdBarrier { unsigned* bar; unsigned x; volatile LAS unsigned* st; };
__device__ __forceinline__ XcdBarrier xcd_barrier_post(unsigned* bar, volatile LAS unsigned* st) {
    XcdBarrier b; b.bar = bar; b.x = xb_xcc_id(); b.st = st;
    if (threadIdx.x == 0) (void)xb_add(&bar[XB_XCNT(b.x)], 1u);
    return b;
}
__device__ __forceinline__ void xcd_barrier_complete(unsigned* bar, unsigned x, unsigned& nloc, unsigned& nx) {
    const unsigned G = gridDim.x * gridDim.y * gridDim.z;
    unsigned sum, cnt, mine, sp = 0u;
    for (;;) {
        sum = 0u; cnt = 0u; mine = 0u;
#pragma unroll
        for (unsigned j = 0; j < 16; ++j) { const unsigned c = xb_ld(&bar[XB_XCNT(j)]); sum += c; cnt += (c > 0u) ? 1u : 0u; mine = (j == x) ? c : mine; }
        if (sum == G) break;
        __builtin_amdgcn_s_sleep(1);
        if ((++sp & 255u) == 0u) { if (xb_ld(&bar[XB_TMO])) break; if (sp > XB_SPIN_CAP) { atomicAdd(&bar[XB_TMO], 1u); break; } }
    }
    nloc = mine > 0u ? mine : 1u; nx = cnt > 0u ? cnt : 1u;
}
__device__ __forceinline__ void xcd_barrier(const XcdBarrier& b) {
    asm volatile("s_waitcnt vmcnt(0)" ::: "memory");
    __syncthreads();
    if (threadIdx.x == 0) {
        unsigned* bar = b.bar;
        __builtin_amdgcn_s_waitcnt(0);
        unsigned nloc = b.st[0], nx = b.st[1];
        if (nloc == 0u) { xcd_barrier_complete(bar, b.x, nloc, nx); b.st[0] = nloc; b.st[1] = nx; }
        const unsigned old = xb_add(&bar[XB_XSUB(b.x)], 1u);
        const unsigned gen = old / nloc;
        if (old + 1u == (gen + 1u) * nloc) {
            __builtin_amdgcn_fence(__ATOMIC_RELEASE, "agent");
            asm volatile("s_waitcnt vmcnt(0)" ::: "memory");
            const unsigned og = xb_add(&bar[XB_TOP], 1u);
            const unsigned tg = og / nx;
            if (og + 1u == (tg + 1u) * nx) xb_add(&bar[XB_TOPGEN], 1u);
            else XB_SPIN(xb_ld(&bar[XB_TOPGEN]) == tg, bar);
            __builtin_amdgcn_fence(__ATOMIC_ACQUIRE, "agent");
            xb_add(&bar[XB_XGEN(b.x)], 1u);
            asm volatile("s_waitcnt vmcnt(0)" ::: "memory");
        } else {
            XB_SPIN(xb_ld(&bar[XB_XGEN(b.x)]) == gen, bar);
            __builtin_amdgcn_fence(__ATOMIC_ACQUIRE, "agent");
            asm volatile("s_waitcnt vmcnt(0)" ::: "memory");
        }
    }
    __syncthreads();
}

__device__ __forceinline__ size_t frag_off(int row, int col, int K) {
    return ((size_t)(row >> 4) * (K >> 5) + (col >> 5)) * 512 + ((row & 15) + 16 * ((col & 31) >> 3)) * 8 + (col & 7);
}

template <int MI, int lda, int ldw, int K, int FRAG = 0>
__device__ __forceinline__ void gemm_tile(const bf16_t* __restrict__ A, const bf16_t* __restrict__ W,
                                          f32x4 (&acc)[MI][8], bf16_t* sW) {
    const int tid = tid_(), lane = tid & 63, wave = tid >> 6, l16 = lane & 15, quad = lane >> 4;
    const int srow = tid >> 3, skc = (tid & 7) * 8;
    constexpr int ASI = FRAG ? (K / 32) * 512 : 16 * lda;
    constexpr int ASK = FRAG ? 512 : 32;
    const bf16_t* ap = FRAG ? A + (size_t)(wave * MI) * ASI + lane * 8 : A + (size_t)(wave * 16 * MI + l16) * lda + quad * 8;
    const bf16_t* wp = W + (size_t)srow * ldw + skc;
    const bf16_t* wr = sW + l16 * GST + quad * 8;
    u32x4 ra[MI][2], rw[4];
#pragma unroll
    for (int i = 0; i < 4; ++i) rw[i] = *(const u32x4*)(wp + (size_t)(i * 32) * ldw);
#pragma unroll
    for (int i = 0; i < MI; ++i)
#pragma unroll
        for (int ks = 0; ks < 2; ++ks) ra[i][ks] = *(const u32x4*)(ap + (size_t)i * ASI + ks * ASK);
#pragma unroll
    for (int i = 0; i < MI; ++i)
#pragma unroll
        for (int j = 0; j < 8; ++j) acc[i][j] = (f32x4){0.f, 0.f, 0.f, 0.f};
    constexpr int nk = K >> 6;
#pragma unroll 1
    for (int kt = 0; kt < nk; ++kt) {
        lds_sync();
#pragma unroll
        for (int i = 0; i < 4; ++i) *(u32x4*)(sW + (srow + i * 32) * GST + skc) = rw[i];
        lds_sync();
        const int k0 = (kt + 1 < nk ? kt + 1 : kt) << 6;
        const int ka = FRAG ? (k0 >> 5) * 512 : k0;
#pragma unroll
        for (int i = 0; i < 4; ++i) rw[i] = *(const u32x4*)(wp + (size_t)(i * 32) * ldw + k0);
        bf16x8 wa[4], wb[4];
#pragma unroll
        for (int j = 0; j < 4; ++j) wa[j] = lds16(wr + (j * 16) * GST);
#pragma unroll
        for (int j = 0; j < 4; ++j) wb[j] = lds16(wr + ((j + 4) * 16) * GST);
        __builtin_amdgcn_sched_barrier(0);
        __builtin_amdgcn_s_setprio(1);
#pragma unroll
        for (int j = 0; j < 4; ++j)
#pragma unroll
            for (int i = 0; i < MI; ++i) acc[i][j] = mfma16(wa[j], __builtin_bit_cast(bf16x8, ra[i][0]), acc[i][j]);
        __builtin_amdgcn_sched_barrier(0);
#pragma unroll
        for (int j = 0; j < 4; ++j) wa[j] = lds16(wr + (j * 16) * GST + 32);
        __builtin_amdgcn_sched_barrier(0);
#pragma unroll
        for (int j = 0; j < 4; ++j)
#pragma unroll
            for (int i = 0; i < MI; ++i) acc[i][j + 4] = mfma16(wb[j], __builtin_bit_cast(bf16x8, ra[i][0]), acc[i][j + 4]);
        __builtin_amdgcn_sched_barrier(0);
#pragma unroll
        for (int i = 0; i < MI; ++i) ra[i][0] = *(const u32x4*)(ap + (size_t)i * ASI + ka);
#pragma unroll
        for (int j = 0; j < 4; ++j) wb[j] = lds16(wr + ((j + 4) * 16) * GST + 32);
        __builtin_amdgcn_sched_barrier(0);
#pragma unroll
        for (int j = 0; j < 4; ++j)
#pragma unroll
            for (int i = 0; i < MI; ++i) acc[i][j] = mfma16(wa[j], __builtin_bit_cast(bf16x8, ra[i][1]), acc[i][j]);
        __builtin_amdgcn_sched_barrier(0);
#pragma unroll
        for (int j = 0; j < 4; ++j)
#pragma unroll
            for (int i = 0; i < MI; ++i) acc[i][j + 4] = mfma16(wb[j], __builtin_bit_cast(bf16x8, ra[i][1]), acc[i][j + 4]);
        __builtin_amdgcn_s_setprio(0);
        __builtin_amdgcn_sched_barrier(0);
#pragma unroll
        for (int i = 0; i < MI; ++i) ra[i][1] = *(const u32x4*)(ap + (size_t)i * ASI + ka + ASK);
    }
}

template <int MI>
__device__ __forceinline__ void epi_resid(CParams& p, int m0, int n0, const f32x4 (&acc)[MI][8], const float* gate  ) {
    const int lane = tid_() & 63, wave = tid_() >> 6, l16 = lane & 15, quad = lane >> 4;
#pragma unroll
    for (int i = 0; i < MI; ++i) {
        const int row = m0 + wave * 16 * MI + i * 16 + l16;
        float* xr = xrow(p, row);
        const float* g = gate + (size_t)seg_of(row) * 6144;
        float ss = 0.f;
#pragma unroll
        for (int j = 0; j < 8; ++j) {
            const int col = n0 + j * 16 + quad * 4;
            const f32x4 gv = *(const f32x4*)(g + col);
            f32x4 xv = *(f32x4*)(xr + col);
            xv += gv * acc[i][j];
            *(f32x4*)(xr + col) = xv;
            ss += xv[0] * xv[0] + xv[1] * xv[1] + xv[2] * xv[2] + xv[3] * xv[3];
        }
        ss += __shfl_xor(ss, 16); ss += __shfl_xor(ss, 32);
        if (quad == 0) ((float*)(p.ws + WS_PART))[(size_t)row * 8 + (n0 >> 7)] = ss;
        __builtin_amdgcn_sched_barrier(0);
    }
}

template <int MI>
__device__ __forceinline__ void epi_swiglu(CParams& p, int m0, int n0, const f32x4 (&acc)[MI][8]) {
    const int lane = tid_() & 63, wave = tid_() >> 6, l16 = lane & 15, quad = lane >> 4;
    bf16_t* hid = (bf16_t*)(p.ws + WS_HID);
#pragma unroll
    for (int i = 0; i < MI; ++i) {
        const int row = m0 + wave * 16 * MI + i * 16 + l16;
#pragma unroll
        for (int jj = 0; jj < 4; ++jj) {
            const f32x4 g = acc[i][2 * jj], u = acc[i][2 * jj + 1];
            const int hc = (n0 >> 1) + jj * 16 + quad * 4;
            const size_t off = ((size_t)(row >> 4) * (FFH / 32) + (hc >> 5)) * 512 + ((row & 15) + 16 * ((hc & 31) >> 3)) * 8 + (hc & 7);
            st4bf(hid + off, siluf(g[0]) * u[0], siluf(g[1]) * u[1], siluf(g[2]) * u[2], siluf(g[3]) * u[3]);
        }
    }
}

template <int MI>
__device__ __forceinline__ void epi_mixin(CParams& p, int j2, int m0, int tn, f32x4 (&acc)[MI][8]) {
    const int lane = tid_() & 63, wave = tid_() >> 6, l16 = lane & 15, quad = lane >> 4;
    if (tn < 5) {
        const float* gsrc = (tn < 4 ? p.q_norm_g : p.k_norm_g) + j2 * 64;
        const float* cosT = (const float*)(p.ws + WS_ROPE);
        const float* sinT = cosT + 8192 * 32;
#pragma unroll
        for (int i = 0; i < MI; ++i) {
            const int row = m0 + wave * 16 * MI + i * 16 + l16;
#pragma unroll
            for (int hh = 0; hh < 2; ++hh) {
                float ss = 0.f;
#pragma unroll
                for (int j = 0; j < 4; ++j) { const f32x4 v = acc[i][hh * 4 + j]; ss += v[0] * v[0] + v[1] * v[1] + v[2] * v[2] + v[3] * v[3]; }
                ss += __shfl_xor(ss, 16); ss += __shfl_xor(ss, 32);
                const float rstd = rsqrtf(ss * (1.f / 64.f) + EPS);
                f32x4 y[4];
#pragma unroll
                for (int j = 0; j < 4; ++j) {
                    const f32x4 gv = *(const f32x4*)(gsrc + j * 16 + quad * 4);
                    y[j] = acc[i][hh * 4 + j] * rstd * gv;
                }
                if (row < ML) {
                    const int s = row & (SEQ - 1);
#pragma unroll
                    for (int j = 0; j < 2; ++j) {
                        const f32x4 cs = *(const f32x4*)(cosT + (size_t)s * 32 + j * 16 + quad * 4);
                        const f32x4 sn = *(const f32x4*)(sinT + (size_t)s * 32 + j * 16 + quad * 4);
                        const f32x4 x1 = y[j], x2 = y[j + 2];
                        y[j] = x1 * cs - x2 * sn;
                        y[j + 2] = x2 * cs + x1 * sn;
                    }
                }
                if (tn < 4) {
                    bf16_t* q = (bf16_t*)(p.ws + WS_Q) + (size_t)row * 512 + (tn * 2 + hh) * 64;
#pragma unroll
                    for (int j = 0; j < 4; ++j) st4bf(q + j * 16 + quad * 4, y[j][0] * QSCALE, y[j][1] * QSCALE, y[j][2] * QSCALE, y[j][3] * QSCALE);
                } else {
                    const int b = row < ML ? (row >> 13) : ((row - ML) >> 8);
                    const int t = row < ML ? CTX + (row & (SEQ - 1)) : ((row - ML) & (CTX - 1));
                    bf16_t* k = (bf16_t*)(p.ws + WS_K) + ((size_t)b * TALL + t) * 128 + hh * 64;
#pragma unroll
                    for (int j = 0; j < 4; ++j) st4bf(k + j * 16 + quad * 4, y[j][0], y[j][1], y[j][2], y[j][3]);
                }
            }
        }
    } else if (tn == 5) {
        bf16_t* vt = (bf16_t*)(p.ws + WS_VT);
#pragma unroll
        for (int i = 0; i < MI; ++i) {
            const int row = m0 + wave * 16 * MI + i * 16 + l16;
            const int b = row < ML ? (row >> 13) : ((row - ML) >> 8);
            const int t = row < ML ? CTX + (row & (SEQ - 1)) : ((row - ML) & (CTX - 1));
#pragma unroll
            for (int j = 0; j < 8; ++j) {
                const int kh = j >> 2;
#pragma unroll
                for (int r = 0; r < 4; ++r) {
                    const int d = (j & 3) * 16 + quad * 4 + r;
                    vt[((size_t)(b * 2 + kh) * 64 + d) * TALL + t] = f2bf(acc[i][j][r]);
                }
            }
        }
    } else if (tn < 10) {
        bf16_t* u = (bf16_t*)(p.ws + WS_U);
#pragma unroll
        for (int i = 0; i < MI; ++i) {
            const int row = m0 + wave * 16 * MI + i * 16 + l16;
#pragma unroll
            for (int j = 0; j < 8; ++j) {
                const f32x4 v = acc[i][j];
                st4bf(u + (size_t)row * 512 + (tn - 6) * 128 + j * 16 + quad * 4, geluf(v[0]), geluf(v[1]), geluf(v[2]), geluf(v[3]));
            }
        }
    } else {
        const int g = tn - 10;
        const float* gn = p.sgu_norm_g + j2 * 512 + g * 128;
        bf16_t* gvt = (bf16_t*)(p.ws + WS_GVT);
#pragma unroll
        for (int i = 0; i < MI; ++i) {
            const int row = m0 + wave * 16 * MI + i * 16 + l16;
            float ss = 0.f;
#pragma unroll
            for (int j = 0; j < 8; ++j) {
                f32x4 v = acc[i][j];
                v[0] = geluf(v[0]); v[1] = geluf(v[1]); v[2] = geluf(v[2]); v[3] = geluf(v[3]);
                acc[i][j] = v;
                ss += v[0] * v[0] + v[1] * v[1] + v[2] * v[2] + v[3] * v[3];
            }
            ss += __shfl_xor(ss, 16); ss += __shfl_xor(ss, 32);
            const float rstd = rsqrtf(ss * (1.f / 128.f) + EPS);
            const int chunk = row >> 7, pt = row & 127;
#pragma unroll
            for (int j = 0; j < 8; ++j) {
                const f32x4 gv = *(const f32x4*)(gn + j * 16 + quad * 4);
#pragma unroll
                for (int r = 0; r < 4; ++r) {
                    const int cc = g * 128 + j * 16 + quad * 4 + r;
                    gvt[((size_t)chunk * 512 + cc) * 128 + pt] = f2bf(acc[i][j][r] * rstd * gv[r]);
                }
            }
        }
    }
}

template <int MI>
__device__ __forceinline__ void epi_ssmin(CParams& p, int j2, int m0, int tn, const f32x4 (&acc)[MI][8]) {
    const int lane = tid_() & 63, wave = tid_() >> 6, l16 = lane & 15, quad = lane >> 4;
#pragma unroll
    for (int i = 0; i < MI; ++i) {
        const int row = m0 + wave * 16 * MI + i * 16 + l16;
        if (tn < 16) {
            bf16_t* z = (bf16_t*)(p.ws + WS_Z);
#pragma unroll
            for (int j = 0; j < 8; ++j) { const f32x4 v = acc[i][j]; st4bf(z + frag_off(row, tn * 128 + j * 16 + quad * 4, 2048), siluf(v[0]), siluf(v[1]), siluf(v[2]), siluf(v[3])); }
        } else if (tn < 40) {
            bf16_t* xb = (bf16_t*)(p.ws + WS_XBC) + (size_t)row * 3072 + (tn - 16) * 128;
#pragma unroll
            for (int j = 0; j < 8; ++j) { const f32x4 v = acc[i][j]; st4bf(xb + j * 16 + quad * 4, v[0], v[1], v[2], v[3]); }
        } else {
            float* dt = (float*)(p.ws + WS_DT) + (size_t)row * 64;
            const float* bias = p.ssm_dt_bias + j2 * 64;
#pragma unroll
            for (int j = 0; j < 4; ++j) {
                const int c = j * 16 + quad * 4;
                const f32x4 v = acc[i][j];
                f32x4 o;
                o[0] = softplusf(v[0] + bias[c + 0]); o[1] = softplusf(v[1] + bias[c + 1]);
                o[2] = softplusf(v[2] + bias[c + 2]); o[3] = softplusf(v[3] + bias[c + 3]);
                *(f32x4*)(dt + c) = o;
            }
        }
    }
}

enum { G_MIXIN = 0, G_MIXOUT, G_SSMIN, G_SSMOUT, G_FFNIN, G_FFNOUT };

template <int KIND>
__device__ __forceinline__ void gemm_phase(CParams& p, int layer, bf16_t* smem) {
    const int j2 = layer >> 1;
    constexpr int lda = (KIND == G_SSMOUT) ? 2048 : (KIND == G_FFNOUT) ? FFH : 1024;
    constexpr int K = lda, ldw = K;
    constexpr int N = (KIND == G_MIXIN) ? MIXIN : (KIND == G_SSMIN) ? SSMIN_PAD : (KIND == G_FFNIN) ? 2 * FFH : 1024;
    constexpr size_t aoff = (KIND == G_MIXOUT) ? WS_AS : (KIND == G_SSMOUT) ? WS_YF : (KIND == G_FFNOUT) ? WS_HID : WS_HN;
    constexpr size_t woff = (KIND == G_MIXIN || KIND == G_SSMIN) ? WT_MIXIN : (KIND == G_MIXOUT || KIND == G_SSMOUT) ? WT_MIXOUT : (KIND == G_FFNIN) ? WT_FFNIN : WT_FFNOUT;
    const bf16_t* A = (const bf16_t*)(p.ws + aoff);
    const bf16_t* W = (const bf16_t*)(p.ws + WS_WT + woff);
    constexpr int MI = (KIND == G_MIXIN) ? 2 : 4;
    constexpr int FRAG = 1;
    constexpr int nN = N >> 7, nM = MT / (64 * MI);
    const float* mod = (const float*)(p.ws + WS_MOD) + (size_t)layer * 3 * 6144;
    bf16_t* sW = smem;
    if (N == 1024) {
        const int nlat = (ML / 256) * 8, nctx = layer == 3 ? 0 : (MC / 64) * 8;
        const float* gate = mod + (KIND == G_FFNOUT ? 5 : 2) * 1024;
        for (int t = blockIdx.x; t < nlat + nctx; t += gridDim.x) {
            if (t < nlat) {
                const int u = (gridDim.x == 512) ? ((t & 7) * 64 + (t >> 3)) : t;
                const int tm = u >> 3, tn = u & 7;
                f32x4 acc[4][8];
                gemm_tile<4, lda, ldw, K, FRAG>(A + (size_t)tm * 256 * lda, W + (size_t)tn * 128 * ldw, acc, sW);
                epi_resid<4>(p, tm * 256, tn * 128, acc, gate);
            } else {
                const int u = t - nlat, tm = u >> 3, tn = u & 7;
                f32x4 acc[1][8];
                gemm_tile<1, lda, ldw, K, FRAG>(A + (size_t)(ML + tm * 64) * lda, W + (size_t)tn * 128 * ldw, acc, sW);
                epi_resid<1>(p, ML + tm * 64, tn * 128, acc, gate);
            }
        }
        return;
    }
    constexpr int T = nM * nN, share = (T + 7) / 8, nsc = (nN + 7) / 8;
    const int xcd = blockIdx.x & 7, slot = blockIdx.x >> 3, nslot = gridDim.x >> 3;
    for (int li = slot; li < share; li += nslot) {
        const int u = xcd * share + li;
        if (u >= T) break;
        int sc = u / (nM * 8); if (sc > nsc - 1) sc = nsc - 1;
        const int rem = u - sc * nM * 8, wd = (sc == nsc - 1) ? (nN - 8 * sc) : 8;
        const int tm = rem / wd, tn = sc * 8 + rem - tm * wd;
        f32x4 acc[MI][8];
        gemm_tile<MI, lda, ldw, K, FRAG>(A + (size_t)tm * (64 * MI) * lda, W + (size_t)tn * 128 * ldw, acc, sW);
        if (KIND == G_MIXIN) epi_mixin<MI>(p, j2, tm * (64 * MI), tn, acc);
        else if (KIND == G_SSMIN) epi_ssmin<MI>(p, j2, tm * (64 * MI), tn, acc);
        else if (KIND == G_FFNIN) epi_swiglu<MI>(p, tm * (64 * MI), tn * 128, acc);
    }
}

__device__ __forceinline__ void norm_phase(CParams& p, int layer, int which) {
    const int lane = tid_() & 63, wave = tid_() >> 6, l16 = lane & 15, quad = lane >> 4;
    const float* g = (which ? p.norm2_g : p.norm1_g) + layer * 1024;
    const float* mod = (const float*)(p.ws + WS_MOD) + (size_t)layer * 3 * 6144;
    const float* part = (const float*)(p.ws + WS_PART);
    bf16_t* hn = (bf16_t*)(p.ws + WS_HN);
#pragma unroll 4
    for (int it = blockIdx.x * 4 + wave; it < (MT / 16) * 32; it += gridDim.x * 4) {
        const int tr = it >> 5, kb = it & 31, row = tr * 16 + l16, col = kb * 32 + quad * 8;
        const f32x4 p0 = *(const f32x4*)(part + (size_t)row * 8), p1 = *(const f32x4*)(part + (size_t)row * 8 + 4);
        const float rs = rsqrtf((((p0[0] + p0[1]) + (p0[2] + p0[3])) + ((p1[0] + p1[1]) + (p1[2] + p1[3]))) * (1.f / 1024.f) + EPS);
        const float* m = mod + (size_t)seg_of(row) * 6144 + (which ? 3 * 1024 : 0);
        const float* xr = xrow(p, row) + col;
        const f32x4 v0 = *(const f32x4*)(xr), v1 = *(const f32x4*)(xr + 4);
        const f32x4 g0 = *(const f32x4*)(g + col), g1 = *(const f32x4*)(g + col + 4);
        const f32x4 sh0 = *(const f32x4*)(m + col), sh1 = *(const f32x4*)(m + col + 4);
        const f32x4 sc0 = *(const f32x4*)(m + 1024 + col), sc1 = *(const f32x4*)(m + 1024 + col + 4);
        const f32x4 y0 = (v0 * rs * g0) * (sc0 + 1.f) + sh0, y1 = (v1 * rs * g1) * (sc1 + 1.f) + sh1;
        u32x4 o; o.x = pack2(y0[0], y0[1]); o.y = pack2(y0[2], y0[3]); o.z = pack2(y1[0], y1[1]); o.w = pack2(y1[2], y1[3]);
        *(u32x4*)(hn + (size_t)it * 512 + lane * 8) = o;
    }
}

__device__ __forceinline__ void convert_wt(const float* __restrict__ W, int K, int N, bf16_t* __restrict__ Wt, int mode, float* tile) {
    const int tid = tid_();
    const int nKt = K >> 6, nNt = N >> 6;
    for (int t = blockIdx.x; t < nKt * nNt; t += gridDim.x) {
        const int kt = t / nNt, nt = t - kt * nNt;
        lds_sync();
#pragma unroll
        for (int i = 0; i < 16; ++i) {
            const int kk = (tid >> 6) + i * 4, nn = tid & 63;
            tile[kk * 65 + nn] = W[(size_t)(kt * 64 + kk) * N + nt * 64 + nn];
        }
        lds_sync();
        {
            const int nn = tid >> 2, kq = (tid & 3) * 16;
            const int n = nt * 64 + nn;
            int dr = n;
            if (mode == 1) { const int hm = n < FFH ? n : n - FFH; dr = (hm >> 4) * 32 + (hm & 15) + (n < FFH ? 0 : 16); }
            u32x4 o0, o1;
            o0.x = pack2(tile[(kq + 0) * 65 + nn], tile[(kq + 1) * 65 + nn]); o0.y = pack2(tile[(kq + 2) * 65 + nn], tile[(kq + 3) * 65 + nn]);
            o0.z = pack2(tile[(kq + 4) * 65 + nn], tile[(kq + 5) * 65 + nn]); o0.w = pack2(tile[(kq + 6) * 65 + nn], tile[(kq + 7) * 65 + nn]);
            o1.x = pack2(tile[(kq + 8) * 65 + nn], tile[(kq + 9) * 65 + nn]); o1.y = pack2(tile[(kq + 10) * 65 + nn], tile[(kq + 11) * 65 + nn]);
            o1.z = pack2(tile[(kq + 12) * 65 + nn], tile[(kq + 13) * 65 + nn]); o1.w = pack2(tile[(kq + 14) * 65 + nn], tile[(kq + 15) * 65 + nn]);
            bf16_t* dst = Wt + (size_t)dr * K + kt * 64 + kq;
            *(u32x4*)dst = o0; *(u32x4*)(dst + 8) = o1;
        }
    }
}

__device__ __forceinline__ void convert_layer_weights(CParams& p, int layer, float* tile) {
    unsigned char* wt = p.ws + WS_WT;
    const int j2 = layer >> 1;
    convert_wt(p.ffn_w_in + (size_t)layer * 1024 * 2 * FFH, 1024, 2 * FFH, (bf16_t*)(wt + WT_FFNIN), 1, tile);
    convert_wt(p.ffn_w_out + (size_t)layer * FFH * 1024, FFH, 1024, (bf16_t*)(wt + WT_FFNOUT), 0, tile);
    if ((layer & 1) == 0) {
        convert_wt(p.mix_w_in + (size_t)j2 * 1024 * MIXIN, 1024, MIXIN, (bf16_t*)(wt + WT_MIXIN), 0, tile);
        convert_wt(p.mix_w_out + (size_t)j2 * 1024 * 1024, 1024, 1024, (bf16_t*)(wt + WT_MIXOUT), 0, tile);
    } else {
        convert_wt(p.ssm_w_in + (size_t)j2 * 1024 * SSMIN, 1024, SSMIN, (bf16_t*)(wt + WT_MIXIN), 0, tile);
        convert_wt(p.ssm_w_out + (size_t)j2 * SSI * 1024, SSI, 1024, (bf16_t*)(wt + WT_MIXOUT), 0, tile);
        bf16_t* padp = (bf16_t*)(wt + WT_MIXIN) + (size_t)SSMIN * 1024;
        for (int i = blockIdx.x * 256 + tid_(); i < (SSMIN_PAD - SSMIN) * 1024; i += gridDim.x * 256) padp[i] = 0;
    }
}

__device__ __forceinline__ void prologue(CParams& p, float* smf) {
    const int tid = tid_();
    const size_t gtid = (size_t)blockIdx.x * 256 + tid, gsz = (size_t)gridDim.x * 256;
    {
        const f32x4* s = (const f32x4*)p.x; f32x4* d = (f32x4*)p.out;
        for (size_t i = gtid; i < (size_t)ML * D / 4; i += gsz) d[i] = s[i];
        const f32x4* s2 = (const f32x4*)p.ctx; f32x4* d2 = (f32x4*)(p.ws + WS_XCTX);
        for (size_t i = gtid; i < (size_t)MC * D / 4; i += gsz) d2[i] = s2[i];
    }
    {
        float* part = (float*)(p.ws + WS_PART);
        const int lane = tid & 63, wv = tid >> 6;
        for (int row = blockIdx.x * 4 + wv; row < MT; row += gridDim.x * 4) {
            const float* xr = row < ML ? p.x + (size_t)row * D : p.ctx + (size_t)(row - ML) * D;
            float ss = 0.f;
#pragma unroll
            for (int i = 0; i < 4; ++i) { const f32x4 v = *(const f32x4*)(xr + i * 256 + lane * 4); ss += v[0] * v[0] + v[1] * v[1] + v[2] * v[2] + v[3] * v[3]; }
#pragma unroll
            for (int o = 1; o < 64; o <<= 1) ss += __shfl_xor(ss, o);
            if (lane < 8) part[(size_t)row * 8 + lane] = lane == 0 ? ss : 0.f;
        }
    }
    {
        float* cosT = (float*)(p.ws + WS_ROPE); float* sinT = cosT + 8192 * 32;
        for (size_t i = gtid; i < (size_t)8192 * 32; i += gsz) {
            const int s = (int)(i >> 5), j = (int)(i & 31), f = j & 15;
            const float inv = powf(10000.f, -(float)f / 16.f);
            const float pos = (float)(j < 16 ? (s >> 6) : (s & 63));
            const float ang = pos * inv;
            cosT[i] = cosf(ang); sinT[i] = sinf(ang);
        }
    }
    {
        bf16_t* sgw = (bf16_t*)(p.ws + WS_SGW);
        for (size_t i = gtid; i < (size_t)2 * 4 * 128 * 128; i += gsz) sgw[i] = f2bf(p.sgu_w[i]);
    }
    {
        float* sc = smf;
        float* red = smf + 3 * 1024;
        lds_sync();
        for (int i = tid; i < 3 * 1024; i += 256) {
            const int sgi = i >> 10, k = i & 1023;
            const float v = sgi < 2 ? p.c[sgi * 1024 + k] : p.c_ctx[k];
            sc[i] = siluf(v);
        }
        lds_sync();
        float* mod = (float*)(p.ws + WS_MOD);
        const int cl = tid & 63, kg = tid >> 6;
        for (int wi = blockIdx.x; wi < 4 * 96; wi += gridDim.x) {
            const int layer = wi / 96, cb = wi - layer * 96;
            const float* w = p.ada_w + (size_t)layer * 1024 * 6144 + cb * 64 + cl;
            float s0 = 0.f, s1 = 0.f, s2 = 0.f;
            for (int k = kg * 256; k < kg * 256 + 256; ++k) {
                const float wv = w[(size_t)k * 6144];
                s0 += sc[k] * wv; s1 += sc[1024 + k] * wv; s2 += sc[2048 + k] * wv;
            }
            lds_sync();
            red[(kg * 3 + 0) * 64 + cl] = s0; red[(kg * 3 + 1) * 64 + cl] = s1; red[(kg * 3 + 2) * 64 + cl] = s2;
            lds_sync();
            if (tid < 192) {
                const int sgi = tid >> 6;
                const float v = red[(0 * 3 + sgi) * 64 + cl] + red[(1 * 3 + sgi) * 64 + cl] + red[(2 * 3 + sgi) * 64 + cl] + red[(3 * 3 + sgi) * 64 + cl];
                const int n = cb * 64 + cl;
                mod[((size_t)layer * 3 + sgi) * 6144 + n] = v + p.ada_b[layer * 6144 + n];
            }
        }
        lds_sync();
    }
    convert_layer_weights(p, 0, smf);
}

__device__ __forceinline__ void attn_item(CParams& p, int j2, int b, int h, int q0row, int nkeys, bf16_t* smem) {
    const int tid = tid_(), lane = tid & 63, wave = tid >> 6, l16 = lane & 15, quad = lane >> 4;
    const int kh = h >> 2;
    const bf16_t* Q = (const bf16_t*)(p.ws + WS_Q);
    const bf16_t* Kb = (const bf16_t*)(p.ws + WS_K) + (size_t)b * TALL * 128 + kh * 64;
    const bf16_t* Vb = (const bf16_t*)(p.ws + WS_VT) + (size_t)(b * 2 + kh) * 64 * TALL;
    bf16_t* sK = smem; bf16_t* sV = smem + 64 * GST;
    constexpr float LOG2E = 1.4426950408889634f;
    float mb;
    {
        float gq = fabsf(p.q_norm_g[j2 * 64 + lane]), gk = fabsf(p.k_norm_g[j2 * 64 + lane]);
#pragma unroll
        for (int o = 1; o < 64; o <<= 1) { gq = fmaxf(gq, __shfl_xor(gq, o)); gk = fmaxf(gk, __shfl_xor(gk, o)); }
        mb = 8.f * 1.02f * gq * gk * LOG2E;
    }
    bf16x8 qf[4][2];
#pragma unroll
    for (int i = 0; i < 4; ++i)
#pragma unroll
        for (int ks = 0; ks < 2; ++ks)
            qf[i][ks] = *(const bf16x8*)(Q + (size_t)(q0row + wave * 64 + i * 16 + l16) * 512 + h * 64 + ks * 32 + quad * 8);
    f32x4 o[5][4];
#pragma unroll
    for (int d = 0; d < 5; ++d)
#pragma unroll
        for (int i = 0; i < 4; ++i) o[d][i] = (f32x4){0.f, 0.f, 0.f, 0.f};
    lds_sync();
    {
        const int r = 64 + (tid >> 4);
        u32x2 one; one.x = r == 64 ? 0x3F803F80u : 0u; one.y = one.x;
        *(u32x2*)(sV + r * GST + (tid & 15) * 4) = one;
    }
    const int srow = tid >> 3, skc = (tid & 7) * 8;
    u32x4 rk[2], rv[2];
#pragma unroll
    for (int i = 0; i < 2; ++i) {
        rk[i] = *(const u32x4*)(Kb + (size_t)(srow + i * 32) * 128 + skc);
        rv[i] = *(const u32x4*)(Vb + (size_t)(srow + i * 32) * TALL + skc);
    }
    const int nt = nkeys >> 6;
#pragma unroll 1
    for (int kt = 0; kt < nt; ++kt) {
        lds_sync();
#pragma unroll
        for (int i = 0; i < 2; ++i) {
            *(u32x4*)(sK + (srow + i * 32) * GST + skc) = rk[i];
            *(u32x4*)(sV + (srow + i * 32) * GST + skc) = rv[i];
        }
        lds_sync();
        {
            const int t0 = (kt + 1 < nt ? kt + 1 : kt) << 6;
#pragma unroll
            for (int i = 0; i < 2; ++i) {
                rk[i] = *(const u32x4*)(Kb + (size_t)(t0 + srow + i * 32) * 128 + skc);
                rv[i] = *(const u32x4*)(Vb + (size_t)(srow + i * 32) * TALL + t0 + skc);
            }
        }
        bf16x8 pf[2][4];
#pragma unroll
        for (int ih = 0; ih < 2; ++ih) {
            f32x4 s[4][2];
#pragma unroll
            for (int tt = 0; tt < 4; ++tt)
#pragma unroll
                for (int i = 0; i < 2; ++i) s[tt][i] = (f32x4){-mb, -mb, -mb, -mb};
#pragma unroll
            for (int ks = 0; ks < 2; ++ks)
#pragma unroll
                for (int tt = 0; tt < 4; ++tt) {
                    const bf16x8 kf = lds16(sK + (tt * 16 + l16) * GST + ks * 32 + quad * 8);
#pragma unroll
                    for (int i = 0; i < 2; ++i) s[tt][i] = mfma16(kf, qf[ih * 2 + i][ks], s[tt][i]);
                }
#pragma unroll
            for (int i = 0; i < 2; ++i) {
#pragma unroll
                for (int tt = 0; tt < 4; ++tt) {
#pragma unroll
                    for (int r = 0; r < 4; ++r) s[tt][i][r] = __builtin_amdgcn_exp2f(s[tt][i][r]);
                }
#pragma unroll
                for (int ksp = 0; ksp < 2; ++ksp) pf[ksp][ih * 2 + i] = pack8(s[2 * ksp][i], s[2 * ksp + 1][i]);
            }
        }
#pragma unroll
        for (int ksp = 0; ksp < 2; ++ksp)
#pragma unroll
            for (int d = 0; d < 5; ++d) {
                const bf16_t* vp = sV + (d * 16 + l16) * GST + ksp * 32 + quad * 4;
                const bf16x8 vf = lds8x2(vp, vp + 16);
#pragma unroll
                for (int i = 0; i < 4; ++i) o[d][i] = mfma16(vf, pf[ksp][i], o[d][i]);
            }
    }
    bf16_t* as = (bf16_t*)(p.ws + WS_AS);
#pragma unroll
    for (int i = 0; i < 4; ++i) {
        const float l = __shfl(o[4][i][0], l16);
        const float inv = 1.f / l;
        const int row = q0row + wave * 64 + i * 16 + l16;
#pragma unroll
        for (int d = 0; d < 4; ++d)
            st4bf(as + frag_off(row, h * 64 + d * 16 + quad * 4, 1024), o[d][i][0] * inv, o[d][i][1] * inv, o[d][i][2] * inv, o[d][i][3] * inv);
    }
}

__device__ __forceinline__ void sg_item(CParams& p, int j2, int chunk, int g, bf16_t* smem) {
    const int lane = tid_() & 63, wave = tid_() >> 6, l16 = lane & 15, quad = lane >> 4;
    const bf16_t* A = (const bf16_t*)(p.ws + WS_SGW) + (size_t)(j2 * 4 + g) * 128 * 128;
    const bf16_t* W = (const bf16_t*)(p.ws + WS_GVT) + ((size_t)chunk * 512 + g * 128) * 128;
    f32x4 acc[2][8];
    gemm_tile<2, 128, 128, 128>(A, W, acc, smem);
    const bf16_t* u = (const bf16_t*)(p.ws + WS_U);
    bf16_t* as = (bf16_t*)(p.ws + WS_AS);
    const float* bs = p.sgu_b + (size_t)(j2 * 4 + g) * 128;
#pragma unroll
    for (int i = 0; i < 2; ++i) {
        const int pt = wave * 32 + i * 16 + l16;
        const int row = chunk * 128 + pt;
        const float bias = bs[pt];
#pragma unroll
        for (int j = 0; j < 8; ++j) {
            const int c = g * 128 + j * 16 + quad * 4;
            const u32x2 uw = *(const u32x2*)(u + (size_t)row * 512 + c);
            const float u0 = __uint_as_float(uw.x << 16), u1 = __uint_as_float(uw.x & 0xffff0000u);
            const float u2 = __uint_as_float(uw.y << 16), u3 = __uint_as_float(uw.y & 0xffff0000u);
            const f32x4 v = acc[i][j];
            st4bf(as + frag_off(row, 512 + c, 1024), u0 * (v[0] + bias), u1 * (v[1] + bias), u2 * (v[2] + bias), u3 * (v[3] + bias));
        }
    }
}

__device__ __forceinline__ void attn_sg_phase(CParams& p, int layer, bf16_t* smem) {
    const int j2 = layer >> 1;
    const int nA = NB * 8 * 32, nS = (MT / 128) * 4, nC = NB * 8;
    for (int t = blockIdx.x; t < nA + nS + nC; t += gridDim.x) {
        if (t < nA) {
            const int xcd = t & 7, li = t >> 3;
            const int bh = xcd * 2 + (li >> 5), qb = li & 31;
            attn_item(p, j2, bh >> 3, bh & 7, (bh >> 3) * SEQ + qb * 256, TALL, smem);
        } else if (t < nA + nS) {
            const int u = t - nA;
            sg_item(p, j2, u >> 2, u & 3, smem);
        } else {
            const int u = t - nA - nS;
            const int h = u & 7, b = u >> 3;
            attn_item(p, j2, b, h, ML + b * CTX, CTX, smem);
        }
    }
}

__device__ __forceinline__ void conv_phase(CParams& p, int layer, float* smf) {
    const int j2 = layer >> 1, tid = tid_();
    const bf16_t* xbc = (const bf16_t*)(p.ws + WS_XBC);
    bf16_t* XT = (bf16_t*)(p.ws + WS_XT); bf16_t* Bn = (bf16_t*)(p.ws + WS_BN); bf16_t* Cn = (bf16_t*)(p.ws + WS_CN); bf16_t* BT = (bf16_t*)(p.ws + WS_BT);
    const float* cw = p.ssm_conv_w + (size_t)j2 * 3 * 3072;
    const float* cb = p.ssm_conv_b + (size_t)j2 * 3072;
    float* sin_ = smf;
    float* sout = smf + 66 * 65;
    const int nCt = 3072 / 64, nRt = MT / 64;
    for (int t = blockIdx.x; t < nCt * nRt; t += gridDim.x) {
        const int rt = t / nCt, ct = t - rt * nCt;
        const int r0 = rt * 64, c0 = ct * 64;
        const bool first = r0 < ML ? ((r0 & (SEQ - 1)) == 0) : (((r0 - ML) & (CTX - 1)) == 0);
        const bool last = r0 < ML ? (((r0 + 64) & (SEQ - 1)) == 0) : ((((r0 + 64) - ML) & (CTX - 1)) == 0);
        lds_sync();
        for (int e = tid; e < 66 * 8; e += 256) {
            const int rr = e >> 3, c8 = (e & 7) * 8;
            const int row = r0 - 1 + rr;
            u32x4 v = (u32x4){0u, 0u, 0u, 0u};
            if (!((rr == 0 && first) || (rr == 65 && last))) v = *(const u32x4*)(xbc + (size_t)row * 3072 + c0 + c8);
            float* d = sin_ + rr * 65 + c8;
            d[0] = __uint_as_float(v.x << 16); d[1] = __uint_as_float(v.x & 0xffff0000u);
            d[2] = __uint_as_float(v.y << 16); d[3] = __uint_as_float(v.y & 0xffff0000u);
            d[4] = __uint_as_float(v.z << 16); d[5] = __uint_as_float(v.z & 0xffff0000u);
            d[6] = __uint_as_float(v.w << 16); d[7] = __uint_as_float(v.w & 0xffff0000u);
        }
        lds_sync();
        {
            const int c = tid & 63;
            const float w0 = cw[c0 + c], w1 = cw[3072 + c0 + c], w2 = cw[2 * 3072 + c0 + c], bb = cb[c0 + c];
#pragma unroll
            for (int k = 0; k < 16; ++k) {
                const int tt = (tid >> 6) + k * 4;
                const float v = w0 * sin_[tt * 65 + c] + w1 * sin_[(tt + 1) * 65 + c] + w2 * sin_[(tt + 2) * 65 + c] + bb;
                sout[c * 65 + tt] = siluf(v);
            }
        }
        lds_sync();
        const int q = tid >> 2, e16 = (tid & 3) * 16;
        if (c0 >= 2048) {
            u32x4 o0, o1;
            o0.x = pack2(sout[(e16 + 0) * 65 + q], sout[(e16 + 1) * 65 + q]); o0.y = pack2(sout[(e16 + 2) * 65 + q], sout[(e16 + 3) * 65 + q]);
            o0.z = pack2(sout[(e16 + 4) * 65 + q], sout[(e16 + 5) * 65 + q]); o0.w = pack2(sout[(e16 + 6) * 65 + q], sout[(e16 + 7) * 65 + q]);
            o1.x = pack2(sout[(e16 + 8) * 65 + q], sout[(e16 + 9) * 65 + q]); o1.y = pack2(sout[(e16 + 10) * 65 + q], sout[(e16 + 11) * 65 + q]);
            o1.z = pack2(sout[(e16 + 12) * 65 + q], sout[(e16 + 13) * 65 + q]); o1.w = pack2(sout[(e16 + 14) * 65 + q], sout[(e16 + 15) * 65 + q]);
            if (c0 < 2560) {
                bf16_t* dst = Bn + (c0 - 2048) + (size_t)(r0 + q) * 512 + e16;
                *(u32x4*)dst = o0; *(u32x4*)(dst + 8) = o1;
            } else {
                *(u32x4*)(Cn + frag_off(r0 + q, c0 - 2560 + e16, 512)) = o0;
                *(u32x4*)(Cn + frag_off(r0 + q, c0 - 2560 + e16 + 8, 512)) = o1;
            }
        }
        if (c0 < 2560) {
            const float* sp = sout + q * 65 + e16;
            u32x4 o0, o1;
            o0.x = pack2(sp[0], sp[1]); o0.y = pack2(sp[2], sp[3]); o0.z = pack2(sp[4], sp[5]); o0.w = pack2(sp[6], sp[7]);
            o1.x = pack2(sp[8], sp[9]); o1.y = pack2(sp[10], sp[11]); o1.z = pack2(sp[12], sp[13]); o1.w = pack2(sp[14], sp[15]);
            if (c0 < 2048) {
                bf16_t* dst = XT + (size_t)(c0 + q) * MT + r0 + e16;
                *(u32x4*)dst = o0; *(u32x4*)(dst + 8) = o1;
            } else {
                *(u32x4*)(BT + frag_off(c0 - 2048 + q, r0 + e16, MT)) = o0;
                *(u32x4*)(BT + frag_off(c0 - 2048 + q, r0 + e16 + 8, MT)) = o1;
            }
        }
    }
}

__device__ __forceinline__ void ssd_diag_item(CParams& p, int j2, int row0, int h, bf16_t* smem) {
    const int tid = tid_(), lane = tid & 63, wave = tid >> 6, l16 = lane & 15, quad = lane >> 4;
    const int g = h >> 3;
    bf16_t* sB = smem;
    bf16_t* sX = sB + 128 * SST;
    float* sda = (float*)(sX + 64 * SST);
    float* sPf = sda + 256;
    float* sRb = sPf + 128;
    float* sdtf = sRb + 128;
    float* sdtb = sdtf + 128;
    float* scolF = sdtb + 128;
    float* scolB = scolF + 128;
    const bf16_t* XT = (const bf16_t*)(p.ws + WS_XT) + (size_t)(h * 64) * MT;
    const bf16_t* Bn = (const bf16_t*)(p.ws + WS_BN) + g * 128;
    const bf16_t* Cn = (const bf16_t*)(p.ws + WS_CN) + (size_t)(g * 4) * 512;
    const float* DT = (const float*)(p.ws + WS_DT);
    bf16_t* Y = (bf16_t*)(p.ws + WS_YF);
    const float af = -expf(p.ssm_a_log[(j2 * 2 + 0) * 32 + h]);
    const float ab = -expf(p.ssm_a_log[(j2 * 2 + 1) * 32 + h]);
    const float dsk = p.ssm_d[j2 * 32 + h];
    lds_sync();
#pragma unroll
    for (int i = 0; i < 8; ++i) {
        const int c = tid + i * 256, r = c >> 4, kc = (c & 15) * 8;
        *(u32x4*)(sB + r * SST + kc) = *(const u32x4*)(Bn + (size_t)(row0 + r) * 512 + kc);
    }
#pragma unroll
    for (int i = 0; i < 4; ++i) {
        const int c = tid + i * 256, r = c >> 4, kc = (c & 15) * 8;
        *(u32x4*)(sX + r * SST + kc) = *(const u32x4*)(XT + (size_t)r * MT + row0 + kc);
    }
    {
        const int d = wave >> 1;
        const float d0 = DT[(size_t)(row0 + lane) * 64 + d * 32 + h], d1 = DT[(size_t)(row0 + 64 + lane) * 64 + d * 32 + h];
        const float aa = d ? ab : af;
        const f32x2 sc2 = scan128(d0 * aa, d1 * aa, lane, d);
        float* sc = d ? sRb : sPf; float* sd = d ? sdtb : sdtf;
        if ((wave & 1) == 0) { sc[lane] = sc2.x; sd[lane] = d0; } else { sc[64 + lane] = sc2.y; sd[64 + lane] = d1; }
        const float own = (wave & 1) == 0 ? sc2.x : sc2.y;
        const float ref = __shfl(own, d == 0 ? (lane | 7) : (lane & ~7));
        float* scol = d ? scolB : scolF;
        scol[(wave & 1) * 64 + lane] = ((wave & 1) == 0 ? d0 : d1) * __expf(ref - own);
    }
    bf16x8 cf[2][4];
#pragma unroll
    for (int i = 0; i < 2; ++i)
#pragma unroll
        for (int ks = 0; ks < 4; ++ks)
            cf[i][ks] = *(const bf16x8*)(Cn + ((size_t)((row0 >> 4) + wave * 2 + i) * 16 + ks) * 512 + lane * 8);
    lds_sync();
    float pfl[2], rbl[2];
#pragma unroll
    for (int i = 0; i < 2; ++i) { pfl[i] = sPf[wave * 32 + i * 16 + l16]; rbl[i] = sRb[wave * 32 + i * 16 + l16]; }
    f32x4 y[4][2];
#pragma unroll
    for (int pt = 0; pt < 4; ++pt)
#pragma unroll
        for (int i = 0; i < 2; ++i) y[pt][i] = (f32x4){0.f, 0.f, 0.f, 0.f};
#pragma unroll 1
    for (int sp = 0; sp < 4; ++sp) {
        f32x4 gt[2][2];
#pragma unroll
        for (int s2 = 0; s2 < 2; ++s2)
#pragma unroll
            for (int i = 0; i < 2; ++i) gt[s2][i] = (f32x4){0.f, 0.f, 0.f, 0.f};
#pragma unroll
        for (int ks = 0; ks < 4; ++ks)
#pragma unroll
            for (int s2 = 0; s2 < 2; ++s2) {
                const bf16x8 bfr = lds16(sB + (sp * 32 + s2 * 16 + l16) * SST + ks * 32 + quad * 8);
#pragma unroll
                for (int i = 0; i < 2; ++i) gt[s2][i] = mfma16(bfr, cf[i][ks], gt[s2][i]);
            }
        bf16x8 mf[2];
#pragma unroll
        for (int i = 0; i < 2; ++i) {
            const int l = wave * 32 + i * 16 + l16;
#pragma unroll
            for (int s2 = 0; s2 < 2; ++s2) {
                const int s0 = sp * 32 + s2 * 16 + quad * 4;
                const float rowF = __expf(fminf(pfl[i] - sPf[s0 | 7], 80.f)), rowB = __expf(fminf(rbl[i] - sRb[s0 & ~7], 80.f));
                const f32x4 cf4 = *(const f32x4*)(scolF + s0), cb4 = *(const f32x4*)(scolB + s0);
#pragma unroll
                for (int r = 0; r < 4; ++r) {
                    const int s = s0 + r;
                    float coef = s < l ? rowF * cf4[r] : rowB * cb4[r];
                    if (s == l) coef = sdtf[s] + sdtb[s];
                    gt[s2][i][r] *= coef;
                }
            }
            mf[i] = pack8(gt[0][i], gt[1][i]);
        }
#pragma unroll
        for (int pt = 0; pt < 4; ++pt) {
            const bf16_t* xp = sX + (pt * 16 + l16) * SST + sp * 32 + quad * 4;
            const bf16x8 xf = lds8x2(xp, xp + 16);
#pragma unroll
            for (int i = 0; i < 2; ++i) y[pt][i] = mfma16(xf, mf[i], y[pt][i]);
        }
    }
#pragma unroll
    for (int i = 0; i < 2; ++i) {
        const int l = wave * 32 + i * 16 + l16;
#pragma unroll
        for (int pt = 0; pt < 4; ++pt) {
            f32x4 v = y[pt][i];
#pragma unroll
            for (int r = 0; r < 4; ++r) v[r] += dsk * bf2f(sX[(pt * 16 + quad * 4 + r) * SST + l]);
            st4bf(Y + frag_off(row0 + l, h * 64 + pt * 16 + quad * 4, 2048), v[0], v[1], v[2], v[3]);
        }
    }
}

__device__ __forceinline__ void ssd_diag_phase(CParams& p, int layer, bf16_t* smem) {
    const int j2 = layer >> 1;
    for (int t = blockIdx.x; t < (MT / 128) * 32; t += gridDim.x) {
        const int h = t & 31, chunk = t >> 5;
        ssd_diag_item(p, j2, chunk * 128, h, smem);
    }
}

struct SsdPre { u32x4 xq; u32x4 bt[2][4]; u32x4 cf[2][4]; u32x2 yold[2]; float dt0, dt1; };

__device__ __forceinline__ int ssd_row0(int b, int dir, int cc) {
    if (cc < 2) { const int ci = dir ? 1 - cc : cc; return ML + b * CTX + ci * 128; }
    const int k = cc - 2; const int ci = dir ? 63 - k : k; return b * SEQ + ci * 128;
}

__device__ __forceinline__ void ssd_scan_item(CParams& p, int j2, int b, int dir, int h, int pq, bf16_t* smem) {
    const int tid = tid_(), lane = tid & 63, wave = tid >> 6, l16 = lane & 15, quad = lane >> 4;
    const int g = h >> 3;
    bf16_t* sX = smem;
    bf16_t* sH = sX + 16 * SST;
    float* seacs = (float*)(sH + 16 * SST);
    float* sw = seacs + 128;
    float* sdec = sw + 128;
    const bf16_t* XT = (const bf16_t*)(p.ws + WS_XT) + (size_t)(h * 64 + pq * 16 + (tid >> 4)) * MT + (tid & 15) * 8;
    const bf16_t* Cn = (const bf16_t*)(p.ws + WS_CN) + ((size_t)(wave * 2) * 16 + g * 4) * 512 + lane * 8;
    const bf16_t* BT = (const bf16_t*)(p.ws + WS_BT) + (size_t)(g * 8 + wave * 2) * (MT / 32) * 512 + lane * 8;
    const float* DT = (const float*)(p.ws + WS_DT) + dir * 32 + h;
    bf16_t* Y = (bf16_t*)(p.ws + (dir ? WS_YB : WS_YF)) + frag_off(wave * 32 + l16, h * 64 + pq * 16 + quad * 4, 2048);
    const float a = -expf(p.ssm_a_log[(j2 * 2 + dir) * 32 + h]);
    f32x4 st[2];
    st[0] = (f32x4){0.f, 0.f, 0.f, 0.f}; st[1] = (f32x4){0.f, 0.f, 0.f, 0.f};
    SsdPre S0, S1;
    auto load_small = [&](SsdPre& S, int r) __attribute__((always_inline)) {
        S.xq = *(const u32x4*)(XT + r);
        S.dt0 = DT[(size_t)(r + lane) * 64]; S.dt1 = DT[(size_t)(r + 64 + lane) * 64];
    };
    auto load_cf = [&](SsdPre& S, int r) __attribute__((always_inline)) {
#pragma unroll
        for (int i = 0; i < 2; ++i)
#pragma unroll
            for (int ks = 0; ks < 4; ++ks) S.cf[i][ks] = *(const u32x4*)(Cn + ((size_t)((r >> 4) + i) * 16 + ks) * 512);
    };
    auto load_yold = [&](SsdPre& S, int r) __attribute__((always_inline)) {
#pragma unroll
        for (int i = 0; i < 2; ++i) S.yold[i] = dir == 0 ? *(const u32x2*)(Y + (size_t)((r >> 4) + i) * (64 * 512)) : (u32x2){0u, 0u};
    };
    auto load_bt = [&](SsdPre& S, int r) __attribute__((always_inline)) {
#pragma unroll
        for (int nt = 0; nt < 2; ++nt)
#pragma unroll
            for (int ks = 0; ks < 4; ++ks) S.bt[nt][ks] = *(const u32x4*)(BT + ((size_t)nt * (MT / 32) + (r >> 5) + ks) * 512);
    };
    {
        const int r0 = ssd_row0(b, dir, 0), r1 = ssd_row0(b, dir, 1);
        load_small(S0, r0); load_cf(S0, r0); load_yold(S0, r0); load_bt(S0, r0);
        load_small(S1, r1); load_cf(S1, r1); load_yold(S1, r1); load_bt(S1, r1);
    }
    auto body = [&](SsdPre& S, int cc) __attribute__((always_inline)) {
        const int row0 = ssd_row0(b, dir, cc);
        const int row2 = ssd_row0(b, dir, cc + 2 < 66 ? cc + 2 : 65);
        lds_sync();
        *(u32x4*)(sX + (tid >> 4) * SST + (tid & 15) * 8) = S.xq;
#pragma unroll
        for (int nt = 0; nt < 2; ++nt) st4bf(sH + l16 * SST + wave * 32 + nt * 16 + quad * 4, st[nt][0], st[nt][1], st[nt][2], st[nt][3]);
        if (wave < 2) {
            const f32x2 sc2 = scan128(S.dt0 * a, S.dt1 * a, lane, dir);
            const float total = dir == 0 ? __shfl(sc2.y, 63) : __shfl(sc2.x, 0);
            if (wave == 0) { seacs[lane] = __expf(sc2.x); sw[lane] = S.dt0 * __expf(total - sc2.x); if (lane == 0) sdec[0] = __expf(total); }
            else { seacs[64 + lane] = __expf(sc2.y); sw[64 + lane] = S.dt1 * __expf(total - sc2.y); }
        }
        lds_sync();
        load_small(S, row2);
        f32x4 yo[2];
        yo[0] = (f32x4){0.f, 0.f, 0.f, 0.f}; yo[1] = (f32x4){0.f, 0.f, 0.f, 0.f};
#pragma unroll
        for (int ks = 0; ks < 4; ++ks) {
            const bf16x8 hf = lds16(sH + l16 * SST + ks * 32 + quad * 8);
#pragma unroll
            for (int i = 0; i < 2; ++i) yo[i] = mfma16(hf, __builtin_bit_cast(bf16x8, S.cf[i][ks]), yo[i]);
        }
        __builtin_amdgcn_sched_barrier(0);
        load_cf(S, row2);
#pragma unroll
        for (int i = 0; i < 2; ++i) {
            const float e = seacs[wave * 32 + i * 16 + l16];
            const float o0 = __uint_as_float(S.yold[i].x << 16), o1 = __uint_as_float(S.yold[i].x & 0xffff0000u);
            const float o2 = __uint_as_float(S.yold[i].y << 16), o3 = __uint_as_float(S.yold[i].y & 0xffff0000u);
            st4bf(Y + (size_t)((row0 >> 4) + i) * (64 * 512), yo[i][0] * e + o0, yo[i][1] * e + o1, yo[i][2] * e + o2, yo[i][3] * e + o3);
        }
        __builtin_amdgcn_sched_barrier(0);
        load_yold(S, row2);
        {
            const float dec = sdec[0];
            st[0] *= dec; st[1] *= dec;
#pragma unroll
            for (int ks = 0; ks < 4; ++ks) {
                const f32x4 w0 = *(const f32x4*)(sw + ks * 32 + quad * 8), w1 = *(const f32x4*)(sw + ks * 32 + quad * 8 + 4);
                const u32x4 raw = *(const u32x4*)(sX + l16 * SST + ks * 32 + quad * 8);
                u32x4 xs;
                xs.x = pack2(__uint_as_float(raw.x << 16) * w0[0], __uint_as_float(raw.x & 0xffff0000u) * w0[1]);
                xs.y = pack2(__uint_as_float(raw.y << 16) * w0[2], __uint_as_float(raw.y & 0xffff0000u) * w0[3]);
                xs.z = pack2(__uint_as_float(raw.z << 16) * w1[0], __uint_as_float(raw.z & 0xffff0000u) * w1[1]);
                xs.w = pack2(__uint_as_float(raw.w << 16) * w1[2], __uint_as_float(raw.w & 0xffff0000u) * w1[3]);
                const bf16x8 xbf = __builtin_bit_cast(bf16x8, xs);
#pragma unroll
                for (int nt = 0; nt < 2; ++nt) st[nt] = mfma16(__builtin_bit_cast(bf16x8, S.bt[nt][ks]), xbf, st[nt]);
            }
        }
        __builtin_amdgcn_sched_barrier(0);
        load_bt(S, row2);
    };
#pragma unroll 1
    for (int cc = 0; cc < 66; cc += 2) {
        body(S0, cc);
        body(S1, cc + 1);
    }
}

__device__ __forceinline__ void ssd_scan_phase(CParams& p, int layer, bf16_t* smem) {
    const int j2 = layer >> 1;
    for (int t = blockIdx.x; t < NB * 2 * 32 * 4; t += gridDim.x) {
        const int xcd = t & 7, li = t >> 3, gi = xcd * 2 + (li >> 5);
        const int pq = li & 3, h = (gi & 3) * 8 + ((li & 31) >> 2), dir = (gi >> 2) & 1, b = gi >> 3;
        ssd_scan_item(p, j2, b, dir, h, pq, smem);
    }
}

__device__ __forceinline__ void finish_phase(CParams& p, int layer) {
    const int j2 = layer >> 1, lane = tid_() & 63, wave = tid_() >> 6, quad = lane >> 4;
    bf16_t* yf = (bf16_t*)(p.ws + WS_YF); const bf16_t* yb = (const bf16_t*)(p.ws + WS_YB); const bf16_t* z = (const bf16_t*)(p.ws + WS_Z);
    const float* gn = p.ssm_norm_g + (size_t)j2 * 2048;
    for (int tr = blockIdx.x * 4 + wave; tr < MT / 16; tr += gridDim.x * 4) {
        const size_t base = (size_t)tr * 64 * 512 + lane * 8;
#pragma unroll 1
        for (int g = 0; g < 4; ++g) {
            float ss = 0.f;
#pragma unroll 4
            for (int kk = 0; kk < 16; ++kk) {
                const size_t off = base + (size_t)(g * 16 + kk) * 512;
                const u32x4 a = *(const u32x4*)(yf + off), bq = *(const u32x4*)(yb + off), zq = *(const u32x4*)(z + off);
                const unsigned aw[4] = {a.x, a.y, a.z, a.w}, bw[4] = {bq.x, bq.y, bq.z, bq.w}, zw[4] = {zq.x, zq.y, zq.z, zq.w};
#pragma unroll
                for (int k = 0; k < 4; ++k) {
                    const float v0 = (__uint_as_float(aw[k] << 16) + __uint_as_float(bw[k] << 16)) * __uint_as_float(zw[k] << 16);
                    const float v1 = (__uint_as_float(aw[k] & 0xffff0000u) + __uint_as_float(bw[k] & 0xffff0000u)) * __uint_as_float(zw[k] & 0xffff0000u);
                    ss += v0 * v0 + v1 * v1;
                }
            }
            ss += __shfl_xor(ss, 16); ss += __shfl_xor(ss, 32);
            const float rstd = rsqrtf(ss * (1.f / 512.f) + EPS);
#pragma unroll 4
            for (int kk = 0; kk < 16; ++kk) {
                const size_t off = base + (size_t)(g * 16 + kk) * 512;
                const u32x4 a = *(const u32x4*)(yf + off), bq = *(const u32x4*)(yb + off), zq = *(const u32x4*)(z + off);
                const unsigned aw[4] = {a.x, a.y, a.z, a.w}, bw[4] = {bq.x, bq.y, bq.z, bq.w}, zw[4] = {zq.x, zq.y, zq.z, zq.w};
                const int col = (g * 16 + kk) * 32 + quad * 8;
                const f32x4 g0 = *(const f32x4*)(gn + col), g1 = *(const f32x4*)(gn + col + 4);
                const float gg[8] = {g0[0], g0[1], g0[2], g0[3], g1[0], g1[1], g1[2], g1[3]};
                unsigned ow[4];
#pragma unroll
                for (int k = 0; k < 4; ++k) {
                    const float v0 = (__uint_as_float(aw[k] << 16) + __uint_as_float(bw[k] << 16)) * __uint_as_float(zw[k] << 16);
                    const float v1 = (__uint_as_float(aw[k] & 0xffff0000u) + __uint_as_float(bw[k] & 0xffff0000u)) * __uint_as_float(zw[k] & 0xffff0000u);
                    ow[k] = pack2(v0 * rstd * gg[2 * k], v1 * rstd * gg[2 * k + 1]);
                }
                u32x4 o4; o4.x = ow[0]; o4.y = ow[1]; o4.z = ow[2]; o4.w = ow[3];
                *(u32x4*)(yf + off) = o4;
            }
        }
    }
}

__global__ void __launch_bounds__(256, 2) hybrid_fwd(Params p) {
    extern __shared__ __attribute__((aligned(16))) unsigned char lds[];
    cg::grid_group grid = cg::this_grid();
    bf16_t* smem = (bf16_t*)lds; float* smf = (float*)lds;
    volatile LAS unsigned* bst = (volatile LAS unsigned*)(lds + LDS_BYTES - 16);
    if (threadIdx.x == 0) { bst[0] = 0u; bst[1] = 0u; }
    __syncthreads();
    const XcdBarrier xb = xcd_barrier_post((unsigned*)(p.ws + WS_BAR), bst);
    enum { C_NORM1 = 0, C_MIXIN, C_ATTN, C_MIXOUT, C_NORM2, C_FFNIN, C_FFNOUT, C_SSMIN, C_CONV, C_SSD, C_FINISH, C_SSMOUT, C_PRO, C_SSDB };
    const unsigned long long evc = 0x6543210ull;
    const unsigned long long odc = 0x654BAD9870ull;
    for (int ph = 0; ph < 35; ++ph) {
        int code, layer;
        if (ph == 0) { code = C_PRO; layer = 0; }
        else {
            const int q = ph - 1, pair = q / 17, r = q - pair * 17;
            if (r < 7) { layer = 2 * pair; code = (int)((evc >> (4 * r)) & 15); }
            else { layer = 2 * pair + 1; code = (int)((odc >> (4 * (r - 7))) & 15); }
        }
        CParams* kp = (CParams*)__builtin_amdgcn_kernarg_segment_ptr();
        asm volatile("" : "+s"(kp));
        CParams& q = *kp;
#define PHASE(c) asm volatile("" : "+s"(code)); if (code == (c))
        PHASE(C_PRO) prologue(q, smf);
        PHASE(C_NORM1) { if (layer > 0) convert_layer_weights(q, layer, smf); norm_phase(q, layer, 0); }
        PHASE(C_NORM2) norm_phase(q, layer, 1);
        PHASE(C_MIXIN) gemm_phase<G_MIXIN>(q, layer, smem);
        PHASE(C_ATTN) attn_sg_phase(q, layer, smem);
        PHASE(C_MIXOUT) gemm_phase<G_MIXOUT>(q, layer, smem);
        PHASE(C_FFNIN) gemm_phase<G_FFNIN>(q, layer, smem);
        PHASE(C_FFNOUT) gemm_phase<G_FFNOUT>(q, layer, smem);
        PHASE(C_SSMIN) gemm_phase<G_SSMIN>(q, layer, smem);
        PHASE(C_CONV) conv_phase(q, layer, smf);
        PHASE(C_SSD) ssd_diag_phase(q, layer, smem);
        PHASE(C_SSDB) ssd_scan_phase(q, layer, smem);
        PHASE(C_FINISH) finish_phase(q, layer);
        PHASE(C_SSMOUT) gemm_phase<G_SSMOUT>(q, layer, smem);
#undef PHASE
        if (q.out == nullptr) grid.sync();
        xcd_barrier(xb);
    }
}

extern "C" void kernel_launch(void* const* d_in, const int* in_sizes, int n_in, void* d_out, int out_size, void* d_ws, size_t ws_size, hipStream_t stream) {
    static int grid_blocks = 0;
    if (grid_blocks == 0) {
        if (ws_size < WS_TOTAL) { fprintf(stderr, "kernel_launch: workspace too small: %zu < %zu\n", ws_size, (size_t)WS_TOTAL); grid_blocks = -1; return; }
        int dev = 0, cus = 0, per_cu = 0;
        hipGetDevice(&dev);
        hipDeviceGetAttribute(&cus, hipDeviceAttributeMultiprocessorCount, dev);
        if (hipFuncSetAttribute((const void*)hybrid_fwd, hipFuncAttributeMaxDynamicSharedMemorySize, LDS_BYTES) != hipSuccess) { fprintf(stderr, "kernel_launch: hipFuncSetAttribute failed\n"); }
        if (hipOccupancyMaxActiveBlocksPerMultiprocessor(&per_cu, (const void*)hybrid_fwd, 256, LDS_BYTES) != hipSuccess || per_cu < 1) { fprintf(stderr, "kernel_launch: occupancy query failed (%d)\n", per_cu); per_cu = 1; }
        if (per_cu > 2) per_cu = 2;
        (void)hipGetLastError();
        grid_blocks = cus * per_cu;
    }
    if (grid_blocks < 0) return;
    if (hipMemsetAsync((char*)d_ws + WS_BAR, 0, XCD_BAR_WORDS * sizeof(unsigned), stream) != hipSuccess) { fprintf(stderr, "kernel_launch: hipMemsetAsync failed\n"); return; }
    Params p{};
    const float** f = (const float**)&p;
    for (int i = 0; i < 25; ++i) f[i] = (const float*)d_in[i];
    p.out = (float*)d_out; p.ws = (unsigned char*)d_ws;
    void* args[] = {&p};
    hipError_t e = hipLaunchCooperativeKernel((const void*)hybrid_fwd, dim3(grid_blocks), dim3(256), args, LDS_BYTES, stream);
    if (e != hipSuccess) fprintf(stderr, "cooperative launch failed: %s (grid %d)\n", hipGetErrorString(e), grid_blocks);
}
```
